# Optimizing an MI355X kernel written in HIP

```python
import math
import jax
import jax.numpy as jnp
from jax import lax
import numpy as np

D_MODEL = 1024
BATCH = 4
SEQ = 8192
DEPTH = 1

GLA_HEADS = 4
GLA_DK = 128
GLA_DV = 256
GLA_GATE_RANK = 16
GLA_GATE_NORMALIZER = 16.0
GLA_CHUNK = 64

SWA_Q_HEADS = 16
SWA_KV_HEADS = 4
SWA_HEAD_DIM = 64
SWA_WINDOW = 128

REL_BUCKETS = 32
REL_MAX_DISTANCE = 128

PEER_HEADS = 8
PEER_N_KEYS = 128
PEER_N_EXPERTS = PEER_N_KEYS * PEER_N_KEYS
PEER_QUERY_DIM = 256
PEER_TOPK = 16
PEER_TOKEN_BLOCK = 128

EPS = 1e-6

IN_SPLITS = (
    GLA_HEADS * GLA_DK,
    GLA_HEADS * GLA_DK,
    GLA_HEADS * GLA_DV,
    GLA_HEADS * GLA_DV,
    GLA_GATE_RANK,
    SWA_Q_HEADS * SWA_HEAD_DIM,
    SWA_KV_HEADS * SWA_HEAD_DIM,
    SWA_KV_HEADS * SWA_HEAD_DIM,
    D_MODEL,
    D_MODEL,
)
IN_WIDTH = sum(IN_SPLITS)

kernel_name = 'hybrid_gla_swa_peer_block'


def rms_norm(x, gain):
    xf = x.astype(jnp.float32)
    y = xf * lax.rsqrt(jnp.mean(xf * xf, axis=-1, keepdims=True) + EPS)
    return (y * gain.astype(jnp.float32)).astype(x.dtype)


def split_columns(proj):
    parts, start = [], 0
    for width in IN_SPLITS:
        parts.append(proj[..., start:start + width])
        start += width
    return parts


def gla_branch(q, k, v, r, a_low, w_gate_up, b_gate_up, out_gain):
    B, S, _ = q.shape
    H, dk, dv, C = GLA_HEADS, GLA_DK, GLA_DV, GLA_CHUNK
    n = S // C
    f32 = jnp.float32
    log_alpha = jax.nn.log_sigmoid((a_low @ w_gate_up + b_gate_up).astype(f32)) / GLA_GATE_NORMALIZER

    def to_chunks(t, d):
        return t.astype(f32).reshape(B, n, C, H, d).transpose(1, 0, 3, 2, 4)

    qc = to_chunks(q, dk) * (dk ** -0.5)
    kc = to_chunks(k, dk)
    vc = to_chunks(v, dv)
    gc = to_chunks(log_alpha, dk)
    causal = jnp.tril(jnp.ones((C, C), dtype=bool))[:, :, None]

    def chunk_step(state, inp):
        qb, kb, vb, gb = inp
        b = jnp.cumsum(gb, axis=-2)
        diff = b[..., :, None, :] - b[..., None, :, :]
        decay = jnp.exp(jnp.where(causal, diff, -jnp.inf))
        scores = jnp.einsum('bhid,bhjd,bhijd->bhij', qb, kb, decay)
        out = (jnp.einsum('bhij,bhjv->bhiv', scores, vb)
               + jnp.einsum('bhid,bhdv->bhiv', qb * jnp.exp(b), state))
        b_last = b[..., -1:, :]
        new_state = (state * jnp.swapaxes(jnp.exp(b_last), -1, -2)
                     + jnp.einsum('bhjd,bhjv->bhdv', kb * jnp.exp(b_last - b), vb))
        return new_state, out

    state0 = jnp.zeros((B, H, dk, dv), f32)
    _, outs = lax.scan(chunk_step, state0, (qc, kc, vc, gc))
    o = outs.transpose(1, 0, 3, 2, 4).reshape(B, S, H, dv)
    o = rms_norm(o, out_gain)
    o = o * jax.nn.silu(r.astype(f32).reshape(B, S, H, dv))
    return o.reshape(B, S, H * dv).astype(q.dtype)


def t5_bucket(rel):
    max_exact = REL_BUCKETS // 2
    rel_f = jnp.maximum(rel, 1).astype(jnp.float32)
    large = max_exact + (jnp.log(rel_f / max_exact)
                         / math.log(REL_MAX_DISTANCE / max_exact)
                         * (REL_BUCKETS - max_exact)).astype(jnp.int32)
    large = jnp.minimum(large, REL_BUCKETS - 1)
    return jnp.where(rel < max_exact, rel, large)


def swa_branch(q, k, v, q_gain, k_gain, sinks, rel_bias):
    B, S, _ = q.shape
    Hq, Hkv, hd, W = SWA_Q_HEADS, SWA_KV_HEADS, SWA_HEAD_DIM, SWA_WINDOW
    G = Hq // Hkv
    nb = S // W
    f32 = jnp.float32
    qn = rms_norm(q.astype(f32).reshape(B, S, Hq, hd), q_gain) * (hd ** -0.5)
    kn = rms_norm(k.astype(f32).reshape(B, S, Hkv, hd), k_gain)
    vf = v.astype(f32).reshape(B, S, Hkv, hd)
    qb = qn.reshape(B, nb, W, Hkv, G, hd)

    def band(t):
        tb = t.reshape(B, nb, W, Hkv, hd)
        prev = jnp.pad(tb, ((0, 0), (1, 0), (0, 0), (0, 0), (0, 0)))[:, :-1]
        return jnp.concatenate([prev, tb], axis=2)

    kb, vb = band(kn), band(vf)
    qi = jnp.arange(W)[:, None]
    kj = jnp.arange(2 * W)[None, :]
    rel = qi + W - kj
    in_window = (rel >= 0) & (rel < W)
    blk = jnp.arange(nb)[:, None, None]
    valid = in_window[None] & ((blk > 0) | (kj[None] >= W))
    bias = rel_bias[t5_bucket(jnp.clip(rel, 0, None))]
    bias = bias.astype(f32).transpose(2, 0, 1).reshape(Hkv, G, W, 2 * W)

    logits = jnp.einsum('bnqhgd,bnkhd->bnhgqk', qb, kb) + bias
    logits = jnp.where(valid[None, :, None, None], logits, -jnp.inf)
    sink = sinks.astype(f32).reshape(Hkv, G, 1, 1)
    m = jnp.maximum(jnp.max(logits, axis=-1, keepdims=True), sink)
    e = jnp.exp(logits - m)
    probs = e / (jnp.sum(e, axis=-1, keepdims=True) + jnp.exp(sink - m))
    o = jnp.einsum('bnhgqk,bnkhd->bnqhgd', probs, vb)
    return o.reshape(B, S, Hq * hd).astype(q.dtype)


def peer_ffn(x, w_query, sub_keys, expert_down, expert_up):
    B, S, D = x.shape
    T = B * S
    H, K, nk = PEER_HEADS, PEER_TOPK, PEER_N_KEYS
    f32 = jnp.float32
    xt = x.reshape(T, D)
    q = (xt @ w_query).astype(f32).reshape(T, H, 2, PEER_QUERY_DIM // 2)
    scores = jnp.einsum('thpd,hpkd->thpk', q, sub_keys.astype(f32))
    top_s, top_i = lax.top_k(scores, K)
    cand_s = (top_s[:, :, 0, :, None] + top_s[:, :, 1, None, :]).reshape(T, H, K * K)
    cand_i = (top_i[:, :, 0, :, None] * nk + top_i[:, :, 1, None, :]).reshape(T, H, K * K)
    best_s, best_pos = lax.top_k(cand_s, K)
    expert_idx = jnp.take_along_axis(cand_i, best_pos, axis=-1)
    gate = jax.nn.softmax(best_s, axis=-1)

    n_blk = T // PEER_TOKEN_BLOCK

    def expert_block(args):
        xb, idx, g = args
        u = expert_down[idx]
        act = jax.nn.gelu(jnp.einsum('td,ted->te', xb, u).astype(f32), approximate=False)
        w = (g * act).astype(x.dtype)
        return jnp.einsum('te,ted->td', w, expert_up[idx])

    out = lax.map(expert_block, (xt.reshape(n_blk, PEER_TOKEN_BLOCK, D),
                                 expert_idx.reshape(n_blk, PEER_TOKEN_BLOCK, H * K),
                                 gate.reshape(n_blk, PEER_TOKEN_BLOCK, H * K)))
    return out.reshape(B, S, D)


def setup_inputs(seed: int = 0) -> dict:
    key = jax.random.key(seed)
    ks = jax.random.split(key, 20)
    L, D = DEPTH, D_MODEL
    f32 = jnp.float32

    def normal(k, shape, scale):
        return jax.random.normal(k, shape, f32) * scale

    def gain(k, shape):
        return 1.0 + 0.01 * jax.random.normal(k, shape, f32)

    return {
        'x': normal(ks[0], (BATCH, SEQ, D), 1.0),
        'norm_mix_gain': gain(ks[1], (L, D)),
        'w_in': normal(ks[2], (L, D, IN_WIDTH), D ** -0.5),
        'w_gate_up': normal(ks[3], (L, GLA_GATE_RANK, GLA_HEADS * GLA_DK), GLA_GATE_RANK ** -0.5),
        'b_gate_up': normal(ks[4], (L, GLA_HEADS * GLA_DK), 0.1),
        'gla_out_gain': gain(ks[5], (L, GLA_DV)),
        'swa_q_gain': gain(ks[6], (L, SWA_HEAD_DIM)),
        'swa_k_gain': gain(ks[7], (L, SWA_HEAD_DIM)),
        'swa_sinks': normal(ks[8], (L, SWA_Q_HEADS), 0.5),
        'rel_bias': normal(ks[9], (REL_BUCKETS, SWA_Q_HEADS), 0.5),
        'w_branch_gla': normal(ks[10], (L, GLA_HEADS * GLA_DV, D), (GLA_HEADS * GLA_DV) ** -0.5),
        'w_branch_swa': normal(ks[11], (L, SWA_Q_HEADS * SWA_HEAD_DIM, D), (SWA_Q_HEADS * SWA_HEAD_DIM) ** -0.5),
        'w_out': normal(ks[12], (L, D, D), D ** -0.5),
        'norm_ffn_gain': gain(ks[13], (L, D)),
        'peer_w_query': normal(ks[14], (L, D, PEER_HEADS * PEER_QUERY_DIM), D ** -0.5),
        'peer_sub_keys': normal(ks[15], (L, PEER_HEADS, 2, PEER_N_KEYS, PEER_QUERY_DIM // 2), (PEER_QUERY_DIM // 2) ** -0.5),
        'peer_expert_down': normal(ks[16], (L, PEER_N_EXPERTS, D), D ** -0.5),
        'peer_expert_up': normal(ks[17], (L, PEER_N_EXPERTS, D), (PEER_HEADS * PEER_TOPK) ** -0.5),
    }


def reference(x, norm_mix_gain, w_in, w_gate_up, b_gate_up, gla_out_gain,
              swa_q_gain, swa_k_gain, swa_sinks, rel_bias, w_branch_gla,
              w_branch_swa, w_out, norm_ffn_gain, peer_w_query, peer_sub_keys,
              peer_expert_down, peer_expert_up):
    h = x
    for layer in range(DEPTH):
        xn = rms_norm(h, norm_mix_gain[layer])
        proj = xn @ w_in[layer]
        gq, gk, gv, gr, ga, sq, sk, sv, gate_a, gate_b = split_columns(proj)
        y_gla = gla_branch(gq, gk, gv, gr, ga, w_gate_up[layer], b_gate_up[layer],
                           gla_out_gain[layer])
        y_swa = swa_branch(sq, sk, sv, swa_q_gain[layer], swa_k_gain[layer],
                           swa_sinks[layer], rel_bias)
        merged = (jax.nn.sigmoid(gate_a) * (y_gla @ w_branch_gla[layer])
                  + jax.nn.sigmoid(gate_b) * (y_swa @ w_branch_swa[layer]))
        h = h + merged @ w_out[layer]
        hn = rms_norm(h, norm_ffn_gain[layer])
        h = h + peer_ffn(hn, peer_w_query[layer], peer_sub_keys[layer],
                         peer_expert_down[layer], peer_expert_up[layer])
    return h
```

```cpp
#include <hip/hip_runtime.h>
#include <hip/hip_cooperative_groups.h>
#include <cstdio>
#include <cstdint>
#include <math.h>
namespace cg = cooperative_groups;
#ifndef WT_AUX
#define WT_AUX 0
#endif
typedef unsigned wt_u32x4 __attribute__((ext_vector_type(4)));
__device__ __forceinline__ __amdgpu_buffer_rsrc_t wt_rsrc(const void* base) { return __builtin_amdgcn_make_buffer_rsrc((void*)base, 0, 0x7FFFFFF0, 0x00020000); }
__device__ __forceinline__ void wt_st16(__amdgpu_buffer_rsrc_t r, unsigned byte_off, wt_u32x4 v) { __builtin_amdgcn_raw_buffer_store_b128(v, r, byte_off, 0, WT_AUX); }
typedef unsigned wt_u32x2 __attribute__((ext_vector_type(2)));
__device__ __forceinline__ void wt_st8(void* p, unsigned lo, unsigned hi) { if (WT_AUX) __hip_atomic_store((unsigned long long*)p, ((unsigned long long)hi << 32) | lo, __ATOMIC_RELAXED, __HIP_MEMORY_SCOPE_AGENT); else *(wt_u32x2*)p = (wt_u32x2){lo, hi}; }
__device__ __forceinline__ void wt_st4(float* p, float v) { if (WT_AUX) __hip_atomic_store(p, v, __ATOMIC_RELAXED, __HIP_MEMORY_SCOPE_AGENT); else *p = v; }
__device__ __forceinline__ void wtx_st16(__amdgpu_buffer_rsrc_t r, unsigned byte_off, wt_u32x4 v) { __builtin_amdgcn_raw_buffer_store_b128(v, r, byte_off, 0, 16); }
__device__ __forceinline__ void wtx_st8(void* p, unsigned lo, unsigned hi) { __hip_atomic_store((unsigned long long*)p, ((unsigned long long)hi << 32) | lo, __ATOMIC_RELAXED, __HIP_MEMORY_SCOPE_AGENT); }
__device__ __forceinline__ void wtx_st4(float* p, float v) { __hip_atomic_store(p, v, __ATOMIC_RELAXED, __HIP_MEMORY_SCOPE_AGENT); }
namespace pg8 {
#define PG8_LAS __attribute__((address_space(3)))
typedef unsigned short bf16_t;
typedef short bf16x8 __attribute__((ext_vector_type(8)));
typedef float f32x4 __attribute__((ext_vector_type(4)));
typedef unsigned u32x4 __attribute__((ext_vector_type(4)));
constexpr int BM = 256, BK = 64, HALF = 128, HTB = HALF * BK * 2  , STAGE_BYTES = 8 * HTB, NXCD = 8, WGM = 8;

__host__ __device__ __forceinline__ int lds_byte(int r, int c) { const int st = (r >> 4) * 2 + (c >> 5), rr = r & 15, cc = c & 31, ob = rr * 64 + cc * 2; return st * 1024 + (ob ^ (((ob >> 9) & 1) << 5)); }
__host__ __device__ __forceinline__ void stage_rc(int b, int& R, int& C) { const int st = b / 1024, sb = b % 1024, swz = sb ^ (((sb >> 9) & 1) << 5); R = (st >> 1) * 16 + swz / 64; C = (st & 1) * 32 + (swz % 64) / 2; }
__host__ __device__ __forceinline__ int perm32(int rho) { const int n = rho >> 4, i = rho & 15; return 8 * (i >> 2) + 4 * n + (i & 3); }

struct Unit { int pm, pn, sel; };
struct Gemm { const bf16_t* A; const bf16_t* Bt; int M, N, K; const bf16_t* A2; const bf16_t* Bt2; };

struct StaticOrder {
    int nM, nN, nwg, G, c;
    __host__ __device__ void init(int M, int N, int G_, int c_) { nM = M / BM; nN = N / BM; nwg = nM * nN; G = G_; c = c_; }
    __host__ __device__ bool next(int i, Unit& u) const {
        const long L = (long)i * G + c; if (L >= nwg) return false;
        int wgid = (int)L; { const int q = nwg / NXCD, r = nwg % NXCD, xcd = wgid % NXCD, off = wgid / NXCD; wgid = (xcd < r ? xcd * (q + 1) : r * (q + 1) + (xcd - r) * q) + off; }
        const int nig = WGM * nN, gid = wgid / nig, fm = gid * WGM, gsz = (nM - fm) < WGM ? (nM - fm) : WGM;
        u.pm = fm + ((wgid % nig) % gsz); u.pn = (wgid % nig) / gsz; u.sel = 0; return true;
    }
    __device__ __forceinline__ void a_ready(const Unit&) const {}
    __device__ __forceinline__ void done(const Unit&) const {}
    __device__ __forceinline__ bool keep(const Unit&) const { return false; }
};

__device__ __forceinline__ unsigned cvt_pk_bf16(float lo, float hi) { unsigned r; asm volatile("v_cvt_pk_bf16_f32 %0, %1, %2" : "=v"(r) : "v"(lo), "v"(hi)); return r; }
typedef float f32x2 __attribute__((ext_vector_type(2)));
__device__ __forceinline__ f32x2 gelu_pk(f32x2 v) {
    const f32x2 av = __builtin_elementwise_abs(v), d = av * 0.2316418882f + 1.0f;
    f32x2 t; t.x = __builtin_amdgcn_rcpf(d.x); t.y = __builtin_amdgcn_rcpf(d.y);
    f32x2 q = t * 0.5307027145f + (-0.7265760135f); q = q * t + 0.7107068705f; q = q * t + (-0.142248368f); q = q * t + 0.127414796f; q = q * t;
    const f32x2 s = (v * v) * (-0.72134752044f);
    f32x2 e; e.x = __builtin_amdgcn_exp2f(s.x); e.y = __builtin_amdgcn_exp2f(s.y);
    const f32x2 m = v * (q * e), r = v - m;
    f32x2 o; o.x = v.x < 0.f ? m.x : r.x; o.y = v.y < 0.f ? m.y : r.y; return o;
}

template <int ACT  > struct EpiBf16 {
    static constexpr bool PERM = true, AFTER_DRAIN = false; static_assert(ACT == 0 || ACT == 1, "EpiBf16: ACT is 0 (none) or 1 (gelu_pk)");
    bf16_t* O; int ldc; const float* bias; int split_cols; size_t split_stride; float scale0;
    __device__ __forceinline__ void operator()(const f32x4 (&acc)[2][2][4][2], const Unit& u, int wr, int wc, int fr, int fq) const {
        const int row0 = u.pm * BM + wr * 64 + fr; int colt = u.pn * BM; bf16_t* base = O;
        float sc = 1.f; if (split_cols) { const int t = colt / split_cols; base += (size_t)t * split_stride; colt -= t * split_cols; if (t == 0) sc = scale0; }
        const int col0 = colt + wc * 32 + 8 * fq, bcol0 = u.pn * BM + wc * 32 + 8 * fq;
        f32x4 bv[2][2];
#pragma unroll
        for (int bj = 0; bj < 2; ++bj)
#pragma unroll
            for (int n = 0; n < 2; ++n) bv[bj][n] = bias ? *(const f32x4*)(bias + bcol0 + bj * HALF + 4 * n) : (f32x4){0.f, 0.f, 0.f, 0.f};
#pragma unroll
        for (int ai = 0; ai < 2; ++ai)
#pragma unroll
            for (int m = 0; m < 4; ++m) { bf16_t* rowp = base + (size_t)(row0 + ai * HALF + m * 16) * ldc + col0;
#pragma unroll
                for (int bj = 0; bj < 2; ++bj) { f32x4 v0 = acc[ai][bj][m][0] + bv[bj][0], v1 = acc[ai][bj][m][1] + bv[bj][1];
                    if (ACT == 1) { f32x2 a = gelu_pk((f32x2){v0[0], v0[1]}), b = gelu_pk((f32x2){v0[2], v0[3]}), c = gelu_pk((f32x2){v1[0], v1[1]}), d = gelu_pk((f32x2){v1[2], v1[3]});
                        v0 = (f32x4){a.x, a.y, b.x, b.y}; v1 = (f32x4){c.x, c.y, d.x, d.y}; }
                    v0 = v0 * sc; v1 = v1 * sc; u32x4 w; w.x = cvt_pk_bf16(v0[0], v0[1]); w.y = cvt_pk_bf16(v0[2], v0[3]); w.z = cvt_pk_bf16(v1[0], v1[1]); w.w = cvt_pk_bf16(v1[2], v1[3]);
                    *(u32x4*)(rowp + bj * HALF) = w; } }
    }
};
__device__ __forceinline__ float sigm_fast(float v) { return __builtin_amdgcn_rcpf(1.0f + __builtin_amdgcn_exp2f(v * -1.4426950408889634f)); }
struct EpiProj {
    static constexpr bool PERM = true, AFTER_DRAIN = false;
    bf16_t *GQ, *GK, *GV, *GR, *SQ, *SK, *SV, *GA, *GB; const float* rstd;
    __device__ __forceinline__ void operator()(const f32x4 (&acc)[2][2][4][2], const Unit& u, int wr, int wc, int fr, int fq) const {
        const int pn = u.pn; bf16_t* base; int ldc, act = 0;
        if (pn < 2) { base = GQ + pn * 256; ldc = 512; }
        else if (pn < 4) { base = GK + (pn - 2) * 256; ldc = 512; }
        else if (pn < 8) { base = GV + (pn - 4) * 256; ldc = 1024; }
        else if (pn < 12) { base = GR + (pn - 8) * 256; ldc = 1024; act = 1; }
        else if (pn < 16) { base = SQ + (pn - 12) * 256; ldc = 1024; }
        else if (pn == 16) { base = SK; ldc = 256; }
        else if (pn == 17) { base = SV; ldc = 256; }
        else if (pn < 22) { base = GA + (pn - 18) * 256; ldc = 1024; act = 2; }
        else { base = GB + (pn - 22) * 256; ldc = 1024; act = 2; }
        const int row0 = u.pm * BM + wr * 64 + fr, col0 = wc * 32 + 8 * fq;
        const __amdgpu_buffer_rsrc_t rs_ = wt_rsrc(base);
#pragma unroll
        for (int ai = 0; ai < 2; ++ai)
#pragma unroll
            for (int m = 0; m < 4; ++m) { const int row = row0 + ai * HALF + m * 16; const float rs = rstd[row]; const unsigned rowoff = (unsigned)(((size_t)row * ldc + col0) * 2);
#pragma unroll
                for (int bj = 0; bj < 2; ++bj) { f32x4 v0 = acc[ai][bj][m][0] * rs, v1 = acc[ai][bj][m][1] * rs;
                    if (act) {
#pragma unroll
                        for (int e = 0; e < 4; ++e) { const float s0 = sigm_fast(v0[e]), s1 = sigm_fast(v1[e]); v0[e] = (act == 1) ? v0[e] * s0 : s0; v1[e] = (act == 1) ? v1[e] * s1 : s1; } }
                    u32x4 w; w.x = cvt_pk_bf16(v0[0], v0[1]); w.y = cvt_pk_bf16(v0[2], v0[3]); w.z = cvt_pk_bf16(v1[0], v1[1]); w.w = cvt_pk_bf16(v1[2], v1[3]);
                    wt_st16(rs_, rowoff + bj * HALF * 2, w); } }
    }
};

__device__ __forceinline__ void bf8_to_f32(const u32x4 raw, float (&f)[8]) {
#pragma unroll
    for (int j = 0; j < 4; ++j) { f[2 * j] = __builtin_bit_cast(float, raw[j] << 16); f[2 * j + 1] = __builtin_bit_cast(float, raw[j] & 0xffff0000u); }
}
template <int STEP> struct EpiMerge {
    static constexpr bool PERM = true, AFTER_DRAIN = false;
    const bf16_t* ga; const bf16_t* gb; bf16_t* outp;
    __device__ __forceinline__ void operator()(f32x4 (&acc)[2][2][4][2], const Unit& u, int wr, int wc, int fr, int fq) const {
        const int row0 = u.pm * BM + wr * 64 + fr, col0 = u.pn * BM + wc * 32 + 8 * fq;
        const __amdgpu_buffer_rsrc_t dst_r = wt_rsrc(outp);
#pragma unroll
        for (int ai = 0; ai < 2; ++ai)
#pragma unroll
            for (int m = 0; m < 4; ++m) { const size_t rb = (size_t)(row0 + ai * HALF + m * 16) * 1024 + col0;
#pragma unroll
                for (int bj = 0; bj < 2; ++bj) { const size_t off = rb + bj * HALF;
                    float b[8]; bf8_to_f32(*(const u32x4*)(gb + off), b);
                    if (STEP == 0) { float a[8]; bf8_to_f32(*(const u32x4*)(ga + off), a);
#pragma unroll
                        for (int e = 0; e < 4; ++e) { acc[ai][bj][m][0][e] *= a[e] * __builtin_amdgcn_rcpf(fmaxf(b[e], 1e-30f)); acc[ai][bj][m][1][e] *= a[4 + e] * __builtin_amdgcn_rcpf(fmaxf(b[4 + e], 1e-30f)); }
                    } else {
                        float v[8];
#pragma unroll
                        for (int e = 0; e < 4; ++e) { v[e] = acc[ai][bj][m][0][e] * fmaxf(b[e], 1e-30f); v[4 + e] = acc[ai][bj][m][1][e] * fmaxf(b[4 + e], 1e-30f); }
                        u32x4 w; w.x = cvt_pk_bf16(v[0], v[1]); w.y = cvt_pk_bf16(v[2], v[3]); w.z = cvt_pk_bf16(v[4], v[5]); w.w = cvt_pk_bf16(v[6], v[7]);
                        wt_st16(dst_r, (unsigned)(off * 2), w); } } }
    }
};
struct EpiOut {
    static constexpr bool PERM = true, AFTER_DRAIN = false;
    const bf16_t* x; float* h1; bf16_t* hb; float* rowss; int M;
    __device__ __forceinline__ void operator()(const f32x4 (&acc)[2][2][4][2], const Unit& u, int wr, int wc, int fr, int fq) const {
        const int row0 = u.pm * BM + wr * 64 + fr, col0 = u.pn * BM + wc * 32 + 8 * fq;
        const __amdgpu_buffer_rsrc_t hb_r = wt_rsrc(hb);
#pragma unroll
        for (int ai = 0; ai < 2; ++ai)
#pragma unroll
            for (int m = 0; m < 4; ++m) { const int row = row0 + ai * HALF + m * 16; const size_t rb = (size_t)row * 1024 + col0; float ss = 0.f;
#pragma unroll
                for (int bj = 0; bj < 2; ++bj) { const size_t off = rb + bj * HALF;
                    const u32x4 xw = *(const u32x4*)(x + off);
                    f32x4 x0, x1; x0[0] = __uint_as_float(xw.x << 16); x0[1] = __uint_as_float(xw.x & 0xffff0000u); x0[2] = __uint_as_float(xw.y << 16); x0[3] = __uint_as_float(xw.y & 0xffff0000u);
                    x1[0] = __uint_as_float(xw.z << 16); x1[1] = __uint_as_float(xw.z & 0xffff0000u); x1[2] = __uint_as_float(xw.w << 16); x1[3] = __uint_as_float(xw.w & 0xffff0000u);
                    const f32x4 v0 = acc[ai][bj][m][0] + x0, v1 = acc[ai][bj][m][1] + x1;
                    u32x4 w; w.x = cvt_pk_bf16(v0[0], v0[1]); w.y = cvt_pk_bf16(v0[2], v0[3]); w.z = cvt_pk_bf16(v1[0], v1[1]); w.w = cvt_pk_bf16(v1[2], v1[3]);
                    wt_st16(hb_r, (unsigned)(off * 2), w);
                    ss += (v0[0] * v0[0] + v0[1] * v0[1]) + (v0[2] * v0[2] + v0[3] * v0[3]) + (v1[0] * v1[0] + v1[1] * v1[1]) + (v1[2] * v1[2] + v1[3] * v1[3]); }
                ss += __shfl_xor(ss, 16); ss += __shfl_xor(ss, 32);
                if (fq == 0) wt_st4(rowss + (size_t)row * 16 + u.pn * 4 + wc, ss); }
    }
};
struct EpiQ {
    static constexpr bool PERM = true, AFTER_DRAIN = false;
    const float* rowss; bf16_t* qp; int M;
    __device__ __forceinline__ void operator()(const f32x4 (&acc)[2][2][4][2], const Unit& u, int wr, int wc, int fr, int fq) const {
        const int row0 = u.pm * BM + wr * 64 + fr, col0 = u.pn * BM + wc * 32 + 8 * fq;
        const __amdgpu_buffer_rsrc_t qp_r = wt_rsrc(qp);
#pragma unroll
        for (int ai = 0; ai < 2; ++ai)
#pragma unroll
            for (int m = 0; m < 4; ++m) { const int row = row0 + ai * HALF + m * 16; float s = 0.f;
#pragma unroll
                for (int k = 0; k < 4; ++k) { const f32x4 p4 = *(const f32x4*)(rowss + (size_t)row * 16 + 4 * k); s += (p4[0] + p4[1]) + (p4[2] + p4[3]); }
                const float rs = rsqrtf(s * (1.f / 1024.f) + 1e-6f);
#pragma unroll
                for (int bj = 0; bj < 2; ++bj) { const f32x4 v0 = acc[ai][bj][m][0] * rs, v1 = acc[ai][bj][m][1] * rs;
                    u32x4 w; w.x = cvt_pk_bf16(v0[0], v0[1]); w.y = cvt_pk_bf16(v0[2], v0[3]); w.z = cvt_pk_bf16(v1[0], v1[1]); w.w = cvt_pk_bf16(v1[2], v1[3]);
                    wt_st16(qp_r, (unsigned)(((size_t)row * 2048 + col0 + bj * HALF) * 2), w); } }
    }
};

struct PairOrder {
    StaticOrder base;
    __device__ bool next(int i, Unit& u) const { const bool ok = base.next(i >> 1, u); u.sel = i & 1; return ok; }
    __device__ __forceinline__ void a_ready(const Unit&) const {}
    __device__ __forceinline__ void done(const Unit&) const {}
    __device__ __forceinline__ bool keep(const Unit& u) const { return u.sel == 0; }
};
struct EpiMergeBoth {
    static constexpr bool PERM = true, AFTER_DRAIN = false;
    EpiMerge<0> e0; EpiMerge<1> e1;
    __device__ __forceinline__ void operator()(f32x4 (&acc)[2][2][4][2], const Unit& u, int wr, int wc, int fr, int fq) const { if (u.sel == 0) e0(acc, u, wr, wc, fr, fq); else e1(acc, u, wr, wc, fr, fq); }
};
template <class Epi, class Sched, bool ALIGN_EPI = false, bool SP2 = false>
__device__ __forceinline__ void gemm_phase(PG8_LAS unsigned char* lds, const Gemm g, const Sched& S, const Epi& E) {
    const int tid = threadIdx.x, wid = __builtin_amdgcn_readfirstlane(tid >> 6), lane = tid & 63, wr = wid >> 2, wc = wid & 3, fr = lane & 15, fq = lane >> 4;
    const int K = g.K, nt = K / BK;
    unsigned voffA[2], voffB[2];
#pragma unroll
    for (int i = 0; i < 2; ++i) { int R, C; stage_rc(tid * 16 + i * 8192, R, C); const int Rb = Epi::PERM ? ((R & ~31) + perm32(R & 31)) : R;
        voffA[i] = (unsigned)(R * K + C) * 2u; voffB[i] = (unsigned)(Rb * K + C) * 2u; }
    const size_t kstep = (size_t)(BK * 2);
    const size_t hstep = (size_t)HALF * K * 2;
    const size_t tstep = 2 * hstep;
    const unsigned ldsw = (unsigned)wid * 1024u;
    const int aoff = lds_byte(wr * 64 + fr, fq * 8), boff = lds_byte(wc * 32 + fr, fq * 8);
#define PG8_SA(b, h) (((b) * 2 + (h)) * HTB)
#define PG8_SB(b, h) ((4 + (b) * 2 + (h)) * HTB)
#define PG8_STAGE(bufoff, gbase, voff) do { _Pragma("unroll") for (int _i = 0; _i < 2; ++_i) \
        __builtin_amdgcn_global_load_lds((const unsigned*)((const char*)(gbase) + (voff)[_i]), (PG8_LAS unsigned*)(lds + (bufoff) + ldsw + _i * 8192), 16, 0, 0); } while (0)
#define PG8_LDA(dst, b, h) do { _Pragma("unroll") for (int m = 0; m < 4; ++m) _Pragma("unroll") for (int k = 0; k < 2; ++k) dst[m][k] = *(const PG8_LAS bf16x8*)(lds + PG8_SA(b, h) + aoff + m * 2048 + k * 1024); } while (0)
#define PG8_LDB(dst, b, h) do { _Pragma("unroll") for (int n = 0; n < 2; ++n) _Pragma("unroll") for (int k = 0; k < 2; ++k) dst[n][k] = *(const PG8_LAS bf16x8*)(lds + PG8_SB(b, h) + boff + n * 2048 + k * 1024); } while (0)
#define PG8_MMA(ai, bj, At, Bt) do { __builtin_amdgcn_s_setprio(1); _Pragma("unroll") for (int m = 0; m < 4; ++m) _Pragma("unroll") for (int n = 0; n < 2; ++n) _Pragma("unroll") for (int k = 0; k < 2; ++k) \
        acc[ai][bj][m][n] = __builtin_amdgcn_mfma_f32_16x16x32_bf16(Bt[n][k], At[m][k], acc[ai][bj][m][n], 0, 0, 0); __builtin_amdgcn_s_setprio(0); } while (0)
#define PG8_WAIT_V(n) asm volatile("s_waitcnt vmcnt(" #n ")" ::: "memory")
#define PG8_WAIT_L(n) asm volatile("s_waitcnt lgkmcnt(" #n ")" ::: "memory")
#define PG8_BAR __builtin_amdgcn_s_barrier()
#define PG8_SCHED __builtin_amdgcn_sched_barrier(0)
    Unit cur, nxt; int ui = 0;
    if (!S.next(0, cur)) return;
    f32x4 acc[2][2][4][2];
#pragma unroll
    for (int a = 0; a < 2; ++a)
#pragma unroll
        for (int b = 0; b < 2; ++b)
#pragma unroll
            for (int m = 0; m < 4; ++m)
#pragma unroll
                for (int n = 0; n < 2; ++n) acc[a][b][m][n] = (f32x4){0.f, 0.f, 0.f, 0.f};
    bf16x8 At[4][2], B0[2][2], B1[2][2];
    const char* cA = (const char*)(cur.sel ? g.A2 : g.A) + (size_t)cur.pm * tstep; const char* cB = (const char*)(cur.sel ? g.Bt2 : g.Bt) + (size_t)cur.pn * tstep;
    S.a_ready(cur);
    if constexpr (SP2) {
        PG8_STAGE(PG8_SB(0, 0), cB, voffB); PG8_STAGE(PG8_SB(0, 1), cB + hstep, voffB); PG8_STAGE(PG8_SA(0, 0), cA, voffA); PG8_STAGE(PG8_SA(0, 1), cA + hstep, voffA);
        if (wr == 1) PG8_BAR;
        PG8_WAIT_V(2); PG8_BAR;
        PG8_STAGE(PG8_SB(1, 0), cB + kstep, voffB); PG8_STAGE(PG8_SA(1, 0), cA + kstep, voffA); PG8_STAGE(PG8_SB(1, 1), cB + hstep + kstep, voffB);
        PG8_WAIT_V(6); PG8_BAR;
    } else {
        PG8_STAGE(PG8_SB(0, 0), cB, voffB); PG8_STAGE(PG8_SA(0, 0), cA, voffA); PG8_STAGE(PG8_SB(0, 1), cB + hstep, voffB); PG8_STAGE(PG8_SA(0, 1), cA + hstep, voffA);
        if (wr == 1) PG8_BAR;
        PG8_WAIT_V(4); PG8_BAR;
        PG8_STAGE(PG8_SB(1, 0), cB + kstep, voffB); PG8_STAGE(PG8_SA(1, 0), cA + kstep, voffA); PG8_STAGE(PG8_SB(1, 1), cB + hstep + kstep, voffB);
        PG8_WAIT_V(6); PG8_BAR;
    }
    for (;;) {
        const bool has_next = S.next(ui + 1, nxt);
        const char* nA = has_next ? (const char*)(nxt.sel ? g.A2 : g.A) + (size_t)nxt.pm * tstep : cA; const char* nB = has_next ? (const char*)(nxt.sel ? g.Bt2 : g.Bt) + (size_t)nxt.pn * tstep : cB;
        for (int t = 0; t < nt; t += 2) {
            const bool last = (t == nt - 2);
            const char* a1 = cA + (size_t)(t + 1) * kstep;
            const char* a2 = last ? nA : cA + (size_t)(t + 2) * kstep; const char* b2 = last ? nB : cB + (size_t)(t + 2) * kstep;
            const char* a3 = a2 + kstep; const char* b3 = b2 + kstep;
            if (last && has_next) S.a_ready(nxt);
            if constexpr (SP2) {
            PG8_LDB(B0, 0, 0); PG8_LDB(B1, 0, 1); PG8_SCHED; PG8_LDA(At, 0, 0); PG8_STAGE(PG8_SA(1, 1), a1 + hstep, voffA);
            PG8_WAIT_V(8); PG8_WAIT_L(0); PG8_BAR; PG8_MMA(0, 0, At, B0); PG8_MMA(0, 1, At, B1); PG8_BAR; PG8_SCHED;
            PG8_LDA(At, 0, 1); PG8_STAGE(PG8_SB(0, 0), b2, voffB); PG8_STAGE(PG8_SB(0, 1), b2 + hstep, voffB); PG8_STAGE(PG8_SA(0, 0), a2, voffA);
            PG8_WAIT_V(8); PG8_WAIT_L(0); PG8_BAR; PG8_MMA(1, 0, At, B0); PG8_MMA(1, 1, At, B1); PG8_BAR; PG8_SCHED;
            PG8_LDB(B0, 1, 0); PG8_LDB(B1, 1, 1); PG8_SCHED; PG8_LDA(At, 1, 0); PG8_STAGE(PG8_SA(0, 1), a2 + hstep, voffA);
            PG8_WAIT_V(8); PG8_WAIT_L(0); PG8_BAR; PG8_MMA(0, 0, At, B0); PG8_MMA(0, 1, At, B1); PG8_BAR; PG8_SCHED;
            PG8_LDA(At, 1, 1); PG8_STAGE(PG8_SB(1, 0), b3, voffB); PG8_STAGE(PG8_SB(1, 1), b3 + hstep, voffB); PG8_STAGE(PG8_SA(1, 0), a3, voffA);
            PG8_WAIT_V(8); PG8_WAIT_L(0); PG8_BAR; PG8_MMA(1, 0, At, B0); PG8_MMA(1, 1, At, B1); PG8_BAR; PG8_SCHED;
            } else {
            PG8_LDB(B0, 0, 0); PG8_SCHED; PG8_LDA(At, 0, 0); PG8_STAGE(PG8_SA(1, 1), a1 + hstep, voffA);
            PG8_WAIT_L(8); PG8_BAR; PG8_WAIT_L(0); PG8_MMA(0, 0, At, B0); PG8_BAR; PG8_SCHED;
            PG8_LDB(B1, 0, 1); PG8_STAGE(PG8_SB(0, 0), b2, voffB);
            PG8_BAR; PG8_WAIT_L(0); PG8_MMA(0, 1, At, B1); PG8_BAR;
            PG8_LDA(At, 0, 1); PG8_STAGE(PG8_SA(0, 0), a2, voffA);
            PG8_BAR; PG8_WAIT_L(0); PG8_MMA(1, 0, At, B0); PG8_BAR; PG8_SCHED;
            PG8_STAGE(PG8_SB(0, 1), b2 + hstep, voffB);
            PG8_WAIT_V(6); PG8_BAR; PG8_MMA(1, 1, At, B1); PG8_BAR;
            PG8_LDB(B0, 1, 0); PG8_SCHED; PG8_LDA(At, 1, 0); PG8_STAGE(PG8_SA(0, 1), a2 + hstep, voffA);
            PG8_WAIT_L(8); PG8_BAR; PG8_WAIT_L(0); PG8_MMA(0, 0, At, B0); PG8_BAR; PG8_SCHED;
            PG8_LDB(B1, 1, 1); PG8_STAGE(PG8_SB(1, 0), b3, voffB);
            PG8_BAR; PG8_WAIT_L(0); PG8_MMA(0, 1, At, B1); PG8_BAR;
            PG8_LDA(At, 1, 1); PG8_STAGE(PG8_SA(1, 0), a3, voffA);
            PG8_BAR; PG8_WAIT_L(0); PG8_MMA(1, 0, At, B0); PG8_BAR; PG8_SCHED;
            PG8_STAGE(PG8_SB(1, 1), b3 + hstep, voffB);
            PG8_WAIT_V(6); PG8_BAR; PG8_MMA(1, 1, At, B1); PG8_BAR;
            }
        }
        if constexpr (ALIGN_EPI) { if (wr == 0) PG8_BAR; }
        if constexpr (!Epi::AFTER_DRAIN) { E(acc, cur, wr, wc, fr, fq); S.done(cur); }
        if (!has_next) break;
        if (!S.keep(cur)) {
#pragma unroll
        for (int a = 0; a < 2; ++a)
#pragma unroll
            for (int b = 0; b < 2; ++b)
#pragma unroll
                for (int m = 0; m < 4; ++m)
#pragma unroll
                    for (int n = 0; n < 2; ++n) acc[a][b][m][n] = (f32x4){0.f, 0.f, 0.f, 0.f};
        }
        cur = nxt; cA = nA; cB = nB; ++ui;
        if constexpr (ALIGN_EPI) { if (wr == 1) PG8_BAR; }
    }
    PG8_WAIT_V(0);
    if constexpr (!ALIGN_EPI) { if (wr == 0) PG8_BAR; }
    PG8_BAR;
    if constexpr (Epi::AFTER_DRAIN) { E.fused(acc, cur, wr, wc, fr, fq, lds, wid, lane); S.done(cur); }
#undef PG8_SA
#undef PG8_SB
#undef PG8_STAGE
#undef PG8_LDA
#undef PG8_LDB
#undef PG8_MMA
#undef PG8_WAIT_V
#undef PG8_WAIT_L
#undef PG8_BAR
#undef PG8_SCHED
}
}
#define PG8_SP2 true
#define PG8_ALIGN true
namespace mk {
using pg8::bf16_t;
#define LAS __attribute__((address_space(3)))
typedef unsigned v4u __attribute__((ext_vector_type(4)));
typedef unsigned v2u __attribute__((ext_vector_type(2)));
typedef float f32x4 __attribute__((ext_vector_type(4)));
typedef float f32x16 __attribute__((ext_vector_type(16)));
typedef short bf16x8 __attribute__((ext_vector_type(8)));
typedef short bf16x4 __attribute__((ext_vector_type(4)));
constexpr int T = 32768, D = 1024, SEQ = 8192, NBATCH = 4, NPROJ = 6656, INW = 6672, C_GA = 3072;
constexpr float EPS = 1e-6f;
constexpr int NWAVES = 8, NTHR = 512;
constexpr int LDS_BYTES = 147456;
constexpr size_t MiB = 1u << 20;
constexpr size_t WS_CTL = 0, CTL_ZERO_BYTES = 1 * MiB;
constexpr size_t WS_RSTD1 = 1 * MiB, WS_ROWSS = WS_RSTD1 + 512 * 1024, WS_ALOW = 2 * MiB, WS_DSC = 4 * MiB, WS_SUBK = 5 * MiB;
constexpr size_t WS_WIN = 8 * MiB, WS_WG = 21 * MiB, WS_WS = 23 * MiB, WS_WO = 25 * MiB, WS_WQ = 27 * MiB;
constexpr size_t WS_XB = 32 * MiB, WS_MERGED = 32 * MiB;
constexpr size_t WS_GQ = 96 * MiB, WS_GK = 128 * MiB, WS_HB = 96 * MiB;
constexpr size_t WS_GV = 160 * MiB, WS_EXD = 160 * MiB, WS_EXU = 192 * MiB;
constexpr size_t WS_GR = 224 * MiB, WS_SQ = 288 * MiB, WS_QP = 224 * MiB;
constexpr size_t WS_SK = 352 * MiB, WS_SV = 368 * MiB, WS_ST = 384 * MiB, WS_IDX = 448 * MiB, WS_GATE = 464 * MiB;
constexpr size_t WS_YG = 448 * MiB, WS_PART = 160 * MiB, WS_MRG = 96 * MiB, WS_HB2 = 160 * MiB, WS_EXD2 = 352 * MiB, WS_EXU2 = 384 * MiB, WS_ROWSS2 = 480 * MiB;

struct Args { const float* in[18]; float* out; unsigned char* ws; int ph_lo, ph_hi; };

__device__ __forceinline__ unsigned f2bf(float f) { unsigned u = __builtin_bit_cast(unsigned, f); return (u + 0x7fffu + ((u >> 16) & 1u)) >> 16; }
typedef float f32x2_t __attribute__((ext_vector_type(2))); typedef __bf16 bf16x2_t __attribute__((ext_vector_type(2)));
__device__ __forceinline__ unsigned pk2(float lo, float hi) { f32x2_t v = {lo, hi}; bf16x2_t b = __builtin_convertvector(v, bf16x2_t); return __builtin_bit_cast(unsigned, b); }
__device__ __forceinline__ float fexp(float x) { return __builtin_amdgcn_exp2f(x * 1.4426950408889634f); }
__device__ __forceinline__ float flog(float x) { return __builtin_amdgcn_logf(x) * 0.6931471805599453f; }
__device__ __forceinline__ float bf2f(unsigned short b) { return __builtin_bit_cast(float, (unsigned)b << 16); }
__device__ __forceinline__ float wave_sum(float v) {
#pragma unroll
    for (int o = 1; o < 64; o <<= 1) v += __shfl_xor(v, o);
    return v;
}
#define LDS_WAIT() asm volatile("s_waitcnt lgkmcnt(0)" ::: "memory")
#define VM_WAIT() asm volatile("s_waitcnt vmcnt(0)" ::: "memory")

struct Frame {
    LAS unsigned char* lds;
    int tid, lane, wave, G, bid;
    float* out; unsigned char* ws;
};

__device__ __forceinline__ void tr_item(const float* __restrict__ W, int ldw, int c0, int K, int nblk, const float* __restrict__ gain, bf16_t* WT, LAS float* scr, int item, int lane) {
    const int kb = item / nblk, nb = item % nblk, k0 = 64 * kb, n0 = 32 * nb;
    const __amdgpu_buffer_rsrc_t wt_r = wt_rsrc(WT);
    const int c = lane & 7;
    f32x4 g0 = {1.f, 1.f, 1.f, 1.f}, g1 = g0;
    if (gain) { g0 = *(const f32x4*)(gain + k0 + 8 * c); g1 = *(const f32x4*)(gain + k0 + 8 * c + 4); }
    float v[32];
    const float* src = W + (size_t)(k0 + (lane >> 5)) * ldw + c0 + n0 + (lane & 31);
#pragma unroll
    for (int i = 0; i < 32; ++i) v[i] = src[(size_t)(2 * i) * ldw];
#pragma unroll
    for (int i = 0; i < 32; ++i) scr[(2 * i + (lane >> 5)) * 33 + (lane & 31)] = v[i];
    LDS_WAIT(); asm volatile("" ::: "memory");
#pragma unroll
    for (int j = 0; j < 4; ++j) { const int n = (lane >> 3) + 8 * j; const LAS float* s = scr + (8 * c) * 33 + n;
        v4u o; o.x = pk2(s[0 * 33] * g0.x, s[1 * 33] * g0.y); o.y = pk2(s[2 * 33] * g0.z, s[3 * 33] * g0.w); o.z = pk2(s[4 * 33] * g1.x, s[5 * 33] * g1.y); o.w = pk2(s[6 * 33] * g1.z, s[7 * 33] * g1.w);
        wt_st16(wt_r, (unsigned)(((size_t)(n0 + n) * K + k0 + 8 * c) * 2), o); }
    LDS_WAIT(); asm volatile("" ::: "memory");
}

__device__ __forceinline__ void p0_prologue(Frame& F, const float* x, const float* gain1, const float* w_in, const float* gain2, const float* wbg, const float* wbs, const float* wout, const float* wq, const float* subk) {
    LAS unsigned char* wb = F.lds;
    LAS float* scr = (LAS float*)(F.lds + 65536 + F.wave * 8704);
    { f32x4 wv[8]; float gk[8];
#pragma unroll
      for (int j = 0; j < 8; ++j) { const int idx = F.tid + NTHR * j, k = idx >> 2; wv[j] = *(const f32x4*)(w_in + (size_t)k * INW + C_GA + 4 * (idx & 3)); gk[j] = gain1[k]; }
#pragma unroll
      for (int j = 0; j < 8; ++j) { const int idx = F.tid + NTHR * j, k = idx >> 2;
#pragma unroll
          for (int e = 0; e < 4; ++e) { const int r = 4 * (idx & 3) + e; const float v = gk[j] * wv[j][e];
              const unsigned h = f2bf(v), l = f2bf(v - __builtin_bit_cast(float, h << 16));
              const int off = (((k >> 5) * 64 + ((k >> 3) & 3) * 16 + r) * 16) + 2 * (k & 7);
              *(LAS unsigned short*)(wb + off) = (unsigned short)h; *(LAS unsigned short*)(wb + 32768 + off) = (unsigned short)l; } } }
    __syncthreads();
    const int gw = F.bid * 4 + (F.wave & 3), NGW = F.G * 4, lane = F.lane;
    bf16_t* XB = (bf16_t*)(F.ws + WS_XB); float* RSTD1 = (float*)(F.ws + WS_RSTD1); float* ALOW = (float*)(F.ws + WS_ALOW);
    const __amdgpu_buffer_rsrc_t xb_r = wt_rsrc(XB);
    if (F.wave < 4) for (int g = gw; g < T / 16; g += NGW) {
        const int m = g * 16 + (lane & 15), q = lane >> 4;
        const float* xr = x + (size_t)m * D + 8 * q;
        f32x4 acc = {0.f, 0.f, 0.f, 0.f}; float ss = 0.f;
        for (int s0 = 0; s0 < 32; s0 += 8) {
            asm volatile("" ::: "memory");
            f32x4 a[8][2];
#pragma unroll
            for (int i = 0; i < 8; ++i) { a[i][0] = *(const f32x4*)(xr + 32 * (s0 + i)); a[i][1] = *(const f32x4*)(xr + 32 * (s0 + i) + 4); }
#pragma unroll
            for (int i = 0; i < 8; ++i) { const f32x4 a0 = a[i][0], a1 = a[i][1];
                ss += ((a0.x * a0.x + a0.y * a0.y) + (a0.z * a0.z + a0.w * a0.w)) + ((a1.x * a1.x + a1.y * a1.y) + (a1.z * a1.z + a1.w * a1.w));
                v4u h; h.x = pk2(a0.x, a0.y); h.y = pk2(a0.z, a0.w); h.z = pk2(a1.x, a1.y); h.w = pk2(a1.z, a1.w);
                wt_st16(xb_r, (unsigned)(((size_t)m * D + 8 * q + 32 * (s0 + i)) * 2), h);
                v4u l;
                l.x = pk2(a0.x - __builtin_bit_cast(float, h.x << 16), a0.y - __builtin_bit_cast(float, h.x & 0xffff0000u));
                l.y = pk2(a0.z - __builtin_bit_cast(float, h.y << 16), a0.w - __builtin_bit_cast(float, h.y & 0xffff0000u));
                l.z = pk2(a1.x - __builtin_bit_cast(float, h.z << 16), a1.y - __builtin_bit_cast(float, h.z & 0xffff0000u));
                l.w = pk2(a1.z - __builtin_bit_cast(float, h.w << 16), a1.w - __builtin_bit_cast(float, h.w & 0xffff0000u));
                const bf16x8 wh = *(const LAS bf16x8*)(wb + ((s0 + i) * 64 + lane) * 16), wl = *(const LAS bf16x8*)(wb + 32768 + ((s0 + i) * 64 + lane) * 16);
                const bf16x8 xh = __builtin_bit_cast(bf16x8, h), xl = __builtin_bit_cast(bf16x8, l);
                acc = __builtin_amdgcn_mfma_f32_16x16x32_bf16(xh, wh, acc, 0, 0, 0);
                acc = __builtin_amdgcn_mfma_f32_16x16x32_bf16(xl, wh, acc, 0, 0, 0);
                acc = __builtin_amdgcn_mfma_f32_16x16x32_bf16(xh, wl, acc, 0, 0, 0); }
        }
        ss += __shfl_xor(ss, 16); ss += __shfl_xor(ss, 32);
        const float rstd = rsqrtf(ss * (1.f / D) + EPS);
#pragma unroll
        for (int i = 0; i < 4; ++i) { const float rs = __shfl(rstd, 4 * q + i); wt_st4(ALOW + (size_t)(g * 16 + 4 * q + i) * 16 + (lane & 15), acc[i] * rs); }
        if (lane < 16) wt_st4(RSTD1 + m, rstd);
    }
    constexpr int I_IN1 = 16 * 96, I_IN2 = 16 * 112, I_SQ = 16 * 32, I_Q = 16 * 64;
    constexpr int NITEMS = I_IN1 + I_IN2 + 3 * I_SQ + I_Q;
    bf16_t* WIN = (bf16_t*)(F.ws + WS_WIN);
    if (F.wave >= 4) for (int it = gw; it < NITEMS; it += NGW) {
        int r = it;
        if (r < I_IN1) { tr_item(w_in, INW, 0, D, 96, gain1, WIN, scr, r, lane); continue; } r -= I_IN1;
        if (r < I_IN2) { tr_item(w_in, INW, 3088, D, 112, gain1, WIN + (size_t)3072 * D, scr, r, lane); continue; } r -= I_IN2;
        if (r < I_SQ) { tr_item(wbg, D, 0, D, 32, nullptr, (bf16_t*)(F.ws + WS_WG), scr, r, lane); continue; } r -= I_SQ;
        if (r < I_SQ) { tr_item(wbs, D, 0, D, 32, nullptr, (bf16_t*)(F.ws + WS_WS), scr, r, lane); continue; } r -= I_SQ;
        if (r < I_SQ) { tr_item(wout, D, 0, D, 32, nullptr, (bf16_t*)(F.ws + WS_WO), scr, r, lane); continue; } r -= I_SQ;
        tr_item(wq, 2048, 0, D, 64, gain2, (bf16_t*)(F.ws + WS_WQ), scr, r, lane);
    }
    { const f32x4* sk = (const f32x4*)subk; v2u* o = (v2u*)(F.ws + WS_SUBK);
      for (int i = F.bid * NTHR + F.tid; i < 8 * 2 * 128 * 128 / 4; i += F.G * NTHR) { const f32x4 v = sk[i]; wt_st8(o + i, pk2(v.x, v.y), pk2(v.z, v.w)); } }
}

constexpr int SWA_KROW = 144, SWA_VROW = 592;
constexpr int SWA_K_OFF = 0, SWA_V_OFF = 256 * SWA_KROW, SWA_TB_OFF = SWA_V_OFF + 64 * SWA_VROW, SWA_LDS = SWA_TB_OFF + 4 * 128 * 4;
__device__ __forceinline__ int t5_bucket(int rel) {
    if (rel < 16) return rel;
    int b = 16;
    b += (rel >= 19); b += (rel >= 21); b += (rel >= 24); b += (rel >= 27); b += (rel >= 31); b += (rel >= 35); b += (rel >= 40); b += (rel >= 46);
    b += (rel >= 52); b += (rel >= 59); b += (rel >= 67); b += (rel >= 77); b += (rel >= 87); b += (rel >= 99); b += (rel >= 113);
    return b;
}
__device__ __forceinline__ void swa_load_kv(const bf16_t* SK, const bf16_t* SV, int u, int tid, int lane, int wave, v4u (&kraw)[4], v4u (&vraw)[4]) {
    const int blk = u & 63, kvh = (u >> 6) & 3, b = u >> 8; const size_t mrow0 = (size_t)b * SEQ; const int t0 = blk * 128, c = tid & 7;
#pragma unroll
    for (int ps = 0; ps < 4; ++ps) {
        const int kjk = ps * 64 + (tid >> 3), posk = t0 - 128 + kjk; kraw[ps] = (v4u){0u, 0u, 0u, 0u};
        if (posk >= 0) kraw[ps] = *(const v4u*)(SK + (mrow0 + posk) * 256 + kvh * 64 + 8 * c);
        const int kjv = ps * 64 + lane, posv = t0 - 128 + kjv; vraw[ps] = (v4u){0u, 0u, 0u, 0u};
        if (posv >= 0) vraw[ps] = *(const v4u*)(SV + (mrow0 + posv) * 256 + kvh * 64 + 8 * wave);
    }
}
__device__ __forceinline__ void swa_phase(Frame& F, const float* qgain, const float* kgain, const float* sinks, const float* rel_bias, size_t ydelta) {
    const bf16_t* SK = (const bf16_t*)(F.ws + WS_SK); const bf16_t* SV = (const bf16_t*)(F.ws + WS_SV); bf16_t* SQ = (bf16_t*)(F.ws + WS_SQ);
    LAS unsigned char* Kn = F.lds + SWA_K_OFF; LAS unsigned char* Vt = F.lds + SWA_V_OFF; LAS float* tb = (LAS float*)(F.lds + SWA_TB_OFF);
    const int tid = F.tid, lane = F.lane, wave = F.wave, l15 = lane & 15, q4 = lane >> 4;
    if (tid < 256) { const int d = tid >> 2, c = tid & 3; *(LAS v4u*)(Vt + d * SWA_VROW + 512 + 16 * c) = (v4u){0u, 0u, 0u, 0u}; }
    v4u kraw[4], vraw[4];
    if (F.bid < 1024) swa_load_kv(SK, SV, F.bid, tid, lane, wave, kraw, vraw);
    for (int u = F.bid; u < 1024; u += F.G) {
        const int blk = u & 63, kvh = (u >> 6) & 3, b = u >> 8;
        const size_t mrow0 = (size_t)b * SEQ; const int t0 = blk * 128;
        const int g = wave >> 1, qh = wave & 1, h = kvh * 4 + g;
        v4u qn[2];
        { const bf16_t* qrow = SQ + (mrow0 + t0 + 64 * qh + l15) * 1024 + h * 64; qn[0] = *(const v4u*)(qrow + 8 * q4); qn[1] = *(const v4u*)(qrow + 32 + 8 * q4); }
        __syncthreads();
        { const int c = tid & 7; f32x4 g0 = *(const f32x4*)(kgain + 8 * c), g1 = *(const f32x4*)(kgain + 8 * c + 4);
#pragma unroll
          for (int ps = 0; ps < 4; ++ps) {
              const int kj = ps * 64 + (tid >> 3);
              const v4u raw = kraw[ps];
              float f[8];
#pragma unroll
              for (int j = 0; j < 4; ++j) { f[2 * j] = __builtin_bit_cast(float, raw[j] << 16); f[2 * j + 1] = __builtin_bit_cast(float, raw[j] & 0xffff0000u); }
              float ss = 0.f;
#pragma unroll
              for (int j = 0; j < 8; ++j) ss += f[j] * f[j];
              ss += __shfl_xor(ss, 1); ss += __shfl_xor(ss, 2); ss += __shfl_xor(ss, 4);
              const float r = rsqrtf(ss * (1.f / 64.f) + EPS);
              v4u w; w.x = pk2(f[0] * r * g0.x, f[1] * r * g0.y); w.y = pk2(f[2] * r * g0.z, f[3] * r * g0.w); w.z = pk2(f[4] * r * g1.x, f[5] * r * g1.y); w.w = pk2(f[6] * r * g1.z, f[7] * r * g1.w);
              *(LAS v4u*)(Kn + kj * SWA_KROW + 16 * c) = w;
          } }
#pragma unroll
        for (int ps = 0; ps < 4; ++ps) {
            const int kj = ps * 64 + lane; const v4u raw = vraw[ps];
#pragma unroll
            for (int j = 0; j < 4; ++j) { *(LAS unsigned short*)(Vt + (8 * wave + 2 * j) * SWA_VROW + kj * 2) = (unsigned short)(raw[j] & 0xffffu); *(LAS unsigned short*)(Vt + (8 * wave + 2 * j + 1) * SWA_VROW + kj * 2) = (unsigned short)(raw[j] >> 16); }
        }
        { const int gg = tid >> 7, rel = tid & 127; tb[tid] = rel_bias[t5_bucket(rel) * 16 + kvh * 4 + gg] * 1.4426950408889634f; }
        if (u + F.G < 1024) swa_load_kv(SK, SV, u + F.G, tid, lane, wave, kraw, vraw);
        __syncthreads();
        const float sink = sinks[h] * 1.4426950408889634f;
        float qg[2][8];
#pragma unroll
        for (int ks = 0; ks < 2; ++ks)
#pragma unroll
            for (int j = 0; j < 8; ++j) qg[ks][j] = qgain[32 * ks + 8 * q4 + j] * (0.125f * 1.4426950408889634f);
        auto prepqk = [&](const int nt, f32x4 (&s)[9]) {
            const int q0 = 64 * qh + 16 * nt, qi = q0 + l15, kt0 = q0 >> 4;
            bf16_t* qrow = SQ + (mrow0 + t0 + qi) * 1024 + h * 64;
            bf16x8 qf[2];
            { v4u raw[2]; float f[2][8]; float ss = 0.f;
              raw[0] = qn[0]; raw[1] = qn[1];
              if (nt < 3) { const bf16_t* qnx = qrow + 16 * 1024; qn[0] = *(const v4u*)(qnx + 8 * q4); qn[1] = *(const v4u*)(qnx + 32 + 8 * q4); }
#pragma unroll
              for (int ks = 0; ks < 2; ++ks) {
#pragma unroll
                  for (int j = 0; j < 4; ++j) { f[ks][2 * j] = __builtin_bit_cast(float, raw[ks][j] << 16); f[ks][2 * j + 1] = __builtin_bit_cast(float, raw[ks][j] & 0xffff0000u); }
#pragma unroll
                  for (int j = 0; j < 8; ++j) ss += f[ks][j] * f[ks][j]; }
              ss += __shfl_xor(ss, 16); ss += __shfl_xor(ss, 32);
              const float r = rsqrtf(ss * (1.f / 64.f) + EPS);
#pragma unroll
              for (int ks = 0; ks < 2; ++ks) { v4u w;
#pragma unroll
                  for (int j = 0; j < 4; ++j) w[j] = pk2(f[ks][2 * j] * r * qg[ks][2 * j], f[ks][2 * j + 1] * r * qg[ks][2 * j + 1]);
                  qf[ks] = __builtin_bit_cast(bf16x8, w); } }
#pragma unroll
            for (int i = 0; i < 9; ++i) { f32x4 acc = (f32x4){0.f, 0.f, 0.f, 0.f};
#pragma unroll
                for (int ks = 0; ks < 2; ++ks) { const bf16x8 a = *(const LAS bf16x8*)(Kn + (16 * (kt0 + i) + l15) * SWA_KROW + (32 * ks + 8 * q4) * 2); acc = __builtin_amdgcn_mfma_f32_16x16x32_bf16(a, qf[ks], acc, 0, 0, 0); }
                s[i] = acc; }
        };
        auto finish = [&](const int nt, f32x4 (&s)[9]) {
            const int q0 = 64 * qh + 16 * nt, qi = q0 + l15, kt0 = q0 >> 4;
            bf16_t* qrow = SQ + (mrow0 + t0 + qi) * 1024 + h * 64;
            const int R0 = l15 + 128 - 4 * q4;
            const LAS float* tbp = tb + g * 128 + R0 - 131;
            float mx = -INFINITY;
            if (blk > 0) {
#pragma unroll
                for (int i = 0; i < 9; ++i)
#pragma unroll
                    for (int r = 0; r < 4; ++r) { const int rel = R0 - 16 * i - r; float v = s[i][r] + tbp[131 - 16 * i - r];
                        if (i == 0) v = (rel < 128) ? v : -INFINITY;
                        if (i == 8) v = (rel >= 0) ? v : -INFINITY;
                        s[i][r] = v; mx = fmaxf(mx, v); }
            } else {
#pragma unroll
                for (int i = 0; i < 9; ++i)
#pragma unroll
                    for (int r = 0; r < 4; ++r) { const int kj = 16 * (kt0 + i) + 4 * q4 + r, rel = R0 - 16 * i - r; const bool valid = ((unsigned)rel < 128u) && (kj >= 128);
                        const float v = valid ? s[i][r] + tbp[131 - 16 * i - r] : -INFINITY; s[i][r] = v; mx = fmaxf(mx, v); }
            }
            mx = fmaxf(mx, __shfl_xor(mx, 16)); mx = fmaxf(mx, __shfl_xor(mx, 32)); mx = fmaxf(mx, sink);
            float sum = 0.f;
#pragma unroll
            for (int i = 0; i < 9; ++i)
#pragma unroll
                for (int r = 0; r < 4; ++r) { const float e = __builtin_amdgcn_exp2f(s[i][r] - mx); s[i][r] = e; sum += e; }
            sum += __shfl_xor(sum, 16); sum += __shfl_xor(sum, 32);
            const float inv = 1.0f / (sum + __builtin_amdgcn_exp2f(sink - mx));
            f32x4 o[4];
#pragma unroll
            for (int mt = 0; mt < 4; ++mt) o[mt] = (f32x4){0.f, 0.f, 0.f, 0.f};
#pragma unroll
            for (int kk = 0; kk < 5; ++kk) {
                v4u w; w.x = pk2(s[2 * kk][0], s[2 * kk][1]); w.y = pk2(s[2 * kk][2], s[2 * kk][3]);
                if (kk < 4) { w.z = pk2(s[2 * kk + 1][0], s[2 * kk + 1][1]); w.w = pk2(s[2 * kk + 1][2], s[2 * kk + 1][3]); } else { w.z = 0u; w.w = 0u; }
                const bf16x8 pb = __builtin_bit_cast(bf16x8, w);
#pragma unroll
                for (int mt = 0; mt < 4; ++mt) {
                    const LAS unsigned char* vr = Vt + (16 * mt + l15) * SWA_VROW + (16 * (kt0 + 2 * kk) + 4 * q4) * 2;
                    const v2u a0 = *(const LAS v2u*)vr, a1 = *(const LAS v2u*)(vr + 32);
                    const bf16x8 a = __builtin_bit_cast(bf16x8, (v4u){a0.x, a0.y, a1.x, a1.y});
                    o[mt] = __builtin_amdgcn_mfma_f32_16x16x32_bf16(a, pb, o[mt], 0, 0, 0);
                }
            }
#pragma unroll
            for (int mt = 0; mt < 4; ++mt) { v2u w; w.x = pk2(o[mt][0] * inv, o[mt][1] * inv); w.y = pk2(o[mt][2] * inv, o[mt][3] * inv); wt_st8((unsigned char*)(qrow + 16 * mt + 4 * q4) + ydelta, w.x, w.y); }
        };
        f32x4 sA[9], sB[9];
        prepqk(0, sA);
#pragma unroll 1
        for (int np = 0; np < 2; ++np) {
            prepqk(2 * np + 1, sB);
            finish(2 * np, sA);
            if (np == 0) prepqk(2, sA);
            finish(2 * np + 1, sB);
        }
    }
    __syncthreads();
}

constexpr int GL_AL = 0, GL_QS = 4096, GL_BL = 6144, GL_DEC = 6656, GL_BQ = 8192, GL_QT = 41984, GL_KT = 59392, GL_OB = 8192, GL_KH = 76800, GL_VT = 95232;
constexpr int GL_BQROW = 528, GL_QROW = 272, GL_KHROW = 144, GL_VROW = 144, GL_OBROW = 1040;
__device__ __forceinline__ f32x16 mfma32(bf16x8 a, bf16x8 b, f32x16 c) { return __builtin_amdgcn_mfma_f32_32x32x16_bf16(a, b, c, 0, 0, 0); }
__device__ __forceinline__ bf16x8 pack8(const f32x16& x, int s) {
    v4u w;
    if (s == 0) { w.x = pk2(x[0], x[1]); w.y = pk2(x[2], x[3]); w.z = pk2(x[4], x[5]); w.w = pk2(x[6], x[7]); }
    else { w.x = pk2(x[8], x[9]); w.y = pk2(x[10], x[11]); w.z = pk2(x[12], x[13]); w.w = pk2(x[14], x[15]); }
    return __builtin_bit_cast(bf16x8, w);
}
__device__ __forceinline__ bf16x8 ld2x8(const LAS unsigned char* p) {
    const v2u a0 = *(const LAS v2u*)p, a1 = *(const LAS v2u*)(p + 16);
    return __builtin_bit_cast(bf16x8, (v4u){a0.x, a0.y, a1.x, a1.y});
}
__device__ __forceinline__ void unpack8(const v4u raw, float (&f)[8]) {
#pragma unroll
    for (int j = 0; j < 4; ++j) { f[2 * j] = __builtin_bit_cast(float, raw[j] << 16); f[2 * j + 1] = __builtin_bit_cast(float, raw[j] & 0xffff0000u); }
}
__device__ __forceinline__ void gla_load_w(Frame& F, const float* wgu, const float* bgu, int h, bf16x8& whi, bf16x8& wlo, float& bias) {
    const int dn = 32 * (F.wave >> 1) + (F.lane & 31), hh = F.lane >> 5;
    float v[8];
#pragma unroll
    for (int j = 0; j < 8; ++j) v[j] = wgu[(8 * hh + j) * 512 + h * 128 + dn];
    v4u hi, lo;
#pragma unroll
    for (int j = 0; j < 4; ++j) { hi[j] = pk2(v[2 * j], v[2 * j + 1]); lo[j] = pk2(v[2 * j] - __builtin_bit_cast(float, hi[j] << 16), v[2 * j + 1] - __builtin_bit_cast(float, hi[j] & 0xffff0000u)); }
    whi = __builtin_bit_cast(bf16x8, (v4u){hi[0], hi[1], hi[2], hi[3]}); wlo = __builtin_bit_cast(bf16x8, (v4u){lo[0], lo[1], lo[2], lo[3]});
    bias = bgu[h * 128 + dn];
}
template <bool FULL> __device__ __forceinline__ float gla_stage(Frame& F, int h, size_t m0, const bf16x8 whi, const bf16x8 wlo, float bias) {
    const int tid = F.tid, lane = F.lane, wave = F.wave, d = tid & 127;
    LAS unsigned char* L = F.lds;
    const float* ALOW = (const float*)(F.ws + WS_ALOW);
    const bf16_t* GQ = (const bf16_t*)(F.ws + WS_GQ); const bf16_t* GK = (const bf16_t*)(F.ws + WS_GK); const bf16_t* GV = (const bf16_t*)(F.ws + WS_GV);
    __syncthreads();
    { typedef float f32x2 __attribute__((ext_vector_type(2))); ((LAS f32x2*)(L + GL_AL))[tid] = ((const f32x2*)(ALOW + m0 * 16))[tid]; }
    __syncthreads();
    const int mt = wave & 1, nt = wave >> 1, l31 = lane & 31, hh = lane >> 5, dn = 32 * nt + l31;
    float p[16];
    { const LAS f32x4* ap = (const LAS f32x4*)(L + GL_AL + (32 * mt + l31) * 64 + hh * 32);
      const f32x4 a0 = ap[0], a1 = ap[1];
      v4u ah, al;
      ah.x = pk2(a0.x, a0.y); ah.y = pk2(a0.z, a0.w); ah.z = pk2(a1.x, a1.y); ah.w = pk2(a1.z, a1.w);
      al.x = pk2(a0.x - __builtin_bit_cast(float, ah.x << 16), a0.y - __builtin_bit_cast(float, ah.x & 0xffff0000u)); al.y = pk2(a0.z - __builtin_bit_cast(float, ah.y << 16), a0.w - __builtin_bit_cast(float, ah.y & 0xffff0000u));
      al.z = pk2(a1.x - __builtin_bit_cast(float, ah.z << 16), a1.y - __builtin_bit_cast(float, ah.z & 0xffff0000u)); al.w = pk2(a1.z - __builtin_bit_cast(float, ah.w << 16), a1.w - __builtin_bit_cast(float, ah.w & 0xffff0000u));
      f32x16 z;
#pragma unroll
      for (int r = 0; r < 16; ++r) z[r] = 0.f;
      z = mfma32(__builtin_bit_cast(bf16x8, ah), whi, z); z = mfma32(__builtin_bit_cast(bf16x8, al), whi, z); z = mfma32(__builtin_bit_cast(bf16x8, ah), wlo, z);
#pragma unroll
      for (int r = 0; r < 16; ++r) { const float zz = z[r] + bias; p[r] = (fminf(zz, 0.f) - flog(1.f + fexp(-fabsf(zz)))) * (1.f / 16.f); } }
    float base = 0.f;
#pragma unroll
    for (int g4 = 0; g4 < 4; ++g4) {
        p[4 * g4 + 1] += p[4 * g4]; p[4 * g4 + 2] += p[4 * g4 + 1]; p[4 * g4 + 3] += p[4 * g4 + 2];
        const float gt = p[4 * g4 + 3], pt = __shfl_xor(gt, 32), off = base + (hh ? pt : 0.f);
#pragma unroll
        for (int k = 0; k < 4; ++k) p[4 * g4 + k] += off;
        base += gt + pt;
    }
    if (hh == 0) ((LAS float*)(L + GL_QS))[mt * 128 + dn] = base;
    __syncthreads();
    { const float q0 = ((const LAS float*)(L + GL_QS))[dn], q1 = ((const LAS float*)(L + GL_QS))[128 + dn], blast = q0 + q1, offs = mt ? q0 : 0.f;
#pragma unroll
      for (int r = 0; r < 16; ++r) *(LAS float*)(L + GL_BQ + (32 * mt + 8 * (r >> 2) + 4 * hh + (r & 3)) * GL_BQROW + dn * 4) = p[r] + offs;
      if (mt == 0 && hh == 0) { ((LAS float*)(L + GL_BL))[dn] = blast; ((LAS float*)(L + GL_DEC))[dn] = fexp(blast); } }
    __syncthreads();
    {
        const int t = lane, dg = wave; const size_t row = m0 + t;
        float b[16], bl[16];
#pragma unroll
        for (int i = 0; i < 4; ++i) { const f32x4 v = *(const LAS f32x4*)(L + GL_BQ + t * GL_BQROW + dg * 64 + 16 * i); b[4 * i] = v.x; b[4 * i + 1] = v.y; b[4 * i + 2] = v.z; b[4 * i + 3] = v.w;
                                      const f32x4 u = *(const LAS f32x4*)(L + (FULL ? GL_DEC : GL_BL) + dg * 64 + 16 * i); bl[4 * i] = u.x; bl[4 * i + 1] = u.y; bl[4 * i + 2] = u.z; bl[4 * i + 3] = u.w; }
        float kf[16];
        { const v4u* kp = (const v4u*)(GK + row * 512 + h * 128 + 16 * dg); float t0[8], t1[8]; unpack8(kp[0], t0); unpack8(kp[1], t1);
#pragma unroll
          for (int e = 0; e < 8; ++e) { kf[e] = t0[e]; kf[8 + e] = t1[e]; } }
        float kh[16];
        if (FULL) {
            float qf[16];
            { const v4u* qp = (const v4u*)(GQ + row * 512 + h * 128 + 16 * dg); float t0[8], t1[8]; unpack8(qp[0], t0); unpack8(qp[1], t1);
#pragma unroll
              for (int e = 0; e < 8; ++e) { qf[e] = t0[e]; qf[8 + e] = t1[e]; } }
            v4u wq[2], wk[2];
#pragma unroll
            for (int e = 0; e < 16; e += 2) { const float e0 = fexp(b[e]), e1 = fexp(b[e + 1]);
                const float k0 = kf[e] * __builtin_amdgcn_rcpf(e0), k1 = kf[e + 1] * __builtin_amdgcn_rcpf(e1);
                wq[e >> 3][(e & 7) >> 1] = pk2(qf[e] * e0 * 0.08838834764831845f, qf[e + 1] * e1 * 0.08838834764831845f);
                wk[e >> 3][(e & 7) >> 1] = pk2(k0, k1);
                kh[e] = k0 * bl[e]; kh[e + 1] = k1 * bl[e + 1]; }
            *(LAS v4u*)(L + GL_QT + t * GL_QROW + dg * 32) = wq[0]; *(LAS v4u*)(L + GL_QT + t * GL_QROW + dg * 32 + 16) = wq[1];
            *(LAS v4u*)(L + GL_KT + t * GL_QROW + dg * 32) = wk[0]; *(LAS v4u*)(L + GL_KT + t * GL_QROW + dg * 32 + 16) = wk[1];
        } else {
#pragma unroll
            for (int e = 0; e < 16; ++e) kh[e] = kf[e] * fexp(bl[e] - b[e]);
        }
#pragma unroll
        for (int e = 0; e < 16; e += 2) { const unsigned pk = pk2(kh[e], kh[e + 1]);
            *(LAS unsigned short*)(L + GL_KH + (16 * dg + e) * GL_KHROW + t * 2) = (unsigned short)(pk & 0xffffu);
            *(LAS unsigned short*)(L + GL_KH + (16 * dg + e + 1) * GL_KHROW + t * 2) = (unsigned short)(pk >> 16); }
#pragma unroll
        for (int i = 0; i < 4; ++i) { const v4u raw = *(const v4u*)(GV + row * 1024 + h * 256 + 32 * wave + 8 * i);
#pragma unroll
            for (int j = 0; j < 4; ++j) { *(LAS unsigned short*)(L + GL_VT + (32 * wave + 8 * i + 2 * j) * GL_VROW + t * 2) = (unsigned short)(raw[j] & 0xffffu);
                                          *(LAS unsigned short*)(L + GL_VT + (32 * wave + 8 * i + 2 * j + 1) * GL_VROW + t * 2) = (unsigned short)(raw[j] >> 16); } }
    }
    __syncthreads();
    return ((const LAS float*)(L + GL_BL))[d];
}
__device__ __forceinline__ void gla_state_update(Frame& F, f32x16 (&S)[4]) {
    const int lane = F.lane, l31 = lane & 31, hh = lane >> 5; LAS unsigned char* L = F.lds;
#pragma unroll
    for (int dt = 0; dt < 4; ++dt) {
#pragma unroll
        for (int g = 0; g < 4; ++g) { const f32x4 dc = *(const LAS f32x4*)(L + GL_DEC + (32 * dt + 8 * g + 4 * hh) * 4);
            S[dt][4 * g] *= dc.x; S[dt][4 * g + 1] *= dc.y; S[dt][4 * g + 2] *= dc.z; S[dt][4 * g + 3] *= dc.w; }
#pragma unroll
        for (int ks = 0; ks < 4; ++ks) {
            const bf16x8 a = *(const LAS bf16x8*)(L + GL_KH + (32 * dt + l31) * GL_KHROW + (16 * ks + 8 * hh) * 2);
            const bf16x8 b = *(const LAS bf16x8*)(L + GL_VT + (32 * F.wave + l31) * GL_VROW + (16 * ks + 8 * hh) * 2);
            S[dt] = mfma32(a, b, S[dt]);
        } __builtin_amdgcn_sched_barrier(0);
    }
}
__device__ __forceinline__ void gla_local_phase(Frame& F, const float* wgu, const float* bgu) {
    float* ST = (float*)(F.ws + WS_ST); float* DSC = (float*)(F.ws + WS_DSC);
    const int lane = F.lane, l31 = lane & 31, hh = lane >> 5;
    for (int u = F.bid; u < 512; u += F.G) {
        const int sc = u & 31, bh = u >> 5, b = bh >> 2, h = bh & 3;
        bf16x8 whi, wlo; float bias; gla_load_w(F, wgu, bgu, h, whi, wlo, bias);
        f32x16 S[4];
#pragma unroll
        for (int dt = 0; dt < 4; ++dt)
#pragma unroll
            for (int r = 0; r < 16; ++r) S[dt][r] = 0.f;
        float sumbl = 0.f;
#pragma unroll 1
        for (int c = 0; c < 4; ++c) {
            const size_t m0 = (size_t)b * SEQ + sc * 256 + c * 64;
            sumbl += gla_stage<false>(F, h, m0, whi, wlo, bias);
            gla_state_update(F, S);
        }
        v4u* st8 = (v4u*)ST + (size_t)(bh * 32 + sc) * 4096 + (F.wave * 4 * 64 + lane) * 2;
#pragma unroll
        for (int dt = 0; dt < 4; ++dt)
#pragma unroll
            for (int hf = 0; hf < 2; ++hf) st8[dt * 128 + hf] = (v4u){pk2(S[dt][8 * hf], S[dt][8 * hf + 1]), pk2(S[dt][8 * hf + 2], S[dt][8 * hf + 3]), pk2(S[dt][8 * hf + 4], S[dt][8 * hf + 5]), pk2(S[dt][8 * hf + 6], S[dt][8 * hf + 7])};
        if (F.tid < 128) wt_st4(DSC + (bh * 32 + sc) * 128 + F.tid, fexp(sumbl));
    }
}
__device__ __forceinline__ void gla_scan_phase(Frame& F) {
    v4u* ST8 = (v4u*)(F.ws + WS_ST); const float* DSC = (const float*)(F.ws + WS_DSC);
    for (int idx = F.bid * NTHR + F.tid; idx < 16 * 4096; idx += F.G * NTHR) {
        const int bh = idx >> 12, u8 = idx & 4095, hf = u8 & 1, ln = (u8 >> 1) & 63, dt = (u8 >> 7) & 3, row0 = 32 * dt + 16 * hf + 4 * (ln >> 5);
        float S[8];
#pragma unroll
        for (int e = 0; e < 8; ++e) S[e] = 0.f;
#pragma unroll 8
        for (int sc = 0; sc < 32; ++sc) {
            v4u* p = ST8 + (size_t)(bh * 32 + sc) * 4096 + u8; const v4u raw = *p; float tmp[8]; unpack8(raw, tmp);
            *p = (v4u){pk2(S[0], S[1]), pk2(S[2], S[3]), pk2(S[4], S[5]), pk2(S[6], S[7])};
            const f32x4 d0 = *(const f32x4*)(DSC + (bh * 32 + sc) * 128 + row0), d1 = *(const f32x4*)(DSC + (bh * 32 + sc) * 128 + row0 + 8);
            S[0] = S[0] * d0.x + tmp[0]; S[1] = S[1] * d0.y + tmp[1]; S[2] = S[2] * d0.z + tmp[2]; S[3] = S[3] * d0.w + tmp[3];
            S[4] = S[4] * d1.x + tmp[4]; S[5] = S[5] * d1.y + tmp[5]; S[6] = S[6] * d1.z + tmp[6]; S[7] = S[7] * d1.w + tmp[7];
        }
    }
}
__device__ __forceinline__ void gla_out_phase(Frame& F, const float* wgu, const float* bgu, const float* ogain) {
    const float* ST = (const float*)(F.ws + WS_ST); const bf16_t* GR = (const bf16_t*)(F.ws + WS_GR); const __amdgpu_buffer_rsrc_t gr_r = wt_rsrc(F.ws + WS_YG);
    const int lane = F.lane, l31 = lane & 31, hh = lane >> 5, wave = F.wave; LAS unsigned char* L = F.lds;
    for (int u = F.bid; u < 512; u += F.G) {
        const int sc = u & 31, bh = u >> 5, b = bh >> 2, h = bh & 3;
        bf16x8 whi, wlo; float bias; gla_load_w(F, wgu, bgu, h, whi, wlo, bias);
        f32x16 S[4];
        { const v4u* st8 = (const v4u*)ST + (size_t)(bh * 32 + sc) * 4096 + (wave * 4 * 64 + lane) * 2;
#pragma unroll
          for (int dt = 0; dt < 4; ++dt)
#pragma unroll
              for (int hf = 0; hf < 2; ++hf) { float f[8]; unpack8(st8[dt * 128 + hf], f);
#pragma unroll
                  for (int e = 0; e < 8; ++e) S[dt][8 * hf + e] = f[e]; } }
#pragma unroll 1
        for (int c = 0; c < 4; ++c) {
            const size_t m0 = (size_t)b * SEQ + sc * 256 + c * 64;
            (void)gla_stage<true>(F, h, m0, whi, wlo, bias);
            f32x16 o0, o1;
#pragma unroll
            for (int r = 0; r < 16; ++r) { o0[r] = 0.f; o1[r] = 0.f; }
#pragma unroll
            for (int dt = 0; dt < 4; ++dt)
#pragma unroll
                for (int s = 0; s < 2; ++s) {
                    const bf16x8 bs = pack8(S[dt], s);
                    const int ko = (32 * dt + 16 * s + 4 * hh) * 2;
                    o0 = mfma32(ld2x8(L + GL_QT + l31 * GL_QROW + ko), bs, o0);
                    o1 = mfma32(ld2x8(L + GL_QT + (32 + l31) * GL_QROW + ko), bs, o1);
                }
            __builtin_amdgcn_sched_barrier(0);
#pragma unroll
            for (int tile = 0; tile < 3; ++tile) {
                const int jt = (tile == 2) ? 1 : 0, it = (tile == 0) ? 0 : 1;
                f32x16 p;
#pragma unroll
                for (int r = 0; r < 16; ++r) p[r] = 0.f;
#pragma unroll
                for (int ks = 0; ks < 8; ++ks) {
                    const int ko = (16 * ks + 8 * hh) * 2;
                    const bf16x8 a = *(const LAS bf16x8*)(L + GL_KT + (32 * jt + l31) * GL_QROW + ko);
                    const bf16x8 b = *(const LAS bf16x8*)(L + GL_QT + (32 * it + l31) * GL_QROW + ko);
                    p = mfma32(a, b, p);
                }
                if (jt == it) {
#pragma unroll
                    for (int r = 0; r < 16; ++r) { const int j = (r & 3) + 8 * (r >> 2) + 4 * hh; p[r] = (j > l31) ? 0.f : p[r]; }
                }
#pragma unroll
                for (int s = 0; s < 2; ++s) {
                    const bf16x8 bv = ld2x8(L + GL_VT + (32 * wave + l31) * GL_VROW + (32 * jt + 16 * s + 4 * hh) * 2);
                    if (it == 0) o0 = mfma32(pack8(p, s), bv, o0); else o1 = mfma32(pack8(p, s), bv, o1);
                }
                __builtin_amdgcn_sched_barrier(0);
            }
            gla_state_update(F, S);
            __syncthreads();
#pragma unroll
            for (int r = 0; r < 16; ++r) { const int i = (r & 3) + 8 * (r >> 2) + 4 * hh;
                *(LAS float*)(L + GL_OB + i * GL_OBROW + (32 * wave + l31) * 4) = o0[r]; *(LAS float*)(L + GL_OB + (32 + i) * GL_OBROW + (32 * wave + l31) * 4) = o1[r]; }
            __syncthreads();
            {
                const int t = F.tid >> 3, part = F.tid & 7;
                float v[32]; float ss = 0.f;
#pragma unroll
                for (int i = 0; i < 8; ++i) { const f32x4 x = *(const LAS f32x4*)(L + GL_OB + t * GL_OBROW + (32 * part + 4 * i) * 4); v[4 * i] = x.x; v[4 * i + 1] = x.y; v[4 * i + 2] = x.z; v[4 * i + 3] = x.w; ss += (x.x * x.x + x.y * x.y) + (x.z * x.z + x.w * x.w); }
                ss += __shfl_xor(ss, 1); ss += __shfl_xor(ss, 2); ss += __shfl_xor(ss, 4);
                const float rstd = rsqrtf(ss * (1.f / 256.f) + EPS);
                const bf16_t* gp = GR + (m0 + t) * 1024 + h * 256 + 32 * part;
#pragma unroll
                for (int i = 0; i < 4; ++i) { const v4u raw = *(const v4u*)(gp + 8 * i); float rr[8]; unpack8(raw, rr);
                    const f32x4 g0 = *(const f32x4*)(ogain + 32 * part + 8 * i), g1 = *(const f32x4*)(ogain + 32 * part + 8 * i + 4);
                    v4u o; o.x = pk2(v[8 * i] * rstd * g0.x * rr[0], v[8 * i + 1] * rstd * g0.y * rr[1]); o.y = pk2(v[8 * i + 2] * rstd * g0.z * rr[2], v[8 * i + 3] * rstd * g0.w * rr[3]);
                    o.z = pk2(v[8 * i + 4] * rstd * g1.x * rr[4], v[8 * i + 5] * rstd * g1.y * rr[5]); o.w = pk2(v[8 * i + 6] * rstd * g1.z * rr[6], v[8 * i + 7] * rstd * g1.w * rr[7]);
                    wt_st16(gr_r, (unsigned)(((m0 + t) * 1024 + h * 256 + 32 * part + 8 * i) * 2), o); }
            }
        }
    }
    __syncthreads();
}

constexpr int PK_KROW = 272, PK_K_OFF = 0, PK_SCR_OFF = 2 * 128 * PK_KROW;
__device__ __forceinline__ void ce(unsigned& a, unsigned& b) { const unsigned mx = a > b ? a : b, mn = a > b ? b : a; a = mx; b = mn; }
template <int N> __device__ __forceinline__ void bitonic_sort_desc(unsigned (&x)[N]) {
#pragma unroll
    for (int k = 2; k <= N; k <<= 1)
#pragma unroll
        for (int j = k >> 1; j > 0; j >>= 1)
#pragma unroll
            for (int i = 0; i < N; ++i) { const int l = i ^ j; if (l > i) { if ((i & k) == 0) ce(x[i], x[l]); else ce(x[l], x[i]); } }
}
__device__ __forceinline__ void sort16_desc(unsigned (&x)[16]) {
    ce(x[0], x[13]); ce(x[1], x[12]); ce(x[2], x[15]); ce(x[3], x[14]); ce(x[4], x[8]); ce(x[5], x[6]); ce(x[7], x[11]); ce(x[9], x[10]); ce(x[0], x[5]); ce(x[1], x[7]); ce(x[2], x[9]); ce(x[3], x[4]); ce(x[6], x[13]); ce(x[8], x[14]); ce(x[10], x[15]); ce(x[11], x[12]); ce(x[0], x[1]); ce(x[2], x[3]); ce(x[4], x[5]); ce(x[6], x[8]); ce(x[7], x[9]); ce(x[10], x[11]); ce(x[12], x[13]); ce(x[14], x[15]); ce(x[0], x[2]); ce(x[1], x[3]); ce(x[4], x[10]); ce(x[5], x[11]); ce(x[6], x[7]); ce(x[8], x[9]); ce(x[12], x[14]); ce(x[13], x[15]); ce(x[1], x[2]); ce(x[3], x[12]); ce(x[4], x[6]); ce(x[5], x[7]); ce(x[8], x[10]); ce(x[9], x[11]); ce(x[13], x[14]); ce(x[1], x[4]); ce(x[2], x[6]); ce(x[5], x[8]); ce(x[7], x[10]); ce(x[9], x[13]); ce(x[11], x[14]); ce(x[2], x[4]); ce(x[3], x[6]); ce(x[9], x[12]); ce(x[11], x[13]); ce(x[3], x[5]); ce(x[6], x[8]); ce(x[7], x[9]); ce(x[10], x[12]); ce(x[3], x[4]); ce(x[5], x[6]); ce(x[7], x[8]); ce(x[9], x[10]); ce(x[11], x[12]); ce(x[6], x[7]); ce(x[8], x[9]);
}
__device__ __forceinline__ void merge16(unsigned (&a)[16], const unsigned (&b)[16]) {
#pragma unroll
    for (int i = 0; i < 16; ++i) a[i] = a[i] > b[15 - i] ? a[i] : b[15 - i];
#pragma unroll
    for (int j = 8; j > 0; j >>= 1)
#pragma unroll
        for (int i = 0; i < 16; ++i) { const int l = i ^ j; if (l > i) ce(a[i], a[l]); }
}
__device__ __forceinline__ void merge16_partner(unsigned (&a)[16]) {
    unsigned b[16];
#pragma unroll
    for (int i = 0; i < 16; ++i) b[i] = (unsigned)__shfl_xor((int)a[i], 32);
    merge16(a, b);
}
__device__ __forceinline__ unsigned f2key(float f) { const unsigned u = __builtin_bit_cast(unsigned, f); return u ^ ((unsigned)((int)u >> 31) | 0x80000000u); }
__device__ __forceinline__ float key2f(unsigned k) { const unsigned m = ~(unsigned)((int)k >> 31) | 0x80000000u; return __builtin_bit_cast(float, k ^ m); }
__device__ constexpr int PEER_CI[50] = {0,0,0,0,0,0,0,0,0,0,0,0,0,0,0,0, 1,1,1,1,1,1,1,1, 2,2,2,2,2, 3,3,3,3, 4,4,4, 5,5, 6,6, 7,7, 8,9,10,11,12,13,14,15};
__device__ constexpr int PEER_CJ[50] = {0,1,2,3,4,5,6,7,8,9,10,11,12,13,14,15, 0,1,2,3,4,5,6,7, 0,1,2,3,4, 0,1,2,3, 0,1,2, 0,1, 0,1, 0,1, 0,0,0,0,0,0,0,0};
__device__ __forceinline__ void top16_of_tiles(const f32x16 (&s)[4], int hh, unsigned (&top)[16]) {
#pragma unroll
    for (int mt = 0; mt < 4; ++mt) {
        unsigned g[16];
#pragma unroll
        for (int r = 0; r < 16; ++r) { const unsigned low = (unsigned)(127 - (32 * mt + (r & 3) + 8 * (r >> 2))) - 4u * (unsigned)hh; g[r] = (f2key(s[mt][r]) & ~127u) | low; }
        sort16_desc(g);
        if (mt == 0) {
#pragma unroll
            for (int i = 0; i < 16; ++i) top[i] = g[i];
        } else merge16(top, g);
    }
    merge16_partner(top);
}
__device__ __forceinline__ void peer_topk_phase(Frame& F) {
    const bf16_t* QP = (const bf16_t*)(F.ws + WS_QP); const bf16_t* SUBK = (const bf16_t*)(F.ws + WS_SUBK);
    unsigned short* IDX = (unsigned short*)(F.ws + WS_IDX); float* GATE = (float*)(F.ws + WS_GATE);
    LAS unsigned char* L = F.lds; const int tid = F.tid, lane = F.lane, wave = F.wave, l31 = lane & 31, hh = lane >> 5;
    LAS unsigned* scr = (LAS unsigned*)(L + PK_SCR_OFF + wave * 8192);
    pg8::StaticOrder S; S.init(T, 2048, F.G, F.bid);
    for (int ui = 0; ; ++ui) {
        pg8::Unit un; if (!S.next(ui, un)) break;
        const int h = un.pn, tile = un.pm;
        __syncthreads();
#pragma unroll
        for (int i = 0; i < 8; ++i) { const int v = tid + 512 * i, row = v >> 4, c = v & 15;
            *(LAS v4u*)(L + PK_K_OFF + row * PK_KROW + c * 16) = *(const v4u*)(SUBK + ((size_t)h * 256 + row) * 128 + c * 8); }
        __syncthreads();
        const int tok = tile * 256 + wave * 32 + l31;
        unsigned ka[16], kb[16];
#pragma unroll
        for (int p = 0; p < 2; ++p) {
            f32x16 s[4];
#pragma unroll
            for (int mt = 0; mt < 4; ++mt)
#pragma unroll
                for (int r = 0; r < 16; ++r) s[mt][r] = 0.f;
            const bf16_t* qrow = QP + (size_t)tok * 2048 + h * 256 + p * 128 + 8 * hh;
#pragma unroll
            for (int k2 = 0; k2 < 4; ++k2) {
                const bf16x8 q0 = *(const bf16x8*)(qrow + 32 * k2), q1 = *(const bf16x8*)(qrow + 32 * k2 + 16);
#pragma unroll
                for (int mt = 0; mt < 4; ++mt) { const bf16x8 a = *(const LAS bf16x8*)(L + PK_K_OFF + (p * 128 + 32 * mt + l31) * PK_KROW + (32 * k2 + 8 * hh) * 2); s[mt] = mfma32(a, q0, s[mt]); }
#pragma unroll
                for (int mt = 0; mt < 4; ++mt) { const bf16x8 a = *(const LAS bf16x8*)(L + PK_K_OFF + (p * 128 + 32 * mt + l31) * PK_KROW + (32 * k2 + 16 + 8 * hh) * 2); s[mt] = mfma32(a, q1, s[mt]); }
                __builtin_amdgcn_sched_barrier(0);
            }
            if (p == 0) top16_of_tiles(s, hh, ka); else top16_of_tiles(s, hh, kb);
        }
        float sa[16], sb[16];
#pragma unroll
        for (int i = 0; i < 16; ++i) { sa[i] = key2f(ka[i] & ~127u); sb[i] = key2f(kb[i] & ~127u); scr[i * 64 + lane] = 127u - (ka[i] & 127u); scr[(16 + i) * 64 + lane] = 127u - (kb[i] & 127u); }
        unsigned c0[16], c1[16];
#pragma unroll
        for (int n = 0; n < 32; ++n) {
            unsigned key = 0u;
            if (n < 25) { const int e0 = 2 * n, e1 = 2 * n + 1;
                const float v0 = sa[PEER_CI[e0]] + sb[PEER_CJ[e0]], v1 = sa[PEER_CI[e1]] + sb[PEER_CJ[e1]];
                const unsigned k0 = (f2key(v0) & ~255u) | (unsigned)(255 - (PEER_CI[e0] * 16 + PEER_CJ[e0])), k1 = (f2key(v1) & ~255u) | (unsigned)(255 - (PEER_CI[e1] * 16 + PEER_CJ[e1]));
                key = hh ? k1 : k0; }
            if (n < 16) c0[n] = key; else c1[n - 16] = key;
        }
        sort16_desc(c0); sort16_desc(c1); merge16(c0, c1); merge16_partner(c0);
        float e[16]; float sum = 0.f; const float mx = key2f(c0[0] & ~255u);
#pragma unroll
        for (int n = 0; n < 16; ++n) { e[n] = fexp(key2f(c0[n] & ~255u) - mx); sum += e[n]; }
        const float inv = 1.0f / sum;
        int eo[8]; float go[8];
#pragma unroll
        for (int n = 0; n < 8; ++n) { const unsigned kk = hh ? c0[8 + n] : c0[n]; const unsigned id = 255u - (kk & 255u);
            const unsigned i1 = scr[(id >> 4) * 64 + lane], i2 = scr[(16 + (id & 15)) * 64 + lane];
            eo[n] = (int)(i1 * 128u + i2); go[n] = (hh ? e[8 + n] : e[n]) * inv; }
        typedef int i32x4 __attribute__((ext_vector_type(4)));
        { const __amdgpu_buffer_rsrc_t gr = wt_rsrc(GATE); const unsigned bo = (unsigned)(((size_t)tok * 128 + h * 16 + 8 * hh) * 4);
          wt_st16(gr, bo, __builtin_bit_cast(wt_u32x4, (f32x4){go[0], go[1], go[2], go[3]})); wt_st16(gr, bo + 16, __builtin_bit_cast(wt_u32x4, (f32x4){go[4], go[5], go[6], go[7]}));
          unsigned short* ip = IDX + (size_t)tok * 128 + 2 * h + hh;
#pragma unroll
          for (int n = 0; n < 8; ++n) ip[16 * n] = (unsigned short)eo[n]; }
    }
    __syncthreads();
}
constexpr size_t WS_RSTD2 = 482 * MiB, WS_EXD8 = 352 * MiB, WS_EXU8 = 368 * MiB, WS_ISD = 6 * MiB, WS_ISU = 6 * MiB + 65536, WS_PA = 32 * MiB, WS_WEX = 416 * MiB, WS_AQ = 96 * MiB, WS_ASC = 130 * MiB;
__device__ __forceinline__ float gelu_exact(float x) { return 0.5f * x * (1.f + erff(x * 0.7071067811865476f)); }
__device__ __forceinline__ unsigned pack_i8x4(float a, float b, float c, float d) {
    const int ia = (int)rintf(a), ib = (int)rintf(b), ic = (int)rintf(c), id = (int)rintf(d);
    return ((unsigned)ia & 0xffu) | (((unsigned)ib & 0xffu) << 8) | (((unsigned)ic & 0xffu) << 16) | ((unsigned)id << 24);
}
__device__ __forceinline__ unsigned nib_lo(unsigned w) { return w & 0x0F0F0F0Fu; }
__device__ __forceinline__ unsigned nib_hi(unsigned w) { return ((((w ^ 0x80808080u) + 0x08080808u) >> 4) & 0x0F0F0F0Fu) ^ 0x08080808u; }
__device__ __forceinline__ void peer_quant_phase(Frame& F) {
    const bf16_t* HB = (const bf16_t*)(F.ws + WS_HB2); unsigned char* AQ = F.ws + WS_AQ; float* ASC = (float*)(F.ws + WS_ASC); const int lane = F.lane;
    for (int t = F.bid * NWAVES + F.wave; t < T; t += F.G * NWAVES) {
        const v4u* hp = (const v4u*)(HB + (size_t)t * D + 16 * lane); float a[8], b[8]; unpack8(hp[0], a); unpack8(hp[1], b);
        float mx = 0.f;
#pragma unroll
        for (int j = 0; j < 8; ++j) mx = fmaxf(mx, fmaxf(fabsf(a[j]), fabsf(b[j])));
        mx = fmaxf(mx, __shfl_xor(mx, 1)); mx = fmaxf(mx, __shfl_xor(mx, 2)); mx = fmaxf(mx, __shfl_xor(mx, 4)); mx = fmaxf(mx, __shfl_xor(mx, 8));
        const float sx = mx > 0.f ? 119.f / mx : 1.f, isx = mx > 0.f ? mx * (1.f / 119.f) : 1.f;
        const unsigned w0 = pack_i8x4(a[0] * sx, a[2] * sx, a[4] * sx, a[6] * sx), w1 = pack_i8x4(a[1] * sx, a[3] * sx, a[5] * sx, a[7] * sx);
        const unsigned w2 = pack_i8x4(b[0] * sx, b[2] * sx, b[4] * sx, b[6] * sx), w3 = pack_i8x4(b[1] * sx, b[3] * sx, b[5] * sx, b[7] * sx);
        unsigned char* base = AQ + ((size_t)(t * 4 + (lane >> 4)) * 8 + ((lane & 15) >> 1)) * 32 + (lane & 1) * 8;
        *(v2u*)base = (v2u){nib_hi(w0) | (nib_hi(w1) << 4), nib_hi(w2) | (nib_hi(w3) << 4)};
        *(v2u*)(base + 16) = (v2u){nib_lo(w0) | (nib_lo(w1) << 4), nib_lo(w2) | (nib_lo(w3) << 4)};
        if ((lane & 15) == 0) ASC[t * 4 + (lane >> 4)] = isx;
    }
}
__device__ __forceinline__ void treduce16(float (&p)[16], int lane, int m) {
#pragma unroll
    for (int i = 0; i < 8; ++i) { const bool hi = lane & m; const float send = hi ? p[i] : p[i + 8], keep = hi ? p[i + 8] : p[i]; p[i] = keep + __shfl_xor(send, m); }
#pragma unroll
    for (int i = 0; i < 4; ++i) { const bool hi = lane & (2 * m); const float send = hi ? p[i] : p[i + 4], keep = hi ? p[i + 4] : p[i]; p[i] = keep + __shfl_xor(send, 2 * m); }
#pragma unroll
    for (int i = 0; i < 2; ++i) { const bool hi = lane & (4 * m); const float send = hi ? p[i] : p[i + 2], keep = hi ? p[i + 2] : p[i]; p[i] = keep + __shfl_xor(send, 4 * m); }
}
typedef int i32x4v __attribute__((ext_vector_type(4)));
__device__ __forceinline__ void treduce16i_g(int (&p)[16], int lane) {
#pragma unroll
    for (int i = 0; i < 8; ++i) { const v2u r = __builtin_amdgcn_permlane32_swap((unsigned)p[i], (unsigned)p[i + 8], false, false); p[i] = (int)(r.x + r.y); }
#pragma unroll
    for (int i = 0; i < 4; ++i) { const v2u r = __builtin_amdgcn_permlane16_swap((unsigned)p[i], (unsigned)p[i + 4], false, false); p[i] = (int)(r.x + r.y); }
    const bool hi = lane & 8;
#pragma unroll
    for (int i = 0; i < 2; ++i) { const int send = hi ? p[i] : p[i + 2], keep = hi ? p[i + 2] : p[i]; p[i] = keep + __builtin_amdgcn_update_dpp(0, send, 0x128, 0xF, 0xF, false); }
}
__device__ __forceinline__ void peer_load_ids(const unsigned short* IDX, size_t t, int g, i32x4v (&id)[4]) {
    const v4u* p = (const v4u*)(IDX + t * 128 + g * 16); const v4u a = p[0], b = p[1];
    id[0] = (i32x4v){(int)(a.x & 0xffffu), (int)(a.x >> 16), (int)(a.y & 0xffffu), (int)(a.y >> 16)}; id[1] = (i32x4v){(int)(a.z & 0xffffu), (int)(a.z >> 16), (int)(a.w & 0xffffu), (int)(a.w >> 16)};
    id[2] = (i32x4v){(int)(b.x & 0xffffu), (int)(b.x >> 16), (int)(b.y & 0xffffu), (int)(b.y >> 16)}; id[3] = (i32x4v){(int)(b.z & 0xffffu), (int)(b.z >> 16), (int)(b.w & 0xffffu), (int)(b.w >> 16)};
}
__device__ __forceinline__ void peer_load_w(const bf16_t* WEX, size_t t, int g, v4u (&w)[2]) {
    const v4u* p = (const v4u*)(WEX + t * 128 + g * 16); w[0] = p[0]; w[1] = p[1];
}
__device__ __forceinline__ void peer_v8_lds(LAS unsigned char* scr, unsigned raw, int lane, int grp, v4u (&o)[2]) {
    *(LAS unsigned*)(scr + 4 * lane) = raw; asm volatile("" ::: "memory");
    o[0] = *(const LAS v4u*)(scr + 32 * grp); o[1] = *(const LAS v4u*)(scr + 32 * grp + 16); asm volatile("" ::: "memory");
}
__device__ __forceinline__ void peer_ids_lds(LAS unsigned char* scr, unsigned raw, int lane, i32x4v (&id)[4]) {
    v4u r[2]; peer_v8_lds(scr, raw, lane, lane >> 3, r); const v4u a = r[0], b = r[1];
    id[0] = (i32x4v){(int)(a.x & 0xffffu), (int)(a.x >> 16), (int)(a.y & 0xffffu), (int)(a.y >> 16)}; id[1] = (i32x4v){(int)(a.z & 0xffffu), (int)(a.z >> 16), (int)(a.w & 0xffffu), (int)(a.w >> 16)};
    id[2] = (i32x4v){(int)(b.x & 0xffffu), (int)(b.x >> 16), (int)(b.y & 0xffffu), (int)(b.y >> 16)}; id[3] = (i32x4v){(int)(b.z & 0xffffu), (int)(b.z >> 16), (int)(b.w & 0xffffu), (int)(b.w >> 16)};
}
#ifndef PEER_GATHER_AUX
#define PEER_GATHER_AUX 16
#endif
__device__ __forceinline__ void peer_gather16(v4u (&q)[16], const __amdgpu_buffer_rsrc_t r, unsigned loff, const i32x4v (&id)[4]) {
#pragma unroll
    for (int i = 0; i < 16; ++i) q[i] = __builtin_bit_cast(v4u, __builtin_amdgcn_raw_buffer_load_b128(r, (unsigned)id[i >> 2][i & 3] * 128u + loff, 0, PEER_GATHER_AUX));
}
__device__ __forceinline__ void peer_down_compute(const v4u (&q)[16], const v4u (&aq)[2], float isx, bf16_t* pa, int lane) {
    float p[16];
#pragma unroll
    for (int i = 0; i < 16; ++i) { int ah = __builtin_amdgcn_sdot8((int)q[i][0], (int)aq[0][0], 0, true), al = __builtin_amdgcn_sdot8((int)q[i][0], (int)aq[1][0], 0, true);
#pragma unroll
        for (int j = 1; j < 4; ++j) { ah = __builtin_amdgcn_sdot8((int)q[i][j], (int)aq[0][j], ah, false); al = __builtin_amdgcn_sdot8((int)q[i][j], (int)aq[1][j], al, false); }
        p[i] = (float)(16 * ah + al) * isx; }
    treduce16(p, lane, 1);
    *(unsigned*)(pa + 2 * lane) = pk2(p[0], p[1]);
}
__device__ __forceinline__ void peer_down_phase(Frame& F) {
    const unsigned char* TD = F.ws + WS_EXD8; const unsigned short* IDX = (const unsigned short*)(F.ws + WS_IDX);
    bf16_t* PA = (bf16_t*)(F.ws + WS_PA); const bf16_t* h1 = (const bf16_t*)(F.ws + WS_HB2);
    const unsigned char* AQ = F.ws + WS_AQ; const float* ASC = (const float*)(F.ws + WS_ASC);
    const int lane = F.lane, g = lane >> 3, cl = lane & 7, k = (F.bid & 7) >> 1, nw = (F.G >> 3) * 2 * NWAVES;
    const __amdgpu_buffer_rsrc_t tk = wt_rsrc(TD + (size_t)k * 16384 * 128); const unsigned loff = 16u * (unsigned)cl;
    int t = ((F.bid >> 3) * 2 + (F.bid & 1)) * NWAVES + F.wave;
    if (t >= T) return;
    LAS unsigned char* scrI = F.lds + F.wave * 512; LAS unsigned char* scrA = scrI + 256;
    const unsigned* IDXW = (const unsigned*)IDX + lane; const unsigned* AQW = (const unsigned*)AQ + k * 64 + lane;
    i32x4v id[4];
    unsigned idr = IDXW[(size_t)t * 64];
    peer_ids_lds(scrI, idr, lane, id);
    v4u qa[16], qb[16];
    peer_gather16(qa, tk, loff, id);
    { const int tl = (t + nw < T) ? t + nw : t; idr = IDXW[(size_t)tl * 64]; }
    float hs = ASC[t * 4 + k];
    unsigned aqr = AQW[(size_t)t * 256];
#define PEER_DOWN_STEP(QC, QN) { \
        const int t1 = t + nw, t2 = t + 2 * nw; const bool has1 = t1 < T; \
        peer_ids_lds(scrI, idr, lane, id); \
        if (has1) peer_gather16(QN, tk, loff, id); \
        { const int tl = (t2 < T) ? t2 : t; idr = IDXW[(size_t)tl * 64]; } \
        v4u hv[2]; peer_v8_lds(scrA, aqr, lane, cl, hv); \
        unsigned aqn; float hsn; { const int tl = has1 ? t1 : t; aqn = AQW[(size_t)tl * 256]; hsn = ASC[tl * 4 + k]; } \
        __builtin_amdgcn_sched_barrier(0); \
        peer_down_compute(QC, hv, hs, PA + ((size_t)k * T + t) * 128, lane); \
        __builtin_amdgcn_sched_barrier(0); \
        if (!has1) break; t = t1; aqr = aqn; hs = hsn; }
    for (;;) { PEER_DOWN_STEP(qa, qb) PEER_DOWN_STEP(qb, qa) }
#undef PEER_DOWN_STEP
}
__device__ __forceinline__ void peer_combine_phase(Frame& F) {
    const unsigned* PAW = (const unsigned*)(F.ws + WS_PA); const unsigned* IDXW = (const unsigned*)(F.ws + WS_IDX); const float* GATE = (const float*)(F.ws + WS_GATE);
    const float* ISD = (const float*)(F.ws + WS_ISD); const float* ISU = (const float*)(F.ws + WS_ISU); unsigned* WQ = (unsigned*)(F.ws + WS_WEX); float* WSC = (float*)(F.ws + WS_WEX + 8 * MiB); const float* RSTD2 = (const float*)(F.ws + WS_RSTD2);
    const int lane = F.lane, g = lane >> 3, w = lane & 7, cl = ((w & 1) << 2) | (w & 2) | ((w >> 2) & 1);
    for (int t = F.bid * NWAVES + F.wave; t < T; t += F.G * NWAVES) {
        float a0 = 0.f, a1 = 0.f;
#pragma unroll
        for (int k = 0; k < 4; ++k) { const unsigned r = PAW[((size_t)k * T + t) * 64 + 8 * g + cl]; a0 += __builtin_bit_cast(float, r << 16); a1 += __builtin_bit_cast(float, r & 0xffff0000u); }
        const unsigned idp = IDXW[(size_t)t * 64 + 8 * g + w]; const int id0 = (int)(idp & 0xffffu), id1 = (int)(idp >> 16);
        const float g0 = GATE[(size_t)t * 128 + 16 * w + g], g1 = GATE[(size_t)t * 128 + 16 * w + 8 + g], rs = RSTD2[t];
        const pg8::f32x2 ge = pg8::gelu_pk((pg8::f32x2){a0 * rs * ISD[id0], a1 * rs * ISD[id1]});
        const float w0 = g0 * ge.x * ISU[id0], w1 = g1 * ge.y * ISU[id1];
        float mx = fmaxf(fabsf(w0), fabsf(w1));
#pragma unroll
        for (int o = 1; o < 64; o <<= 1) mx = fmaxf(mx, __shfl_xor(mx, o));
        const float sw = mx > 0.f ? 119.f / mx : 1.f, isw = mx > 0.f ? mx * (1.f / 119.f) : 1.f;
        const unsigned by = ((unsigned)(int)rintf(w0 * sw) & 0xffu) | (((unsigned)(int)rintf(w1 * sw) & 0xffu) << 8);
        const unsigned h = nib_hi(by) & 0x0F0Fu, l = nib_lo(by) & 0x0F0Fu;
        unsigned hv = ((h | (h >> 4)) & 0xffu) << (8 * (w & 3)), lv = ((l | (l >> 4)) & 0xffu) << (8 * (w & 3));
        hv |= (unsigned)__builtin_amdgcn_update_dpp(0, (int)hv, 0xB1, 0xF, 0xF, false); hv |= (unsigned)__builtin_amdgcn_update_dpp(0, (int)hv, 0x4E, 0xF, 0xF, false);
        lv |= (unsigned)__builtin_amdgcn_update_dpp(0, (int)lv, 0xB1, 0xF, 0xF, false); lv |= (unsigned)__builtin_amdgcn_update_dpp(0, (int)lv, 0x4E, 0xF, 0xF, false);
        if ((w & 3) == 0) { WQ[(size_t)t * 32 + 4 * g + (w >> 2)] = hv; WQ[(size_t)t * 32 + 4 * g + 2 + (w >> 2)] = lv; }
        if (lane == 0) WSC[t] = isw;
    }
}
__device__ __forceinline__ void peer_up_compute(const v4u (&q)[16], const v4u wq, float isw, v2u hraw, float* dstp, int lane) {
    const int whi[2] = {(int)wq.x, (int)wq.y}, wlo[2] = {(int)wq.z, (int)wq.w};
    constexpr unsigned NM = 0x0F0F0F0Fu;
    int res[4];
#pragma unroll
    for (int jj = 0; jj < 2; ++jj) {
    int f[16];
#pragma unroll
    for (int j2 = 0; j2 < 2; ++j2) { const int j = 2 * jj + j2;
        unsigned tcc[2][8];
#pragma unroll
        for (int o = 0; o < 2; ++o) {
            unsigned a0[4], a1[4];
#pragma unroll
            for (int pr = 0; pr < 4; ++pr) { const unsigned r0 = q[8 * o + 2 * pr][j], r1 = q[8 * o + 2 * pr + 1][j];
                a0[pr] = (r0 & NM) | ((r1 << 4) & ~NM); a1[pr] = ((r0 >> 4) & NM) | (r1 & ~NM); }
#pragma unroll
            for (int x = 0; x < 2; ++x) {
                unsigned b[2][2];
#pragma unroll
                for (int h = 0; h < 2; ++h) { const unsigned lo = x ? a1[2 * h] : a0[2 * h], hi = x ? a1[2 * h + 1] : a0[2 * h + 1];
                    b[h][0] = __builtin_amdgcn_perm(hi, lo, 0x05010400u); b[h][1] = __builtin_amdgcn_perm(hi, lo, 0x07030602u); }
#pragma unroll
                for (int p = 0; p < 2; ++p) { tcc[o][2 * (2 * p) + x] = __builtin_amdgcn_perm(b[1][p], b[0][p], 0x05040100u); tcc[o][2 * (2 * p + 1) + x] = __builtin_amdgcn_perm(b[1][p], b[0][p], 0x07060302u); }
            }
        }
#pragma unroll
        for (int n = 0; n < 8; ++n) { int a = __builtin_amdgcn_sdot8((int)tcc[0][n], whi[0], 0, true);     a = __builtin_amdgcn_sdot8((int)tcc[1][n], whi[1], a, false);
            a = __builtin_amdgcn_sdot8((int)tcc[0][n], wlo[0], a << 4, false); a = __builtin_amdgcn_sdot8((int)tcc[1][n], wlo[1], a, false); f[8 * j2 + n] = a; }
    }
    treduce16i_g(f, lane); res[2 * jj] = f[0]; res[2 * jj + 1] = f[1];
    }
    *(f32x2_t*)dstp = (f32x2_t){__builtin_bit_cast(float, hraw.x << 16) + (float)res[0] * isw, __builtin_bit_cast(float, hraw.x & 0xffff0000u) + (float)res[1] * isw};
    *(f32x2_t*)(dstp + 16) = (f32x2_t){__builtin_bit_cast(float, hraw.y << 16) + (float)res[2] * isw, __builtin_bit_cast(float, hraw.y & 0xffff0000u) + (float)res[3] * isw};
}
__device__ __forceinline__ void peer_up_phase(Frame& F, float* dst) {
    const unsigned char* TU = F.ws + WS_EXU8; const unsigned short* IDX = (const unsigned short*)(F.ws + WS_IDX); const bf16_t* WEX = (const bf16_t*)(F.ws + WS_WEX);
    float* out = F.out;
    const int lane = F.lane, g = lane >> 3, cl = lane & 7, k = (F.bid & 7) >> 1, nw = (F.G >> 3) * 2 * NWAVES;
    const __amdgpu_buffer_rsrc_t tk = wt_rsrc(TU + (size_t)k * 16384 * 128); const unsigned loff = 16u * (unsigned)cl;
    const int ccol = 256 * k + 32 * cl + 2 * g;
    int t = ((F.bid >> 3) * 2 + (F.bid & 1)) * NWAVES + F.wave;
    if (t >= T) return;
    LAS unsigned char* scrI = F.lds + F.wave * 512; LAS unsigned char* scrW = scrI + 256;
    const unsigned* IDXW = (const unsigned*)IDX + lane; const unsigned* WEXW = (const unsigned*)WEX + (lane & 31); const float* WSC = (const float*)(F.ws + WS_WEX + 8 * MiB);
    i32x4v id[4];
    unsigned idr = IDXW[(size_t)t * 64], wr = WEXW[(size_t)t * 32]; float ws = WSC[t];
    peer_ids_lds(scrI, idr, lane, id);
    v4u qa[16], qb[16];
    peer_gather16(qa, tk, loff, id);
    { const int tl = (t + nw < T) ? t + nw : t; idr = IDXW[(size_t)tl * 64]; }
    const bf16_t* hb16 = (const bf16_t*)(F.ws + WS_HB2);
    v2u hcur; hcur.x = *(const unsigned*)(hb16 + (size_t)t * D + ccol); hcur.y = *(const unsigned*)(hb16 + (size_t)t * D + ccol + 16);
#define PEER_UP_STEP(QC, QN) { \
        const int t1 = t + nw, t2 = t + 2 * nw; const bool has1 = t1 < T; \
        peer_ids_lds(scrI, idr, lane, id); \
        if (has1) peer_gather16(QN, tk, loff, id); \
        { const int tl = (t2 < T) ? t2 : t; idr = IDXW[(size_t)tl * 64]; } \
        const unsigned wrn = WEXW[(size_t)(has1 ? t1 : t) * 32]; const float wsn = WSC[has1 ? t1 : t]; \
        v2u hnext; hnext.x = *(const unsigned*)(hb16 + (size_t)(has1 ? t1 : t) * D + ccol); hnext.y = *(const unsigned*)(hb16 + (size_t)(has1 ? t1 : t) * D + ccol + 16); \
        *(LAS unsigned*)(scrW + 4 * (lane & 31)) = wr; asm volatile("" ::: "memory"); const v4u wc = *(const LAS v4u*)(scrW + 16 * g); asm volatile("" ::: "memory"); \
        __builtin_amdgcn_sched_barrier(0); \
        peer_up_compute(QC, wc, ws, hcur, dst + (size_t)t * D + ccol, lane); \
        __builtin_amdgcn_sched_barrier(0); \
        if (!has1) break; t = t1; hcur = hnext; wr = wrn; ws = wsn; }
    for (;;) { PEER_UP_STEP(qa, qb) PEER_UP_STEP(qb, qa) }
#undef PEER_UP_STEP
}
__device__ __forceinline__ void expert_convert(Frame& F, const float* exd, const float* exu, const float* gain2) {
    const int lane = F.lane;
    f32x4 gv[4];
#pragma unroll
    for (int j = 0; j < 4; ++j) gv[j] = *(const f32x4*)(gain2 + 16 * lane + 4 * j);
    for (int r4 = (F.bid * NWAVES + F.wave) * 4; r4 < 2 * 16384; r4 += F.G * NWAVES * 4) {
        const int tb = r4 >> 14, row0 = r4 & 16383;
        const float* src = (tb ? exu : exd) + (size_t)row0 * D + 16 * lane;
        f32x4 v[4][4]; float mx[4];
#pragma unroll
        for (int r = 0; r < 4; ++r)
#pragma unroll
            for (int j = 0; j < 4; ++j) v[r][j] = *(const f32x4*)(src + (size_t)r * D + 4 * j);
#pragma unroll
        for (int r = 0; r < 4; ++r) { float m = 0.f;
#pragma unroll
            for (int j = 0; j < 4; ++j) { if (tb == 0) v[r][j] = v[r][j] * gv[j]; m = fmaxf(m, fmaxf(fmaxf(fabsf(v[r][j].x), fabsf(v[r][j].y)), fmaxf(fabsf(v[r][j].z), fabsf(v[r][j].w)))); }
            mx[r] = m; }
#pragma unroll
        for (int o = 1; o < 64; o <<= 1)
#pragma unroll
            for (int r = 0; r < 4; ++r) mx[r] = fmaxf(mx[r], __shfl_xor(mx[r], o));
        {
            float ss[4];
#pragma unroll
            for (int r = 0; r < 4; ++r) { float s = 0.f;
#pragma unroll
                for (int j = 0; j < 4; ++j) s += (v[r][j].x * v[r][j].x + v[r][j].y * v[r][j].y) + (v[r][j].z * v[r][j].z + v[r][j].w * v[r][j].w);
                ss[r] = s; }
#pragma unroll
            for (int o = 1; o < 64; o <<= 1)
#pragma unroll
                for (int r = 0; r < 4; ++r) ss[r] += __shfl_xor(ss[r], o);
#pragma unroll
            for (int r = 0; r < 4; ++r) {
                const float rms = sqrtf(ss[r] * (1.f / 1024.f)), step = rms > 0.f ? 0.35f * rms : 1.f, sc = 1.f / step;
                f32x4 c[4];
#pragma unroll
                for (int j = 0; j < 4; ++j) { c[j] = v[r][j] * sc; c[j].x = fminf(fmaxf(c[j].x, -7.f), 7.f); c[j].y = fminf(fmaxf(c[j].y, -7.f), 7.f); c[j].z = fminf(fmaxf(c[j].z, -7.f), 7.f); c[j].w = fminf(fmaxf(c[j].w, -7.f), 7.f); }
                const unsigned x0 = pack_i8x4(c[0].x, c[0].z, c[1].x, c[1].z), y0 = pack_i8x4(c[0].y, c[0].w, c[1].y, c[1].w);
                const unsigned x1 = pack_i8x4(c[2].x, c[2].z, c[3].x, c[3].z), y1 = pack_i8x4(c[2].y, c[2].w, c[3].y, c[3].w);
                *(v2u*)(F.ws + (tb ? WS_EXU8 : WS_EXD8) + ((size_t)(lane >> 4) * 16384 + row0 + r) * 128 + (lane & 15) * 8) = (v2u){nib_lo(x0) | (nib_lo(y0) << 4), nib_lo(x1) | (nib_lo(y1) << 4)};
                if (lane == 0) wt_st4((float*)(F.ws + (tb ? WS_ISU : WS_ISD)) + row0 + r, step);
            }
            continue;
        }
        const __amdgpu_buffer_rsrc_t rr = wt_rsrc(F.ws + (tb ? WS_EXU8 : WS_EXD8));
#pragma unroll
        for (int r = 0; r < 4; ++r) {
            const float sc = mx[r] > 0.f ? 127.f / mx[r] : 1.f, isc = mx[r] > 0.f ? mx[r] * (1.f / 127.f) : 1.f;
            v4u q;
#pragma unroll
            for (int j = 0; j < 4; ++j) q[j] = pack_i8x4(v[r][j].x * sc, v[r][j].y * sc, v[r][j].z * sc, v[r][j].w * sc);
            wt_st16(rr, (unsigned)(((lane >> 3) * 16384 + row0 + r) * 128 + (lane & 7) * 16), q);
            if (lane == 0) wt_st4((float*)(F.ws + (tb ? WS_ISU : WS_ISD)) + row0 + r, isc);
        }
    }
}
#define XB_TMO      128
#define XB_XCNT(j)  (256  + 64 * (j))
#define XB_XSUB(j)  (1280 + 64 * (j))
#define XB_XGEN(j)  (2304 + 64 * (j))
#define XB_TOP      3328
#define XB_TOPGEN   3392
#define XCD_BAR_WORDS 3456
#define XB_SPIN_CAP (1u << 18)

__device__ __forceinline__ unsigned xb_ld(unsigned* p)              { return __hip_atomic_load(p, __ATOMIC_RELAXED, __HIP_MEMORY_SCOPE_AGENT); }
__device__ __forceinline__ unsigned xb_add(unsigned* p, unsigned v) { return __hip_atomic_fetch_add(p, v, __ATOMIC_RELAXED, __HIP_MEMORY_SCOPE_AGENT); }
__device__ __forceinline__ unsigned xb_xcc_id() { return (unsigned)__builtin_amdgcn_s_getreg((3 << 11) | 20) & 0xFu; }
#define XB_SPIN(cond, bar) do { unsigned _sp = 0; while (cond) { __builtin_amdgcn_s_sleep(1); \
    if ((++_sp & 255u) == 0u) { if (xb_ld(&(bar)[XB_TMO])) break; if (_sp > XB_SPIN_CAP) { atomicAdd(&(bar)[XB_TMO], 1u); break; } } } } while (0)

struct XcdBarrier {
    unsigned* bar; unsigned x;
    volatile LAS unsigned* st;
};

__device__ __forceinline__ XcdBarrier xcd_barrier_post(unsigned* bar, volatile LAS unsigned* st) {
    XcdBarrier b; b.bar = bar; b.x = xb_xcc_id(); b.st = st;
    if (threadIdx.x == 0) (void)xb_add(&bar[XB_XCNT(b.x)], 1u);
    return b;
}
__device__ __forceinline__ void xcd_barrier_complete(unsigned* bar, unsigned x, unsigned& nloc, unsigned& nx) {
    const unsigned G = gridDim.x * gridDim.y * gridDim.z;
    unsigned sum, cnt, mine, sp = 0u;
    for (;;) {
        sum = 0u; cnt = 0u; mine = 0u;
#pragma unroll
        for (unsigned j = 0; j < 16; ++j) { const unsigned c = xb_ld(&bar[XB_XCNT(j)]); sum += c; cnt += (c > 0u) ? 1u : 0u; mine = (j == x) ? c : mine; }
        if (sum == G) break;
        __builtin_amdgcn_s_sleep(1);
        if ((++sp & 255u) == 0u) { if (xb_ld(&bar[XB_TMO])) break; if (sp > XB_SPIN_CAP) { atomicAdd(&bar[XB_TMO], 1u); break; } }
    }
    nloc = mine > 0u ? mine : 1u; nx = cnt > 0u ? cnt : 1u;
}

__device__ __forceinline__ void xcd_barrier(const XcdBarrier& b) {
    asm volatile("s_waitcnt vmcnt(0)" ::: "memory");
    __syncthreads();
    if (threadIdx.x == 0) {
        unsigned* bar = b.bar;
        __builtin_amdgcn_s_waitcnt(0);
        unsigned nloc = b.st[0], nx = b.st[1];
        if (nloc == 0u) { xcd_barrier_complete(bar, b.x, nloc, nx); b.st[0] = nloc; b.st[1] = nx; }
        const unsigned old = xb_add(&bar[XB_XSUB(b.x)], 1u);
        const unsigned gen = old / nloc;
        if (old + 1u == (gen + 1u) * nloc) {
            __builtin_amdgcn_fence(__ATOMIC_RELEASE, "agent");
            asm volatile("s_waitcnt vmcnt(0)" ::: "memory");
            const unsigned og = xb_add(&bar[XB_TOP], 1u);
            const unsigned tg = og / nx;
            if (og + 1u == (tg + 1u) * nx) xb_add(&bar[XB_TOPGEN], 1u);
            else XB_SPIN(xb_ld(&bar[XB_TOPGEN]) == tg, bar);
            __builtin_amdgcn_fence(__ATOMIC_ACQUIRE, "agent");
            xb_add(&bar[XB_XGEN(b.x)], 1u);
            asm volatile("s_waitcnt vmcnt(0)" ::: "memory");
        } else {
            XB_SPIN(xb_ld(&bar[XB_XGEN(b.x)]) == gen, bar);
            __builtin_amdgcn_fence(__ATOMIC_ACQUIRE, "agent");
            asm volatile("s_waitcnt vmcnt(0)" ::: "memory");
        }
    }
    __syncthreads();
}

__global__ void __launch_bounds__(NTHR, 2) mega(Args args) {
    extern __shared__ __attribute__((aligned(16))) unsigned char lds_raw[];
    Frame F;
    F.lds = (LAS unsigned char*)lds_raw;
    F.tid = threadIdx.x; F.lane = F.tid & 63; F.wave = __builtin_amdgcn_readfirstlane(F.tid >> 6); F.G = gridDim.x; F.bid = blockIdx.x;
    F.out = args.out; F.ws = args.ws;
    const int lo = args.ph_lo, hi = args.ph_hi;
    cg::grid_group grid = cg::this_grid();
    volatile LAS unsigned* MISC = (volatile LAS unsigned*)(F.lds + LDS_BYTES - 64);
    if (F.tid < 16) MISC[F.tid] = 0u;
    __syncthreads();
    XcdBarrier bar = xcd_barrier_post((unsigned*)(F.ws + WS_CTL) + 4096, MISC + 8);
    if (hi - lo > 1) grid.sync();
#define IN(k) (lo <= (k) && (k) < hi)
#define SEAM(k) do { if (IN(k) && IN((k) + 1)) xcd_barrier(bar); } while (0)
    if (IN(0)) { p0_prologue(F, args.in[0], args.in[1], args.in[2], args.in[13], args.in[10], args.in[11], args.in[12], args.in[14], args.in[15]); }
    SEAM(0);
    if (IN(1)) {
        pg8::Gemm g{(const bf16_t*)(F.ws + WS_XB), (const bf16_t*)(F.ws + WS_WIN), T, NPROJ, D}; pg8::StaticOrder S; S.init(T, NPROJ, F.G, F.bid);
        pg8::EpiProj E{(bf16_t*)(F.ws + WS_GQ), (bf16_t*)(F.ws + WS_GK), (bf16_t*)(F.ws + WS_GV), (bf16_t*)(F.ws + WS_GR), (bf16_t*)(F.ws + WS_SQ), (bf16_t*)(F.ws + WS_SK), (bf16_t*)(F.ws + WS_SV),
                       (bf16_t*)F.out, (bf16_t*)F.out + (size_t)T * D, (const float*)(F.ws + WS_RSTD1)};
        pg8::gemm_phase<pg8::EpiProj, pg8::StaticOrder, PG8_ALIGN, PG8_SP2>(F.lds, g, S, E);
    }
    SEAM(1);
    if (IN(2)) { gla_local_phase(F, args.in[3], args.in[4]); swa_phase(F, args.in[6], args.in[7], args.in[8], args.in[9], (size_t)0); }
    SEAM(2);
    if (IN(3)) { gla_scan_phase(F); expert_convert(F, args.in[16], args.in[17], args.in[13]); }
    SEAM(3);
    if (IN(4)) { gla_out_phase(F, args.in[3], args.in[4], args.in[5]); }
    SEAM(4);
    if (IN(5)) {
        pg8::PairOrder S; S.base.init(T, D, F.G, F.bid);
        pg8::Gemm g{(const bf16_t*)(F.ws + WS_YG), (const bf16_t*)(F.ws + WS_WG), T, D, D, (const bf16_t*)(F.ws + WS_SQ), (const bf16_t*)(F.ws + WS_WS)};
        pg8::EpiMergeBoth E{{(const bf16_t*)F.out, (const bf16_t*)F.out + (size_t)T * D, (bf16_t*)(F.ws + WS_MRG)}, {(const bf16_t*)F.out, (const bf16_t*)F.out + (size_t)T * D, (bf16_t*)(F.ws + WS_MRG)}};
        pg8::gemm_phase<pg8::EpiMergeBoth, pg8::PairOrder, PG8_ALIGN, PG8_SP2>(F.lds, g, S, E);
    }
    SEAM(5);
    if (IN(6)) {
        pg8::StaticOrder S; S.init(T, D, F.G, F.bid);
        pg8::Gemm g{(const bf16_t*)(F.ws + WS_MRG), (const bf16_t*)(F.ws + WS_WO), T, D, D};
        pg8::EpiOut E{(const bf16_t*)(F.ws + WS_XB), F.out, (bf16_t*)(F.ws + WS_HB2), (float*)(F.ws + WS_ROWSS2), T};
        pg8::gemm_phase<pg8::EpiOut, pg8::StaticOrder, PG8_ALIGN, PG8_SP2>(F.lds, g, S, E);
    }
    SEAM(6);
    if (IN(7)) {
        pg8::StaticOrder S; S.init(T, 2048, F.G, F.bid);
        pg8::Gemm g{(const bf16_t*)(F.ws + WS_HB2), (const bf16_t*)(F.ws + WS_WQ), T, 2048, D};
        pg8::EpiQ E{(const float*)(F.ws + WS_ROWSS2), (bf16_t*)(F.ws + WS_QP), T};
        pg8::gemm_phase<pg8::EpiQ, pg8::StaticOrder, PG8_ALIGN, PG8_SP2>(F.lds, g, S, E);
    }
    if (IN(7) && IN(8)) __syncthreads();
    if (IN(8)) {
        { const float* ROWSS = (const float*)(F.ws + WS_ROWSS2); float* RSTD2 = (float*)(F.ws + WS_RSTD2);
          for (int t = F.bid * NTHR + F.tid; t < T; t += F.G * NTHR) { float s = 0.f;
#pragma unroll
              for (int kk = 0; kk < 4; ++kk) { const f32x4 p4 = *(const f32x4*)(ROWSS + (size_t)t * 16 + 4 * kk); s += (p4.x + p4.y) + (p4.z + p4.w); }
              wt_st4(RSTD2 + t, rsqrtf(s * (1.f / 1024.f) + EPS)); } }
        peer_quant_phase(F);
        peer_topk_phase(F);
    }
    SEAM(8);
    if (IN(9)) { peer_down_phase(F); }
    SEAM(9);
    if (IN(10)) { peer_combine_phase(F); }
    SEAM(10);
    if (IN(11)) { peer_up_phase(F, F.out); }
#undef IN
#undef SEAM
}
}

extern "C" void kernel_launch(void* const* d_in, const int* in_sizes, int n_in, void* d_out, int out_size, void* d_ws, size_t ws_size, hipStream_t stream) {
    using namespace mk;
    static int grid = 0;
    if (grid == 0) {
        int dev_ = 0, cus = 0, per_cu = 0;
        if (hipGetDevice(&dev_) != hipSuccess || hipDeviceGetAttribute(&cus, hipDeviceAttributeMultiprocessorCount, dev_) != hipSuccess) { fprintf(stderr, "device query failed\n"); grid = -1; return; }
        if (hipFuncSetAttribute((const void*)mega, hipFuncAttributeMaxDynamicSharedMemorySize, LDS_BYTES) != hipSuccess) { fprintf(stderr, "hipFuncSetAttribute failed\n"); grid = -1; return; }
        if (hipOccupancyMaxActiveBlocksPerMultiprocessor(&per_cu, (const void*)mega, NTHR, LDS_BYTES) != hipSuccess || per_cu < 1) { fprintf(stderr, "occupancy query: %d\n", per_cu); per_cu = 1; }
        (void)hipGetLastError();
        grid = cus * 1;
        fprintf(stderr, "mega: cus %d per_cu %d grid %d\n", cus, per_cu, grid);
    }
    if (grid < 0) return;
    (void)hipMemsetAsync((char*)d_ws + WS_CTL, 0, CTL_ZERO_BYTES, stream);
    Args a{};
    for (int i = 0; i < 18; ++i) a.in[i] = (const float*)d_in[i];
    a.out = (float*)d_out; a.ws = (unsigned char*)d_ws; a.ph_lo = 0; a.ph_hi = 12;
    void* kargs[] = {&a};
    hipError_t e = hipLaunchCooperativeKernel((const void*)mega, dim3(grid), dim3(NTHR), kargs, LDS_BYTES, stream);
    if (e != hipSuccess) fprintf(stderr, "cooperative launch failed: %s\n", hipGetErrorString(e));
}
```

```cpp
#include <hip/hip_runtime.h>
#include <hip/hip_cooperative_groups.h>
#include <cstdio>
#include <cstdint>
#include <math.h>
namespace cg = cooperative_groups;
#ifndef WT_AUX
#define WT_AUX 0
#endif
typedef unsigned wt_u32x4 __attribute__((ext_vector_type(4)));
__device__ __forceinline__ __amdgpu_buffer_rsrc_t wt_rsrc(const void* base) { return __builtin_amdgcn_make_buffer_rsrc((void*)base, 0, 0x7FFFFFF0, 0x00020000); }
__device__ __forceinline__ void wt_st16(__amdgpu_buffer_rsrc_t r, unsigned byte_off, wt_u32x4 v) { __builtin_amdgcn_raw_buffer_store_b128(v, r, byte_off, 0, WT_AUX); }
typedef unsigned wt_u32x2 __attribute__((ext_vector_type(2)));
__device__ __forceinline__ void wt_st8(void* p, unsigned lo, unsigned hi) { if (WT_AUX) __hip_atomic_store((unsigned long long*)p, ((unsigned long long)hi << 32) | lo, __ATOMIC_RELAXED, __HIP_MEMORY_SCOPE_AGENT); else *(wt_u32x2*)p = (wt_u32x2){lo, hi}; }
__device__ __forceinline__ void wt_st4(float* p, float v) { if (WT_AUX) __hip_atomic_store(p, v, __ATOMIC_RELAXED, __HIP_MEMORY_SCOPE_AGENT); else *p = v; }
__device__ __forceinline__ void wtx_st16(__amdgpu_buffer_rsrc_t r, unsigned byte_off, wt_u32x4 v) { __builtin_amdgcn_raw_buffer_store_b128(v, r, byte_off, 0, 16); }
__device__ __forceinline__ void wtx_st8(void* p, unsigned lo, unsigned hi) { __hip_atomic_store((unsigned long long*)p, ((unsigned long long)hi << 32) | lo, __ATOMIC_RELAXED, __HIP_MEMORY_SCOPE_AGENT); }
__device__ __forceinline__ void wtx_st4(float* p, float v) { __hip_atomic_store(p, v, __ATOMIC_RELAXED, __HIP_MEMORY_SCOPE_AGENT); }
namespace pg8 {
#define PG8_LAS __attribute__((address_space(3)))
typedef unsigned short bf16_t;
typedef short bf16x8 __attribute__((ext_vector_type(8)));
typedef float f32x4 __attribute__((ext_vector_type(4)));
typedef unsigned u32x4 __attribute__((ext_vector_type(4)));
constexpr int BM = 256, BK = 64, HALF = 128, HTB = HALF * BK * 2  , STAGE_BYTES = 8 * HTB, NXCD = 8, WGM = 8;

__host__ __device__ __forceinline__ int lds_byte(int r, int c) { const int st = (r >> 4) * 2 + (c >> 5), rr = r & 15, cc = c & 31, ob = rr * 64 + cc * 2; return st * 1024 + (ob ^ (((ob >> 9) & 1) << 5)); }
__host__ __device__ __forceinline__ void stage_rc(int b, int& R, int& C) { const int st = b / 1024, sb = b % 1024, swz = sb ^ (((sb >> 9) & 1) << 5); R = (st >> 1) * 16 + swz / 64; C = (st & 1) * 32 + (swz % 64) / 2; }
__host__ __device__ __forceinline__ int perm32(int rho) { const int n = rho >> 4, i = rho & 15; return 8 * (i >> 2) + 4 * n + (i & 3); }

struct Unit { int pm, pn, sel; };
struct Gemm { const bf16_t* A; const bf16_t* Bt; int M, N, K; const bf16_t* A2; const bf16_t* Bt2; };

struct StaticOrder {
    int nM, nN, nwg, G, c;
    __host__ __device__ void init(int M, int N, int G_, int c_) { nM = M / BM; nN = N / BM; nwg = nM * nN; G = G_; c = c_; }
    __host__ __device__ bool next(int i, Unit& u) const {
        const long L = (long)i * G + c; if (L >= nwg) return false;
        int wgid = (int)L; { const int q = nwg / NXCD, r = nwg % NXCD, xcd = wgid % NXCD, off = wgid / NXCD; wgid = (xcd < r ? xcd * (q + 1) : r * (q + 1) + (xcd - r) * q) + off; }
        const int nig = WGM * nN, gid = wgid / nig, fm = gid * WGM, gsz = (nM - fm) < WGM ? (nM - fm) : WGM;
        u.pm = fm + ((wgid % nig) % gsz); u.pn = (wgid % nig) / gsz; u.sel = 0; return true;
    }
    __device__ __forceinline__ void a_ready(const Unit&) const {}
    __device__ __forceinline__ void done(const Unit&) const {}
    __device__ __forceinline__ bool keep(const Unit&) const { return false; }
};

__device__ __forceinline__ unsigned cvt_pk_bf16(float lo, float hi) { unsigned r; asm volatile("v_cvt_pk_bf16_f32 %0, %1, %2" : "=v"(r) : "v"(lo), "v"(hi)); return r; }
typedef float f32x2 __attribute__((ext_vector_type(2)));
__device__ __forceinline__ f32x2 gelu_pk(f32x2 v) {
    const f32x2 av = __builtin_elementwise_abs(v), d = av * 0.2316418882f + 1.0f;
    f32x2 t; t.x = __builtin_amdgcn_rcpf(d.x); t.y = __builtin_amdgcn_rcpf(d.y);
    f32x2 q = t * 0.5307027145f + (-0.7265760135f); q = q * t + 0.7107068705f; q = q * t + (-0.142248368f); q = q * t + 0.127414796f; q = q * t;
    const f32x2 s = (v * v) * (-0.72134752044f);
    f32x2 e; e.x = __builtin_amdgcn_exp2f(s.x); e.y = __builtin_amdgcn_exp2f(s.y);
    const f32x2 m = v * (q * e), r = v - m;
    f32x2 o; o.x = v.x < 0.f ? m.x : r.x; o.y = v.y < 0.f ? m.y : r.y; return o;
}

template <int ACT  > struct EpiBf16 {
    static constexpr bool PERM = true, AFTER_DRAIN = false; static_assert(ACT == 0 || ACT == 1, "EpiBf16: ACT is 0 (none) or 1 (gelu_pk)");
    bf16_t* O; int ldc; const float* bias; int split_cols; size_t split_stride; float scale0;
    __device__ __forceinline__ void operator()(const f32x4 (&acc)[2][2][4][2], const Unit& u, int wr, int wc, int fr, int fq) const {
        const int row0 = u.pm * BM + wr * 64 + fr; int colt = u.pn * BM; bf16_t* base = O;
        float sc = 1.f; if (split_cols) { const int t = colt / split_cols; base += (size_t)t * split_stride; colt -= t * split_cols; if (t == 0) sc = scale0; }
        const int col0 = colt + wc * 32 + 8 * fq, bcol0 = u.pn * BM + wc * 32 + 8 * fq;
        f32x4 bv[2][2];
#pragma unroll
        for (int bj = 0; bj < 2; ++bj)
#pragma unroll
            for (int n = 0; n < 2; ++n) bv[bj][n] = bias ? *(const f32x4*)(bias + bcol0 + bj * HALF + 4 * n) : (f32x4){0.f, 0.f, 0.f, 0.f};
#pragma unroll
        for (int ai = 0; ai < 2; ++ai)
#pragma unroll
            for (int m = 0; m < 4; ++m) { bf16_t* rowp = base + (size_t)(row0 + ai * HALF + m * 16) * ldc + col0;
#pragma unroll
                for (int bj = 0; bj < 2; ++bj) { f32x4 v0 = acc[ai][bj][m][0] + bv[bj][0], v1 = acc[ai][bj][m][1] + bv[bj][1];
                    if (ACT == 1) { f32x2 a = gelu_pk((f32x2){v0[0], v0[1]}), b = gelu_pk((f32x2){v0[2], v0[3]}), c = gelu_pk((f32x2){v1[0], v1[1]}), d = gelu_pk((f32x2){v1[2], v1[3]});
                        v0 = (f32x4){a.x, a.y, b.x, b.y}; v1 = (f32x4){c.x, c.y, d.x, d.y}; }
                    v0 = v0 * sc; v1 = v1 * sc; u32x4 w; w.x = cvt_pk_bf16(v0[0], v0[1]); w.y = cvt_pk_bf16(v0[2], v0[3]); w.z = cvt_pk_bf16(v1[0], v1[1]); w.w = cvt_pk_bf16(v1[2], v1[3]);
                    *(u32x4*)(rowp + bj * HALF) = w; } }
    }
};
__device__ __forceinline__ float sigm_fast(float v) { return __builtin_amdgcn_rcpf(1.0f + __builtin_amdgcn_exp2f(v * -1.4426950408889634f)); }
struct EpiProj {
    static constexpr bool PERM = true, AFTER_DRAIN = false;
    bf16_t *GQ, *GK, *GV, *GR, *SQ, *SK, *SV, *GA, *GB; const float* rstd;
    __device__ __forceinline__ void operator()(const f32x4 (&acc)[2][2][4][2], const Unit& u, int wr, int wc, int fr, int fq) const {
        const int pn = u.pn; bf16_t* base; int ldc, act = 0;
        if (pn < 2) { base = GQ + pn * 256; ldc = 512; }
        else if (pn < 4) { base = GK + (pn - 2) * 256; ldc = 512; }
        else if (pn < 8) { base = GV + (pn - 4) * 256; ldc = 1024; }
        else if (pn < 12) { base = GR + (pn - 8) * 256; ldc = 1024; act = 1; }
        else if (pn < 16) { base = SQ + (pn - 12) * 256; ldc = 1024; }
        else if (pn == 16) { base = SK; ldc = 256; }
        else if (pn == 17) { base = SV; ldc = 256; }
        else if (pn < 22) { base = GA + (pn - 18) * 256; ldc = 1024; act = 2; }
        else { base = GB + (pn - 22) * 256; ldc = 1024; act = 2; }
        const int row0 = u.pm * BM + wr * 64 + fr, col0 = wc * 32 + 8 * fq;
        const __amdgpu_buffer_rsrc_t rs_ = wt_rsrc(base);
#pragma unroll
        for (int ai = 0; ai < 2; ++ai)
#pragma unroll
            for (int m = 0; m < 4; ++m) { const int row = row0 + ai * HALF + m * 16; const float rs = rstd[row]; const unsigned rowoff = (unsigned)(((size_t)row * ldc + col0) * 2);
#pragma unroll
                for (int bj = 0; bj < 2; ++bj) { f32x4 v0 = acc[ai][bj][m][0] * rs, v1 = acc[ai][bj][m][1] * rs;
                    if (act) {
#pragma unroll
                        for (int e = 0; e < 4; ++e) { const float s0 = sigm_fast(v0[e]), s1 = sigm_fast(v1[e]); v0[e] = (act == 1) ? v0[e] * s0 : s0; v1[e] = (act == 1) ? v1[e] * s1 : s1; } }
                    u32x4 w; w.x = cvt_pk_bf16(v0[0], v0[1]); w.y = cvt_pk_bf16(v0[2], v0[3]); w.z = cvt_pk_bf16(v1[0], v1[1]); w.w = cvt_pk_bf16(v1[2], v1[3]);
                    wt_st16(rs_, rowoff + bj * HALF * 2, w); } }
    }
};

__device__ __forceinline__ void bf8_to_f32(const u32x4 raw, float (&f)[8]) {
#pragma unroll
    for (int j = 0; j < 4; ++j) { f[2 * j] = __builtin_bit_cast(float, raw[j] << 16); f[2 * j + 1] = __builtin_bit_cast(float, raw[j] & 0xffff0000u); }
}
template <int STEP> struct EpiMerge {
    static constexpr bool PERM = true, AFTER_DRAIN = false;
    const bf16_t* ga; const bf16_t* gb; bf16_t* outp;
    __device__ __forceinline__ void operator()(f32x4 (&acc)[2][2][4][2], const Unit& u, int wr, int wc, int fr, int fq) const {
        const int row0 = u.pm * BM + wr * 64 + fr, col0 = u.pn * BM + wc * 32 + 8 * fq;
        const __amdgpu_buffer_rsrc_t dst_r = wt_rsrc(outp);
#pragma unroll
        for (int ai = 0; ai < 2; ++ai)
#pragma unroll
            for (int m = 0; m < 4; ++m) { const size_t rb = (size_t)(row0 + ai * HALF + m * 16) * 1024 + col0;
#pragma unroll
                for (int bj = 0; bj < 2; ++bj) { const size_t off = rb + bj * HALF;
                    float b[8]; bf8_to_f32(*(const u32x4*)(gb + off), b);
                    if (STEP == 0) { float a[8]; bf8_to_f32(*(const u32x4*)(ga + off), a);
#pragma unroll
                        for (int e = 0; e < 4; ++e) { acc[ai][bj][m][0][e] *= a[e] * __builtin_amdgcn_rcpf(fmaxf(b[e], 1e-30f)); acc[ai][bj][m][1][e] *= a[4 + e] * __builtin_amdgcn_rcpf(fmaxf(b[4 + e], 1e-30f)); }
                    } else {
                        float v[8];
#pragma unroll
                        for (int e = 0; e < 4; ++e) { v[e] = acc[ai][bj][m][0][e] * fmaxf(b[e], 1e-30f); v[4 + e] = acc[ai][bj][m][1][e] * fmaxf(b[4 + e], 1e-30f); }
                        u32x4 w; w.x = cvt_pk_bf16(v[0], v[1]); w.y = cvt_pk_bf16(v[2], v[3]); w.z = cvt_pk_bf16(v[4], v[5]); w.w = cvt_pk_bf16(v[6], v[7]);
                        wt_st16(dst_r, (unsigned)(off * 2), w); } } }
    }
};
struct EpiOut {
    static constexpr bool PERM = true, AFTER_DRAIN = false;
    const bf16_t* x; float* h1; bf16_t* hb; float* rowss; int M;
    __device__ __forceinline__ void operator()(const f32x4 (&acc)[2][2][4][2], const Unit& u, int wr, int wc, int fr, int fq) const {
        const int row0 = u.pm * BM + wr * 64 + fr, col0 = u.pn * BM + wc * 32 + 8 * fq;
        const __amdgpu_buffer_rsrc_t hb_r = wt_rsrc(hb);
#pragma unroll
        for (int ai = 0; ai < 2; ++ai)
#pragma unroll
            for (int m = 0; m < 4; ++m) { const int row = row0 + ai * HALF + m * 16; const size_t rb = (size_t)row * 1024 + col0; float ss = 0.f;
#pragma unroll
                for (int bj = 0; bj < 2; ++bj) { const size_t off = rb + bj * HALF;
                    const u32x4 xw = *(const u32x4*)(x + off);
                    f32x4 x0, x1; x0[0] = __uint_as_float(xw.x << 16); x0[1] = __uint_as_float(xw.x & 0xffff0000u); x0[2] = __uint_as_float(xw.y << 16); x0[3] = __uint_as_float(xw.y & 0xffff0000u);
                    x1[0] = __uint_as_float(xw.z << 16); x1[1] = __uint_as_float(xw.z & 0xffff0000u); x1[2] = __uint_as_float(xw.w << 16); x1[3] = __uint_as_float(xw.w & 0xffff0000u);
                    const f32x4 v0 = acc[ai][bj][m][0] + x0, v1 = acc[ai][bj][m][1] + x1;
                    u32x4 w; w.x = cvt_pk_bf16(v0[0], v0[1]); w.y = cvt_pk_bf16(v0[2], v0[3]); w.z = cvt_pk_bf16(v1[0], v1[1]); w.w = cvt_pk_bf16(v1[2], v1[3]);
                    wt_st16(hb_r, (unsigned)(off * 2), w);
                    ss += (v0[0] * v0[0] + v0[1] * v0[1]) + (v0[2] * v0[2] + v0[3] * v0[3]) + (v1[0] * v1[0] + v1[1] * v1[1]) + (v1[2] * v1[2] + v1[3] * v1[3]); }
                ss += __shfl_xor(ss, 16); ss += __shfl_xor(ss, 32);
                if (fq == 0) wt_st4(rowss + (size_t)row * 16 + u.pn * 4 + wc, ss); }
    }
};
struct EpiQ {
    static constexpr bool PERM = true, AFTER_DRAIN = false;
    const float* rowss; bf16_t* qp; int M;
    __device__ __forceinline__ void operator()(const f32x4 (&acc)[2][2][4][2], const Unit& u, int wr, int wc, int fr, int fq) const {
        const int row0 = u.pm * BM + wr * 64 + fr, col0 = u.pn * BM + wc * 32 + 8 * fq;
        const __amdgpu_buffer_rsrc_t qp_r = wt_rsrc(qp);
#pragma unroll
        for (int ai = 0; ai < 2; ++ai)
#pragma unroll
            for (int m = 0; m < 4; ++m) { const int row = row0 + ai * HALF + m * 16; float s = 0.f;
#pragma unroll
                for (int k = 0; k < 4; ++k) { const f32x4 p4 = *(const f32x4*)(rowss + (size_t)row * 16 + 4 * k); s += (p4[0] + p4[1]) + (p4[2] + p4[3]); }
                const float rs = rsqrtf(s * (1.f / 1024.f) + 1e-6f);
#pragma unroll
                for (int bj = 0; bj < 2; ++bj) { const f32x4 v0 = acc[ai][bj][m][0] * rs, v1 = acc[ai][bj][m][1] * rs;
                    u32x4 w; w.x = cvt_pk_bf16(v0[0], v0[1]); w.y = cvt_pk_bf16(v0[2], v0[3]); w.z = cvt_pk_bf16(v1[0], v1[1]); w.w = cvt_pk_bf16(v1[2], v1[3]);
                    wt_st16(qp_r, (unsigned)(((size_t)row * 2048 + col0 + bj * HALF) * 2), w); } }
    }
};

struct PairOrder {
    StaticOrder base;
    __device__ bool next(int i, Unit& u) const { const bool ok = base.next(i >> 1, u); u.sel = i & 1; return ok; }
    __device__ __forceinline__ void a_ready(const Unit&) const {}
    __device__ __forceinline__ void done(const Unit&) const {}
    __device__ __forceinline__ bool keep(const Unit& u) const { return u.sel == 0; }
};
struct EpiMergeBoth {
    static constexpr bool PERM = true, AFTER_DRAIN = false;
    EpiMerge<0> e0; EpiMerge<1> e1;
    __device__ __forceinline__ void operator()(f32x4 (&acc)[2][2][4][2], const Unit& u, int wr, int wc, int fr, int fq) const { if (u.sel == 0) e0(acc, u, wr, wc, fr, fq); else e1(acc, u, wr, wc, fr, fq); }
};
template <class Epi, class Sched, bool ALIGN_EPI = false, bool SP2 = false>
__device__ __forceinline__ void gemm_phase(PG8_LAS unsigned char* lds, const Gemm g, const Sched& S, const Epi& E) {
    const int tid = threadIdx.x, wid = __builtin_amdgcn_readfirstlane(tid >> 6), lane = tid & 63, wr = wid >> 2, wc = wid & 3, fr = lane & 15, fq = lane >> 4;
    const int K = g.K, nt = K / BK;
    unsigned voffA[2], voffB[2];
#pragma unroll
    for (int i = 0; i < 2; ++i) { int R, C; stage_rc(tid * 16 + i * 8192, R, C); const int Rb = Epi::PERM ? ((R & ~31) + perm32(R & 31)) : R;
        voffA[i] = (unsigned)(R * K + C) * 2u; voffB[i] = (unsigned)(Rb * K + C) * 2u; }
    const size_t kstep = (size_t)(BK * 2);
    const size_t hstep = (size_t)HALF * K * 2;
    const size_t tstep = 2 * hstep;
    const unsigned ldsw = (unsigned)wid * 1024u;
    const int aoff = lds_byte(wr * 64 + fr, fq * 8), boff = lds_byte(wc * 32 + fr, fq * 8);
#define PG8_SA(b, h) (((b) * 2 + (h)) * HTB)
#define PG8_SB(b, h) ((4 + (b) * 2 + (h)) * HTB)
#define PG8_STAGE(bufoff, gbase, voff) do { _Pragma("unroll") for (int _i = 0; _i < 2; ++_i) \
        __builtin_amdgcn_global_load_lds((const unsigned*)((const char*)(gbase) + (voff)[_i]), (PG8_LAS unsigned*)(lds + (bufoff) + ldsw + _i * 8192), 16, 0, 0); } while (0)
#define PG8_LDA(dst, b, h) do { _Pragma("unroll") for (int m = 0; m < 4; ++m) _Pragma("unroll") for (int k = 0; k < 2; ++k) dst[m][k] = *(const PG8_LAS bf16x8*)(lds + PG8_SA(b, h) + aoff + m * 2048 + k * 1024); } while (0)
#define PG8_LDB(dst, b, h) do { _Pragma("unroll") for (int n = 0; n < 2; ++n) _Pragma("unroll") for (int k = 0; k < 2; ++k) dst[n][k] = *(const PG8_LAS bf16x8*)(lds + PG8_SB(b, h) + boff + n * 2048 + k * 1024); } while (0)
#define PG8_MMA(ai, bj, At, Bt) do { __builtin_amdgcn_s_setprio(1); _Pragma("unroll") for (int m = 0; m < 4; ++m) _Pragma("unroll") for (int n = 0; n < 2; ++n) _Pragma("unroll") for (int k = 0; k < 2; ++k) \
        acc[ai][bj][m][n] = __builtin_amdgcn_mfma_f32_16x16x32_bf16(Bt[n][k], At[m][k], acc[ai][bj][m][n], 0, 0, 0); __builtin_amdgcn_s_setprio(0); } while (0)
#define PG8_WAIT_V(n) asm volatile("s_waitcnt vmcnt(" #n ")" ::: "memory")
#define PG8_WAIT_L(n) asm volatile("s_waitcnt lgkmcnt(" #n ")" ::: "memory")
#define PG8_BAR __builtin_amdgcn_s_barrier()
#define PG8_SCHED __builtin_amdgcn_sched_barrier(0)
    Unit cur, nxt; int ui = 0;
    if (!S.next(0, cur)) return;
    f32x4 acc[2][2][4][2];
#pragma unroll
    for (int a = 0; a < 2; ++a)
#pragma unroll
        for (int b = 0; b < 2; ++b)
#pragma unroll
            for (int m = 0; m < 4; ++m)
#pragma unroll
                for (int n = 0; n < 2; ++n) acc[a][b][m][n] = (f32x4){0.f, 0.f, 0.f, 0.f};
    bf16x8 At[4][2], B0[2][2], B1[2][2];
    const char* cA = (const char*)(cur.sel ? g.A2 : g.A) + (size_t)cur.pm * tstep; const char* cB = (const char*)(cur.sel ? g.Bt2 : g.Bt) + (size_t)cur.pn * tstep;
    S.a_ready(cur);
    if constexpr (SP2) {
        PG8_STAGE(PG8_SB(0, 0), cB, voffB); PG8_STAGE(PG8_SB(0, 1), cB + hstep, voffB); PG8_STAGE(PG8_SA(0, 0), cA, voffA); PG8_STAGE(PG8_SA(0, 1), cA + hstep, voffA);
        if (wr == 1) PG8_BAR;
        PG8_WAIT_V(2); PG8_BAR;
        PG8_STAGE(PG8_SB(1, 0), cB + kstep, voffB); PG8_STAGE(PG8_SA(1, 0), cA + kstep, voffA); PG8_STAGE(PG8_SB(1, 1), cB + hstep + kstep, voffB);
        PG8_WAIT_V(6); PG8_BAR;
    } else {
        PG8_STAGE(PG8_SB(0, 0), cB, voffB); PG8_STAGE(PG8_SA(0, 0), cA, voffA); PG8_STAGE(PG8_SB(0, 1), cB + hstep, voffB); PG8_STAGE(PG8_SA(0, 1), cA + hstep, voffA);
        if (wr == 1) PG8_BAR;
        PG8_WAIT_V(4); PG8_BAR;
        PG8_STAGE(PG8_SB(1, 0), cB + kstep, voffB); PG8_STAGE(PG8_SA(1, 0), cA + kstep, voffA); PG8_STAGE(PG8_SB(1, 1), cB + hstep + kstep, voffB);
        PG8_WAIT_V(6); PG8_BAR;
    }
    for (;;) {
        const bool has_next = S.next(ui + 1, nxt);
        const char* nA = has_next ? (const char*)(nxt.sel ? g.A2 : g.A) + (size_t)nxt.pm * tstep : cA; const char* nB = has_next ? (const char*)(nxt.sel ? g.Bt2 : g.Bt) + (size_t)nxt.pn * tstep : cB;
        for (int t = 0; t < nt; t += 2) {
            const bool last = (t == nt - 2);
            const char* a1 = cA + (size_t)(t + 1) * kstep;
            const char* a2 = last ? nA : cA + (size_t)(t + 2) * kstep; const char* b2 = last ? nB : cB + (size_t)(t + 2) * kstep;
            const char* a3 = a2 + kstep; const char* b3 = b2 + kstep;
            if (last && has_next) S.a_ready(nxt);
            if constexpr (SP2) {
            PG8_LDB(B0, 0, 0); PG8_LDB(B1, 0, 1); PG8_SCHED; PG8_LDA(At, 0, 0); PG8_STAGE(PG8_SA(1, 1), a1 + hstep, voffA);
            PG8_WAIT_V(8); PG8_WAIT_L(0); PG8_BAR; PG8_MMA(0, 0, At, B0); PG8_MMA(0, 1, At, B1); PG8_BAR; PG8_SCHED;
            PG8_LDA(At, 0, 1); PG8_STAGE(PG8_SB(0, 0), b2, voffB); PG8_STAGE(PG8_SB(0, 1), b2 + hstep, voffB); PG8_STAGE(PG8_SA(0, 0), a2, voffA);
            PG8_WAIT_V(8); PG8_WAIT_L(0); PG8_BAR; PG8_MMA(1, 0, At, B0); PG8_MMA(1, 1, At, B1); PG8_BAR; PG8_SCHED;
            PG8_LDB(B0, 1, 0); PG8_LDB(B1, 1, 1); PG8_SCHED; PG8_LDA(At, 1, 0); PG8_STAGE(PG8_SA(0, 1), a2 + hstep, voffA);
            PG8_WAIT_V(8); PG8_WAIT_L(0); PG8_BAR; PG8_MMA(0, 0, At, B0); PG8_MMA(0, 1, At, B1); PG8_BAR; PG8_SCHED;
            PG8_LDA(At, 1, 1); PG8_STAGE(PG8_SB(1, 0), b3, voffB); PG8_STAGE(PG8_SB(1, 1), b3 + hstep, voffB); PG8_STAGE(PG8_SA(1, 0), a3, voffA);
            PG8_WAIT_V(8); PG8_WAIT_L(0); PG8_BAR; PG8_MMA(1, 0, At, B0); PG8_MMA(1, 1, At, B1); PG8_BAR; PG8_SCHED;
            } else {
            PG8_LDB(B0, 0, 0); PG8_SCHED; PG8_LDA(At, 0, 0); PG8_STAGE(PG8_SA(1, 1), a1 + hstep, voffA);
            PG8_WAIT_L(8); PG8_BAR; PG8_WAIT_L(0); PG8_MMA(0, 0, At, B0); PG8_BAR; PG8_SCHED;
            PG8_LDB(B1, 0, 1); PG8_STAGE(PG8_SB(0, 0), b2, voffB);
            PG8_BAR; PG8_WAIT_L(0); PG8_MMA(0, 1, At, B1); PG8_BAR;
            PG8_LDA(At, 0, 1); PG8_STAGE(PG8_SA(0, 0), a2, voffA);
            PG8_BAR; PG8_WAIT_L(0); PG8_MMA(1, 0, At, B0); PG8_BAR; PG8_SCHED;
            PG8_STAGE(PG8_SB(0, 1), b2 + hstep, voffB);
            PG8_WAIT_V(6); PG8_BAR; PG8_MMA(1, 1, At, B1); PG8_BAR;
            PG8_LDB(B0, 1, 0); PG8_SCHED; PG8_LDA(At, 1, 0); PG8_STAGE(PG8_SA(0, 1), a2 + hstep, voffA);
            PG8_WAIT_L(8); PG8_BAR; PG8_WAIT_L(0); PG8_MMA(0, 0, At, B0); PG8_BAR; PG8_SCHED;
            PG8_LDB(B1, 1, 1); PG8_STAGE(PG8_SB(1, 0), b3, voffB);
            PG8_BAR; PG8_WAIT_L(0); PG8_MMA(0, 1, At, B1); PG8_BAR;
            PG8_LDA(At, 1, 1); PG8_STAGE(PG8_SA(1, 0), a3, voffA);
            PG8_BAR; PG8_WAIT_L(0); PG8_MMA(1, 0, At, B0); PG8_BAR; PG8_SCHED;
            PG8_STAGE(PG8_SB(1, 1), b3 + hstep, voffB);
            PG8_WAIT_V(6); PG8_BAR; PG8_MMA(1, 1, At, B1); PG8_BAR;
            }
        }
        if constexpr (ALIGN_EPI) { if (wr == 0) PG8_BAR; }
        if constexpr (!Epi::AFTER_DRAIN) { E(acc, cur, wr, wc, fr, fq); S.done(cur); }
        if (!has_next) break;
        if (!S.keep(cur)) {
#pragma unroll
        for (int a = 0; a < 2; ++a)
#pragma unroll
            for (int b = 0; b < 2; ++b)
#pragma unroll
                for (int m = 0; m < 4; ++m)
#pragma unroll
                    for (int n = 0; n < 2; ++n) acc[a][b][m][n] = (f32x4){0.f, 0.f, 0.f, 0.f};
        }
        cur = nxt; cA = nA; cB = nB; ++ui;
        if constexpr (ALIGN_EPI) { if (wr == 1) PG8_BAR; }
    }
    PG8_WAIT_V(0);
    if constexpr (!ALIGN_EPI) { if (wr == 0) PG8_BAR; }
    PG8_BAR;
    if constexpr (Epi::AFTER_DRAIN) { E.fused(acc, cur, wr, wc, fr, fq, lds, wid, lane); S.done(cur); }
#undef PG8_SA
#undef PG8_SB
#undef PG8_STAGE
#undef PG8_LDA
#undef PG8_LDB
#undef PG8_MMA
#undef PG8_WAIT_V
#undef PG8_WAIT_L
#undef PG8_BAR
#undef PG8_SCHED
}
}
#define PG8_SP2 true
#define PG8_ALIGN true
namespace mk {
using pg8::bf16_t;
#define LAS __attribute__((address_space(3)))
typedef unsigned v4u __attribute__((ext_vector_type(4)));
typedef unsigned v2u __attribute__((ext_vector_type(2)));
typedef float f32x4 __attribute__((ext_vector_type(4)));
typedef float f32x16 __attribute__((ext_vector_type(16)));
typedef short bf16x8 __attribute__((ext_vector_type(8)));
typedef short bf16x4 __attribute__((ext_vector_type(4)));
constexpr int T = 32768, D = 1024, SEQ = 8192, NBATCH = 4, NPROJ = 6656, INW = 6672, C_GA = 3072;
constexpr float EPS = 1e-6f;
constexpr int NWAVES = 8, NTHR = 512;
constexpr int LDS_BYTES = 147456;
constexpr size_t MiB = 1u << 20;
constexpr size_t WS_CTL = 0, CTL_ZERO_BYTES = 1 * MiB;
constexpr size_t WS_RSTD1 = 1 * MiB, WS_ROWSS = WS_RSTD1 + 512 * 1024, WS_ALOW = 2 * MiB, WS_DSC = 4 * MiB, WS_SUBK = 5 * MiB;
constexpr size_t WS_WIN = 8 * MiB, WS_WG = 21 * MiB, WS_WS = 23 * MiB, WS_WO = 25 * MiB, WS_WQ = 27 * MiB;
constexpr size_t WS_XB = 32 * MiB, WS_MERGED = 32 * MiB;
constexpr size_t WS_GQ = 96 * MiB, WS_GK = 128 * MiB, WS_HB = 96 * MiB;
constexpr size_t WS_GV = 160 * MiB, WS_EXD = 160 * MiB, WS_EXU = 192 * MiB;
constexpr size_t WS_GR = 224 * MiB, WS_SQ = 288 * MiB, WS_QP = 224 * MiB;
constexpr size_t WS_SK = 448 * MiB, WS_SV = 464 * MiB,
                  WS_ST = 384 * MiB, WS_IDX = 448 * MiB, WS_GATE = 464 * MiB;
constexpr size_t WS_YG = 448 * MiB, WS_PART = 160 * MiB, WS_MRG = 96 * MiB, WS_HB2 = 160 * MiB, WS_EXD2 = 352 * MiB, WS_EXU2 = 384 * MiB, WS_ROWSS2 = 480 * MiB;

struct Args { const float* in[18]; float* out; unsigned char* ws; int ph_lo, ph_hi; };

__device__ __forceinline__ unsigned f2bf(float f) { unsigned u = __builtin_bit_cast(unsigned, f); return (u + 0x7fffu + ((u >> 16) & 1u)) >> 16; }
typedef float f32x2_t __attribute__((ext_vector_type(2))); typedef __bf16 bf16x2_t __attribute__((ext_vector_type(2)));
__device__ __forceinline__ unsigned pk2(float lo, float hi) { f32x2_t v = {lo, hi}; bf16x2_t b = __builtin_convertvector(v, bf16x2_t); return __builtin_bit_cast(unsigned, b); }
__device__ __forceinline__ float fexp(float x) { return __builtin_amdgcn_exp2f(x * 1.4426950408889634f); }
__device__ __forceinline__ float flog(float x) { return __builtin_amdgcn_logf(x) * 0.6931471805599453f; }
__device__ __forceinline__ float bf2f(unsigned short b) { return __builtin_bit_cast(float, (unsigned)b << 16); }
__device__ __forceinline__ float wave_sum(float v) {
#pragma unroll
    for (int o = 1; o < 64; o <<= 1) v += __shfl_xor(v, o);
    return v;
}
#define LDS_WAIT() asm volatile("s_waitcnt lgkmcnt(0)" ::: "memory")
#define VM_WAIT() asm volatile("s_waitcnt vmcnt(0)" ::: "memory")

struct Frame {
    LAS unsigned char* lds;
    int tid, lane, wave, G, bid;
    float* out; unsigned char* ws;
};

__device__ __forceinline__ void tr_item(const float* __restrict__ W, int ldw, int c0, int K, int nblk, const float* __restrict__ gain, bf16_t* WT, LAS float* scr, int item, int lane) {
    const int kb = item / nblk, nb = item % nblk, k0 = 64 * kb, n0 = 32 * nb;
    const __amdgpu_buffer_rsrc_t wt_r = wt_rsrc(WT);
    const int c = lane & 7;
    f32x4 g0 = {1.f, 1.f, 1.f, 1.f}, g1 = g0;
    if (gain) { g0 = *(const f32x4*)(gain + k0 + 8 * c); g1 = *(const f32x4*)(gain + k0 + 8 * c + 4); }
    float v[32];
    const float* src = W + (size_t)(k0 + (lane >> 5)) * ldw + c0 + n0 + (lane & 31);
#pragma unroll
    for (int i = 0; i < 32; ++i) v[i] = src[(size_t)(2 * i) * ldw];
#pragma unroll
    for (int i = 0; i < 32; ++i) scr[(2 * i + (lane >> 5)) * 33 + (lane & 31)] = v[i];
    LDS_WAIT(); asm volatile("" ::: "memory");
#pragma unroll
    for (int j = 0; j < 4; ++j) { const int n = (lane >> 3) + 8 * j; const LAS float* s = scr + (8 * c) * 33 + n;
        v4u o; o.x = pk2(s[0 * 33] * g0.x, s[1 * 33] * g0.y); o.y = pk2(s[2 * 33] * g0.z, s[3 * 33] * g0.w); o.z = pk2(s[4 * 33] * g1.x, s[5 * 33] * g1.y); o.w = pk2(s[6 * 33] * g1.z, s[7 * 33] * g1.w);
        wt_st16(wt_r, (unsigned)(((size_t)(n0 + n) * K + k0 + 8 * c) * 2), o); }
    LDS_WAIT(); asm volatile("" ::: "memory");
}

__device__ __forceinline__ void p0_prologue(Frame& F, const float* x, const float* gain1, const float* w_in, const float* gain2, const float* wbg, const float* wbs, const float* wout, const float* wq, const float* subk) {
    LAS unsigned char* wb = F.lds;
    LAS float* scr = (LAS float*)(F.lds + 65536 + F.wave * 8704);
    { f32x4 wv[8]; float gk[8];
#pragma unroll
      for (int j = 0; j < 8; ++j) { const int idx = F.tid + NTHR * j, k = idx >> 2; wv[j] = *(const f32x4*)(w_in + (size_t)k * INW + C_GA + 4 * (idx & 3)); gk[j] = gain1[k]; }
#pragma unroll
      for (int j = 0; j < 8; ++j) { const int idx = F.tid + NTHR * j, k = idx >> 2;
#pragma unroll
          for (int e = 0; e < 4; ++e) { const int r = 4 * (idx & 3) + e; const float v = gk[j] * wv[j][e];
              const unsigned h = f2bf(v), l = f2bf(v - __builtin_bit_cast(float, h << 16));
              const int off = (((k >> 5) * 64 + ((k >> 3) & 3) * 16 + r) * 16) + 2 * (k & 7);
              *(LAS unsigned short*)(wb + off) = (unsigned short)h; *(LAS unsigned short*)(wb + 32768 + off) = (unsigned short)l; } } }
    __syncthreads();
    const int gw = F.bid * 4 + (F.wave & 3), NGW = F.G * 4, lane = F.lane;
    bf16_t* XB = (bf16_t*)(F.ws + WS_XB); float* RSTD1 = (float*)(F.ws + WS_RSTD1); float* ALOW = (float*)(F.ws + WS_ALOW);
    const __amdgpu_buffer_rsrc_t xb_r = wt_rsrc(XB);
    if (F.wave < 4) for (int g = gw; g < T / 16; g += NGW) {
        const int m = g * 16 + (lane & 15), q = lane >> 4;
        const float* xr = x + (size_t)m * D + 8 * q;
        f32x4 acc = {0.f, 0.f, 0.f, 0.f}; float ss = 0.f;
        for (int s0 = 0; s0 < 32; s0 += 8) {
            asm volatile("" ::: "memory");
            f32x4 a[8][2];
#pragma unroll
            for (int i = 0; i < 8; ++i) { a[i][0] = *(const f32x4*)(xr + 32 * (s0 + i)); a[i][1] = *(const f32x4*)(xr + 32 * (s0 + i) + 4); }
#pragma unroll
            for (int i = 0; i < 8; ++i) { const f32x4 a0 = a[i][0], a1 = a[i][1];
                ss += ((a0.x * a0.x + a0.y * a0.y) + (a0.z * a0.z + a0.w * a0.w)) + ((a1.x * a1.x + a1.y * a1.y) + (a1.z * a1.z + a1.w * a1.w));
                v4u h; h.x = pk2(a0.x, a0.y); h.y = pk2(a0.z, a0.w); h.z = pk2(a1.x, a1.y); h.w = pk2(a1.z, a1.w);
                wt_st16(xb_r, (unsigned)(((size_t)m * D + 8 * q + 32 * (s0 + i)) * 2), h);
                v4u l;
                l.x = pk2(a0.x - __builtin_bit_cast(float, h.x << 16), a0.y - __builtin_bit_cast(float, h.x & 0xffff0000u));
                l.y = pk2(a0.z - __builtin_bit_cast(float, h.y << 16), a0.w - __builtin_bit_cast(float, h.y & 0xffff0000u));
                l.z = pk2(a1.x - __builtin_bit_cast(float, h.z << 16), a1.y - __builtin_bit_cast(float, h.z & 0xffff0000u));
                l.w = pk2(a1.z - __builtin_bit_cast(float, h.w << 16), a1.w - __builtin_bit_cast(float, h.w & 0xffff0000u));
                const bf16x8 wh = *(const LAS bf16x8*)(wb + ((s0 + i) * 64 + lane) * 16), wl = *(const LAS bf16x8*)(wb + 32768 + ((s0 + i) * 64 + lane) * 16);
                const bf16x8 xh = __builtin_bit_cast(bf16x8, h), xl = __builtin_bit_cast(bf16x8, l);
                acc = __builtin_amdgcn_mfma_f32_16x16x32_bf16(xh, wh, acc, 0, 0, 0);
                acc = __builtin_amdgcn_mfma_f32_16x16x32_bf16(xl, wh, acc, 0, 0, 0);
                acc = __builtin_amdgcn_mfma_f32_16x16x32_bf16(xh, wl, acc, 0, 0, 0); }
        }
        ss += __shfl_xor(ss, 16); ss += __shfl_xor(ss, 32);
        const float rstd = rsqrtf(ss * (1.f / D) + EPS);
#pragma unroll
        for (int i = 0; i < 4; ++i) { const float rs = __shfl(rstd, 4 * q + i); wt_st4(ALOW + (size_t)(g * 16 + 4 * q + i) * 16 + (lane & 15), acc[i] * rs); }
        if (lane < 16) wt_st4(RSTD1 + m, rstd);
    }
    constexpr int I_IN1 = 16 * 96, I_IN2 = 16 * 112, I_SQ = 16 * 32, I_Q = 16 * 64;
    constexpr int NITEMS = I_IN1 + I_IN2 + 3 * I_SQ + I_Q;
    bf16_t* WIN = (bf16_t*)(F.ws + WS_WIN);
    if (F.wave >= 4) for (int it = gw; it < NITEMS; it += NGW) {
        int r = it;
        if (r < I_IN1) { tr_item(w_in, INW, 0, D, 96, gain1, WIN, scr, r, lane); continue; } r -= I_IN1;
        if (r < I_IN2) { tr_item(w_in, INW, 3088, D, 112, gain1, WIN + (size_t)3072 * D, scr, r, lane); continue; } r -= I_IN2;
        if (r < I_SQ) { tr_item(wbg, D, 0, D, 32, nullptr, (bf16_t*)(F.ws + WS_WG), scr, r, lane); continue; } r -= I_SQ;
        if (r < I_SQ) { tr_item(wbs, D, 0, D, 32, nullptr, (bf16_t*)(F.ws + WS_WS), scr, r, lane); continue; } r -= I_SQ;
        if (r < I_SQ) { tr_item(wout, D, 0, D, 32, nullptr, (bf16_t*)(F.ws + WS_WO), scr, r, lane); continue; } r -= I_SQ;
        tr_item(wq, 2048, 0, D, 64, gain2, (bf16_t*)(F.ws + WS_WQ), scr, r, lane);
    }
    { const f32x4* sk = (const f32x4*)subk; v2u* o = (v2u*)(F.ws + WS_SUBK);
      for (int i = F.bid * NTHR + F.tid; i < 8 * 2 * 128 * 128 / 4; i += F.G * NTHR) { const f32x4 v = sk[i]; wt_st8(o + i, pk2(v.x, v.y), pk2(v.z, v.w)); } }
}

constexpr int SWA_KROW = 144, SWA_VROW = 592;
constexpr int SWA_K_OFF = 0, SWA_V_OFF = 256 * SWA_KROW, SWA_TB_OFF = SWA_V_OFF + 64 * SWA_VROW, SWA_LDS = SWA_TB_OFF + 4 * 128 * 4;
__device__ __forceinline__ int t5_bucket(int rel) {
    if (rel < 16) return rel;
    int b = 16;
    b += (rel >= 19); b += (rel >= 21); b += (rel >= 24); b += (rel >= 27); b += (rel >= 31); b += (rel >= 35); b += (rel >= 40); b += (rel >= 46);
    b += (rel >= 52); b += (rel >= 59); b += (rel >= 67); b += (rel >= 77); b += (rel >= 87); b += (rel >= 99); b += (rel >= 113);
    return b;
}
__device__ __forceinline__ void swa_load_kv(const bf16_t* SK, const bf16_t* SV, int u, int tid, int lane, int wave, v4u (&kraw)[4], v4u (&vraw)[4]) {
    const int blk = u & 63, kvh = (u >> 6) & 3, b = u >> 8; const size_t mrow0 = (size_t)b * SEQ; const int t0 = blk * 128, c = tid & 7;
#pragma unroll
    for (int ps = 0; ps < 4; ++ps) {
        const int kjk = ps * 64 + (tid >> 3), posk = t0 - 128 + kjk; kraw[ps] = (v4u){0u, 0u, 0u, 0u};
        if (posk >= 0) kraw[ps] = *(const v4u*)(SK + (mrow0 + posk) * 256 + kvh * 64 + 8 * c);
        const int kjv = ps * 64 + lane, posv = t0 - 128 + kjv; vraw[ps] = (v4u){0u, 0u, 0u, 0u};
        if (posv >= 0) vraw[ps] = *(const v4u*)(SV + (mrow0 + posv) * 256 + kvh * 64 + 8 * wave);
    }
}
__device__ __forceinline__ void swa_phase(Frame& F, const float* qgain, const float* kgain, const float* sinks, const float* rel_bias, size_t ydelta) {
    const bf16_t* SK = (const bf16_t*)(F.ws + WS_SK); const bf16_t* SV = (const bf16_t*)(F.ws + WS_SV); bf16_t* SQ = (bf16_t*)(F.ws + WS_SQ);
    LAS unsigned char* Kn = F.lds + SWA_K_OFF; LAS unsigned char* Vt = F.lds + SWA_V_OFF; LAS float* tb = (LAS float*)(F.lds + SWA_TB_OFF);
    const int tid = F.tid, lane = F.lane, wave = F.wave, l15 = lane & 15, q4 = lane >> 4;
    if (tid < 256) { const int d = tid >> 2, c = tid & 3; *(LAS v4u*)(Vt + d * SWA_VROW + 512 + 16 * c) = (v4u){0u, 0u, 0u, 0u}; }
    v4u kraw[4], vraw[4];
    if (F.bid < 1024) swa_load_kv(SK, SV, F.bid, tid, lane, wave, kraw, vraw);
    for (int u = F.bid; u < 1024; u += F.G) {
        const int blk = u & 63, kvh = (u >> 6) & 3, b = u >> 8;
        const size_t mrow0 = (size_t)b * SEQ; const int t0 = blk * 128;
        const int g = wave >> 1, qh = wave & 1, h = kvh * 4 + g;
        v4u qn[2];
        { const bf16_t* qrow = SQ + (mrow0 + t0 + 64 * qh + l15) * 1024 + h * 64; qn[0] = *(const v4u*)(qrow + 8 * q4); qn[1] = *(const v4u*)(qrow + 32 + 8 * q4); }
        __syncthreads();
        { const int c = tid & 7; f32x4 g0 = *(const f32x4*)(kgain + 8 * c), g1 = *(const f32x4*)(kgain + 8 * c + 4);
#pragma unroll
          for (int ps = 0; ps < 4; ++ps) {
              const int kj = ps * 64 + (tid >> 3);
              const v4u raw = kraw[ps];
              float f[8];
#pragma unroll
              for (int j = 0; j < 4; ++j) { f[2 * j] = __builtin_bit_cast(float, raw[j] << 16); f[2 * j + 1] = __builtin_bit_cast(float, raw[j] & 0xffff0000u); }
              float ss = 0.f;
#pragma unroll
              for (int j = 0; j < 8; ++j) ss += f[j] * f[j];
              ss += __shfl_xor(ss, 1); ss += __shfl_xor(ss, 2); ss += __shfl_xor(ss, 4);
              const float r = rsqrtf(ss * (1.f / 64.f) + EPS);
              v4u w; w.x = pk2(f[0] * r * g0.x, f[1] * r * g0.y); w.y = pk2(f[2] * r * g0.z, f[3] * r * g0.w); w.z = pk2(f[4] * r * g1.x, f[5] * r * g1.y); w.w = pk2(f[6] * r * g1.z, f[7] * r * g1.w);
              *(LAS v4u*)(Kn + kj * SWA_KROW + 16 * c) = w;
          } }
#pragma unroll
        for (int ps = 0; ps < 4; ++ps) {
            const int kj = ps * 64 + lane; const v4u raw = vraw[ps];
#pragma unroll
            for (int j = 0; j < 4; ++j) { *(LAS unsigned short*)(Vt + (8 * wave + 2 * j) * SWA_VROW + kj * 2) = (unsigned short)(raw[j] & 0xffffu); *(LAS unsigned short*)(Vt + (8 * wave + 2 * j + 1) * SWA_VROW + kj * 2) = (unsigned short)(raw[j] >> 16); }
        }
        { const int gg = tid >> 7, rel = tid & 127; tb[tid] = rel_bias[t5_bucket(rel) * 16 + kvh * 4 + gg] * 1.4426950408889634f; }
        if (u + F.G < 1024) swa_load_kv(SK, SV, u + F.G, tid, lane, wave, kraw, vraw);
        __syncthreads();
        const float sink = sinks[h] * 1.4426950408889634f;
        float qg[2][8];
#pragma unroll
        for (int ks = 0; ks < 2; ++ks)
#pragma unroll
            for (int j = 0; j < 8; ++j) qg[ks][j] = qgain[32 * ks + 8 * q4 + j] * (0.125f * 1.4426950408889634f);
#pragma unroll 1
        for (int nt = 0; nt < 4; ++nt) {
            const int q0 = 64 * qh + 16 * nt, qi = q0 + l15, kt0 = q0 >> 4;
            bf16_t* qrow = SQ + (mrow0 + t0 + qi) * 1024 + h * 64;
            bf16x8 qf[2];
            { v4u raw[2]; float f[2][8]; float ss = 0.f;
              raw[0] = qn[0]; raw[1] = qn[1];
              if (nt < 3) { const bf16_t* qnx = qrow + 16 * 1024; qn[0] = *(const v4u*)(qnx + 8 * q4); qn[1] = *(const v4u*)(qnx + 32 + 8 * q4); }
#pragma unroll
              for (int ks = 0; ks < 2; ++ks) {
#pragma unroll
                  for (int j = 0; j < 4; ++j) { f[ks][2 * j] = __builtin_bit_cast(float, raw[ks][j] << 16); f[ks][2 * j + 1] = __builtin_bit_cast(float, raw[ks][j] & 0xffff0000u); }
#pragma unroll
                  for (int j = 0; j < 8; ++j) ss += f[ks][j] * f[ks][j]; }
              ss += __shfl_xor(ss, 16); ss += __shfl_xor(ss, 32);
              const float r = rsqrtf(ss * (1.f / 64.f) + EPS);
#pragma unroll
              for (int ks = 0; ks < 2; ++ks) { v4u w;
#pragma unroll
                  for (int j = 0; j < 4; ++j) w[j] = pk2(f[ks][2 * j] * r * qg[ks][2 * j], f[ks][2 * j + 1] * r * qg[ks][2 * j + 1]);
                  qf[ks] = __builtin_bit_cast(bf16x8, w); } }
            f32x4 s[9];
#pragma unroll
            for (int i = 0; i < 9; ++i) { f32x4 acc = (f32x4){0.f, 0.f, 0.f, 0.f};
#pragma unroll
                for (int ks = 0; ks < 2; ++ks) { const bf16x8 a = *(const LAS bf16x8*)(Kn + (16 * (kt0 + i) + l15) * SWA_KROW + (32 * ks + 8 * q4) * 2); acc = __builtin_amdgcn_mfma_f32_16x16x32_bf16(a, qf[ks], acc, 0, 0, 0); }
                s[i] = acc; }
            const int R0 = l15 + 128 - 4 * q4;
            const LAS float* tbp = tb + g * 128 + R0 - 131;
            float mx = -INFINITY;
            if (blk > 0) {
#pragma unroll
                for (int i = 0; i < 9; ++i)
#pragma unroll
                    for (int r = 0; r < 4; ++r) { const int rel = R0 - 16 * i - r; float v = s[i][r] + tbp[131 - 16 * i - r];
                        if (i == 0) v = (rel < 128) ? v : -INFINITY;
                        if (i == 8) v = (rel >= 0) ? v : -INFINITY;
                        s[i][r] = v; mx = fmaxf(mx, v); }
            } else {
#pragma unroll
                for (int i = 0; i < 9; ++i)
#pragma unroll
                    for (int r = 0; r < 4; ++r) { const int kj = 16 * (kt0 + i) + 4 * q4 + r, rel = R0 - 16 * i - r; const bool valid = ((unsigned)rel < 128u) && (kj >= 128);
                        const float v = valid ? s[i][r] + tbp[131 - 16 * i - r] : -INFINITY; s[i][r] = v; mx = fmaxf(mx, v); }
            }
            mx = fmaxf(mx, __shfl_xor(mx, 16)); mx = fmaxf(mx, __shfl_xor(mx, 32)); mx = fmaxf(mx, sink);
            float sum = 0.f;
#pragma unroll
            for (int i = 0; i < 9; ++i)
#pragma unroll
                for (int r = 0; r < 4; ++r) { const float e = __builtin_amdgcn_exp2f(s[i][r] - mx); s[i][r] = e; sum += e; }
            sum += __shfl_xor(sum, 16); sum += __shfl_xor(sum, 32);
            const float inv = 1.0f / (sum + __builtin_amdgcn_exp2f(sink - mx));
            f32x4 o[4];
#pragma unroll
            for (int mt = 0; mt < 4; ++mt) o[mt] = (f32x4){0.f, 0.f, 0.f, 0.f};
#pragma unroll
            for (int kk = 0; kk < 5; ++kk) {
                v4u w; w.x = pk2(s[2 * kk][0], s[2 * kk][1]); w.y = pk2(s[2 * kk][2], s[2 * kk][3]);
                if (kk < 4) { w.z = pk2(s[2 * kk + 1][0], s[2 * kk + 1][1]); w.w = pk2(s[2 * kk + 1][2], s[2 * kk + 1][3]); } else { w.z = 0u; w.w = 0u; }
                const bf16x8 pb = __builtin_bit_cast(bf16x8, w);
#pragma unroll
                for (int mt = 0; mt < 4; ++mt) {
                    const LAS unsigned char* vr = Vt + (16 * mt + l15) * SWA_VROW + (16 * (kt0 + 2 * kk) + 4 * q4) * 2;
                    const v2u a0 = *(const LAS v2u*)vr, a1 = *(const LAS v2u*)(vr + 32);
                    const bf16x8 a = __builtin_bit_cast(bf16x8, (v4u){a0.x, a0.y, a1.x, a1.y});
                    o[mt] = __builtin_amdgcn_mfma_f32_16x16x32_bf16(a, pb, o[mt], 0, 0, 0);
                }
            }
#pragma unroll
            for (int mt = 0; mt < 4; ++mt) { v2u w; w.x = pk2(o[mt][0] * inv, o[mt][1] * inv); w.y = pk2(o[mt][2] * inv, o[mt][3] * inv); wt_st8((unsigned char*)(qrow + 16 * mt + 4 * q4) + ydelta, w.x, w.y); }
        }
    }
    __syncthreads();
}

constexpr int GL_AL = 0, GL_QS = 4096, GL_BL = 6144, GL_DEC = 6656, GL_BQ = 8192, GL_QT = 41984, GL_KT = 59392, GL_OB = 8192, GL_KH = 76800, GL_VT = 95232;
constexpr int GL_BQROW = 528, GL_QROW = 272, GL_KHROW = 144, GL_VROW = 144, GL_OBROW = 1040;
__device__ __forceinline__ f32x16 mfma32(bf16x8 a, bf16x8 b, f32x16 c) { return __builtin_amdgcn_mfma_f32_32x32x16_bf16(a, b, c, 0, 0, 0); }
__device__ __forceinline__ bf16x8 pack8(const f32x16& x, int s) {
    v4u w;
    if (s == 0) { w.x = pk2(x[0], x[1]); w.y = pk2(x[2], x[3]); w.z = pk2(x[4], x[5]); w.w = pk2(x[6], x[7]); }
    else { w.x = pk2(x[8], x[9]); w.y = pk2(x[10], x[11]); w.z = pk2(x[12], x[13]); w.w = pk2(x[14], x[15]); }
    return __builtin_bit_cast(bf16x8, w);
}
__device__ __forceinline__ bf16x8 ld2x8(const LAS unsigned char* p) {
    const v2u a0 = *(const LAS v2u*)p, a1 = *(const LAS v2u*)(p + 16);
    return __builtin_bit_cast(bf16x8, (v4u){a0.x, a0.y, a1.x, a1.y});
}
__device__ __forceinline__ void unpack8(const v4u raw, float (&f)[8]) {
#pragma unroll
    for (int j = 0; j < 4; ++j) { f[2 * j] = __builtin_bit_cast(float, raw[j] << 16); f[2 * j + 1] = __builtin_bit_cast(float, raw[j] & 0xffff0000u); }
}
__device__ __forceinline__ void gla_load_w(Frame& F, const float* wgu, const float* bgu, int h, bf16x8& whi, bf16x8& wlo, float& bias) {
    const int dn = 32 * (F.wave >> 1) + (F.lane & 31), hh = F.lane >> 5;
    float v[8];
#pragma unroll
    for (int j = 0; j < 8; ++j) v[j] = wgu[(8 * hh + j) * 512 + h * 128 + dn];
    v4u hi, lo;
#pragma unroll
    for (int j = 0; j < 4; ++j) { hi[j] = pk2(v[2 * j], v[2 * j + 1]); lo[j] = pk2(v[2 * j] - __builtin_bit_cast(float, hi[j] << 16), v[2 * j + 1] - __builtin_bit_cast(float, hi[j] & 0xffff0000u)); }
    whi = __builtin_bit_cast(bf16x8, (v4u){hi[0], hi[1], hi[2], hi[3]}); wlo = __builtin_bit_cast(bf16x8, (v4u){lo[0], lo[1], lo[2], lo[3]});
    bias = bgu[h * 128 + dn];
}
template <bool FULL> __device__ __forceinline__ float gla_stage(Frame& F, int h, size_t m0, const bf16x8 whi, const bf16x8 wlo, float bias) {
    const int tid = F.tid, lane = F.lane, wave = F.wave, d = tid & 127;
    LAS unsigned char* L = F.lds;
    const float* ALOW = (const float*)(F.ws + WS_ALOW);
    const bf16_t* GQ = (const bf16_t*)(F.ws + WS_GQ); const bf16_t* GK = (const bf16_t*)(F.ws + WS_GK); const bf16_t* GV = (const bf16_t*)(F.ws + WS_GV);
    __syncthreads();
    { typedef float f32x2 __attribute__((ext_vector_type(2))); ((LAS f32x2*)(L + GL_AL))[tid] = ((const f32x2*)(ALOW + m0 * 16))[tid]; }
    __syncthreads();
    const int mt = wave & 1, nt = wave >> 1, l31 = lane & 31, hh = lane >> 5, dn = 32 * nt + l31;
    float p[16];
    { const LAS f32x4* ap = (const LAS f32x4*)(L + GL_AL + (32 * mt + l31) * 64 + hh * 32);
      const f32x4 a0 = ap[0], a1 = ap[1];
      v4u ah, al;
      ah.x = pk2(a0.x, a0.y); ah.y = pk2(a0.z, a0.w); ah.z = pk2(a1.x, a1.y); ah.w = pk2(a1.z, a1.w);
      al.x = pk2(a0.x - __builtin_bit_cast(float, ah.x << 16), a0.y - __builtin_bit_cast(float, ah.x & 0xffff0000u)); al.y = pk2(a0.z - __builtin_bit_cast(float, ah.y << 16), a0.w - __builtin_bit_cast(float, ah.y & 0xffff0000u));
      al.z = pk2(a1.x - __builtin_bit_cast(float, ah.z << 16), a1.y - __builtin_bit_cast(float, ah.z & 0xffff0000u)); al.w = pk2(a1.z - __builtin_bit_cast(float, ah.w << 16), a1.w - __builtin_bit_cast(float, ah.w & 0xffff0000u));
      f32x16 z;
#pragma unroll
      for (int r = 0; r < 16; ++r) z[r] = 0.f;
      z = mfma32(__builtin_bit_cast(bf16x8, ah), whi, z); z = mfma32(__builtin_bit_cast(bf16x8, al), whi, z); z = mfma32(__builtin_bit_cast(bf16x8, ah), wlo, z);
#pragma unroll
      for (int r = 0; r < 16; ++r) { const float zz = z[r] + bias; p[r] = (fminf(zz, 0.f) - flog(1.f + fexp(-fabsf(zz)))) * (1.f / 16.f); } }
    float base = 0.f;
#pragma unroll
    for (int g4 = 0; g4 < 4; ++g4) {
        p[4 * g4 + 1] += p[4 * g4]; p[4 * g4 + 2] += p[4 * g4 + 1]; p[4 * g4 + 3] += p[4 * g4 + 2];
        const float gt = p[4 * g4 + 3], pt = __shfl_xor(gt, 32), off = base + (hh ? pt : 0.f);
#pragma unroll
        for (int k = 0; k < 4; ++k) p[4 * g4 + k] += off;
        base += gt + pt;
    }
    if (hh == 0) ((LAS float*)(L + GL_QS))[mt * 128 + dn] = base;
    __syncthreads();
    { const float q0 = ((const LAS float*)(L + GL_QS))[dn], q1 = ((const LAS float*)(L + GL_QS))[128 + dn], blast = q0 + q1, offs = mt ? q0 : 0.f;
#pragma unroll
      for (int r = 0; r < 16; ++r) *(LAS float*)(L + GL_BQ + (32 * mt + 8 * (r >> 2) + 4 * hh + (r & 3)) * GL_BQROW + dn * 4) = p[r] + offs;
      if (mt == 0 && hh == 0) { ((LAS float*)(L + GL_BL))[dn] = blast; ((LAS float*)(L + GL_DEC))[dn] = fexp(blast); } }
    __syncthreads();
    {
        const int t = lane, dg = wave; const size_t row = m0 + t;
        float b[16], bl[16];
#pragma unroll
        for (int i = 0; i < 4; ++i) { const f32x4 v = *(const LAS f32x4*)(L + GL_BQ + t * GL_BQROW + dg * 64 + 16 * i); b[4 * i] = v.x; b[4 * i + 1] = v.y; b[4 * i + 2] = v.z; b[4 * i + 3] = v.w;
                                      const f32x4 u = *(const LAS f32x4*)(L + (FULL ? GL_DEC : GL_BL) + dg * 64 + 16 * i); bl[4 * i] = u.x; bl[4 * i + 1] = u.y; bl[4 * i + 2] = u.z; bl[4 * i + 3] = u.w; }
        float kf[16];
        { const v4u* kp = (const v4u*)(GK + row * 512 + h * 128 + 16 * dg); float t0[8], t1[8]; unpack8(kp[0], t0); unpack8(kp[1], t1);
#pragma unroll
          for (int e = 0; e < 8; ++e) { kf[e] = t0[e]; kf[8 + e] = t1[e]; } }
        float kh[16];
        if (FULL) {
            float qf[16];
            { const v4u* qp = (const v4u*)(GQ + row * 512 + h * 128 + 16 * dg); float t0[8], t1[8]; unpack8(qp[0], t0); unpack8(qp[1], t1);
#pragma unroll
              for (int e = 0; e < 8; ++e) { qf[e] = t0[e]; qf[8 + e] = t1[e]; } }
            v4u wq[2], wk[2];
#pragma unroll
            for (int e = 0; e < 16; e += 2) { const float e0 = fexp(b[e]), e1 = fexp(b[e + 1]);
                const float k0 = kf[e] * __builtin_amdgcn_rcpf(e0), k1 = kf[e + 1] * __builtin_amdgcn_rcpf(e1);
                wq[e >> 3][(e & 7) >> 1] = pk2(qf[e] * e0 * 0.08838834764831845f, qf[e + 1] * e1 * 0.08838834764831845f);
                wk[e >> 3][(e & 7) >> 1] = pk2(k0, k1);
                kh[e] = k0 * bl[e]; kh[e + 1] = k1 * bl[e + 1]; }
            *(LAS v4u*)(L + GL_QT + t * GL_QROW + dg * 32) = wq[0]; *(LAS v4u*)(L + GL_QT + t * GL_QROW + dg * 32 + 16) = wq[1];
            *(LAS v4u*)(L + GL_KT + t * GL_QROW + dg * 32) = wk[0]; *(LAS v4u*)(L + GL_KT + t * GL_QROW + dg * 32 + 16) = wk[1];
        } else {
#pragma unroll
            for (int e = 0; e < 16; ++e) kh[e] = kf[e] * fexp(bl[e] - b[e]);
        }
#pragma unroll
        for (int e = 0; e < 16; e += 2) { const unsigned pk = pk2(kh[e], kh[e + 1]);
            *(LAS unsigned short*)(L + GL_KH + (16 * dg + e) * GL_KHROW + t * 2) = (unsigned short)(pk & 0xffffu);
            *(LAS unsigned short*)(L + GL_KH + (16 * dg + e + 1) * GL_KHROW + t * 2) = (unsigned short)(pk >> 16); }
#pragma unroll
        for (int i = 0; i < 4; ++i) { const v4u raw = *(const v4u*)(GV + row * 1024 + h * 256 + 32 * wave + 8 * i);
#pragma unroll
            for (int j = 0; j < 4; ++j) { *(LAS unsigned short*)(L + GL_VT + (32 * wave + 8 * i + 2 * j) * GL_VROW + t * 2) = (unsigned short)(raw[j] & 0xffffu);
                                          *(LAS unsigned short*)(L + GL_VT + (32 * wave + 8 * i + 2 * j + 1) * GL_VROW + t * 2) = (unsigned short)(raw[j] >> 16); } }
    }
    __syncthreads();
    return ((const LAS float*)(L + GL_BL))[d];
}
__device__ __forceinline__ void gla_state_update(Frame& F, f32x16 (&S)[4]) {
    const int lane = F.lane, l31 = lane & 31, hh = lane >> 5; LAS unsigned char* L = F.lds;
#pragma unroll
    for (int dt = 0; dt < 4; ++dt) {
#pragma unroll
        for (int g = 0; g < 4; ++g) { const f32x4 dc = *(const LAS f32x4*)(L + GL_DEC + (32 * dt + 8 * g + 4 * hh) * 4);
            S[dt][4 * g] *= dc.x; S[dt][4 * g + 1] *= dc.y; S[dt][4 * g + 2] *= dc.z; S[dt][4 * g + 3] *= dc.w; }
#pragma unroll
        for (int ks = 0; ks < 4; ++ks) {
            const bf16x8 a = *(const LAS bf16x8*)(L + GL_KH + (32 * dt + l31) * GL_KHROW + (16 * ks + 8 * hh) * 2);
            const bf16x8 b = *(const LAS bf16x8*)(L + GL_VT + (32 * F.wave + l31) * GL_VROW + (16 * ks + 8 * hh) * 2);
            S[dt] = mfma32(a, b, S[dt]);
        } __builtin_amdgcn_sched_barrier(0);
    }
}
__device__ __forceinline__ void gla_local_phase(Frame& F, const float* wgu, const float* bgu) {
    float* ST = (float*)(F.ws + WS_ST); float* DSC = (float*)(F.ws + WS_DSC);
    const int lane = F.lane, l31 = lane & 31, hh = lane >> 5;
    for (int u = F.bid; u < 512; u += F.G) {
        const int sc = u & 31, bh = u >> 5, b = bh >> 2, h = bh & 3;
        bf16x8 whi, wlo; float bias; gla_load_w(F, wgu, bgu, h, whi, wlo, bias);
        f32x16 S[4];
#pragma unroll
        for (int dt = 0; dt < 4; ++dt)
#pragma unroll
            for (int r = 0; r < 16; ++r) S[dt][r] = 0.f;
        float sumbl = 0.f;
#pragma unroll 1
        for (int c = 0; c < 4; ++c) {
            const size_t m0 = (size_t)b * SEQ + sc * 256 + c * 64;
            sumbl += gla_stage<false>(F, h, m0, whi, wlo, bias);
            gla_state_update(F, S);
        }
        v4u* st8 = (v4u*)ST + (size_t)(bh * 32 + sc) * 4096 + (F.wave * 4 * 64 + lane) * 2;
#pragma unroll
        for (int dt = 0; dt < 4; ++dt)
#pragma unroll
            for (int hf = 0; hf < 2; ++hf) st8[dt * 128 + hf] = (v4u){pk2(S[dt][8 * hf], S[dt][8 * hf + 1]), pk2(S[dt][8 * hf + 2], S[dt][8 * hf + 3]), pk2(S[dt][8 * hf + 4], S[dt][8 * hf + 5]), pk2(S[dt][8 * hf + 6], S[dt][8 * hf + 7])};
        if (F.tid < 128) wt_st4(DSC + (bh * 32 + sc) * 128 + F.tid, fexp(sumbl));
    }
}
__device__ __forceinline__ void gla_scan_phase(Frame& F) {
    v4u* ST8 = (v4u*)(F.ws + WS_ST); const float* DSC = (const float*)(F.ws + WS_DSC);
    for (int idx = F.bid * NTHR + F.tid; idx < 16 * 4096; idx += F.G * NTHR) {
        const int bh = idx >> 12, u8 = idx & 4095, hf = u8 & 1, ln = (u8 >> 1) & 63, dt = (u8 >> 7) & 3, row0 = 32 * dt + 16 * hf + 4 * (ln >> 5);
        float S[8];
#pragma unroll
        for (int e = 0; e < 8; ++e) S[e] = 0.f;
#pragma unroll 8
        for (int sc = 0; sc < 32; ++sc) {
            v4u* p = ST8 + (size_t)(bh * 32 + sc) * 4096 + u8; const v4u raw = *p; float tmp[8]; unpack8(raw, tmp);
            *p = (v4u){pk2(S[0], S[1]), pk2(S[2], S[3]), pk2(S[4], S[5]), pk2(S[6], S[7])};
            const f32x4 d0 = *(const f32x4*)(DSC + (bh * 32 + sc) * 128 + row0), d1 = *(const f32x4*)(DSC + (bh * 32 + sc) * 128 + row0 + 8);
            S[0] = S[0] * d0.x + tmp[0]; S[1] = S[1] * d0.y + tmp[1]; S[2] = S[2] * d0.z + tmp[2]; S[3] = S[3] * d0.w + tmp[3];
            S[4] = S[4] * d1.x + tmp[4]; S[5] = S[5] * d1.y + tmp[5]; S[6] = S[6] * d1.z + tmp[6]; S[7] = S[7] * d1.w + tmp[7];
        }
    }
}
__device__ __forceinline__ void gla_out_phase(Frame& F, const float* wgu, const float* bgu, const float* ogain) {
    const float* ST = (const float*)(F.ws + WS_ST); const bf16_t* GR = (const bf16_t*)(F.ws + WS_GR); const __amdgpu_buffer_rsrc_t gr_r = wt_rsrc(F.ws + WS_YG);
    const int lane = F.lane, l31 = lane & 31, hh = lane >> 5, wave = F.wave; LAS unsigned char* L = F.lds;
    for (int u = F.bid; u < 512; u += F.G) {
        const int sc = u & 31, bh = u >> 5, b = bh >> 2, h = bh & 3;
        bf16x8 whi, wlo; float bias; gla_load_w(F, wgu, bgu, h, whi, wlo, bias);
        f32x16 S[4];
        { const v4u* st8 = (const v4u*)ST + (size_t)(bh * 32 + sc) * 4096 + (wave * 4 * 64 + lane) * 2;
#pragma unroll
          for (int dt = 0; dt < 4; ++dt)
#pragma unroll
              for (int hf = 0; hf < 2; ++hf) { float f[8]; unpack8(st8[dt * 128 + hf], f);
#pragma unroll
                  for (int e = 0; e < 8; ++e) S[dt][8 * hf + e] = f[e]; } }
#pragma unroll 1
        for (int c = 0; c < 4; ++c) {
            const size_t m0 = (size_t)b * SEQ + sc * 256 + c * 64;
            (void)gla_stage<true>(F, h, m0, whi, wlo, bias);
            f32x16 o0, o1;
#pragma unroll
            for (int r = 0; r < 16; ++r) { o0[r] = 0.f; o1[r] = 0.f; }
#pragma unroll
            for (int dt = 0; dt < 4; ++dt)
#pragma unroll
                for (int s = 0; s < 2; ++s) {
                    const bf16x8 bs = pack8(S[dt], s);
                    const int ko = (32 * dt + 16 * s + 4 * hh) * 2;
                    o0 = mfma32(ld2x8(L + GL_QT + l31 * GL_QROW + ko), bs, o0);
                    o1 = mfma32(ld2x8(L + GL_QT + (32 + l31) * GL_QROW + ko), bs, o1);
                }
            __builtin_amdgcn_sched_barrier(0);
#pragma unroll
            for (int tile = 0; tile < 3; ++tile) {
                const int jt = (tile == 2) ? 1 : 0, it = (tile == 0) ? 0 : 1;
                f32x16 p;
#pragma unroll
                for (int r = 0; r < 16; ++r) p[r] = 0.f;
#pragma unroll
                for (int ks = 0; ks < 8; ++ks) {
                    const int ko = (16 * ks + 8 * hh) * 2;
                    const bf16x8 a = *(const LAS bf16x8*)(L + GL_KT + (32 * jt + l31) * GL_QROW + ko);
                    const bf16x8 b = *(const LAS bf16x8*)(L + GL_QT + (32 * it + l31) * GL_QROW + ko);
                    p = mfma32(a, b, p);
                }
                if (jt == it) {
#pragma unroll
                    for (int r = 0; r < 16; ++r) { const int j = (r & 3) + 8 * (r >> 2) + 4 * hh; p[r] = (j > l31) ? 0.f : p[r]; }
                }
#pragma unroll
                for (int s = 0; s < 2; ++s) {
                    const bf16x8 bv = ld2x8(L + GL_VT + (32 * wave + l31) * GL_VROW + (32 * jt + 16 * s + 4 * hh) * 2);
                    if (it == 0) o0 = mfma32(pack8(p, s), bv, o0); else o1 = mfma32(pack8(p, s), bv, o1);
                }
                __builtin_amdgcn_sched_barrier(0);
            }
            gla_state_update(F, S);
            __syncthreads();
#pragma unroll
            for (int r = 0; r < 16; ++r) { const int i = (r & 3) + 8 * (r >> 2) + 4 * hh;
                *(LAS float*)(L + GL_OB + i * GL_OBROW + (32 * wave + l31) * 4) = o0[r]; *(LAS float*)(L + GL_OB + (32 + i) * GL_OBROW + (32 * wave + l31) * 4) = o1[r]; }
            __syncthreads();
            {
                const int t = F.tid >> 3, part = F.tid & 7;
                float v[32]; float ss = 0.f;
#pragma unroll
                for (int i = 0; i < 8; ++i) { const f32x4 x = *(const LAS f32x4*)(L + GL_OB + t * GL_OBROW + (32 * part + 4 * i) * 4); v[4 * i] = x.x; v[4 * i + 1] = x.y; v[4 * i + 2] = x.z; v[4 * i + 3] = x.w; ss += (x.x * x.x + x.y * x.y) + (x.z * x.z + x.w * x.w); }
                ss += __shfl_xor(ss, 1); ss += __shfl_xor(ss, 2); ss += __shfl_xor(ss, 4);
                const float rstd = rsqrtf(ss * (1.f / 256.f) + EPS);
                const bf16_t* gp = GR + (m0 + t) * 1024 + h * 256 + 32 * part;
#pragma unroll
                for (int i = 0; i < 4; ++i) { const v4u raw = *(const v4u*)(gp + 8 * i); float rr[8]; unpack8(raw, rr);
                    const f32x4 g0 = *(const f32x4*)(ogain + 32 * part + 8 * i), g1 = *(const f32x4*)(ogain + 32 * part + 8 * i + 4);
                    v4u o; o.x = pk2(v[8 * i] * rstd * g0.x * rr[0], v[8 * i + 1] * rstd * g0.y * rr[1]); o.y = pk2(v[8 * i + 2] * rstd * g0.z * rr[2], v[8 * i + 3] * rstd * g0.w * rr[3]);
                    o.z = pk2(v[8 * i + 4] * rstd * g1.x * rr[4], v[8 * i + 5] * rstd * g1.y * rr[5]); o.w = pk2(v[8 * i + 6] * rstd * g1.z * rr[6], v[8 * i + 7] * rstd * g1.w * rr[7]);
                    wt_st16(gr_r, (unsigned)(((m0 + t) * 1024 + h * 256 + 32 * part + 8 * i) * 2), o); }
            }
        }
    }
    __syncthreads();
}

constexpr int PK_KROW = 272, PK_K_OFF = 0, PK_SCR_OFF = 2 * 128 * PK_KROW;
__device__ __forceinline__ void ce(unsigned& a, unsigned& b) { const unsigned mx = a > b ? a : b, mn = a > b ? b : a; a = mx; b = mn; }
template <int N> __device__ __forceinline__ void bitonic_sort_desc(unsigned (&x)[N]) {
#pragma unroll
    for (int k = 2; k <= N; k <<= 1)
#pragma unroll
        for (int j = k >> 1; j > 0; j >>= 1)
#pragma unroll
            for (int i = 0; i < N; ++i) { const int l = i ^ j; if (l > i) { if ((i & k) == 0) ce(x[i], x[l]); else ce(x[l], x[i]); } }
}
__device__ __forceinline__ void sort16_desc(unsigned (&x)[16]) {
    ce(x[0], x[13]); ce(x[1], x[12]); ce(x[2], x[15]); ce(x[3], x[14]); ce(x[4], x[8]); ce(x[5], x[6]); ce(x[7], x[11]); ce(x[9], x[10]); ce(x[0], x[5]); ce(x[1], x[7]); ce(x[2], x[9]); ce(x[3], x[4]); ce(x[6], x[13]); ce(x[8], x[14]); ce(x[10], x[15]); ce(x[11], x[12]); ce(x[0], x[1]); ce(x[2], x[3]); ce(x[4], x[5]); ce(x[6], x[8]); ce(x[7], x[9]); ce(x[10], x[11]); ce(x[12], x[13]); ce(x[14], x[15]); ce(x[0], x[2]); ce(x[1], x[3]); ce(x[4], x[10]); ce(x[5], x[11]); ce(x[6], x[7]); ce(x[8], x[9]); ce(x[12], x[14]); ce(x[13], x[15]); ce(x[1], x[2]); ce(x[3], x[12]); ce(x[4], x[6]); ce(x[5], x[7]); ce(x[8], x[10]); ce(x[9], x[11]); ce(x[13], x[14]); ce(x[1], x[4]); ce(x[2], x[6]); ce(x[5], x[8]); ce(x[7], x[10]); ce(x[9], x[13]); ce(x[11], x[14]); ce(x[2], x[4]); ce(x[3], x[6]); ce(x[9], x[12]); ce(x[11], x[13]); ce(x[3], x[5]); ce(x[6], x[8]); ce(x[7], x[9]); ce(x[10], x[12]); ce(x[3], x[4]); ce(x[5], x[6]); ce(x[7], x[8]); ce(x[9], x[10]); ce(x[11], x[12]); ce(x[6], x[7]); ce(x[8], x[9]);
}
__device__ __forceinline__ void merge16(unsigned (&a)[16], const unsigned (&b)[16]) {
#pragma unroll
    for (int i = 0; i < 16; ++i) a[i] = a[i] > b[15 - i] ? a[i] : b[15 - i];
#pragma unroll
    for (int j = 8; j > 0; j >>= 1)
#pragma unroll
        for (int i = 0; i < 16; ++i) { const int l = i ^ j; if (l > i) ce(a[i], a[l]); }
}
__device__ __forceinline__ void merge16_partner(unsigned (&a)[16]) {
    unsigned b[16];
#pragma unroll
    for (int i = 0; i < 16; ++i) b[i] = (unsigned)__shfl_xor((int)a[i], 32);
    merge16(a, b);
}
__device__ __forceinline__ unsigned f2key(float f) { const unsigned u = __builtin_bit_cast(unsigned, f); return u ^ ((unsigned)((int)u >> 31) | 0x80000000u); }
__device__ __forceinline__ float key2f(unsigned k) { const unsigned m = ~(unsigned)((int)k >> 31) | 0x80000000u; return __builtin_bit_cast(float, k ^ m); }
__device__ constexpr int PEER_CI[50] = {0,0,0,0,0,0,0,0,0,0,0,0,0,0,0,0, 1,1,1,1,1,1,1,1, 2,2,2,2,2, 3,3,3,3, 4,4,4, 5,5, 6,6, 7,7, 8,9,10,11,12,13,14,15};
__device__ constexpr int PEER_CJ[50] = {0,1,2,3,4,5,6,7,8,9,10,11,12,13,14,15, 0,1,2,3,4,5,6,7, 0,1,2,3,4, 0,1,2,3, 0,1,2, 0,1, 0,1, 0,1, 0,0,0,0,0,0,0,0};
__device__ __forceinline__ void top16_of_tiles(const f32x16 (&s)[4], int hh, unsigned (&top)[16]) {
#pragma unroll
    for (int mt = 0; mt < 4; ++mt) {
        unsigned g[16];
#pragma unroll
        for (int r = 0; r < 16; ++r) { const unsigned low = (unsigned)(127 - (32 * mt + (r & 3) + 8 * (r >> 2))) - 4u * (unsigned)hh; g[r] = (f2key(s[mt][r]) & ~127u) | low; }
        sort16_desc(g);
        if (mt == 0) {
#pragma unroll
            for (int i = 0; i < 16; ++i) top[i] = g[i];
        } else merge16(top, g);
    }
    merge16_partner(top);
}
__device__ __forceinline__ void peer_topk_phase(Frame& F) {
    const bf16_t* QP = (const bf16_t*)(F.ws + WS_QP); const bf16_t* SUBK = (const bf16_t*)(F.ws + WS_SUBK);
    unsigned short* IDX = (unsigned short*)(F.ws + WS_IDX); float* GATE = (float*)(F.ws + WS_GATE);
    LAS unsigned char* L = F.lds; const int tid = F.tid, lane = F.lane, wave = F.wave, l31 = lane & 31, hh = lane >> 5;
    LAS unsigned* scr = (LAS unsigned*)(L + PK_SCR_OFF + wave * 8192);
    pg8::StaticOrder S; S.init(T, 2048, F.G, F.bid);
    for (int ui = 0; ; ++ui) {
        pg8::Unit un; if (!S.next(ui, un)) break;
        const int h = un.pn, tile = un.pm;
        __syncthreads();
#pragma unroll
        for (int i = 0; i < 8; ++i) { const int v = tid + 512 * i, row = v >> 4, c = v & 15;
            *(LAS v4u*)(L + PK_K_OFF + row * PK_KROW + c * 16) = *(const v4u*)(SUBK + ((size_t)h * 256 + row) * 128 + c * 8); }
        __syncthreads();
        const int tok = tile * 256 + wave * 32 + l31;
        unsigned ka[16], kb[16];
#pragma unroll
        for (int p = 0; p < 2; ++p) {
            f32x16 s[4];
#pragma unroll
            for (int mt = 0; mt < 4; ++mt)
#pragma unroll
                for (int r = 0; r < 16; ++r) s[mt][r] = 0.f;
            const bf16_t* qrow = QP + (size_t)tok * 2048 + h * 256 + p * 128 + 8 * hh;
#pragma unroll
            for (int k2 = 0; k2 < 4; ++k2) {
                const bf16x8 q0 = *(const bf16x8*)(qrow + 32 * k2), q1 = *(const bf16x8*)(qrow + 32 * k2 + 16);
#pragma unroll
                for (int mt = 0; mt < 4; ++mt) { const bf16x8 a = *(const LAS bf16x8*)(L + PK_K_OFF + (p * 128 + 32 * mt + l31) * PK_KROW + (32 * k2 + 8 * hh) * 2); s[mt] = mfma32(a, q0, s[mt]); }
#pragma unroll
                for (int mt = 0; mt < 4; ++mt) { const bf16x8 a = *(const LAS bf16x8*)(L + PK_K_OFF + (p * 128 + 32 * mt + l31) * PK_KROW + (32 * k2 + 16 + 8 * hh) * 2); s[mt] = mfma32(a, q1, s[mt]); }
                __builtin_amdgcn_sched_barrier(0);
            }
            if (p == 0) top16_of_tiles(s, hh, ka); else top16_of_tiles(s, hh, kb);
        }
        float sa[16], sb[16];
#pragma unroll
        for (int i = 0; i < 16; ++i) { sa[i] = key2f(ka[i] & ~127u); sb[i] = key2f(kb[i] & ~127u); scr[i * 64 + lane] = 127u - (ka[i] & 127u); scr[(16 + i) * 64 + lane] = 127u - (kb[i] & 127u); }
        unsigned c0[16], c1[16];
#pragma unroll
        for (int n = 0; n < 32; ++n) {
            unsigned key = 0u;
            if (n < 25) { const int e0 = 2 * n, e1 = 2 * n + 1;
                const float v0 = sa[PEER_CI[e0]] + sb[PEER_CJ[e0]], v1 = sa[PEER_CI[e1]] + sb[PEER_CJ[e1]];
                const unsigned k0 = (f2key(v0) & ~255u) | (unsigned)(255 - (PEER_CI[e0] * 16 + PEER_CJ[e0])), k1 = (f2key(v1) & ~255u) | (unsigned)(255 - (PEER_CI[e1] * 16 + PEER_CJ[e1]));
                key = hh ? k1 : k0; }
            if (n < 16) c0[n] = key; else c1[n - 16] = key;
        }
        sort16_desc(c0); sort16_desc(c1); merge16(c0, c1); merge16_partner(c0);
        float e[16]; float sum = 0.f; const float mx = key2f(c0[0] & ~255u);
#pragma unroll
        for (int n = 0; n < 16; ++n) { e[n] = fexp(key2f(c0[n] & ~255u) - mx); sum += e[n]; }
        const float inv = 1.0f / sum;
        int eo[8]; float go[8];
#pragma unroll
        for (int n = 0; n < 8; ++n) { const unsigned kk = hh ? c0[8 + n] : c0[n]; const unsigned id = 255u - (kk & 255u);
            const unsigned i1 = scr[(id >> 4) * 64 + lane], i2 = scr[(16 + (id & 15)) * 64 + lane];
            eo[n] = (int)(i1 * 128u + i2); go[n] = (hh ? e[8 + n] : e[n]) * inv; }
        typedef int i32x4 __attribute__((ext_vector_type(4)));
        { const __amdgpu_buffer_rsrc_t gr = wt_rsrc(GATE); const unsigned bo = (unsigned)(((size_t)tok * 128 + h * 16 + 8 * hh) * 4);
          wt_st16(gr, bo, __builtin_bit_cast(wt_u32x4, (f32x4){go[0], go[1], go[2], go[3]})); wt_st16(gr, bo + 16, __builtin_bit_cast(wt_u32x4, (f32x4){go[4], go[5], go[6], go[7]}));
          unsigned short* ip = IDX + (size_t)tok * 128 + 2 * h + hh;
#pragma unroll
          for (int n = 0; n < 8; ++n) ip[16 * n] = (unsigned short)eo[n]; }
    }
    __syncthreads();
}
constexpr size_t WS_RSTD2 = 482 * MiB, WS_EXD8 = 352 * MiB, WS_EXU8 = 368 * MiB, WS_ISD = 6 * MiB, WS_ISU = 6 * MiB + 65536, WS_PA = 32 * MiB, WS_WEX = 416 * MiB, WS_AQ = 96 * MiB, WS_ASC = 130 * MiB;
__device__ __forceinline__ float gelu_exact(float x) { return 0.5f * x * (1.f + erff(x * 0.7071067811865476f)); }
__device__ __forceinline__ unsigned pack_i8x4(float a, float b, float c, float d) {
    const int ia = (int)rintf(a), ib = (int)rintf(b), ic = (int)rintf(c), id = (int)rintf(d);
    return ((unsigned)ia & 0xffu) | (((unsigned)ib & 0xffu) << 8) | (((unsigned)ic & 0xffu) << 16) | ((unsigned)id << 24);
}
__device__ __forceinline__ unsigned nib_lo(unsigned w) { return w & 0x0F0F0F0Fu; }
__device__ __forceinline__ unsigned nib_hi(unsigned w) { return ((((w ^ 0x80808080u) + 0x08080808u) >> 4) & 0x0F0F0F0Fu) ^ 0x08080808u; }
__device__ __forceinline__ void peer_quant_phase(Frame& F) {
    const bf16_t* HB = (const bf16_t*)(F.ws + WS_HB2); unsigned char* AQ = F.ws + WS_AQ; float* ASC = (float*)(F.ws + WS_ASC); const int lane = F.lane;
    for (int t = F.bid * NWAVES + F.wave; t < T; t += F.G * NWAVES) {
        const v4u* hp = (const v4u*)(HB + (size_t)t * D + 16 * lane); float a[8], b[8]; unpack8(hp[0], a); unpack8(hp[1], b);
        float mx = 0.f;
#pragma unroll
        for (int j = 0; j < 8; ++j) mx = fmaxf(mx, fmaxf(fabsf(a[j]), fabsf(b[j])));
        mx = fmaxf(mx, __shfl_xor(mx, 1)); mx = fmaxf(mx, __shfl_xor(mx, 2)); mx = fmaxf(mx, __shfl_xor(mx, 4)); mx = fmaxf(mx, __shfl_xor(mx, 8));
        const float sx = mx > 0.f ? 119.f / mx : 1.f, isx = mx > 0.f ? mx * (1.f / 119.f) : 1.f;
        const unsigned w0 = pack_i8x4(a[0] * sx, a[2] * sx, a[4] * sx, a[6] * sx), w1 = pack_i8x4(a[1] * sx, a[3] * sx, a[5] * sx, a[7] * sx);
        const unsigned w2 = pack_i8x4(b[0] * sx, b[2] * sx, b[4] * sx, b[6] * sx), w3 = pack_i8x4(b[1] * sx, b[3] * sx, b[5] * sx, b[7] * sx);
        unsigned char* base = AQ + ((size_t)(t * 4 + (lane >> 4)) * 8 + ((lane & 15) >> 1)) * 32 + (lane & 1) * 8;
        *(v2u*)base = (v2u){nib_hi(w0) | (nib_hi(w1) << 4), nib_hi(w2) | (nib_hi(w3) << 4)};
        *(v2u*)(base + 16) = (v2u){nib_lo(w0) | (nib_lo(w1) << 4), nib_lo(w2) | (nib_lo(w3) << 4)};
        if ((lane & 15) == 0) ASC[t * 4 + (lane >> 4)] = isx;
    }
}
__device__ __forceinline__ void treduce16(float (&p)[16], int lane, int m) {
#pragma unroll
    for (int i = 0; i < 8; ++i) { const bool hi = lane & m; const float send = hi ? p[i] : p[i + 8], keep = hi ? p[i + 8] : p[i]; p[i] = keep + __shfl_xor(send, m); }
#pragma unroll
    for (int i = 0; i < 4; ++i) { const bool hi = lane & (2 * m); const float send = hi ? p[i] : p[i + 4], keep = hi ? p[i + 4] : p[i]; p[i] = keep + __shfl_xor(send, 2 * m); }
#pragma unroll
    for (int i = 0; i < 2; ++i) { const bool hi = lane & (4 * m); const float send = hi ? p[i] : p[i + 2], keep = hi ? p[i + 2] : p[i]; p[i] = keep + __shfl_xor(send, 4 * m); }
}
typedef int i32x4v __attribute__((ext_vector_type(4)));
__device__ __forceinline__ void treduce16i_g(int (&p)[16], int lane) {
#pragma unroll
    for (int i = 0; i < 8; ++i) { const v2u r = __builtin_amdgcn_permlane32_swap((unsigned)p[i], (unsigned)p[i + 8], false, false); p[i] = (int)(r.x + r.y); }
#pragma unroll
    for (int i = 0; i < 4; ++i) { const v2u r = __builtin_amdgcn_permlane16_swap((unsigned)p[i], (unsigned)p[i + 4], false, false); p[i] = (int)(r.x + r.y); }
    const bool hi = lane & 8;
#pragma unroll
    for (int i = 0; i < 2; ++i) { const int send = hi ? p[i] : p[i + 2], keep = hi ? p[i + 2] : p[i]; p[i] = keep + __builtin_amdgcn_update_dpp(0, send, 0x128, 0xF, 0xF, false); }
}
__device__ __forceinline__ void peer_load_ids(const unsigned short* IDX, size_t t, int g, i32x4v (&id)[4]) {
    const v4u* p = (const v4u*)(IDX + t * 128 + g * 16); const v4u a = p[0], b = p[1];
    id[0] = (i32x4v){(int)(a.x & 0xffffu), (int)(a.x >> 16), (int)(a.y & 0xffffu), (int)(a.y >> 16)}; id[1] = (i32x4v){(int)(a.z & 0xffffu), (int)(a.z >> 16), (int)(a.w & 0xffffu), (int)(a.w >> 16)};
    id[2] = (i32x4v){(int)(b.x & 0xffffu), (int)(b.x >> 16), (int)(b.y & 0xffffu), (int)(b.y >> 16)}; id[3] = (i32x4v){(int)(b.z & 0xffffu), (int)(b.z >> 16), (int)(b.w & 0xffffu), (int)(b.w >> 16)};
}
__device__ __forceinline__ void peer_load_w(const bf16_t* WEX, size_t t, int g, v4u (&w)[2]) {
    const v4u* p = (const v4u*)(WEX + t * 128 + g * 16); w[0] = p[0]; w[1] = p[1];
}
__device__ __forceinline__ void peer_v8_lds(LAS unsigned char* scr, unsigned raw, int lane, int grp, v4u (&o)[2]) {
    *(LAS unsigned*)(scr + 4 * lane) = raw; asm volatile("" ::: "memory");
    o[0] = *(const LAS v4u*)(scr + 32 * grp); o[1] = *(const LAS v4u*)(scr + 32 * grp + 16); asm volatile("" ::: "memory");
}
__device__ __forceinline__ void peer_ids_lds(LAS unsigned char* scr, unsigned raw, int lane, i32x4v (&id)[4]) {
    v4u r[2]; peer_v8_lds(scr, raw, lane, lane >> 3, r); const v4u a = r[0], b = r[1];
    id[0] = (i32x4v){(int)(a.x & 0xffffu), (int)(a.x >> 16), (int)(a.y & 0xffffu), (int)(a.y >> 16)}; id[1] = (i32x4v){(int)(a.z & 0xffffu), (int)(a.z >> 16), (int)(a.w & 0xffffu), (int)(a.w >> 16)};
    id[2] = (i32x4v){(int)(b.x & 0xffffu), (int)(b.x >> 16), (int)(b.y & 0xffffu), (int)(b.y >> 16)}; id[3] = (i32x4v){(int)(b.z & 0xffffu), (int)(b.z >> 16), (int)(b.w & 0xffffu), (int)(b.w >> 16)};
}
#ifndef PEER_GATHER_AUX
#define PEER_GATHER_AUX 16
#endif
__device__ __forceinline__ void peer_gather16(v4u (&q)[16], const __amdgpu_buffer_rsrc_t r, unsigned loff, const i32x4v (&id)[4]) {
#pragma unroll
    for (int i = 0; i < 16; ++i) q[i] = __builtin_bit_cast(v4u, __builtin_amdgcn_raw_buffer_load_b128(r, (unsigned)id[i >> 2][i & 3] * 128u + loff, 0, PEER_GATHER_AUX));
}
__device__ __forceinline__ void peer_down_compute(const v4u (&q)[16], const v4u (&aq)[2], float isx, bf16_t* pa, int lane) {
    float p[16];
#pragma unroll
    for (int i = 0; i < 16; ++i) { int ah = __builtin_amdgcn_sdot8((int)q[i][0], (int)aq[0][0], 0, true), al = __builtin_amdgcn_sdot8((int)q[i][0], (int)aq[1][0], 0, true);
#pragma unroll
        for (int j = 1; j < 4; ++j) { ah = __builtin_amdgcn_sdot8((int)q[i][j], (int)aq[0][j], ah, false); al = __builtin_amdgcn_sdot8((int)q[i][j], (int)aq[1][j], al, false); }
        p[i] = (float)(16 * ah + al) * isx; }
    treduce16(p, lane, 1);
    *(unsigned*)(pa + 2 * lane) = pk2(p[0], p[1]);
}
__device__ __forceinline__ void peer_down_phase(Frame& F) {
    const unsigned char* TD = F.ws + WS_EXD8; const unsigned short* IDX = (const unsigned short*)(F.ws + WS_IDX);
    bf16_t* PA = (bf16_t*)(F.ws + WS_PA); const bf16_t* h1 = (const bf16_t*)(F.ws + WS_HB2);
    const unsigned char* AQ = F.ws + WS_AQ; const float* ASC = (const float*)(F.ws + WS_ASC);
    const int lane = F.lane, g = lane >> 3, cl = lane & 7, k = (F.bid & 7) >> 1, nw = (F.G >> 3) * 2 * NWAVES;
    const __amdgpu_buffer_rsrc_t tk = wt_rsrc(TD + (size_t)k * 16384 * 128); const unsigned loff = 16u * (unsigned)cl;
    int t = ((F.bid >> 3) * 2 + (F.bid & 1)) * NWAVES + F.wave;
    if (t >= T) return;
    LAS unsigned char* scrI = F.lds + F.wave * 512; LAS unsigned char* scrA = scrI + 256;
    const unsigned* IDXW = (const unsigned*)IDX + lane; const unsigned* AQW = (const unsigned*)AQ + k * 64 + lane;
    i32x4v id[4];
    unsigned idr = IDXW[(size_t)t * 64];
    peer_ids_lds(scrI, idr, lane, id);
    v4u qa[16], qb[16];
    peer_gather16(qa, tk, loff, id);
    { const int tl = (t + nw < T) ? t + nw : t; idr = IDXW[(size_t)tl * 64]; }
    float hs = ASC[t * 4 + k];
    unsigned aqr = AQW[(size_t)t * 256];
#define PEER_DOWN_STEP(QC, QN) { \
        const int t1 = t + nw, t2 = t + 2 * nw; const bool has1 = t1 < T; \
        peer_ids_lds(scrI, idr, lane, id); \
        if (has1) peer_gather16(QN, tk, loff, id); \
        { const int tl = (t2 < T) ? t2 : t; idr = IDXW[(size_t)tl * 64]; } \
        v4u hv[2]; peer_v8_lds(scrA, aqr, lane, cl, hv); \
        unsigned aqn; float hsn; { const int tl = has1 ? t1 : t; aqn = AQW[(size_t)tl * 256]; hsn = ASC[tl * 4 + k]; } \
        __builtin_amdgcn_sched_barrier(0); \
        peer_down_compute(QC, hv, hs, PA + ((size_t)k * T + t) * 128, lane); \
        __builtin_amdgcn_sched_barrier(0); \
        if (!has1) break; t = t1; aqr = aqn; hs = hsn; }
    for (;;) { PEER_DOWN_STEP(qa, qb) PEER_DOWN_STEP(qb, qa) }
#undef PEER_DOWN_STEP
}
__device__ __forceinline__ void peer_combine_phase(Frame& F) {
    const unsigned* PAW = (const unsigned*)(F.ws + WS_PA); const unsigned* IDXW = (const unsigned*)(F.ws + WS_IDX); const float* GATE = (const float*)(F.ws + WS_GATE);
    const float* ISD = (const float*)(F.ws + WS_ISD); const float* ISU = (const float*)(F.ws + WS_ISU); unsigned* WQ = (unsigned*)(F.ws + WS_WEX); float* WSC = (float*)(F.ws + WS_WEX + 8 * MiB); const float* RSTD2 = (const float*)(F.ws + WS_RSTD2);
    const int lane = F.lane, g = lane >> 3, w = lane & 7, cl = ((w & 1) << 2) | (w & 2) | ((w >> 2) & 1);
    for (int t = F.bid * NWAVES + F.wave; t < T; t += F.G * NWAVES) {
        float a0 = 0.f, a1 = 0.f;
#pragma unroll
        for (int k = 0; k < 4; ++k) { const unsigned r = PAW[((size_t)k * T + t) * 64 + 8 * g + cl]; a0 += __builtin_bit_cast(float, r << 16); a1 += __builtin_bit_cast(float, r & 0xffff0000u); }
        const unsigned idp = IDXW[(size_t)t * 64 + 8 * g + w]; const int id0 = (int)(idp & 0xffffu), id1 = (int)(idp >> 16);
        const float g0 = GATE[(size_t)t * 128 + 16 * w + g], g1 = GATE[(size_t)t * 128 + 16 * w + 8 + g], rs = RSTD2[t];
        const pg8::f32x2 ge = pg8::gelu_pk((pg8::f32x2){a0 * rs * ISD[id0], a1 * rs * ISD[id1]});
        const float w0 = g0 * ge.x * ISU[id0], w1 = g1 * ge.y * ISU[id1];
        float mx = fmaxf(fabsf(w0), fabsf(w1));
#pragma unroll
        for (int o = 1; o < 64; o <<= 1) mx = fmaxf(mx, __shfl_xor(mx, o));
        const float sw = mx > 0.f ? 119.f / mx : 1.f, isw = mx > 0.f ? mx * (1.f / 119.f) : 1.f;
        const unsigned by = ((unsigned)(int)rintf(w0 * sw) & 0xffu) | (((unsigned)(int)rintf(w1 * sw) & 0xffu) << 8);
        const unsigned h = nib_hi(by) & 0x0F0Fu, l = nib_lo(by) & 0x0F0Fu;
        unsigned hv = ((h | (h >> 4)) & 0xffu) << (8 * (w & 3)), lv = ((l | (l >> 4)) & 0xffu) << (8 * (w & 3));
        hv |= (unsigned)__builtin_amdgcn_update_dpp(0, (int)hv, 0xB1, 0xF, 0xF, false); hv |= (unsigned)__builtin_amdgcn_update_dpp(0, (int)hv, 0x4E, 0xF, 0xF, false);
        lv |= (unsigned)__builtin_amdgcn_update_dpp(0, (int)lv, 0xB1, 0xF, 0xF, false); lv |= (unsigned)__builtin_amdgcn_update_dpp(0, (int)lv, 0x4E, 0xF, 0xF, false);
        if ((w & 3) == 0) { WQ[(size_t)t * 32 + 4 * g + (w >> 2)] = hv; WQ[(size_t)t * 32 + 4 * g + 2 + (w >> 2)] = lv; }
        if (lane == 0) WSC[t] = isw;
    }
}
__device__ __forceinline__ void peer_up_compute(const v4u (&q)[16], const v4u wq, float isw, v2u hraw, float* dstp, int lane) {
    const int whi[2] = {(int)wq.x, (int)wq.y}, wlo[2] = {(int)wq.z, (int)wq.w};
    constexpr unsigned NM = 0x0F0F0F0Fu;
    int res[4];
#pragma unroll
    for (int jj = 0; jj < 2; ++jj) {
    int f[16];
#pragma unroll
    for (int j2 = 0; j2 < 2; ++j2) { const int j = 2 * jj + j2;
        unsigned tcc[2][8];
#pragma unroll
        for (int o = 0; o < 2; ++o) {
            unsigned a0[4], a1[4];
#pragma unroll
            for (int pr = 0; pr < 4; ++pr) { const unsigned r0 = q[8 * o + 2 * pr][j], r1 = q[8 * o + 2 * pr + 1][j];
                a0[pr] = (r0 & NM) | ((r1 << 4) & ~NM); a1[pr] = ((r0 >> 4) & NM) | (r1 & ~NM); }
#pragma unroll
            for (int x = 0; x < 2; ++x) {
                unsigned b[2][2];
#pragma unroll
                for (int h = 0; h < 2; ++h) { const unsigned lo = x ? a1[2 * h] : a0[2 * h], hi = x ? a1[2 * h + 1] : a0[2 * h + 1];
                    b[h][0] = __builtin_amdgcn_perm(hi, lo, 0x05010400u); b[h][1] = __builtin_amdgcn_perm(hi, lo, 0x07030602u); }
#pragma unroll
                for (int p = 0; p < 2; ++p) { tcc[o][2 * (2 * p) + x] = __builtin_amdgcn_perm(b[1][p], b[0][p], 0x05040100u); tcc[o][2 * (2 * p + 1) + x] = __builtin_amdgcn_perm(b[1][p], b[0][p], 0x07060302u); }
            }
        }
#pragma unroll
        for (int n = 0; n < 8; ++n) { int a = __builtin_amdgcn_sdot8((int)tcc[0][n], whi[0], 0, true);     a = __builtin_amdgcn_sdot8((int)tcc[1][n], whi[1], a, false);
            a = __builtin_amdgcn_sdot8((int)tcc[0][n], wlo[0], a << 4, false); a = __builtin_amdgcn_sdot8((int)tcc[1][n], wlo[1], a, false); f[8 * j2 + n] = a; }
    }
    treduce16i_g(f, lane); res[2 * jj] = f[0]; res[2 * jj + 1] = f[1];
    }
    *(f32x2_t*)dstp = (f32x2_t){__builtin_bit_cast(float, hraw.x << 16) + (float)res[0] * isw, __builtin_bit_cast(float, hraw.x & 0xffff0000u) + (float)res[1] * isw};
    *(f32x2_t*)(dstp + 16) = (f32x2_t){__builtin_bit_cast(float, hraw.y << 16) + (float)res[2] * isw, __builtin_bit_cast(float, hraw.y & 0xffff0000u) + (float)res[3] * isw};
}
__device__ __forceinline__ void peer_up_phase(Frame& F, float* dst) {
    const unsigned char* TU = F.ws + WS_EXU8; const unsigned short* IDX = (const unsigned short*)(F.ws + WS_IDX); const bf16_t* WEX = (const bf16_t*)(F.ws + WS_WEX);
    float* out = F.out;
    const int lane = F.lane, g = lane >> 3, cl = lane & 7, k = (F.bid & 7) >> 1, nw = (F.G >> 3) * 2 * NWAVES;
    const __amdgpu_buffer_rsrc_t tk = wt_rsrc(TU + (size_t)k * 16384 * 128); const unsigned loff = 16u * (unsigned)cl;
    const int ccol = 256 * k + 32 * cl + 2 * g;
    int t = ((F.bid >> 3) * 2 + (F.bid & 1)) * NWAVES + F.wave;
    if (t >= T) return;
    LAS unsigned char* scrI = F.lds + F.wave * 512; LAS unsigned char* scrW = scrI + 256;
    const unsigned* IDXW = (const unsigned*)IDX + lane; const unsigned* WEXW = (const unsigned*)WEX + (lane & 31); const float* WSC = (const float*)(F.ws + WS_WEX + 8 * MiB);
    i32x4v id[4];
    unsigned idr = IDXW[(size_t)t * 64], wr = WEXW[(size_t)t * 32]; float ws = WSC[t];
    peer_ids_lds(scrI, idr, lane, id);
    v4u qa[16], qb[16];
    peer_gather16(qa, tk, loff, id);
    { const int tl = (t + nw < T) ? t + nw : t; idr = IDXW[(size_t)tl * 64]; }
    const bf16_t* hb16 = (const bf16_t*)(F.ws + WS_HB2);
    v2u hcur; hcur.x = *(const unsigned*)(hb16 + (size_t)t * D + ccol); hcur.y = *(const unsigned*)(hb16 + (size_t)t * D + ccol + 16);
#define PEER_UP_STEP(QC, QN) { \
        const int t1 = t + nw, t2 = t + 2 * nw; const bool has1 = t1 < T; \
        peer_ids_lds(scrI, idr, lane, id); \
        if (has1) peer_gather16(QN, tk, loff, id); \
        { const int tl = (t2 < T) ? t2 : t; idr = IDXW[(size_t)tl * 64]; } \
        const unsigned wrn = WEXW[(size_t)(has1 ? t1 : t) * 32]; const float wsn = WSC[has1 ? t1 : t]; \
        v2u hnext; hnext.x = *(const unsigned*)(hb16 + (size_t)(has1 ? t1 : t) * D + ccol); hnext.y = *(const unsigned*)(hb16 + (size_t)(has1 ? t1 : t) * D + ccol + 16); \
        *(LAS unsigned*)(scrW + 4 * (lane & 31)) = wr; asm volatile("" ::: "memory"); const v4u wc = *(const LAS v4u*)(scrW + 16 * g); asm volatile("" ::: "memory"); \
        __builtin_amdgcn_sched_barrier(0); \
        peer_up_compute(QC, wc, ws, hcur, dst + (size_t)t * D + ccol, lane); \
        __builtin_amdgcn_sched_barrier(0); \
        if (!has1) break; t = t1; hcur = hnext; wr = wrn; ws = wsn; }
    for (;;) { PEER_UP_STEP(qa, qb) PEER_UP_STEP(qb, qa) }
#undef PEER_UP_STEP
}
__device__ __forceinline__ void expert_convert(Frame& F, const float* exd, const float* exu, const float* gain2) {
    const int lane = F.lane;
    f32x4 gv[4];
#pragma unroll
    for (int j = 0; j < 4; ++j) gv[j] = *(const f32x4*)(gain2 + 16 * lane + 4 * j);
    const bool wsplit = (F.G == 256); const int nscan = 128 * NWAVES;
    int gi = F.bid * NWAVES + F.wave, gstep = F.G * NWAVES, gend = 8192;
    if (wsplit) { gstep = nscan; if (F.bid < 128) { gend = 2 * nscan; } else { gi = 2 * nscan + (F.bid - 128) * NWAVES + F.wave; } }
    for (; gi < gend; gi += gstep) { const int r4 = gi * 4;
        const int tb = r4 >> 14, row0 = r4 & 16383;
        const float* src = (tb ? exu : exd) + (size_t)row0 * D + 16 * lane;
        f32x4 v[4][4]; float mx[4];
#pragma unroll
        for (int r = 0; r < 4; ++r)
#pragma unroll
            for (int j = 0; j < 4; ++j) v[r][j] = *(const f32x4*)(src + (size_t)r * D + 4 * j);
#pragma unroll
        for (int r = 0; r < 4; ++r) { float m = 0.f;
#pragma unroll
            for (int j = 0; j < 4; ++j) { if (tb == 0) v[r][j] = v[r][j] * gv[j]; m = fmaxf(m, fmaxf(fmaxf(fabsf(v[r][j].x), fabsf(v[r][j].y)), fmaxf(fabsf(v[r][j].z), fabsf(v[r][j].w)))); }
            mx[r] = m; }
#pragma unroll
        for (int o = 1; o < 64; o <<= 1)
#pragma unroll
            for (int r = 0; r < 4; ++r) mx[r] = fmaxf(mx[r], __shfl_xor(mx[r], o));
        {
            float ss[4];
#pragma unroll
            for (int r = 0; r < 4; ++r) { float s = 0.f;
#pragma unroll
                for (int j = 0; j < 4; ++j) s += (v[r][j].x * v[r][j].x + v[r][j].y * v[r][j].y) + (v[r][j].z * v[r][j].z + v[r][j].w * v[r][j].w);
                ss[r] = s; }
#pragma unroll
            for (int o = 1; o < 64; o <<= 1)
#pragma unroll
                for (int r = 0; r < 4; ++r) ss[r] += __shfl_xor(ss[r], o);
#pragma unroll
            for (int r = 0; r < 4; ++r) {
                const float rms = sqrtf(ss[r] * (1.f / 1024.f)), step = rms > 0.f ? 0.35f * rms : 1.f, sc = 1.f / step;
                f32x4 c[4];
#pragma unroll
                for (int j = 0; j < 4; ++j) { c[j] = v[r][j] * sc; c[j].x = fminf(fmaxf(c[j].x, -7.f), 7.f); c[j].y = fminf(fmaxf(c[j].y, -7.f), 7.f); c[j].z = fminf(fmaxf(c[j].z, -7.f), 7.f); c[j].w = fminf(fmaxf(c[j].w, -7.f), 7.f); }
                const unsigned x0 = pack_i8x4(c[0].x, c[0].z, c[1].x, c[1].z), y0 = pack_i8x4(c[0].y, c[0].w, c[1].y, c[1].w);
                const unsigned x1 = pack_i8x4(c[2].x, c[2].z, c[3].x, c[3].z), y1 = pack_i8x4(c[2].y, c[2].w, c[3].y, c[3].w);
                *(v2u*)(F.ws + (tb ? WS_EXU8 : WS_EXD8) + ((size_t)(lane >> 4) * 16384 + row0 + r) * 128 + (lane & 15) * 8) = (v2u){nib_lo(x0) | (nib_lo(y0) << 4), nib_lo(x1) | (nib_lo(y1) << 4)};
                if (lane == 0) wt_st4((float*)(F.ws + (tb ? WS_ISU : WS_ISD)) + row0 + r, step);
            }
            continue;
        }
        const __amdgpu_buffer_rsrc_t rr = wt_rsrc(F.ws + (tb ? WS_EXU8 : WS_EXD8));
#pragma unroll
        for (int r = 0; r < 4; ++r) {
            const float sc = mx[r] > 0.f ? 127.f / mx[r] : 1.f, isc = mx[r] > 0.f ? mx[r] * (1.f / 127.f) : 1.f;
            v4u q;
#pragma unroll
            for (int j = 0; j < 4; ++j) q[j] = pack_i8x4(v[r][j].x * sc, v[r][j].y * sc, v[r][j].z * sc, v[r][j].w * sc);
            wt_st16(rr, (unsigned)(((lane >> 3) * 16384 + row0 + r) * 128 + (lane & 7) * 16), q);
            if (lane == 0) wt_st4((float*)(F.ws + (tb ? WS_ISU : WS_ISD)) + row0 + r, isc);
        }
    }
}
#define XB_TMO      128
#define XB_XCNT(j)  (256  + 64 * (j))
#define XB_XSUB(j)  (1280 + 64 * (j))
#define XB_XGEN(j)  (2304 + 64 * (j))
#define XB_TOP      3328
#define XB_TOPGEN   3392
#define XCD_BAR_WORDS 3456
#define XB_SPIN_CAP (1u << 18)

__device__ __forceinline__ unsigned xb_ld(unsigned* p)              { return __hip_atomic_load(p, __ATOMIC_RELAXED, __HIP_MEMORY_SCOPE_AGENT); }
__device__ __forceinline__ unsigned xb_add(unsigned* p, unsigned v) { return __hip_atomic_fetch_add(p, v, __ATOMIC_RELAXED, __HIP_MEMORY_SCOPE_AGENT); }
__device__ __forceinline__ unsigned xb_xcc_id() { return (unsigned)__builtin_amdgcn_s_getreg((3 << 11) | 20) & 0xFu; }
#define XB_SPIN(cond, bar) do { unsigned _sp = 0; while (cond) { __builtin_amdgcn_s_sleep(1); \
    if ((++_sp & 255u) == 0u) { if (xb_ld(&(bar)[XB_TMO])) break; if (_sp > XB_SPIN_CAP) { atomicAdd(&(bar)[XB_TMO], 1u); break; } } } } while (0)

struct XcdBarrier {
    unsigned* bar; unsigned x;
    volatile LAS unsigned* st;
};

__device__ __forceinline__ XcdBarrier xcd_barrier_post(unsigned* bar, volatile LAS unsigned* st) {
    XcdBarrier b; b.bar = bar; b.x = xb_xcc_id(); b.st = st;
    if (threadIdx.x == 0) (void)xb_add(&bar[XB_XCNT(b.x)], 1u);
    return b;
}
__device__ __forceinline__ void xcd_barrier_complete(unsigned* bar, unsigned x, unsigned& nloc, unsigned& nx) {
    const unsigned G = gridDim.x * gridDim.y * gridDim.z;
    unsigned sum, cnt, mine, sp = 0u;
    for (;;) {
        sum = 0u; cnt = 0u; mine = 0u;
#pragma unroll
        for (unsigned j = 0; j < 16; ++j) { const unsigned c = xb_ld(&bar[XB_XCNT(j)]); sum += c; cnt += (c > 0u) ? 1u : 0u; mine = (j == x) ? c : mine; }
        if (sum == G) break;
        __builtin_amdgcn_s_sleep(1);
        if ((++sp & 255u) == 0u) { if (xb_ld(&bar[XB_TMO])) break; if (sp > XB_SPIN_CAP) { atomicAdd(&bar[XB_TMO], 1u); break; } }
    }
    nloc = mine > 0u ? mine : 1u; nx = cnt > 0u ? cnt : 1u;
}

__device__ __forceinline__ void xcd_barrier(const XcdBarrier& b) {
    asm volatile("s_waitcnt vmcnt(0)" ::: "memory");
    __syncthreads();
    if (threadIdx.x == 0) {
        unsigned* bar = b.bar;
        __builtin_amdgcn_s_waitcnt(0);
        unsigned nloc = b.st[0], nx = b.st[1];
        if (nloc == 0u) { xcd_barrier_complete(bar, b.x, nloc, nx); b.st[0] = nloc; b.st[1] = nx; }
        const unsigned old = xb_add(&bar[XB_XSUB(b.x)], 1u);
        const unsigned gen = old / nloc;
        if (old + 1u == (gen + 1u) * nloc) {
            __builtin_amdgcn_fence(__ATOMIC_RELEASE, "agent");
            asm volatile("s_waitcnt vmcnt(0)" ::: "memory");
            const unsigned og = xb_add(&bar[XB_TOP], 1u);
            const unsigned tg = og / nx;
            if (og + 1u == (tg + 1u) * nx) xb_add(&bar[XB_TOPGEN], 1u);
            else XB_SPIN(xb_ld(&bar[XB_TOPGEN]) == tg, bar);
            __builtin_amdgcn_fence(__ATOMIC_ACQUIRE, "agent");
            xb_add(&bar[XB_XGEN(b.x)], 1u);
            asm volatile("s_waitcnt vmcnt(0)" ::: "memory");
        } else {
            XB_SPIN(xb_ld(&bar[XB_XGEN(b.x)]) == gen, bar);
            __builtin_amdgcn_fence(__ATOMIC_ACQUIRE, "agent");
            asm volatile("s_waitcnt vmcnt(0)" ::: "memory");
        }
    }
    __syncthreads();
}

__global__ void __launch_bounds__(NTHR, 2) mega(Args args) {
    extern __shared__ __attribute__((aligned(16))) unsigned char lds_raw[];
    Frame F;
    F.lds = (LAS unsigned char*)lds_raw;
    F.tid = threadIdx.x; F.lane = F.tid & 63; F.wave = __builtin_amdgcn_readfirstlane(F.tid >> 6); F.G = gridDim.x; F.bid = blockIdx.x;
    F.out = args.out; F.ws = args.ws;
    const int lo = args.ph_lo, hi = args.ph_hi;
    cg::grid_group grid = cg::this_grid();
    volatile LAS unsigned* MISC = (volatile LAS unsigned*)(F.lds + LDS_BYTES - 64);
    if (F.tid < 16) MISC[F.tid] = 0u;
    __syncthreads();
    XcdBarrier bar = xcd_barrier_post((unsigned*)(F.ws + WS_CTL) + 4096, MISC + 8);
    if (hi - lo > 1) grid.sync();
#define IN(k) (lo <= (k) && (k) < hi)
#define SEAM(k) do { if (IN(k) && IN((k) + 1)) xcd_barrier(bar); } while (0)
    if (IN(0)) { p0_prologue(F, args.in[0], args.in[1], args.in[2], args.in[13], args.in[10], args.in[11], args.in[12], args.in[14], args.in[15]); }
    SEAM(0);
    if (IN(1)) {
        pg8::Gemm g{(const bf16_t*)(F.ws + WS_XB), (const bf16_t*)(F.ws + WS_WIN), T, NPROJ, D}; pg8::StaticOrder S; S.init(T, NPROJ, F.G, F.bid);
        pg8::EpiProj E{(bf16_t*)(F.ws + WS_GQ), (bf16_t*)(F.ws + WS_GK), (bf16_t*)(F.ws + WS_GV), (bf16_t*)(F.ws + WS_GR), (bf16_t*)(F.ws + WS_SQ), (bf16_t*)(F.ws + WS_SK), (bf16_t*)(F.ws + WS_SV),
                       (bf16_t*)F.out, (bf16_t*)F.out + (size_t)T * D, (const float*)(F.ws + WS_RSTD1)};
        pg8::gemm_phase<pg8::EpiProj, pg8::StaticOrder, PG8_ALIGN, PG8_SP2>(F.lds, g, S, E);
    }
    SEAM(1);
    if (IN(2)) { gla_local_phase(F, args.in[3], args.in[4]); }
    SEAM(2);
    if (IN(3)) { gla_scan_phase(F); expert_convert(F, args.in[16], args.in[17], args.in[13]); swa_phase(F, args.in[6], args.in[7], args.in[8], args.in[9], (size_t)0); }
    SEAM(3);
    if (IN(4)) { gla_out_phase(F, args.in[3], args.in[4], args.in[5]); }
    SEAM(4);
    if (IN(5)) {
        pg8::PairOrder S; S.base.init(T, D, F.G, F.bid);
        pg8::Gemm g{(const bf16_t*)(F.ws + WS_YG), (const bf16_t*)(F.ws + WS_WG), T, D, D, (const bf16_t*)(F.ws + WS_SQ), (const bf16_t*)(F.ws + WS_WS)};
        pg8::EpiMergeBoth E{{(const bf16_t*)F.out, (const bf16_t*)F.out + (size_t)T * D, (bf16_t*)(F.ws + WS_MRG)}, {(const bf16_t*)F.out, (const bf16_t*)F.out + (size_t)T * D, (bf16_t*)(F.ws + WS_MRG)}};
        pg8::gemm_phase<pg8::EpiMergeBoth, pg8::PairOrder, PG8_ALIGN, PG8_SP2>(F.lds, g, S, E);
    }
    SEAM(5);
    if (IN(6)) {
        pg8::StaticOrder S; S.init(T, D, F.G, F.bid);
        pg8::Gemm g{(const bf16_t*)(F.ws + WS_MRG), (const bf16_t*)(F.ws + WS_WO), T, D, D};
        pg8::EpiOut E{(const bf16_t*)(F.ws + WS_XB), F.out, (bf16_t*)(F.ws + WS_HB2), (float*)(F.ws + WS_ROWSS2), T};
        pg8::gemm_phase<pg8::EpiOut, pg8::StaticOrder, PG8_ALIGN, PG8_SP2>(F.lds, g, S, E);
    }
    SEAM(6);
    if (IN(7)) {
        pg8::StaticOrder S; S.init(T, 2048, F.G, F.bid);
        pg8::Gemm g{(const bf16_t*)(F.ws + WS_HB2), (const bf16_t*)(F.ws + WS_WQ), T, 2048, D};
        pg8::EpiQ E{(const float*)(F.ws + WS_ROWSS2), (bf16_t*)(F.ws + WS_QP), T};
        pg8::gemm_phase<pg8::EpiQ, pg8::StaticOrder, PG8_ALIGN, PG8_SP2>(F.lds, g, S, E);
    }
    if (IN(7) && IN(8)) __syncthreads();
    if (IN(8)) {
        { const float* ROWSS = (const float*)(F.ws + WS_ROWSS2); float* RSTD2 = (float*)(F.ws + WS_RSTD2);
          for (int t = F.bid * NTHR + F.tid; t < T; t += F.G * NTHR) { float s = 0.f;
#pragma unroll
              for (int kk = 0; kk < 4; ++kk) { const f32x4 p4 = *(const f32x4*)(ROWSS + (size_t)t * 16 + 4 * kk); s += (p4.x + p4.y) + (p4.z + p4.w); }
              wt_st4(RSTD2 + t, rsqrtf(s * (1.f / 1024.f) + EPS)); } }
        peer_quant_phase(F);
        peer_topk_phase(F);
    }
    SEAM(8);
    if (IN(9)) { peer_down_phase(F); }
    SEAM(9);
    if (IN(10)) { peer_combine_phase(F); }
    SEAM(10);
    if (IN(11)) { peer_up_phase(F, F.out); }
#undef IN
#undef SEAM
}
}

extern "C" void kernel_launch(void* const* d_in, const int* in_sizes, int n_in, void* d_out, int out_size, void* d_ws, size_t ws_size, hipStream_t stream) {
    using namespace mk;
    static int grid = 0;
    if (grid == 0) {
        int dev_ = 0, cus = 0, per_cu = 0;
        if (hipGetDevice(&dev_) != hipSuccess || hipDeviceGetAttribute(&cus, hipDeviceAttributeMultiprocessorCount, dev_) != hipSuccess) { fprintf(stderr, "device query failed\n"); grid = -1; return; }
        if (hipFuncSetAttribute((const void*)mega, hipFuncAttributeMaxDynamicSharedMemorySize, LDS_BYTES) != hipSuccess) { fprintf(stderr, "hipFuncSetAttribute failed\n"); grid = -1; return; }
        if (hipOccupancyMaxActiveBlocksPerMultiprocessor(&per_cu, (const void*)mega, NTHR, LDS_BYTES) != hipSuccess || per_cu < 1) { fprintf(stderr, "occupancy query: %d\n", per_cu); per_cu = 1; }
        (void)hipGetLastError();
        grid = cus * 1;
        fprintf(stderr, "mega: cus %d per_cu %d grid %d\n", cus, per_cu, grid);
    }
    if (grid < 0) return;
    (void)hipMemsetAsync((char*)d_ws + WS_CTL, 0, CTL_ZERO_BYTES, stream);
    Args a{};
    for (int i = 0; i < 18; ++i) a.in[i] = (const float*)d_in[i];
    a.out = (float*)d_out; a.ws = (unsigned char*)d_ws; a.ph_lo = 0; a.ph_hi = 12;
    void* kargs[] = {&a};
    hipError_t e = hipLaunchCooperativeKernel((const void*)mega, dim3(grid), dim3(NTHR), kargs, LDS_BYTES, stream);
    if (e != hipSuccess) fprintf(stderr, "cooperative launch failed: %s\n", hipGetErrorString(e));
}
```

```cpp
#include <hip/hip_runtime.h>
#include <hip/hip_cooperative_groups.h>
#include <cstdio>
#include <cstdint>
#include <math.h>
namespace cg = cooperative_groups;
#ifndef WT_AUX
#define WT_AUX 0
#endif
typedef unsigned wt_u32x4 __attribute__((ext_vector_type(4)));
__device__ __forceinline__ __amdgpu_buffer_rsrc_t wt_rsrc(const void* base) { return __builtin_amdgcn_make_buffer_rsrc((void*)base, 0, 0x7FFFFFF0, 0x00020000); }
__device__ __forceinline__ void wt_st16(__amdgpu_buffer_rsrc_t r, unsigned byte_off, wt_u32x4 v) { __builtin_amdgcn_raw_buffer_store_b128(v, r, byte_off, 0, WT_AUX); }
typedef unsigned wt_u32x2 __attribute__((ext_vector_type(2)));
__device__ __forceinline__ void wt_st8(void* p, unsigned lo, unsigned hi) { if (WT_AUX) __hip_atomic_store((unsigned long long*)p, ((unsigned long long)hi << 32) | lo, __ATOMIC_RELAXED, __HIP_MEMORY_SCOPE_AGENT); else *(wt_u32x2*)p = (wt_u32x2){lo, hi}; }
__device__ __forceinline__ void wt_st4(float* p, float v) { if (WT_AUX) __hip_atomic_store(p, v, __ATOMIC_RELAXED, __HIP_MEMORY_SCOPE_AGENT); else *p = v; }
__device__ __forceinline__ void wtx_st16(__amdgpu_buffer_rsrc_t r, unsigned byte_off, wt_u32x4 v) { __builtin_amdgcn_raw_buffer_store_b128(v, r, byte_off, 0, 16); }
__device__ __forceinline__ void wtx_st8(void* p, unsigned lo, unsigned hi) { __hip_atomic_store((unsigned long long*)p, ((unsigned long long)hi << 32) | lo, __ATOMIC_RELAXED, __HIP_MEMORY_SCOPE_AGENT); }
__device__ __forceinline__ void wtx_st4(float* p, float v) { __hip_atomic_store(p, v, __ATOMIC_RELAXED, __HIP_MEMORY_SCOPE_AGENT); }
namespace pg8 {
#define PG8_LAS __attribute__((address_space(3)))
typedef unsigned short bf16_t;
typedef short bf16x8 __attribute__((ext_vector_type(8)));
typedef float f32x4 __attribute__((ext_vector_type(4)));
typedef unsigned u32x4 __attribute__((ext_vector_type(4)));
constexpr int BM = 256, BK = 64, HALF = 128, HTB = HALF * BK * 2  , STAGE_BYTES = 8 * HTB, NXCD = 8, WGM = 8;

__host__ __device__ __forceinline__ int lds_byte(int r, int c) { const int st = (r >> 4) * 2 + (c >> 5), rr = r & 15, cc = c & 31, ob = rr * 64 + cc * 2; return st * 1024 + (ob ^ (((ob >> 9) & 1) << 5)); }
__host__ __device__ __forceinline__ void stage_rc(int b, int& R, int& C) { const int st = b / 1024, sb = b % 1024, swz = sb ^ (((sb >> 9) & 1) << 5); R = (st >> 1) * 16 + swz / 64; C = (st & 1) * 32 + (swz % 64) / 2; }
__host__ __device__ __forceinline__ int perm32(int rho) { const int n = rho >> 4, i = rho & 15; return 8 * (i >> 2) + 4 * n + (i & 3); }

struct Unit { int pm, pn, sel; };
struct Gemm { const bf16_t* A; const bf16_t* Bt; int M, N, K; const bf16_t* A2; const bf16_t* Bt2; };

struct StaticOrder {
    int nM, nN, nwg, G, c;
    __host__ __device__ void init(int M, int N, int G_, int c_) { nM = M / BM; nN = N / BM; nwg = nM * nN; G = G_; c = c_; }
    __host__ __device__ bool next(int i, Unit& u) const {
        const long L = (long)i * G + c; if (L >= nwg) return false;
        int wgid = (int)L; { const int q = nwg / NXCD, r = nwg % NXCD, xcd = wgid % NXCD, off = wgid / NXCD; wgid = (xcd < r ? xcd * (q + 1) : r * (q + 1) + (xcd - r) * q) + off; }
        const int nig = WGM * nN, gid = wgid / nig, fm = gid * WGM, gsz = (nM - fm) < WGM ? (nM - fm) : WGM;
        u.pm = fm + ((wgid % nig) % gsz); u.pn = (wgid % nig) / gsz; u.sel = 0; return true;
    }
    __device__ __forceinline__ void a_ready(const Unit&) const {}
    __device__ __forceinline__ void done(const Unit&) const {}
    __device__ __forceinline__ bool keep(const Unit&) const { return false; }
};

__device__ __forceinline__ unsigned cvt_pk_bf16(float lo, float hi) { unsigned r; asm volatile("v_cvt_pk_bf16_f32 %0, %1, %2" : "=v"(r) : "v"(lo), "v"(hi)); return r; }
typedef float f32x2 __attribute__((ext_vector_type(2)));
__device__ __forceinline__ f32x2 gelu_pk(f32x2 v) {
    const f32x2 av = __builtin_elementwise_abs(v), d = av * 0.2316418882f + 1.0f;
    f32x2 t; t.x = __builtin_amdgcn_rcpf(d.x); t.y = __builtin_amdgcn_rcpf(d.y);
    f32x2 q = t * 0.5307027145f + (-0.7265760135f); q = q * t + 0.7107068705f; q = q * t + (-0.142248368f); q = q * t + 0.127414796f; q = q * t;
    const f32x2 s = (v * v) * (-0.72134752044f);
    f32x2 e; e.x = __builtin_amdgcn_exp2f(s.x); e.y = __builtin_amdgcn_exp2f(s.y);
    const f32x2 m = v * (q * e), r = v - m;
    f32x2 o; o.x = v.x < 0.f ? m.x : r.x; o.y = v.y < 0.f ? m.y : r.y; return o;
}

template <int ACT  > struct EpiBf16 {
    static constexpr bool PERM = true, AFTER_DRAIN = false; static_assert(ACT == 0 || ACT == 1, "EpiBf16: ACT is 0 (none) or 1 (gelu_pk)");
    bf16_t* O; int ldc; const float* bias; int split_cols; size_t split_stride; float scale0;
    __device__ __forceinline__ void operator()(const f32x4 (&acc)[2][2][4][2], const Unit& u, int wr, int wc, int fr, int fq) const {
        const int row0 = u.pm * BM + wr * 64 + fr; int colt = u.pn * BM; bf16_t* base = O;
        float sc = 1.f; if (split_cols) { const int t = colt / split_cols; base += (size_t)t * split_stride; colt -= t * split_cols; if (t == 0) sc = scale0; }
        const int col0 = colt + wc * 32 + 8 * fq, bcol0 = u.pn * BM + wc * 32 + 8 * fq;
        f32x4 bv[2][2];
#pragma unroll
        for (int bj = 0; bj < 2; ++bj)
#pragma unroll
            for (int n = 0; n < 2; ++n) bv[bj][n] = bias ? *(const f32x4*)(bias + bcol0 + bj * HALF + 4 * n) : (f32x4){0.f, 0.f, 0.f, 0.f};
#pragma unroll
        for (int ai = 0; ai < 2; ++ai)
#pragma unroll
            for (int m = 0; m < 4; ++m) { bf16_t* rowp = base + (size_t)(row0 + ai * HALF + m * 16) * ldc + col0;
#pragma unroll
                for (int bj = 0; bj < 2; ++bj) { f32x4 v0 = acc[ai][bj][m][0] + bv[bj][0], v1 = acc[ai][bj][m][1] + bv[bj][1];
                    if (ACT == 1) { f32x2 a = gelu_pk((f32x2){v0[0], v0[1]}), b = gelu_pk((f32x2){v0[2], v0[3]}), c = gelu_pk((f32x2){v1[0], v1[1]}), d = gelu_pk((f32x2){v1[2], v1[3]});
                        v0 = (f32x4){a.x, a.y, b.x, b.y}; v1 = (f32x4){c.x, c.y, d.x, d.y}; }
                    v0 = v0 * sc; v1 = v1 * sc; u32x4 w; w.x = cvt_pk_bf16(v0[0], v0[1]); w.y = cvt_pk_bf16(v0[2], v0[3]); w.z = cvt_pk_bf16(v1[0], v1[1]); w.w = cvt_pk_bf16(v1[2], v1[3]);
                    *(u32x4*)(rowp + bj * HALF) = w; } }
    }
};
__device__ __forceinline__ float sigm_fast(float v) { return __builtin_amdgcn_rcpf(1.0f + __builtin_amdgcn_exp2f(v * -1.4426950408889634f)); }
struct EpiProj {
    static constexpr bool PERM = true, AFTER_DRAIN = false;
    bf16_t *GQ, *GK, *GV, *GR, *SQ, *SK, *SV, *GA, *GB; const float* rstd;
    __device__ __forceinline__ void operator()(const f32x4 (&acc)[2][2][4][2], const Unit& u, int wr, int wc, int fr, int fq) const {
        const int pn = u.pn; bf16_t* base; int ldc, act = 0;
        if (pn < 2) { base = GQ + pn * 256; ldc = 512; }
        else if (pn < 4) { base = GK + (pn - 2) * 256; ldc = 512; }
        else if (pn < 8) { base = GV + (pn - 4) * 256; ldc = 1024; }
        else if (pn < 12) { base = GR + (pn - 8) * 256; ldc = 1024; act = 1; }
        else if (pn < 16) { base = SQ + (pn - 12) * 256; ldc = 1024; }
        else if (pn == 16) { base = SK; ldc = 256; }
        else if (pn == 17) { base = SV; ldc = 256; }
        else if (pn < 22) { base = GA + (pn - 18) * 256; ldc = 1024; act = 2; }
        else { base = GB + (pn - 22) * 256; ldc = 1024; act = 2; }
        const int row0 = u.pm * BM + wr * 64 + fr, col0 = wc * 32 + 8 * fq;
        const __amdgpu_buffer_rsrc_t rs_ = wt_rsrc(base);
#pragma unroll
        for (int ai = 0; ai < 2; ++ai)
#pragma unroll
            for (int m = 0; m < 4; ++m) { const int row = row0 + ai * HALF + m * 16; const float rs = rstd[row]; const unsigned rowoff = (unsigned)(((size_t)row * ldc + col0) * 2);
#pragma unroll
                for (int bj = 0; bj < 2; ++bj) { f32x4 v0 = acc[ai][bj][m][0] * rs, v1 = acc[ai][bj][m][1] * rs;
                    if (act) {
#pragma unroll
                        for (int e = 0; e < 4; ++e) { const float s0 = sigm_fast(v0[e]), s1 = sigm_fast(v1[e]); v0[e] = (act == 1) ? v0[e] * s0 : s0; v1[e] = (act == 1) ? v1[e] * s1 : s1; } }
                    u32x4 w; w.x = cvt_pk_bf16(v0[0], v0[1]); w.y = cvt_pk_bf16(v0[2], v0[3]); w.z = cvt_pk_bf16(v1[0], v1[1]); w.w = cvt_pk_bf16(v1[2], v1[3]);
                    wt_st16(rs_, rowoff + bj * HALF * 2, w); } }
    }
};

__device__ __forceinline__ void bf8_to_f32(const u32x4 raw, float (&f)[8]) {
#pragma unroll
    for (int j = 0; j < 4; ++j) { f[2 * j] = __builtin_bit_cast(float, raw[j] << 16); f[2 * j + 1] = __builtin_bit_cast(float, raw[j] & 0xffff0000u); }
}
template <int STEP> struct EpiMerge {
    static constexpr bool PERM = true, AFTER_DRAIN = false;
    const bf16_t* ga; const bf16_t* gb; bf16_t* outp;
    __device__ __forceinline__ void operator()(f32x4 (&acc)[2][2][4][2], const Unit& u, int wr, int wc, int fr, int fq) const {
        const int row0 = u.pm * BM + wr * 64 + fr, col0 = u.pn * BM + wc * 32 + 8 * fq;
        const __amdgpu_buffer_rsrc_t dst_r = wt_rsrc(outp);
#pragma unroll
        for (int ai = 0; ai < 2; ++ai)
#pragma unroll
            for (int m = 0; m < 4; ++m) { const size_t rb = (size_t)(row0 + ai * HALF + m * 16) * 1024 + col0;
#pragma unroll
                for (int bj = 0; bj < 2; ++bj) { const size_t off = rb + bj * HALF;
                    float b[8]; bf8_to_f32(*(const u32x4*)(gb + off), b);
                    if (STEP == 0) { float a[8]; bf8_to_f32(*(const u32x4*)(ga + off), a);
#pragma unroll
                        for (int e = 0; e < 4; ++e) { acc[ai][bj][m][0][e] *= a[e] * __builtin_amdgcn_rcpf(fmaxf(b[e], 1e-30f)); acc[ai][bj][m][1][e] *= a[4 + e] * __builtin_amdgcn_rcpf(fmaxf(b[4 + e], 1e-30f)); }
                    } else {
                        float v[8];
#pragma unroll
                        for (int e = 0; e < 4; ++e) { v[e] = acc[ai][bj][m][0][e] * fmaxf(b[e], 1e-30f); v[4 + e] = acc[ai][bj][m][1][e] * fmaxf(b[4 + e], 1e-30f); }
                        u32x4 w; w.x = cvt_pk_bf16(v[0], v[1]); w.y = cvt_pk_bf16(v[2], v[3]); w.z = cvt_pk_bf16(v[4], v[5]); w.w = cvt_pk_bf16(v[6], v[7]);
                        wt_st16(dst_r, (unsigned)(off * 2), w); } } }
    }
};
struct EpiOut {
    static constexpr bool PERM = true, AFTER_DRAIN = false;
    const bf16_t* x; float* h1; bf16_t* hb; float* rowss; int M;
    __device__ __forceinline__ void operator()(const f32x4 (&acc)[2][2][4][2], const Unit& u, int wr, int wc, int fr, int fq) const {
        const int row0 = u.pm * BM + wr * 64 + fr, col0 = u.pn * BM + wc * 32 + 8 * fq;
        const __amdgpu_buffer_rsrc_t hb_r = wt_rsrc(hb);
#pragma unroll
        for (int ai = 0; ai < 2; ++ai)
#pragma unroll
            for (int m = 0; m < 4; ++m) { const int row = row0 + ai * HALF + m * 16; const size_t rb = (size_t)row * 1024 + col0; float ss = 0.f;
#pragma unroll
                for (int bj = 0; bj < 2; ++bj) { const size_t off = rb + bj * HALF;
                    const u32x4 xw = *(const u32x4*)(x + off);
                    f32x4 x0, x1; x0[0] = __uint_as_float(xw.x << 16); x0[1] = __uint_as_float(xw.x & 0xffff0000u); x0[2] = __uint_as_float(xw.y << 16); x0[3] = __uint_as_float(xw.y & 0xffff0000u);
                    x1[0] = __uint_as_float(xw.z << 16); x1[1] = __uint_as_float(xw.z & 0xffff0000u); x1[2] = __uint_as_float(xw.w << 16); x1[3] = __uint_as_float(xw.w & 0xffff0000u);
                    const f32x4 v0 = acc[ai][bj][m][0] + x0, v1 = acc[ai][bj][m][1] + x1;
                    u32x4 w; w.x = cvt_pk_bf16(v0[0], v0[1]); w.y = cvt_pk_bf16(v0[2], v0[3]); w.z = cvt_pk_bf16(v1[0], v1[1]); w.w = cvt_pk_bf16(v1[2], v1[3]);
                    wt_st16(hb_r, (unsigned)(off * 2), w);
                    ss += (v0[0] * v0[0] + v0[1] * v0[1]) + (v0[2] * v0[2] + v0[3] * v0[3]) + (v1[0] * v1[0] + v1[1] * v1[1]) + (v1[2] * v1[2] + v1[3] * v1[3]); }
                ss += __shfl_xor(ss, 16); ss += __shfl_xor(ss, 32);
                if (fq == 0) wt_st4(rowss + (size_t)row * 16 + u.pn * 4 + wc, ss); }
    }
};
struct EpiQ {
    static constexpr bool PERM = true, AFTER_DRAIN = false;
    const float* rowss; bf16_t* qp; int M;
    __device__ __forceinline__ void operator()(const f32x4 (&acc)[2][2][4][2], const Unit& u, int wr, int wc, int fr, int fq) const {
        const int row0 = u.pm * BM + wr * 64 + fr, col0 = u.pn * BM + wc * 32 + 8 * fq;
        const __amdgpu_buffer_rsrc_t qp_r = wt_rsrc(qp);
#pragma unroll
        for (int ai = 0; ai < 2; ++ai)
#pragma unroll
            for (int m = 0; m < 4; ++m) { const int row = row0 + ai * HALF + m * 16; float s = 0.f;
#pragma unroll
                for (int k = 0; k < 4; ++k) { const f32x4 p4 = *(const f32x4*)(rowss + (size_t)row * 16 + 4 * k); s += (p4[0] + p4[1]) + (p4[2] + p4[3]); }
                const float rs = rsqrtf(s * (1.f / 1024.f) + 1e-6f);
#pragma unroll
                for (int bj = 0; bj < 2; ++bj) { const f32x4 v0 = acc[ai][bj][m][0] * rs, v1 = acc[ai][bj][m][1] * rs;
                    u32x4 w; w.x = cvt_pk_bf16(v0[0], v0[1]); w.y = cvt_pk_bf16(v0[2], v0[3]); w.z = cvt_pk_bf16(v1[0], v1[1]); w.w = cvt_pk_bf16(v1[2], v1[3]);
                    wt_st16(qp_r, (unsigned)(((size_t)row * 2048 + col0 + bj * HALF) * 2), w); } }
    }
};

struct PairOrder {
    StaticOrder base;
    __device__ bool next(int i, Unit& u) const { const bool ok = base.next(i >> 1, u); u.sel = i & 1; return ok; }
    __device__ __forceinline__ void a_ready(const Unit&) const {}
    __device__ __forceinline__ void done(const Unit&) const {}
    __device__ __forceinline__ bool keep(const Unit& u) const { return u.sel == 0; }
};
struct EpiMergeBoth {
    static constexpr bool PERM = true, AFTER_DRAIN = false;
    EpiMerge<0> e0; EpiMerge<1> e1;
    __device__ __forceinline__ void operator()(f32x4 (&acc)[2][2][4][2], const Unit& u, int wr, int wc, int fr, int fq) const { if (u.sel == 0) e0(acc, u, wr, wc, fr, fq); else e1(acc, u, wr, wc, fr, fq); }
};
template <class Epi, class Sched, bool ALIGN_EPI = false, bool SP2 = false>
__device__ __forceinline__ void gemm_phase(PG8_LAS unsigned char* lds, const Gemm g, const Sched& S, const Epi& E) {
    const int tid = threadIdx.x, wid = __builtin_amdgcn_readfirstlane(tid >> 6), lane = tid & 63, wr = wid >> 2, wc = wid & 3, fr = lane & 15, fq = lane >> 4;
    const int K = g.K, nt = K / BK;
    unsigned voffA[2], voffB[2];
#pragma unroll
    for (int i = 0; i < 2; ++i) { int R, C; stage_rc(tid * 16 + i * 8192, R, C); const int Rb = Epi::PERM ? ((R & ~31) + perm32(R & 31)) : R;
        voffA[i] = (unsigned)(R * K + C) * 2u; voffB[i] = (unsigned)(Rb * K + C) * 2u; }
    const size_t kstep = (size_t)(BK * 2);
    const size_t hstep = (size_t)HALF * K * 2;
    const size_t tstep = 2 * hstep;
    const unsigned ldsw = (unsigned)wid * 1024u;
    const int aoff = lds_byte(wr * 64 + fr, fq * 8), boff = lds_byte(wc * 32 + fr, fq * 8);
#define PG8_SA(b, h) (((b) * 2 + (h)) * HTB)
#define PG8_SB(b, h) ((4 + (b) * 2 + (h)) * HTB)
#define PG8_STAGE(bufoff, gbase, voff) do { _Pragma("unroll") for (int _i = 0; _i < 2; ++_i) \
        __builtin_amdgcn_global_load_lds((const unsigned*)((const char*)(gbase) + (voff)[_i]), (PG8_LAS unsigned*)(lds + (bufoff) + ldsw + _i * 8192), 16, 0, 0); } while (0)
#define PG8_LDA(dst, b, h) do { _Pragma("unroll") for (int m = 0; m < 4; ++m) _Pragma("unroll") for (int k = 0; k < 2; ++k) dst[m][k] = *(const PG8_LAS bf16x8*)(lds + PG8_SA(b, h) + aoff + m * 2048 + k * 1024); } while (0)
#define PG8_LDB(dst, b, h) do { _Pragma("unroll") for (int n = 0; n < 2; ++n) _Pragma("unroll") for (int k = 0; k < 2; ++k) dst[n][k] = *(const PG8_LAS bf16x8*)(lds + PG8_SB(b, h) + boff + n * 2048 + k * 1024); } while (0)
#define PG8_MMA(ai, bj, At, Bt) do { __builtin_amdgcn_s_setprio(1); _Pragma("unroll") for (int m = 0; m < 4; ++m) _Pragma("unroll") for (int n = 0; n < 2; ++n) _Pragma("unroll") for (int k = 0; k < 2; ++k) \
        acc[ai][bj][m][n] = __builtin_amdgcn_mfma_f32_16x16x32_bf16(Bt[n][k], At[m][k], acc[ai][bj][m][n], 0, 0, 0); __builtin_amdgcn_s_setprio(0); } while (0)
#define PG8_WAIT_V(n) asm volatile("s_waitcnt vmcnt(" #n ")" ::: "memory")
#define PG8_WAIT_L(n) asm volatile("s_waitcnt lgkmcnt(" #n ")" ::: "memory")
#define PG8_BAR __builtin_amdgcn_s_barrier()
#define PG8_SCHED __builtin_amdgcn_sched_barrier(0)
    Unit cur, nxt; int ui = 0;
    if (!S.next(0, cur)) return;
    f32x4 acc[2][2][4][2];
#pragma unroll
    for (int a = 0; a < 2; ++a)
#pragma unroll
        for (int b = 0; b < 2; ++b)
#pragma unroll
            for (int m = 0; m < 4; ++m)
#pragma unroll
                for (int n = 0; n < 2; ++n) acc[a][b][m][n] = (f32x4){0.f, 0.f, 0.f, 0.f};
    bf16x8 At[4][2], B0[2][2], B1[2][2];
    const char* cA = (const char*)(cur.sel ? g.A2 : g.A) + (size_t)cur.pm * tstep; const char* cB = (const char*)(cur.sel ? g.Bt2 : g.Bt) + (size_t)cur.pn * tstep;
    S.a_ready(cur);
    if constexpr (SP2) {
        PG8_STAGE(PG8_SB(0, 0), cB, voffB); PG8_STAGE(PG8_SB(0, 1), cB + hstep, voffB); PG8_STAGE(PG8_SA(0, 0), cA, voffA); PG8_STAGE(PG8_SA(0, 1), cA + hstep, voffA);
        if (wr == 1) PG8_BAR;
        PG8_WAIT_V(2); PG8_BAR;
        PG8_STAGE(PG8_SB(1, 0), cB + kstep, voffB); PG8_STAGE(PG8_SA(1, 0), cA + kstep, voffA); PG8_STAGE(PG8_SB(1, 1), cB + hstep + kstep, voffB);
        PG8_WAIT_V(6); PG8_BAR;
    } else {
        PG8_STAGE(PG8_SB(0, 0), cB, voffB); PG8_STAGE(PG8_SA(0, 0), cA, voffA); PG8_STAGE(PG8_SB(0, 1), cB + hstep, voffB); PG8_STAGE(PG8_SA(0, 1), cA + hstep, voffA);
        if (wr == 1) PG8_BAR;
        PG8_WAIT_V(4); PG8_BAR;
        PG8_STAGE(PG8_SB(1, 0), cB + kstep, voffB); PG8_STAGE(PG8_SA(1, 0), cA + kstep, voffA); PG8_STAGE(PG8_SB(1, 1), cB + hstep + kstep, voffB);
        PG8_WAIT_V(6); PG8_BAR;
    }
    for (;;) {
        const bool has_next = S.next(ui + 1, nxt);
        const char* nA = has_next ? (const char*)(nxt.sel ? g.A2 : g.A) + (size_t)nxt.pm * tstep : cA; const char* nB = has_next ? (const char*)(nxt.sel ? g.Bt2 : g.Bt) + (size_t)nxt.pn * tstep : cB;
        for (int t = 0; t < nt; t += 2) {
            const bool last = (t == nt - 2);
            const char* a1 = cA + (size_t)(t + 1) * kstep;
            const char* a2 = last ? nA : cA + (size_t)(t + 2) * kstep; const char* b2 = last ? nB : cB + (size_t)(t + 2) * kstep;
            const char* a3 = a2 + kstep; const char* b3 = b2 + kstep;
            if (last && has_next) S.a_ready(nxt);
            if constexpr (SP2) {
            PG8_LDB(B0, 0, 0); PG8_LDB(B1, 0, 1); PG8_SCHED; PG8_LDA(At, 0, 0); PG8_STAGE(PG8_SA(1, 1), a1 + hstep, voffA);
            PG8_WAIT_V(8); PG8_WAIT_L(0); PG8_BAR; PG8_MMA(0, 0, At, B0); PG8_MMA(0, 1, At, B1); PG8_BAR; PG8_SCHED;
            PG8_LDA(At, 0, 1); PG8_STAGE(PG8_SB(0, 0), b2, voffB); PG8_STAGE(PG8_SB(0, 1), b2 + hstep, voffB); PG8_STAGE(PG8_SA(0, 0), a2, voffA);
            PG8_WAIT_V(8); PG8_WAIT_L(0); PG8_BAR; PG8_MMA(1, 0, At, B0); PG8_MMA(1, 1, At, B1); PG8_BAR; PG8_SCHED;
            PG8_LDB(B0, 1, 0); PG8_LDB(B1, 1, 1); PG8_SCHED; PG8_LDA(At, 1, 0); PG8_STAGE(PG8_SA(0, 1), a2 + hstep, voffA);
            PG8_WAIT_V(8); PG8_WAIT_L(0); PG8_BAR; PG8_MMA(0, 0, At, B0); PG8_MMA(0, 1, At, B1); PG8_BAR; PG8_SCHED;
            PG8_LDA(At, 1, 1); PG8_STAGE(PG8_SB(1, 0), b3, voffB); PG8_STAGE(PG8_SB(1, 1), b3 + hstep, voffB); PG8_STAGE(PG8_SA(1, 0), a3, voffA);
            PG8_WAIT_V(8); PG8_WAIT_L(0); PG8_BAR; PG8_MMA(1, 0, At, B0); PG8_MMA(1, 1, At, B1); PG8_BAR; PG8_SCHED;
            } else {
            PG8_LDB(B0, 0, 0); PG8_SCHED; PG8_LDA(At, 0, 0); PG8_STAGE(PG8_SA(1, 1), a1 + hstep, voffA);
            PG8_WAIT_L(8); PG8_BAR; PG8_WAIT_L(0); PG8_MMA(0, 0, At, B0); PG8_BAR; PG8_SCHED;
            PG8_LDB(B1, 0, 1); PG8_STAGE(PG8_SB(0, 0), b2, voffB);
            PG8_BAR; PG8_WAIT_L(0); PG8_MMA(0, 1, At, B1); PG8_BAR;
            PG8_LDA(At, 0, 1); PG8_STAGE(PG8_SA(0, 0), a2, voffA);
            PG8_BAR; PG8_WAIT_L(0); PG8_MMA(1, 0, At, B0); PG8_BAR; PG8_SCHED;
            PG8_STAGE(PG8_SB(0, 1), b2 + hstep, voffB);
            PG8_WAIT_V(6); PG8_BAR; PG8_MMA(1, 1, At, B1); PG8_BAR;
            PG8_LDB(B0, 1, 0); PG8_SCHED; PG8_LDA(At, 1, 0); PG8_STAGE(PG8_SA(0, 1), a2 + hstep, voffA);
            PG8_WAIT_L(8); PG8_BAR; PG8_WAIT_L(0); PG8_MMA(0, 0, At, B0); PG8_BAR; PG8_SCHED;
            PG8_LDB(B1, 1, 1); PG8_STAGE(PG8_SB(1, 0), b3, voffB);
            PG8_BAR; PG8_WAIT_L(0); PG8_MMA(0, 1, At, B1); PG8_BAR;
            PG8_LDA(At, 1, 1); PG8_STAGE(PG8_SA(1, 0), a3, voffA);
            PG8_BAR; PG8_WAIT_L(0); PG8_MMA(1, 0, At, B0); PG8_BAR; PG8_SCHED;
            PG8_STAGE(PG8_SB(1, 1), b3 + hstep, voffB);
            PG8_WAIT_V(6); PG8_BAR; PG8_MMA(1, 1, At, B1); PG8_BAR;
            }
        }
        if constexpr (ALIGN_EPI) { if (wr == 0) PG8_BAR; }
        if constexpr (!Epi::AFTER_DRAIN) { E(acc, cur, wr, wc, fr, fq); S.done(cur); }
        if (!has_next) break;
        if (!S.keep(cur)) {
#pragma unroll
        for (int a = 0; a < 2; ++a)
#pragma unroll
            for (int b = 0; b < 2; ++b)
#pragma unroll
                for (int m = 0; m < 4; ++m)
#pragma unroll
                    for (int n = 0; n < 2; ++n) acc[a][b][m][n] = (f32x4){0.f, 0.f, 0.f, 0.f};
        }
        cur = nxt; cA = nA; cB = nB; ++ui;
        if constexpr (ALIGN_EPI) { if (wr == 1) PG8_BAR; }
    }
    PG8_WAIT_V(0);
    if constexpr (!ALIGN_EPI) { if (wr == 0) PG8_BAR; }
    PG8_BAR;
    if constexpr (Epi::AFTER_DRAIN) { E.fused(acc, cur, wr, wc, fr, fq, lds, wid, lane); S.done(cur); }
#undef PG8_SA
#undef PG8_SB
#undef PG8_STAGE
#undef PG8_LDA
#undef PG8_LDB
#undef PG8_MMA
#undef PG8_WAIT_V
#undef PG8_WAIT_L
#undef PG8_BAR
#undef PG8_SCHED
}
}
#define PG8_SP2 true
#define PG8_ALIGN true
namespace mk {
using pg8::bf16_t;
#define LAS __attribute__((address_space(3)))
typedef unsigned v4u __attribute__((ext_vector_type(4)));
typedef unsigned v2u __attribute__((ext_vector_type(2)));
typedef float f32x4 __attribute__((ext_vector_type(4)));
typedef float f32x16 __attribute__((ext_vector_type(16)));
typedef short bf16x8 __attribute__((ext_vector_type(8)));
typedef short bf16x4 __attribute__((ext_vector_type(4)));
constexpr int T = 32768, D = 1024, SEQ = 8192, NBATCH = 4, NPROJ = 6656, INW = 6672, C_GA = 3072;
constexpr float EPS = 1e-6f;
constexpr int NWAVES = 8, NTHR = 512;
constexpr int LDS_BYTES = 147456;
constexpr size_t MiB = 1u << 20;
constexpr size_t WS_CTL = 0, CTL_ZERO_BYTES = 1 * MiB;
constexpr size_t WS_RSTD1 = 1 * MiB, WS_ROWSS = WS_RSTD1 + 512 * 1024, WS_ALOW = 2 * MiB, WS_DSC = 4 * MiB, WS_SUBK = 5 * MiB;
constexpr size_t WS_WIN = 8 * MiB, WS_WG = 21 * MiB, WS_WS = 23 * MiB, WS_WO = 25 * MiB, WS_WQ = 27 * MiB;
constexpr size_t WS_XB = 32 * MiB, WS_MERGED = 32 * MiB;
constexpr size_t WS_GQ = 96 * MiB, WS_GK = 128 * MiB, WS_HB = 96 * MiB;
constexpr size_t WS_GV = 160 * MiB, WS_EXD = 160 * MiB, WS_EXU = 192 * MiB;
constexpr size_t WS_GR = 224 * MiB, WS_SQ = 288 * MiB, WS_QP = 224 * MiB;
constexpr size_t WS_SK = 448 * MiB, WS_SV = 464 * MiB,
                  WS_ST = 384 * MiB, WS_IDX = 448 * MiB, WS_GATE = 464 * MiB;
constexpr size_t WS_YG = 448 * MiB, WS_PART = 160 * MiB, WS_MRG = 96 * MiB, WS_HB2 = 160 * MiB, WS_EXD2 = 352 * MiB, WS_EXU2 = 384 * MiB, WS_ROWSS2 = 480 * MiB;

struct Args { const float* in[18]; float* out; unsigned char* ws; int ph_lo, ph_hi; };

__device__ __forceinline__ unsigned f2bf(float f) { unsigned u = __builtin_bit_cast(unsigned, f); return (u + 0x7fffu + ((u >> 16) & 1u)) >> 16; }
typedef float f32x2_t __attribute__((ext_vector_type(2))); typedef __bf16 bf16x2_t __attribute__((ext_vector_type(2)));
__device__ __forceinline__ unsigned pk2(float lo, float hi) { f32x2_t v = {lo, hi}; bf16x2_t b = __builtin_convertvector(v, bf16x2_t); return __builtin_bit_cast(unsigned, b); }
__device__ __forceinline__ float fexp(float x) { return __builtin_amdgcn_exp2f(x * 1.4426950408889634f); }
__device__ __forceinline__ float flog(float x) { return __builtin_amdgcn_logf(x) * 0.6931471805599453f; }
__device__ __forceinline__ float bf2f(unsigned short b) { return __builtin_bit_cast(float, (unsigned)b << 16); }
__device__ __forceinline__ float wave_sum(float v) {
#pragma unroll
    for (int o = 1; o < 64; o <<= 1) v += __shfl_xor(v, o);
    return v;
}
#define LDS_WAIT() asm volatile("s_waitcnt lgkmcnt(0)" ::: "memory")
#define VM_WAIT() asm volatile("s_waitcnt vmcnt(0)" ::: "memory")

struct Frame {
    LAS unsigned char* lds;
    int tid, lane, wave, G, bid;
    float* out; unsigned char* ws;
};

__device__ __forceinline__ void tr_item(const float* __restrict__ W, int ldw, int c0, int K, int nblk, const float* __restrict__ gain, bf16_t* WT, LAS float* scr, int item, int lane) {
    const int kb = item / nblk, nb = item % nblk, k0 = 64 * kb, n0 = 32 * nb;
    const __amdgpu_buffer_rsrc_t wt_r = wt_rsrc(WT);
    const int c = lane & 7;
    f32x4 g0 = {1.f, 1.f, 1.f, 1.f}, g1 = g0;
    if (gain) { g0 = *(const f32x4*)(gain + k0 + 8 * c); g1 = *(const f32x4*)(gain + k0 + 8 * c + 4); }
    float v[32];
    const float* src = W + (size_t)(k0 + (lane >> 5)) * ldw + c0 + n0 + (lane & 31);
#pragma unroll
    for (int i = 0; i < 32; ++i) v[i] = src[(size_t)(2 * i) * ldw];
#pragma unroll
    for (int i = 0; i < 32; ++i) scr[(2 * i + (lane >> 5)) * 33 + (lane & 31)] = v[i];
    LDS_WAIT(); asm volatile("" ::: "memory");
#pragma unroll
    for (int j = 0; j < 4; ++j) { const int n = (lane >> 3) + 8 * j; const LAS float* s = scr + (8 * c) * 33 + n;
        v4u o; o.x = pk2(s[0 * 33] * g0.x, s[1 * 33] * g0.y); o.y = pk2(s[2 * 33] * g0.z, s[3 * 33] * g0.w); o.z = pk2(s[4 * 33] * g1.x, s[5 * 33] * g1.y); o.w = pk2(s[6 * 33] * g1.z, s[7 * 33] * g1.w);
        wt_st16(wt_r, (unsigned)(((size_t)(n0 + n) * K + k0 + 8 * c) * 2), o); }
    LDS_WAIT(); asm volatile("" ::: "memory");
}

__device__ __forceinline__ void p0_prologue(Frame& F, const float* x, const float* gain1, const float* w_in, const float* gain2, const float* wbg, const float* wbs, const float* wout, const float* wq, const float* subk) {
    LAS unsigned char* wb = F.lds;
    LAS float* scr = (LAS float*)(F.lds + 65536 + F.wave * 8704);
    { f32x4 wv[8]; float gk[8];
#pragma unroll
      for (int j = 0; j < 8; ++j) { const int idx = F.tid + NTHR * j, k = idx >> 2; wv[j] = *(const f32x4*)(w_in + (size_t)k * INW + C_GA + 4 * (idx & 3)); gk[j] = gain1[k]; }
#pragma unroll
      for (int j = 0; j < 8; ++j) { const int idx = F.tid + NTHR * j, k = idx >> 2;
#pragma unroll
          for (int e = 0; e < 4; ++e) { const int r = 4 * (idx & 3) + e; const float v = gk[j] * wv[j][e];
              const unsigned h = f2bf(v), l = f2bf(v - __builtin_bit_cast(float, h << 16));
              const int off = (((k >> 5) * 64 + ((k >> 3) & 3) * 16 + r) * 16) + 2 * (k & 7);
              *(LAS unsigned short*)(wb + off) = (unsigned short)h; *(LAS unsigned short*)(wb + 32768 + off) = (unsigned short)l; } } }
    __syncthreads();
    const int gw = F.bid * 4 + (F.wave & 3), NGW = F.G * 4, lane = F.lane;
    bf16_t* XB = (bf16_t*)(F.ws + WS_XB); float* RSTD1 = (float*)(F.ws + WS_RSTD1); float* ALOW = (float*)(F.ws + WS_ALOW);
    const __amdgpu_buffer_rsrc_t xb_r = wt_rsrc(XB);
    if (F.wave < 4) for (int g = gw; g < T / 16; g += NGW) {
        const int m = g * 16 + (lane & 15), q = lane >> 4;
        const float* xr = x + (size_t)m * D + 8 * q;
        f32x4 acc = {0.f, 0.f, 0.f, 0.f}; float ss = 0.f;
        for (int s0 = 0; s0 < 32; s0 += 8) {
            asm volatile("" ::: "memory");
            f32x4 a[8][2];
#pragma unroll
            for (int i = 0; i < 8; ++i) { a[i][0] = *(const f32x4*)(xr + 32 * (s0 + i)); a[i][1] = *(const f32x4*)(xr + 32 * (s0 + i) + 4); }
#pragma unroll
            for (int i = 0; i < 8; ++i) { const f32x4 a0 = a[i][0], a1 = a[i][1];
                ss += ((a0.x * a0.x + a0.y * a0.y) + (a0.z * a0.z + a0.w * a0.w)) + ((a1.x * a1.x + a1.y * a1.y) + (a1.z * a1.z + a1.w * a1.w));
                v4u h; h.x = pk2(a0.x, a0.y); h.y = pk2(a0.z, a0.w); h.z = pk2(a1.x, a1.y); h.w = pk2(a1.z, a1.w);
                wt_st16(xb_r, (unsigned)(((size_t)m * D + 8 * q + 32 * (s0 + i)) * 2), h);
                v4u l;
                l.x = pk2(a0.x - __builtin_bit_cast(float, h.x << 16), a0.y - __builtin_bit_cast(float, h.x & 0xffff0000u));
                l.y = pk2(a0.z - __builtin_bit_cast(float, h.y << 16), a0.w - __builtin_bit_cast(float, h.y & 0xffff0000u));
                l.z = pk2(a1.x - __builtin_bit_cast(float, h.z << 16), a1.y - __builtin_bit_cast(float, h.z & 0xffff0000u));
                l.w = pk2(a1.z - __builtin_bit_cast(float, h.w << 16), a1.w - __builtin_bit_cast(float, h.w & 0xffff0000u));
                const bf16x8 wh = *(const LAS bf16x8*)(wb + ((s0 + i) * 64 + lane) * 16), wl = *(const LAS bf16x8*)(wb + 32768 + ((s0 + i) * 64 + lane) * 16);
                const bf16x8 xh = __builtin_bit_cast(bf16x8, h), xl = __builtin_bit_cast(bf16x8, l);
                acc = __builtin_amdgcn_mfma_f32_16x16x32_bf16(xh, wh, acc, 0, 0, 0);
                acc = __builtin_amdgcn_mfma_f32_16x16x32_bf16(xl, wh, acc, 0, 0, 0);
                acc = __builtin_amdgcn_mfma_f32_16x16x32_bf16(xh, wl, acc, 0, 0, 0); }
        }
        ss += __shfl_xor(ss, 16); ss += __shfl_xor(ss, 32);
        const float rstd = rsqrtf(ss * (1.f / D) + EPS);
#pragma unroll
        for (int i = 0; i < 4; ++i) { const float rs = __shfl(rstd, 4 * q + i); wt_st4(ALOW + (size_t)(g * 16 + 4 * q + i) * 16 + (lane & 15), acc[i] * rs); }
        if (lane < 16) wt_st4(RSTD1 + m, rstd);
    }
    constexpr int I_IN1 = 16 * 96, I_IN2 = 16 * 112, I_SQ = 16 * 32, I_Q = 16 * 64;
    constexpr int NITEMS = I_IN1 + I_IN2 + 3 * I_SQ + I_Q;
    bf16_t* WIN = (bf16_t*)(F.ws + WS_WIN);
    if (F.wave >= 4) for (int it = gw; it < NITEMS; it += NGW) {
        int r = it;
        if (r < I_IN1) { tr_item(w_in, INW, 0, D, 96, gain1, WIN, scr, r, lane); continue; } r -= I_IN1;
        if (r < I_IN2) { tr_item(w_in, INW, 3088, D, 112, gain1, WIN + (size_t)3072 * D, scr, r, lane); continue; } r -= I_IN2;
        if (r < I_SQ) { tr_item(wbg, D, 0, D, 32, nullptr, (bf16_t*)(F.ws + WS_WG), scr, r, lane); continue; } r -= I_SQ;
        if (r < I_SQ) { tr_item(wbs, D, 0, D, 32, nullptr, (bf16_t*)(F.ws + WS_WS), scr, r, lane); continue; } r -= I_SQ;
        if (r < I_SQ) { tr_item(wout, D, 0, D, 32, nullptr, (bf16_t*)(F.ws + WS_WO), scr, r, lane); continue; } r -= I_SQ;
        tr_item(wq, 2048, 0, D, 64, gain2, (bf16_t*)(F.ws + WS_WQ), scr, r, lane);
    }
    { const f32x4* sk = (const f32x4*)subk; v2u* o = (v2u*)(F.ws + WS_SUBK);
      for (int i = F.bid * NTHR + F.tid; i < 8 * 2 * 128 * 128 / 4; i += F.G * NTHR) { const f32x4 v = sk[i]; wt_st8(o + i, pk2(v.x, v.y), pk2(v.z, v.w)); } }
}

constexpr int SWA_KROW = 144, SWA_VROW = 592;
constexpr int SWA_K_OFF = 0, SWA_V_OFF = 256 * SWA_KROW, SWA_TB_OFF = SWA_V_OFF + 64 * SWA_VROW, SWA_LDS = SWA_TB_OFF + 4 * 128 * 4;
__device__ __forceinline__ int t5_bucket(int rel) {
    if (rel < 16) return rel;
    int b = 16;
    b += (rel >= 19); b += (rel >= 21); b += (rel >= 24); b += (rel >= 27); b += (rel >= 31); b += (rel >= 35); b += (rel >= 40); b += (rel >= 46);
    b += (rel >= 52); b += (rel >= 59); b += (rel >= 67); b += (rel >= 77); b += (rel >= 87); b += (rel >= 99); b += (rel >= 113);
    return b;
}
__device__ __forceinline__ void swa_load_kv(const bf16_t* SK, const bf16_t* SV, int u, int tid, int lane, int wave, v4u (&kraw)[4], v4u (&vraw)[4]) {
    const int blk = u & 63, kvh = (u >> 6) & 3, b = u >> 8; const size_t mrow0 = (size_t)b * SEQ; const int t0 = blk * 128, c = tid & 7;
#pragma unroll
    for (int ps = 0; ps < 4; ++ps) {
        const int kjk = ps * 64 + (tid >> 3), posk = t0 - 128 + kjk; kraw[ps] = (v4u){0u, 0u, 0u, 0u};
        if (posk >= 0) kraw[ps] = *(const v4u*)(SK + (mrow0 + posk) * 256 + kvh * 64 + 8 * c);
        const int kjv = ps * 64 + lane, posv = t0 - 128 + kjv; vraw[ps] = (v4u){0u, 0u, 0u, 0u};
        if (posv >= 0) vraw[ps] = *(const v4u*)(SV + (mrow0 + posv) * 256 + kvh * 64 + 8 * wave);
    }
}
__device__ __forceinline__ void swa_phase(Frame& F, const float* qgain, const float* kgain, const float* sinks, const float* rel_bias, size_t ydelta) {
    const bf16_t* SK = (const bf16_t*)(F.ws + WS_SK); const bf16_t* SV = (const bf16_t*)(F.ws + WS_SV); bf16_t* SQ = (bf16_t*)(F.ws + WS_SQ);
    LAS unsigned char* Kn = F.lds + SWA_K_OFF; LAS unsigned char* Vt = F.lds + SWA_V_OFF; LAS float* tb = (LAS float*)(F.lds + SWA_TB_OFF);
    const int tid = F.tid, lane = F.lane, wave = F.wave, l15 = lane & 15, q4 = lane >> 4;
    if (tid < 256) { const int d = tid >> 2, c = tid & 3; *(LAS v4u*)(Vt + d * SWA_VROW + 512 + 16 * c) = (v4u){0u, 0u, 0u, 0u}; }
    v4u kraw[4], vraw[4];
    if (F.bid < 1024) swa_load_kv(SK, SV, F.bid, tid, lane, wave, kraw, vraw);
    for (int u = F.bid; u < 1024; u += F.G) {
        const int blk = u & 63, kvh = (u >> 6) & 3, b = u >> 8;
        const size_t mrow0 = (size_t)b * SEQ; const int t0 = blk * 128;
        const int g = wave >> 1, qh = wave & 1, h = kvh * 4 + g;
        v4u qn[2];
        { const bf16_t* qrow = SQ + (mrow0 + t0 + 64 * qh + l15) * 1024 + h * 64; qn[0] = *(const v4u*)(qrow + 8 * q4); qn[1] = *(const v4u*)(qrow + 32 + 8 * q4); }
        __syncthreads();
        { const int c = tid & 7; f32x4 g0 = *(const f32x4*)(kgain + 8 * c), g1 = *(const f32x4*)(kgain + 8 * c + 4);
#pragma unroll
          for (int ps = 0; ps < 4; ++ps) {
              const int kj = ps * 64 + (tid >> 3);
              const v4u raw = kraw[ps];
              float f[8];
#pragma unroll
              for (int j = 0; j < 4; ++j) { f[2 * j] = __builtin_bit_cast(float, raw[j] << 16); f[2 * j + 1] = __builtin_bit_cast(float, raw[j] & 0xffff0000u); }
              float ss = 0.f;
#pragma unroll
              for (int j = 0; j < 8; ++j) ss += f[j] * f[j];
              ss += __shfl_xor(ss, 1); ss += __shfl_xor(ss, 2); ss += __shfl_xor(ss, 4);
              const float r = rsqrtf(ss * (1.f / 64.f) + EPS);
              v4u w; w.x = pk2(f[0] * r * g0.x, f[1] * r * g0.y); w.y = pk2(f[2] * r * g0.z, f[3] * r * g0.w); w.z = pk2(f[4] * r * g1.x, f[5] * r * g1.y); w.w = pk2(f[6] * r * g1.z, f[7] * r * g1.w);
              *(LAS v4u*)(Kn + kj * SWA_KROW + 16 * c) = w;
          } }
#pragma unroll
        for (int ps = 0; ps < 4; ++ps) {
            const int kj = ps * 64 + lane; const v4u raw = vraw[ps];
#pragma unroll
            for (int j = 0; j < 4; ++j) { *(LAS unsigned short*)(Vt + (8 * wave + 2 * j) * SWA_VROW + kj * 2) = (unsigned short)(raw[j] & 0xffffu); *(LAS unsigned short*)(Vt + (8 * wave + 2 * j + 1) * SWA_VROW + kj * 2) = (unsigned short)(raw[j] >> 16); }
        }
        { const int gg = tid >> 7, rel = tid & 127; tb[tid] = rel_bias[t5_bucket(rel) * 16 + kvh * 4 + gg] * 1.4426950408889634f; }
        if (u + F.G < 1024) swa_load_kv(SK, SV, u + F.G, tid, lane, wave, kraw, vraw);
        __syncthreads();
        const float sink = sinks[h] * 1.4426950408889634f;
        float qg[2][8];
#pragma unroll
        for (int ks = 0; ks < 2; ++ks)
#pragma unroll
            for (int j = 0; j < 8; ++j) qg[ks][j] = qgain[32 * ks + 8 * q4 + j] * (0.125f * 1.4426950408889634f);
#pragma unroll 1
        for (int nt = 0; nt < 4; ++nt) {
            const int q0 = 64 * qh + 16 * nt, qi = q0 + l15, kt0 = q0 >> 4;
            bf16_t* qrow = SQ + (mrow0 + t0 + qi) * 1024 + h * 64;
            bf16x8 qf[2];
            { v4u raw[2]; float f[2][8]; float ss = 0.f;
              raw[0] = qn[0]; raw[1] = qn[1];
              if (nt < 3) { const bf16_t* qnx = qrow + 16 * 1024; qn[0] = *(const v4u*)(qnx + 8 * q4); qn[1] = *(const v4u*)(qnx + 32 + 8 * q4); }
#pragma unroll
              for (int ks = 0; ks < 2; ++ks) {
#pragma unroll
                  for (int j = 0; j < 4; ++j) { f[ks][2 * j] = __builtin_bit_cast(float, raw[ks][j] << 16); f[ks][2 * j + 1] = __builtin_bit_cast(float, raw[ks][j] & 0xffff0000u); }
#pragma unroll
                  for (int j = 0; j < 8; ++j) ss += f[ks][j] * f[ks][j]; }
              ss += __shfl_xor(ss, 16); ss += __shfl_xor(ss, 32);
              const float r = rsqrtf(ss * (1.f / 64.f) + EPS);
#pragma unroll
              for (int ks = 0; ks < 2; ++ks) { v4u w;
#pragma unroll
                  for (int j = 0; j < 4; ++j) w[j] = pk2(f[ks][2 * j] * r * qg[ks][2 * j], f[ks][2 * j + 1] * r * qg[ks][2 * j + 1]);
                  qf[ks] = __builtin_bit_cast(bf16x8, w); } }
            f32x4 s[9];
#pragma unroll
            for (int i = 0; i < 9; ++i) { f32x4 acc = (f32x4){0.f, 0.f, 0.f, 0.f};
#pragma unroll
                for (int ks = 0; ks < 2; ++ks) { const bf16x8 a = *(const LAS bf16x8*)(Kn + (16 * (kt0 + i) + l15) * SWA_KROW + (32 * ks + 8 * q4) * 2); acc = __builtin_amdgcn_mfma_f32_16x16x32_bf16(a, qf[ks], acc, 0, 0, 0); }
                s[i] = acc; }
            const int R0 = l15 + 128 - 4 * q4;
            const LAS float* tbp = tb + g * 128 + R0 - 131;
            float mx = -INFINITY;
            if (blk > 0) {
#pragma unroll
                for (int i = 0; i < 9; ++i)
#pragma unroll
                    for (int r = 0; r < 4; ++r) { const int rel = R0 - 16 * i - r; float v = s[i][r] + tbp[131 - 16 * i - r];
                        if (i == 0) v = (rel < 128) ? v : -INFINITY;
                        if (i == 8) v = (rel >= 0) ? v : -INFINITY;
                        s[i][r] = v; mx = fmaxf(mx, v); }
            } else {
#pragma unroll
                for (int i = 0; i < 9; ++i)
#pragma unroll
                    for (int r = 0; r < 4; ++r) { const int kj = 16 * (kt0 + i) + 4 * q4 + r, rel = R0 - 16 * i - r; const bool valid = ((unsigned)rel < 128u) && (kj >= 128);
                        const float v = valid ? s[i][r] + tbp[131 - 16 * i - r] : -INFINITY; s[i][r] = v; mx = fmaxf(mx, v); }
            }
            mx = fmaxf(mx, __shfl_xor(mx, 16)); mx = fmaxf(mx, __shfl_xor(mx, 32)); mx = fmaxf(mx, sink);
            float sum = 0.f;
#pragma unroll
            for (int i = 0; i < 9; ++i)
#pragma unroll
                for (int r = 0; r < 4; ++r) { const float e = __builtin_amdgcn_exp2f(s[i][r] - mx); s[i][r] = e; sum += e; }
            sum += __shfl_xor(sum, 16); sum += __shfl_xor(sum, 32);
            const float inv = 1.0f / (sum + __builtin_amdgcn_exp2f(sink - mx));
            f32x4 o[4];
#pragma unroll
            for (int mt = 0; mt < 4; ++mt) o[mt] = (f32x4){0.f, 0.f, 0.f, 0.f};
#pragma unroll
            for (int kk = 0; kk < 5; ++kk) {
                v4u w; w.x = pk2(s[2 * kk][0], s[2 * kk][1]); w.y = pk2(s[2 * kk][2], s[2 * kk][3]);
                if (kk < 4) { w.z = pk2(s[2 * kk + 1][0], s[2 * kk + 1][1]); w.w = pk2(s[2 * kk + 1][2], s[2 * kk + 1][3]); } else { w.z = 0u; w.w = 0u; }
                const bf16x8 pb = __builtin_bit_cast(bf16x8, w);
#pragma unroll
                for (int mt = 0; mt < 4; ++mt) {
                    const LAS unsigned char* vr = Vt + (16 * mt + l15) * SWA_VROW + (16 * (kt0 + 2 * kk) + 4 * q4) * 2;
                    const v2u a0 = *(const LAS v2u*)vr, a1 = *(const LAS v2u*)(vr + 32);
                    const bf16x8 a = __builtin_bit_cast(bf16x8, (v4u){a0.x, a0.y, a1.x, a1.y});
                    o[mt] = __builtin_amdgcn_mfma_f32_16x16x32_bf16(a, pb, o[mt], 0, 0, 0);
                }
            }
#pragma unroll
            for (int mt = 0; mt < 4; ++mt) { v2u w; w.x = pk2(o[mt][0] * inv, o[mt][1] * inv); w.y = pk2(o[mt][2] * inv, o[mt][3] * inv); wt_st8((unsigned char*)(qrow + 16 * mt + 4 * q4) + ydelta, w.x, w.y); }
        }
    }
    __syncthreads();
}

constexpr int GL_AL = 0, GL_QS = 4096, GL_BL = 6144, GL_DEC = 6656, GL_BQ = 8192, GL_QT = 41984, GL_KT = 59392, GL_OB = 8192, GL_KH = 76800, GL_VT = 95232;
constexpr int GL_BQROW = 528, GL_QROW = 272, GL_KHROW = 144, GL_VROW = 144, GL_OBROW = 1040;
__device__ __forceinline__ f32x16 mfma32(bf16x8 a, bf16x8 b, f32x16 c) { return __builtin_amdgcn_mfma_f32_32x32x16_bf16(a, b, c, 0, 0, 0); }
__device__ __forceinline__ bf16x8 pack8(const f32x16& x, int s) {
    v4u w;
    if (s == 0) { w.x = pk2(x[0], x[1]); w.y = pk2(x[2], x[3]); w.z = pk2(x[4], x[5]); w.w = pk2(x[6], x[7]); }
    else { w.x = pk2(x[8], x[9]); w.y = pk2(x[10], x[11]); w.z = pk2(x[12], x[13]); w.w = pk2(x[14], x[15]); }
    return __builtin_bit_cast(bf16x8, w);
}
__device__ __forceinline__ bf16x8 ld2x8(const LAS unsigned char* p) {
    const v2u a0 = *(const LAS v2u*)p, a1 = *(const LAS v2u*)(p + 16);
    return __builtin_bit_cast(bf16x8, (v4u){a0.x, a0.y, a1.x, a1.y});
}
__device__ __forceinline__ void unpack8(const v4u raw, float (&f)[8]) {
#pragma unroll
    for (int j = 0; j < 4; ++j) { f[2 * j] = __builtin_bit_cast(float, raw[j] << 16); f[2 * j + 1] = __builtin_bit_cast(float, raw[j] & 0xffff0000u); }
}
__device__ __forceinline__ unsigned gl_off(unsigned row, unsigned ch) { return 2048u * (row >> 3) + 512u * (ch >> 2) + 64u * (row & 7) + 16u * ((ch & 3) ^ ((row >> 2) & 3)); }
__device__ __forceinline__ unsigned gl_tr_base(unsigned lane, unsigned rb) { const unsigned blk = (lane >> 4) & 1, q = (lane & 15) >> 2, p = lane & 3; return gl_off(rb + q, 2 * blk + (p >> 1)) + 8 * (p & 1); }
typedef short gl_v4s __attribute__((ext_vector_type(4)));
__device__ __forceinline__ bf16x8 gl_tr2(const LAS unsigned char* p0, const LAS unsigned char* p1) {
    const gl_v4s x = __builtin_amdgcn_ds_read_tr16_b64_v4i16((LAS gl_v4s*)p0), y = __builtin_amdgcn_ds_read_tr16_b64_v4i16((LAS gl_v4s*)p1);
    return (bf16x8){x[0], x[1], x[2], x[3], y[0], y[1], y[2], y[3]};
}
__device__ __forceinline__ void gla_load_w(Frame& F, const float* wgu, const float* bgu, int h, bf16x8& whi, bf16x8& wlo, float& bias) {
    const int dn = 32 * (F.wave >> 1) + (F.lane & 31), hh = F.lane >> 5;
    float v[8];
#pragma unroll
    for (int j = 0; j < 8; ++j) v[j] = wgu[(8 * hh + j) * 512 + h * 128 + dn];
    v4u hi, lo;
#pragma unroll
    for (int j = 0; j < 4; ++j) { hi[j] = pk2(v[2 * j], v[2 * j + 1]); lo[j] = pk2(v[2 * j] - __builtin_bit_cast(float, hi[j] << 16), v[2 * j + 1] - __builtin_bit_cast(float, hi[j] & 0xffff0000u)); }
    whi = __builtin_bit_cast(bf16x8, (v4u){hi[0], hi[1], hi[2], hi[3]}); wlo = __builtin_bit_cast(bf16x8, (v4u){lo[0], lo[1], lo[2], lo[3]});
    bias = bgu[h * 128 + dn];
}
template <bool FULL> __device__ __forceinline__ float gla_stage(Frame& F, int h, size_t m0, const bf16x8 whi, const bf16x8 wlo, float bias) {
    const int tid = F.tid, lane = F.lane, wave = F.wave, d = tid & 127;
    LAS unsigned char* L = F.lds;
    const float* ALOW = (const float*)(F.ws + WS_ALOW);
    const bf16_t* GQ = (const bf16_t*)(F.ws + WS_GQ); const bf16_t* GK = (const bf16_t*)(F.ws + WS_GK); const bf16_t* GV = (const bf16_t*)(F.ws + WS_GV);
    __syncthreads();
    { typedef float f32x2 __attribute__((ext_vector_type(2))); ((LAS f32x2*)(L + GL_AL))[tid] = ((const f32x2*)(ALOW + m0 * 16))[tid]; }
    __syncthreads();
    const int mt = wave & 1, nt = wave >> 1, l31 = lane & 31, hh = lane >> 5, dn = 32 * nt + l31;
    float p[16];
    { const LAS f32x4* ap = (const LAS f32x4*)(L + GL_AL + (32 * mt + l31) * 64 + hh * 32);
      const f32x4 a0 = ap[0], a1 = ap[1];
      v4u ah, al;
      ah.x = pk2(a0.x, a0.y); ah.y = pk2(a0.z, a0.w); ah.z = pk2(a1.x, a1.y); ah.w = pk2(a1.z, a1.w);
      al.x = pk2(a0.x - __builtin_bit_cast(float, ah.x << 16), a0.y - __builtin_bit_cast(float, ah.x & 0xffff0000u)); al.y = pk2(a0.z - __builtin_bit_cast(float, ah.y << 16), a0.w - __builtin_bit_cast(float, ah.y & 0xffff0000u));
      al.z = pk2(a1.x - __builtin_bit_cast(float, ah.z << 16), a1.y - __builtin_bit_cast(float, ah.z & 0xffff0000u)); al.w = pk2(a1.z - __builtin_bit_cast(float, ah.w << 16), a1.w - __builtin_bit_cast(float, ah.w & 0xffff0000u));
      f32x16 z;
#pragma unroll
      for (int r = 0; r < 16; ++r) z[r] = 0.f;
      z = mfma32(__builtin_bit_cast(bf16x8, ah), whi, z); z = mfma32(__builtin_bit_cast(bf16x8, al), whi, z); z = mfma32(__builtin_bit_cast(bf16x8, ah), wlo, z);
#pragma unroll
      for (int r = 0; r < 16; ++r) { const float zz = z[r] + bias; p[r] = (fminf(zz, 0.f) - flog(1.f + fexp(-fabsf(zz)))) * (1.f / 16.f); } }
    float base = 0.f;
#pragma unroll
    for (int g4 = 0; g4 < 4; ++g4) {
        p[4 * g4 + 1] += p[4 * g4]; p[4 * g4 + 2] += p[4 * g4 + 1]; p[4 * g4 + 3] += p[4 * g4 + 2];
        const float gt = p[4 * g4 + 3], pt = __shfl_xor(gt, 32), off = base + (hh ? pt : 0.f);
#pragma unroll
        for (int k = 0; k < 4; ++k) p[4 * g4 + k] += off;
        base += gt + pt;
    }
    if (hh == 0) ((LAS float*)(L + GL_QS))[mt * 128 + dn] = base;
    __syncthreads();
    { const float q0 = ((const LAS float*)(L + GL_QS))[dn], q1 = ((const LAS float*)(L + GL_QS))[128 + dn], blast = q0 + q1, offs = mt ? q0 : 0.f;
#pragma unroll
      for (int r = 0; r < 16; ++r) *(LAS float*)(L + GL_BQ + (32 * mt + 8 * (r >> 2) + 4 * hh + (r & 3)) * GL_BQROW + dn * 4) = p[r] + offs;
      if (mt == 0 && hh == 0) { ((LAS float*)(L + GL_BL))[dn] = blast; ((LAS float*)(L + GL_DEC))[dn] = fexp(blast); } }
    __syncthreads();
    {
        const int t = lane, dg = wave; const size_t row = m0 + t;
        float b[16], bl[16];
#pragma unroll
        for (int i = 0; i < 4; ++i) { const f32x4 v = *(const LAS f32x4*)(L + GL_BQ + t * GL_BQROW + dg * 64 + 16 * i); b[4 * i] = v.x; b[4 * i + 1] = v.y; b[4 * i + 2] = v.z; b[4 * i + 3] = v.w;
                                      const f32x4 u = *(const LAS f32x4*)(L + (FULL ? GL_DEC : GL_BL) + dg * 64 + 16 * i); bl[4 * i] = u.x; bl[4 * i + 1] = u.y; bl[4 * i + 2] = u.z; bl[4 * i + 3] = u.w; }
        float kf[16];
        { const v4u* kp = (const v4u*)(GK + row * 512 + h * 128 + 16 * dg); float t0[8], t1[8]; unpack8(kp[0], t0); unpack8(kp[1], t1);
#pragma unroll
          for (int e = 0; e < 8; ++e) { kf[e] = t0[e]; kf[8 + e] = t1[e]; } }
        float kh[16];
        if (FULL) {
            float qf[16];
            { const v4u* qp = (const v4u*)(GQ + row * 512 + h * 128 + 16 * dg); float t0[8], t1[8]; unpack8(qp[0], t0); unpack8(qp[1], t1);
#pragma unroll
              for (int e = 0; e < 8; ++e) { qf[e] = t0[e]; qf[8 + e] = t1[e]; } }
            v4u wq[2], wk[2];
#pragma unroll
            for (int e = 0; e < 16; e += 2) { const float e0 = fexp(b[e]), e1 = fexp(b[e + 1]);
                const float k0 = kf[e] * __builtin_amdgcn_rcpf(e0), k1 = kf[e + 1] * __builtin_amdgcn_rcpf(e1);
                wq[e >> 3][(e & 7) >> 1] = pk2(qf[e] * e0 * 0.08838834764831845f, qf[e + 1] * e1 * 0.08838834764831845f);
                wk[e >> 3][(e & 7) >> 1] = pk2(k0, k1);
                kh[e] = k0 * bl[e]; kh[e + 1] = k1 * bl[e + 1]; }
            *(LAS v4u*)(L + GL_QT + t * GL_QROW + dg * 32) = wq[0]; *(LAS v4u*)(L + GL_QT + t * GL_QROW + dg * 32 + 16) = wq[1];
            *(LAS v4u*)(L + GL_KT + t * GL_QROW + dg * 32) = wk[0]; *(LAS v4u*)(L + GL_KT + t * GL_QROW + dg * 32 + 16) = wk[1];
        } else {
#pragma unroll
            for (int e = 0; e < 16; ++e) kh[e] = kf[e] * fexp(bl[e] - b[e]);
        }
        { v4u k0, k1; k0.x = pk2(kh[0], kh[1]); k0.y = pk2(kh[2], kh[3]); k0.z = pk2(kh[4], kh[5]); k0.w = pk2(kh[6], kh[7]); k1.x = pk2(kh[8], kh[9]); k1.y = pk2(kh[10], kh[11]); k1.z = pk2(kh[12], kh[13]); k1.w = pk2(kh[14], kh[15]);
          *(LAS v4u*)(L + GL_KH + gl_off(t, 2 * dg)) = k0; *(LAS v4u*)(L + GL_KH + gl_off(t, 2 * dg + 1)) = k1; }
#pragma unroll
        for (int i = 0; i < 4; ++i) { const v4u raw = *(const v4u*)(GV + row * 1024 + h * 256 + 32 * wave + 8 * i);
            *(LAS v4u*)(L + GL_VT + (wave >> 2) * 16384 + gl_off(t, 4 * (wave & 3) + i)) = raw; }
    }
    __syncthreads();
    return ((const LAS float*)(L + GL_BL))[d];
}
__device__ __forceinline__ void gla_state_update(Frame& F, f32x16 (&S)[4]) {
    const int lane = F.lane, l31 = lane & 31, hh = lane >> 5; LAS unsigned char* L = F.lds;
    const LAS unsigned char* ka0 = L + GL_KH + gl_tr_base(lane, 8 * hh); const LAS unsigned char* ka1 = L + GL_KH + gl_tr_base(lane, 8 * hh + 4);
    const LAS unsigned char* va0 = ka0 + (GL_VT - GL_KH) + (F.wave >> 2) * 16384 + (F.wave & 3) * 512; const LAS unsigned char* va1 = ka1 + (GL_VT - GL_KH) + (F.wave >> 2) * 16384 + (F.wave & 3) * 512;
#pragma unroll
    for (int dt = 0; dt < 4; ++dt) {
#pragma unroll
        for (int g = 0; g < 4; ++g) { const f32x4 dc = *(const LAS f32x4*)(L + GL_DEC + (32 * dt + 8 * g + 4 * hh) * 4);
            S[dt][4 * g] *= dc.x; S[dt][4 * g + 1] *= dc.y; S[dt][4 * g + 2] *= dc.z; S[dt][4 * g + 3] *= dc.w; }
#pragma unroll
        for (int ks = 0; ks < 4; ++ks) {
            const bf16x8 a = gl_tr2(ka0 + 4096 * ks + 512 * dt, ka1 + 4096 * ks + 512 * dt);
            const bf16x8 b = gl_tr2(va0 + 4096 * ks, va1 + 4096 * ks);
            S[dt] = mfma32(a, b, S[dt]);
        } __builtin_amdgcn_sched_barrier(0);
    }
}
__device__ __forceinline__ void gla_local_phase(Frame& F, const float* wgu, const float* bgu) {
    float* ST = (float*)(F.ws + WS_ST); float* DSC = (float*)(F.ws + WS_DSC);
    const int lane = F.lane, l31 = lane & 31, hh = lane >> 5;
    for (int u = F.bid; u < 512; u += F.G) {
        const int sc = u & 31, bh = u >> 5, b = bh >> 2, h = bh & 3;
        bf16x8 whi, wlo; float bias; gla_load_w(F, wgu, bgu, h, whi, wlo, bias);
        f32x16 S[4];
#pragma unroll
        for (int dt = 0; dt < 4; ++dt)
#pragma unroll
            for (int r = 0; r < 16; ++r) S[dt][r] = 0.f;
        float sumbl = 0.f;
#pragma unroll 1
        for (int c = 0; c < 4; ++c) {
            const size_t m0 = (size_t)b * SEQ + sc * 256 + c * 64;
            sumbl += gla_stage<false>(F, h, m0, whi, wlo, bias);
            gla_state_update(F, S);
        }
        v4u* st8 = (v4u*)ST + (size_t)(bh * 32 + sc) * 4096 + (F.wave * 4 * 64 + lane) * 2;
#pragma unroll
        for (int dt = 0; dt < 4; ++dt)
#pragma unroll
            for (int hf = 0; hf < 2; ++hf) st8[dt * 128 + hf] = (v4u){pk2(S[dt][8 * hf], S[dt][8 * hf + 1]), pk2(S[dt][8 * hf + 2], S[dt][8 * hf + 3]), pk2(S[dt][8 * hf + 4], S[dt][8 * hf + 5]), pk2(S[dt][8 * hf + 6], S[dt][8 * hf + 7])};
        if (F.tid < 128) wt_st4(DSC + (bh * 32 + sc) * 128 + F.tid, fexp(sumbl));
    }
}
__device__ __forceinline__ void gla_scan_phase(Frame& F) {
    v4u* ST8 = (v4u*)(F.ws + WS_ST); const float* DSC = (const float*)(F.ws + WS_DSC);
    for (int idx = F.bid * NTHR + F.tid; idx < 16 * 4096; idx += F.G * NTHR) {
        const int bh = idx >> 12, u8 = idx & 4095, hf = u8 & 1, ln = (u8 >> 1) & 63, dt = (u8 >> 7) & 3, row0 = 32 * dt + 16 * hf + 4 * (ln >> 5);
        float S[8];
#pragma unroll
        for (int e = 0; e < 8; ++e) S[e] = 0.f;
#pragma unroll 8
        for (int sc = 0; sc < 32; ++sc) {
            v4u* p = ST8 + (size_t)(bh * 32 + sc) * 4096 + u8; const v4u raw = *p; float tmp[8]; unpack8(raw, tmp);
            *p = (v4u){pk2(S[0], S[1]), pk2(S[2], S[3]), pk2(S[4], S[5]), pk2(S[6], S[7])};
            const f32x4 d0 = *(const f32x4*)(DSC + (bh * 32 + sc) * 128 + row0), d1 = *(const f32x4*)(DSC + (bh * 32 + sc) * 128 + row0 + 8);
            S[0] = S[0] * d0.x + tmp[0]; S[1] = S[1] * d0.y + tmp[1]; S[2] = S[2] * d0.z + tmp[2]; S[3] = S[3] * d0.w + tmp[3];
            S[4] = S[4] * d1.x + tmp[4]; S[5] = S[5] * d1.y + tmp[5]; S[6] = S[6] * d1.z + tmp[6]; S[7] = S[7] * d1.w + tmp[7];
        }
    }
}
__device__ __forceinline__ void gla_out_phase(Frame& F, const float* wgu, const float* bgu, const float* ogain) {
    const float* ST = (const float*)(F.ws + WS_ST); const bf16_t* GR = (const bf16_t*)(F.ws + WS_GR); const __amdgpu_buffer_rsrc_t gr_r = wt_rsrc(F.ws + WS_YG);
    const int lane = F.lane, l31 = lane & 31, hh = lane >> 5, wave = F.wave; LAS unsigned char* L = F.lds;
    const LAS unsigned char* pv0 = L + GL_VT + (wave >> 2) * 16384 + (wave & 3) * 512 + gl_tr_base(lane, 4 * hh); const LAS unsigned char* pv1 = L + GL_VT + (wave >> 2) * 16384 + (wave & 3) * 512 + gl_tr_base(lane, 4 * hh + 8);
    for (int u = F.bid; u < 512; u += F.G) {
        const int sc = u & 31, bh = u >> 5, b = bh >> 2, h = bh & 3;
        bf16x8 whi, wlo; float bias; gla_load_w(F, wgu, bgu, h, whi, wlo, bias);
        f32x16 S[4];
        { const v4u* st8 = (const v4u*)ST + (size_t)(bh * 32 + sc) * 4096 + (wave * 4 * 64 + lane) * 2;
#pragma unroll
          for (int dt = 0; dt < 4; ++dt)
#pragma unroll
              for (int hf = 0; hf < 2; ++hf) { float f[8]; unpack8(st8[dt * 128 + hf], f);
#pragma unroll
                  for (int e = 0; e < 8; ++e) S[dt][8 * hf + e] = f[e]; } }
#pragma unroll 1
        for (int c = 0; c < 4; ++c) {
            const size_t m0 = (size_t)b * SEQ + sc * 256 + c * 64;
            (void)gla_stage<true>(F, h, m0, whi, wlo, bias);
            f32x16 o0, o1;
#pragma unroll
            for (int r = 0; r < 16; ++r) { o0[r] = 0.f; o1[r] = 0.f; }
#pragma unroll
            for (int dt = 0; dt < 4; ++dt)
#pragma unroll
                for (int s = 0; s < 2; ++s) {
                    const bf16x8 bs = pack8(S[dt], s);
                    const int ko = (32 * dt + 16 * s + 4 * hh) * 2;
                    o0 = mfma32(ld2x8(L + GL_QT + l31 * GL_QROW + ko), bs, o0);
                    o1 = mfma32(ld2x8(L + GL_QT + (32 + l31) * GL_QROW + ko), bs, o1);
                }
            __builtin_amdgcn_sched_barrier(0);
#pragma unroll
            for (int tile = 0; tile < 3; ++tile) {
                const int jt = (tile == 2) ? 1 : 0, it = (tile == 0) ? 0 : 1;
                f32x16 p;
#pragma unroll
                for (int r = 0; r < 16; ++r) p[r] = 0.f;
#pragma unroll
                for (int ks = 0; ks < 8; ++ks) {
                    const int ko = (16 * ks + 8 * hh) * 2;
                    const bf16x8 a = *(const LAS bf16x8*)(L + GL_KT + (32 * jt + l31) * GL_QROW + ko);
                    const bf16x8 b = *(const LAS bf16x8*)(L + GL_QT + (32 * it + l31) * GL_QROW + ko);
                    p = mfma32(a, b, p);
                }
                if (jt == it) {
#pragma unroll
                    for (int r = 0; r < 16; ++r) { const int j = (r & 3) + 8 * (r >> 2) + 4 * hh; p[r] = (j > l31) ? 0.f : p[r]; }
                }
#pragma unroll
                for (int s = 0; s < 2; ++s) {
                    const bf16x8 bv = gl_tr2(pv0 + 8192 * jt + 4096 * s, pv1 + 8192 * jt + 4096 * s);
                    if (it == 0) o0 = mfma32(pack8(p, s), bv, o0); else o1 = mfma32(pack8(p, s), bv, o1);
                }
                __builtin_amdgcn_sched_barrier(0);
            }
            gla_state_update(F, S);
            __syncthreads();
#pragma unroll
            for (int r = 0; r < 16; ++r) { const int i = (r & 3) + 8 * (r >> 2) + 4 * hh;
                *(LAS float*)(L + GL_OB + i * GL_OBROW + (32 * wave + l31) * 4) = o0[r]; *(LAS float*)(L + GL_OB + (32 + i) * GL_OBROW + (32 * wave + l31) * 4) = o1[r]; }
            __syncthreads();
            {
                const int t = F.tid >> 3, part = F.tid & 7;
                float v[32]; float ss = 0.f;
#pragma unroll
                for (int i = 0; i < 8; ++i) { const f32x4 x = *(const LAS f32x4*)(L + GL_OB + t * GL_OBROW + (32 * part + 4 * i) * 4); v[4 * i] = x.x; v[4 * i + 1] = x.y; v[4 * i + 2] = x.z; v[4 * i + 3] = x.w; ss += (x.x * x.x + x.y * x.y) + (x.z * x.z + x.w * x.w); }
                ss += __shfl_xor(ss, 1); ss += __shfl_xor(ss, 2); ss += __shfl_xor(ss, 4);
                const float rstd = rsqrtf(ss * (1.f / 256.f) + EPS);
                const bf16_t* gp = GR + (m0 + t) * 1024 + h * 256 + 32 * part;
#pragma unroll
                for (int i = 0; i < 4; ++i) { const v4u raw = *(const v4u*)(gp + 8 * i); float rr[8]; unpack8(raw, rr);
                    const f32x4 g0 = *(const f32x4*)(ogain + 32 * part + 8 * i), g1 = *(const f32x4*)(ogain + 32 * part + 8 * i + 4);
                    v4u o; o.x = pk2(v[8 * i] * rstd * g0.x * rr[0], v[8 * i + 1] * rstd * g0.y * rr[1]); o.y = pk2(v[8 * i + 2] * rstd * g0.z * rr[2], v[8 * i + 3] * rstd * g0.w * rr[3]);
                    o.z = pk2(v[8 * i + 4] * rstd * g1.x * rr[4], v[8 * i + 5] * rstd * g1.y * rr[5]); o.w = pk2(v[8 * i + 6] * rstd * g1.z * rr[6], v[8 * i + 7] * rstd * g1.w * rr[7]);
                    wt_st16(gr_r, (unsigned)(((m0 + t) * 1024 + h * 256 + 32 * part + 8 * i) * 2), o); }
            }
        }
    }
    __syncthreads();
}

constexpr int PK_KROW = 272, PK_K_OFF = 0, PK_SCR_OFF = 2 * 128 * PK_KROW;
__device__ __forceinline__ void ce(unsigned& a, unsigned& b) { const unsigned mx = a > b ? a : b, mn = a > b ? b : a; a = mx; b = mn; }
template <int N> __device__ __forceinline__ void bitonic_sort_desc(unsigned (&x)[N]) {
#pragma unroll
    for (int k = 2; k <= N; k <<= 1)
#pragma unroll
        for (int j = k >> 1; j > 0; j >>= 1)
#pragma unroll
            for (int i = 0; i < N; ++i) { const int l = i ^ j; if (l > i) { if ((i & k) == 0) ce(x[i], x[l]); else ce(x[l], x[i]); } }
}
__device__ __forceinline__ void sort16_desc(unsigned (&x)[16]) {
    ce(x[0], x[13]); ce(x[1], x[12]); ce(x[2], x[15]); ce(x[3], x[14]); ce(x[4], x[8]); ce(x[5], x[6]); ce(x[7], x[11]); ce(x[9], x[10]); ce(x[0], x[5]); ce(x[1], x[7]); ce(x[2], x[9]); ce(x[3], x[4]); ce(x[6], x[13]); ce(x[8], x[14]); ce(x[10], x[15]); ce(x[11], x[12]); ce(x[0], x[1]); ce(x[2], x[3]); ce(x[4], x[5]); ce(x[6], x[8]); ce(x[7], x[9]); ce(x[10], x[11]); ce(x[12], x[13]); ce(x[14], x[15]); ce(x[0], x[2]); ce(x[1], x[3]); ce(x[4], x[10]); ce(x[5], x[11]); ce(x[6], x[7]); ce(x[8], x[9]); ce(x[12], x[14]); ce(x[13], x[15]); ce(x[1], x[2]); ce(x[3], x[12]); ce(x[4], x[6]); ce(x[5], x[7]); ce(x[8], x[10]); ce(x[9], x[11]); ce(x[13], x[14]); ce(x[1], x[4]); ce(x[2], x[6]); ce(x[5], x[8]); ce(x[7], x[10]); ce(x[9], x[13]); ce(x[11], x[14]); ce(x[2], x[4]); ce(x[3], x[6]); ce(x[9], x[12]); ce(x[11], x[13]); ce(x[3], x[5]); ce(x[6], x[8]); ce(x[7], x[9]); ce(x[10], x[12]); ce(x[3], x[4]); ce(x[5], x[6]); ce(x[7], x[8]); ce(x[9], x[10]); ce(x[11], x[12]); ce(x[6], x[7]); ce(x[8], x[9]);
}
__device__ __forceinline__ void merge16(unsigned (&a)[16], const unsigned (&b)[16]) {
#pragma unroll
    for (int i = 0; i < 16; ++i) a[i] = a[i] > b[15 - i] ? a[i] : b[15 - i];
#pragma unroll
    for (int j = 8; j > 0; j >>= 1)
#pragma unroll
        for (int i = 0; i < 16; ++i) { const int l = i ^ j; if (l > i) ce(a[i], a[l]); }
}
__device__ __forceinline__ void merge16_partner(unsigned (&a)[16]) {
    unsigned b[16];
#pragma unroll
    for (int i = 0; i < 16; ++i) b[i] = (unsigned)__shfl_xor((int)a[i], 32);
    merge16(a, b);
}
__device__ __forceinline__ unsigned f2key(float f) { const unsigned u = __builtin_bit_cast(unsigned, f); return u ^ ((unsigned)((int)u >> 31) | 0x80000000u); }
__device__ __forceinline__ float key2f(unsigned k) { const unsigned m = ~(unsigned)((int)k >> 31) | 0x80000000u; return __builtin_bit_cast(float, k ^ m); }
__device__ constexpr int PEER_CI[50] = {0,0,0,0,0,0,0,0,0,0,0,0,0,0,0,0, 1,1,1,1,1,1,1,1, 2,2,2,2,2, 3,3,3,3, 4,4,4, 5,5, 6,6, 7,7, 8,9,10,11,12,13,14,15};
__device__ constexpr int PEER_CJ[50] = {0,1,2,3,4,5,6,7,8,9,10,11,12,13,14,15, 0,1,2,3,4,5,6,7, 0,1,2,3,4, 0,1,2,3, 0,1,2, 0,1, 0,1, 0,1, 0,0,0,0,0,0,0,0};
__device__ __forceinline__ void top16_of_tiles(const f32x16 (&s)[4], int hh, unsigned (&top)[16]) {
#pragma unroll
    for (int mt = 0; mt < 4; ++mt) {
        unsigned g[16];
#pragma unroll
        for (int r = 0; r < 16; ++r) { const unsigned low = (unsigned)(127 - (32 * mt + (r & 3) + 8 * (r >> 2))) - 4u * (unsigned)hh; g[r] = (f2key(s[mt][r]) & ~127u) | low; }
        sort16_desc(g);
        if (mt == 0) {
#pragma unroll
            for (int i = 0; i < 16; ++i) top[i] = g[i];
        } else merge16(top, g);
    }
    merge16_partner(top);
}
__device__ __forceinline__ void peer_topk_phase(Frame& F) {
    const bf16_t* QP = (const bf16_t*)(F.ws + WS_QP); const bf16_t* SUBK = (const bf16_t*)(F.ws + WS_SUBK);
    unsigned short* IDX = (unsigned short*)(F.ws + WS_IDX); float* GATE = (float*)(F.ws + WS_GATE);
    LAS unsigned char* L = F.lds; const int tid = F.tid, lane = F.lane, wave = F.wave, l31 = lane & 31, hh = lane >> 5;
    LAS unsigned* scr = (LAS unsigned*)(L + PK_SCR_OFF + wave * 8192);
    pg8::StaticOrder S; S.init(T, 2048, F.G, F.bid);
    for (int ui = 0; ; ++ui) {
        pg8::Unit un; if (!S.next(ui, un)) break;
        const int h = un.pn, tile = un.pm;
        __syncthreads();
#pragma unroll
        for (int i = 0; i < 8; ++i) { const int v = tid + 512 * i, row = v >> 4, c = v & 15;
            *(LAS v4u*)(L + PK_K_OFF + row * PK_KROW + c * 16) = *(const v4u*)(SUBK + ((size_t)h * 256 + row) * 128 + c * 8); }
        __syncthreads();
        const int tok = tile * 256 + wave * 32 + l31;
        unsigned ka[16], kb[16];
#pragma unroll
        for (int p = 0; p < 2; ++p) {
            f32x16 s[4];
#pragma unroll
            for (int mt = 0; mt < 4; ++mt)
#pragma unroll
                for (int r = 0; r < 16; ++r) s[mt][r] = 0.f;
            const bf16_t* qrow = QP + (size_t)tok * 2048 + h * 256 + p * 128 + 8 * hh;
#pragma unroll
            for (int k2 = 0; k2 < 4; ++k2) {
                const bf16x8 q0 = *(const bf16x8*)(qrow + 32 * k2), q1 = *(const bf16x8*)(qrow + 32 * k2 + 16);
#pragma unroll
                for (int mt = 0; mt < 4; ++mt) { const bf16x8 a = *(const LAS bf16x8*)(L + PK_K_OFF + (p * 128 + 32 * mt + l31) * PK_KROW + (32 * k2 + 8 * hh) * 2); s[mt] = mfma32(a, q0, s[mt]); }
#pragma unroll
                for (int mt = 0; mt < 4; ++mt) { const bf16x8 a = *(const LAS bf16x8*)(L + PK_K_OFF + (p * 128 + 32 * mt + l31) * PK_KROW + (32 * k2 + 16 + 8 * hh) * 2); s[mt] = mfma32(a, q1, s[mt]); }
                __builtin_amdgcn_sched_barrier(0);
            }
            if (p == 0) top16_of_tiles(s, hh, ka); else top16_of_tiles(s, hh, kb);
        }
        float sa[16], sb[16];
#pragma unroll
        for (int i = 0; i < 16; ++i) { sa[i] = key2f(ka[i] & ~127u); sb[i] = key2f(kb[i] & ~127u); scr[i * 64 + lane] = 127u - (ka[i] & 127u); scr[(16 + i) * 64 + lane] = 127u - (kb[i] & 127u); }
        unsigned c0[16], c1[16];
#pragma unroll
        for (int n = 0; n < 32; ++n) {
            unsigned key = 0u;
            if (n < 25) { const int e0 = 2 * n, e1 = 2 * n + 1;
                const float v0 = sa[PEER_CI[e0]] + sb[PEER_CJ[e0]], v1 = sa[PEER_CI[e1]] + sb[PEER_CJ[e1]];
                const unsigned k0 = (f2key(v0) & ~255u) | (unsigned)(255 - (PEER_CI[e0] * 16 + PEER_CJ[e0])), k1 = (f2key(v1) & ~255u) | (unsigned)(255 - (PEER_CI[e1] * 16 + PEER_CJ[e1]));
                key = hh ? k1 : k0; }
            if (n < 16) c0[n] = key; else c1[n - 16] = key;
        }
        sort16_desc(c0); sort16_desc(c1); merge16(c0, c1); merge16_partner(c0);
        float e[16]; float sum = 0.f; const float mx = key2f(c0[0] & ~255u);
#pragma unroll
        for (int n = 0; n < 16; ++n) { e[n] = fexp(key2f(c0[n] & ~255u) - mx); sum += e[n]; }
        const float inv = 1.0f / sum;
        int eo[8]; float go[8];
#pragma unroll
        for (int n = 0; n < 8; ++n) { const unsigned kk = hh ? c0[8 + n] : c0[n]; const unsigned id = 255u - (kk & 255u);
            const unsigned i1 = scr[(id >> 4) * 64 + lane], i2 = scr[(16 + (id & 15)) * 64 + lane];
            eo[n] = (int)(i1 * 128u + i2); go[n] = (hh ? e[8 + n] : e[n]) * inv; }
        typedef int i32x4 __attribute__((ext_vector_type(4)));
        { const __amdgpu_buffer_rsrc_t gr = wt_rsrc(GATE); const unsigned bo = (unsigned)(((size_t)tok * 128 + h * 16 + 8 * hh) * 4);
          wt_st16(gr, bo, __builtin_bit_cast(wt_u32x4, (f32x4){go[0], go[1], go[2], go[3]})); wt_st16(gr, bo + 16, __builtin_bit_cast(wt_u32x4, (f32x4){go[4], go[5], go[6], go[7]}));
          unsigned short* ip = IDX + (size_t)tok * 128 + 2 * h + hh;
#pragma unroll
          for (int n = 0; n < 8; ++n) ip[16 * n] = (unsigned short)eo[n]; }
    }
    __syncthreads();
}
constexpr size_t WS_RSTD2 = 482 * MiB, WS_EXD8 = 352 * MiB, WS_EXU8 = 368 * MiB, WS_ISD = 6 * MiB, WS_ISU = 6 * MiB + 65536, WS_PA = 32 * MiB, WS_WEX = 416 * MiB, WS_AQ = 96 * MiB, WS_ASC = 130 * MiB;
__device__ __forceinline__ float gelu_exact(float x) { return 0.5f * x * (1.f + erff(x * 0.7071067811865476f)); }
__device__ __forceinline__ unsigned pack_i8x4(float a, float b, float c, float d) {
    const int ia = (int)rintf(a), ib = (int)rintf(b), ic = (int)rintf(c), id = (int)rintf(d);
    return ((unsigned)ia & 0xffu) | (((unsigned)ib & 0xffu) << 8) | (((unsigned)ic & 0xffu) << 16) | ((unsigned)id << 24);
}
__device__ __forceinline__ unsigned nib_lo(unsigned w) { return w & 0x0F0F0F0Fu; }
__device__ __forceinline__ unsigned nib_hi(unsigned w) { return ((((w ^ 0x80808080u) + 0x08080808u) >> 4) & 0x0F0F0F0Fu) ^ 0x08080808u; }
__device__ __forceinline__ void peer_quant_phase(Frame& F) {
    const bf16_t* HB = (const bf16_t*)(F.ws + WS_HB2); unsigned char* AQ = F.ws + WS_AQ; float* ASC = (float*)(F.ws + WS_ASC); const int lane = F.lane;
    for (int t = F.bid * NWAVES + F.wave; t < T; t += F.G * NWAVES) {
        const v4u* hp = (const v4u*)(HB + (size_t)t * D + 16 * lane); float a[8], b[8]; unpack8(hp[0], a); unpack8(hp[1], b);
        float mx = 0.f;
#pragma unroll
        for (int j = 0; j < 8; ++j) mx = fmaxf(mx, fmaxf(fabsf(a[j]), fabsf(b[j])));
        mx = fmaxf(mx, __shfl_xor(mx, 1)); mx = fmaxf(mx, __shfl_xor(mx, 2)); mx = fmaxf(mx, __shfl_xor(mx, 4)); mx = fmaxf(mx, __shfl_xor(mx, 8));
        const float sx = mx > 0.f ? 119.f / mx : 1.f, isx = mx > 0.f ? mx * (1.f / 119.f) : 1.f;
        const unsigned w0 = pack_i8x4(a[0] * sx, a[2] * sx, a[4] * sx, a[6] * sx), w1 = pack_i8x4(a[1] * sx, a[3] * sx, a[5] * sx, a[7] * sx);
        const unsigned w2 = pack_i8x4(b[0] * sx, b[2] * sx, b[4] * sx, b[6] * sx), w3 = pack_i8x4(b[1] * sx, b[3] * sx, b[5] * sx, b[7] * sx);
        unsigned char* base = AQ + ((size_t)(t * 4 + (lane >> 4)) * 8 + ((lane & 15) >> 1)) * 32 + (lane & 1) * 8;
        *(v2u*)base = (v2u){nib_hi(w0) | (nib_hi(w1) << 4), nib_hi(w2) | (nib_hi(w3) << 4)};
        *(v2u*)(base + 16) = (v2u){nib_lo(w0) | (nib_lo(w1) << 4), nib_lo(w2) | (nib_lo(w3) << 4)};
        if ((lane & 15) == 0) ASC[t * 4 + (lane >> 4)] = isx;
    }
}
__device__ __forceinline__ void treduce16(float (&p)[16], int lane, int m) {
#pragma unroll
    for (int i = 0; i < 8; ++i) { const bool hi = lane & m; const float send = hi ? p[i] : p[i + 8], keep = hi ? p[i + 8] : p[i]; p[i] = keep + __shfl_xor(send, m); }
#pragma unroll
    for (int i = 0; i < 4; ++i) { const bool hi = lane & (2 * m); const float send = hi ? p[i] : p[i + 4], keep = hi ? p[i + 4] : p[i]; p[i] = keep + __shfl_xor(send, 2 * m); }
#pragma unroll
    for (int i = 0; i < 2; ++i) { const bool hi = lane & (4 * m); const float send = hi ? p[i] : p[i + 2], keep = hi ? p[i + 2] : p[i]; p[i] = keep + __shfl_xor(send, 4 * m); }
}
typedef int i32x4v __attribute__((ext_vector_type(4)));
__device__ __forceinline__ void treduce16i_g(int (&p)[16], int lane) {
#pragma unroll
    for (int i = 0; i < 8; ++i) { const v2u r = __builtin_amdgcn_permlane32_swap((unsigned)p[i], (unsigned)p[i + 8], false, false); p[i] = (int)(r.x + r.y); }
#pragma unroll
    for (int i = 0; i < 4; ++i) { const v2u r = __builtin_amdgcn_permlane16_swap((unsigned)p[i], (unsigned)p[i + 4], false, false); p[i] = (int)(r.x + r.y); }
    const bool hi = lane & 8;
#pragma unroll
    for (int i = 0; i < 2; ++i) { const int send = hi ? p[i] : p[i + 2], keep = hi ? p[i + 2] : p[i]; p[i] = keep + __builtin_amdgcn_update_dpp(0, send, 0x128, 0xF, 0xF, false); }
}
__device__ __forceinline__ void peer_load_ids(const unsigned short* IDX, size_t t, int g, i32x4v (&id)[4]) {
    const v4u* p = (const v4u*)(IDX + t * 128 + g * 16); const v4u a = p[0], b = p[1];
    id[0] = (i32x4v){(int)(a.x & 0xffffu), (int)(a.x >> 16), (int)(a.y & 0xffffu), (int)(a.y >> 16)}; id[1] = (i32x4v){(int)(a.z & 0xffffu), (int)(a.z >> 16), (int)(a.w & 0xffffu), (int)(a.w >> 16)};
    id[2] = (i32x4v){(int)(b.x & 0xffffu), (int)(b.x >> 16), (int)(b.y & 0xffffu), (int)(b.y >> 16)}; id[3] = (i32x4v){(int)(b.z & 0xffffu), (int)(b.z >> 16), (int)(b.w & 0xffffu), (int)(b.w >> 16)};
}
__device__ __forceinline__ void peer_load_w(const bf16_t* WEX, size_t t, int g, v4u (&w)[2]) {
    const v4u* p = (const v4u*)(WEX + t * 128 + g * 16); w[0] = p[0]; w[1] = p[1];
}
__device__ __forceinline__ void peer_v8_lds(LAS unsigned char* scr, unsigned raw, int lane, int grp, v4u (&o)[2]) {
    *(LAS unsigned*)(scr + 4 * lane) = raw; asm volatile("" ::: "memory");
    o[0] = *(const LAS v4u*)(scr + 32 * grp); o[1] = *(const LAS v4u*)(scr + 32 * grp + 16); asm volatile("" ::: "memory");
}
__device__ __forceinline__ void peer_ids_lds(LAS unsigned char* scr, unsigned raw, int lane, i32x4v (&id)[4]) {
    v4u r[2]; peer_v8_lds(scr, raw, lane, lane >> 3, r); const v4u a = r[0], b = r[1];
    id[0] = (i32x4v){(int)(a.x & 0xffffu), (int)(a.x >> 16), (int)(a.y & 0xffffu), (int)(a.y >> 16)}; id[1] = (i32x4v){(int)(a.z & 0xffffu), (int)(a.z >> 16), (int)(a.w & 0xffffu), (int)(a.w >> 16)};
    id[2] = (i32x4v){(int)(b.x & 0xffffu), (int)(b.x >> 16), (int)(b.y & 0xffffu), (int)(b.y >> 16)}; id[3] = (i32x4v){(int)(b.z & 0xffffu), (int)(b.z >> 16), (int)(b.w & 0xffffu), (int)(b.w >> 16)};
}
#ifndef PEER_GATHER_AUX
#define PEER_GATHER_AUX 16
#endif
__device__ __forceinline__ void peer_gather16(v4u (&q)[16], const __amdgpu_buffer_rsrc_t r, unsigned loff, const i32x4v (&id)[4]) {
#pragma unroll
    for (int i = 0; i < 16; ++i) q[i] = __builtin_bit_cast(v4u, __builtin_amdgcn_raw_buffer_load_b128(r, (unsigned)id[i >> 2][i & 3] * 128u + loff, 0, PEER_GATHER_AUX));
}
__device__ __forceinline__ void peer_down_compute(const v4u (&q)[16], const v4u (&aq)[2], float isx, bf16_t* pa, int lane) {
    float p[16];
#pragma unroll
    for (int i = 0; i < 16; ++i) { int ah = __builtin_amdgcn_sdot8((int)q[i][0], (int)aq[0][0], 0, true), al = __builtin_amdgcn_sdot8((int)q[i][0], (int)aq[1][0], 0, true);
#pragma unroll
        for (int j = 1; j < 4; ++j) { ah = __builtin_amdgcn_sdot8((int)q[i][j], (int)aq[0][j], ah, false); al = __builtin_amdgcn_sdot8((int)q[i][j], (int)aq[1][j], al, false); }
        p[i] = (float)(16 * ah + al) * isx; }
    treduce16(p, lane, 1);
    *(unsigned*)(pa + 2 * lane) = pk2(p[0], p[1]);
}
__device__ __forceinline__ void peer_down_phase(Frame& F) {
    const unsigned char* TD = F.ws + WS_EXD8; const unsigned short* IDX = (const unsigned short*)(F.ws + WS_IDX);
    bf16_t* PA = (bf16_t*)(F.ws + WS_PA); const bf16_t* h1 = (const bf16_t*)(F.ws + WS_HB2);
    const unsigned char* AQ = F.ws + WS_AQ; const float* ASC = (const float*)(F.ws + WS_ASC);
    const int lane = F.lane, g = lane >> 3, cl = lane & 7, k = (F.bid & 7) >> 1, nw = (F.G >> 3) * 2 * NWAVES;
    const __amdgpu_buffer_rsrc_t tk = wt_rsrc(TD + (size_t)k * 16384 * 128); const unsigned loff = 16u * (unsigned)cl;
    int t = ((F.bid >> 3) * 2 + (F.bid & 1)) * NWAVES + F.wave;
    if (t >= T) return;
    LAS unsigned char* scrI = F.lds + F.wave * 512; LAS unsigned char* scrA = scrI + 256;
    const unsigned* IDXW = (const unsigned*)IDX + lane; const unsigned* AQW = (const unsigned*)AQ + k * 64 + lane;
    i32x4v id[4];
    unsigned idr = IDXW[(size_t)t * 64];
    peer_ids_lds(scrI, idr, lane, id);
    v4u qa[16], qb[16];
    peer_gather16(qa, tk, loff, id);
    { const int tl = (t + nw < T) ? t + nw : t; idr = IDXW[(size_t)tl * 64]; }
    float hs = ASC[t * 4 + k];
    unsigned aqr = AQW[(size_t)t * 256];
#define PEER_DOWN_STEP(QC, QN) { \
        const int t1 = t + nw, t2 = t + 2 * nw; const bool has1 = t1 < T; \
        peer_ids_lds(scrI, idr, lane, id); \
        if (has1) peer_gather16(QN, tk, loff, id); \
        { const int tl = (t2 < T) ? t2 : t; idr = IDXW[(size_t)tl * 64]; } \
        v4u hv[2]; peer_v8_lds(scrA, aqr, lane, cl, hv); \
        unsigned aqn; float hsn; { const int tl = has1 ? t1 : t; aqn = AQW[(size_t)tl * 256]; hsn = ASC[tl * 4 + k]; } \
        __builtin_amdgcn_sched_barrier(0); \
        peer_down_compute(QC, hv, hs, PA + ((size_t)k * T + t) * 128, lane); \
        __builtin_amdgcn_sched_barrier(0); \
        if (!has1) break; t = t1; aqr = aqn; hs = hsn; }
    for (;;) { PEER_DOWN_STEP(qa, qb) PEER_DOWN_STEP(qb, qa) }
#undef PEER_DOWN_STEP
}
__device__ __forceinline__ void peer_combine_phase(Frame& F) {
    const unsigned* PAW = (const unsigned*)(F.ws + WS_PA); const unsigned* IDXW = (const unsigned*)(F.ws + WS_IDX); const float* GATE = (const float*)(F.ws + WS_GATE);
    const float* ISD = (const float*)(F.ws + WS_ISD); const float* ISU = (const float*)(F.ws + WS_ISU); unsigned* WQ = (unsigned*)(F.ws + WS_WEX); float* WSC = (float*)(F.ws + WS_WEX + 8 * MiB); const float* RSTD2 = (const float*)(F.ws + WS_RSTD2);
    const int lane = F.lane, g = lane >> 3, w = lane & 7, cl = ((w & 1) << 2) | (w & 2) | ((w >> 2) & 1);
    for (int t = F.bid * NWAVES + F.wave; t < T; t += F.G * NWAVES) {
        float a0 = 0.f, a1 = 0.f;
#pragma unroll
        for (int k = 0; k < 4; ++k) { const unsigned r = PAW[((size_t)k * T + t) * 64 + 8 * g + cl]; a0 += __builtin_bit_cast(float, r << 16); a1 += __builtin_bit_cast(float, r & 0xffff0000u); }
        const unsigned idp = IDXW[(size_t)t * 64 + 8 * g + w]; const int id0 = (int)(idp & 0xffffu), id1 = (int)(idp >> 16);
        const float g0 = GATE[(size_t)t * 128 + 16 * w + g], g1 = GATE[(size_t)t * 128 + 16 * w + 8 + g], rs = RSTD2[t];
        const pg8::f32x2 ge = pg8::gelu_pk((pg8::f32x2){a0 * rs * ISD[id0], a1 * rs * ISD[id1]});
        const float w0 = g0 * ge.x * ISU[id0], w1 = g1 * ge.y * ISU[id1];
        float mx = fmaxf(fabsf(w0), fabsf(w1));
#pragma unroll
        for (int o = 1; o < 64; o <<= 1) mx = fmaxf(mx, __shfl_xor(mx, o));
        const float sw = mx > 0.f ? 119.f / mx : 1.f, isw = mx > 0.f ? mx * (1.f / 119.f) : 1.f;
        const unsigned by = ((unsigned)(int)rintf(w0 * sw) & 0xffu) | (((unsigned)(int)rintf(w1 * sw) & 0xffu) << 8);
        const unsigned h = nib_hi(by) & 0x0F0Fu, l = nib_lo(by) & 0x0F0Fu;
        unsigned hv = ((h | (h >> 4)) & 0xffu) << (8 * (w & 3)), lv = ((l | (l >> 4)) & 0xffu) << (8 * (w & 3));
        hv |= (unsigned)__builtin_amdgcn_update_dpp(0, (int)hv, 0xB1, 0xF, 0xF, false); hv |= (unsigned)__builtin_amdgcn_update_dpp(0, (int)hv, 0x4E, 0xF, 0xF, false);
        lv |= (unsigned)__builtin_amdgcn_update_dpp(0, (int)lv, 0xB1, 0xF, 0xF, false); lv |= (unsigned)__builtin_amdgcn_update_dpp(0, (int)lv, 0x4E, 0xF, 0xF, false);
        if ((w & 3) == 0) { WQ[(size_t)t * 32 + 4 * g + (w >> 2)] = hv; WQ[(size_t)t * 32 + 4 * g + 2 + (w >> 2)] = lv; }
        if (lane == 0) WSC[t] = isw;
    }
}
__device__ __forceinline__ void peer_up_compute(const v4u (&q)[16], const v4u wq, float isw, v2u hraw, float* dstp, int lane) {
    const int whi[2] = {(int)wq.x, (int)wq.y}, wlo[2] = {(int)wq.z, (int)wq.w};
    constexpr unsigned NM = 0x0F0F0F0Fu;
    int res[4];
#pragma unroll
    for (int jj = 0; jj < 2; ++jj) {
    int f[16];
#pragma unroll
    for (int j2 = 0; j2 < 2; ++j2) { const int j = 2 * jj + j2;
        unsigned tcc[2][8];
#pragma unroll
        for (int o = 0; o < 2; ++o) {
            unsigned a0[4], a1[4];
#pragma unroll
            for (int pr = 0; pr < 4; ++pr) { const unsigned r0 = q[8 * o + 2 * pr][j], r1 = q[8 * o + 2 * pr + 1][j];
                a0[pr] = (r0 & NM) | ((r1 << 4) & ~NM); a1[pr] = ((r0 >> 4) & NM) | (r1 & ~NM); }
#pragma unroll
            for (int x = 0; x < 2; ++x) {
                unsigned b[2][2];
#pragma unroll
                for (int h = 0; h < 2; ++h) { const unsigned lo = x ? a1[2 * h] : a0[2 * h], hi = x ? a1[2 * h + 1] : a0[2 * h + 1];
                    b[h][0] = __builtin_amdgcn_perm(hi, lo, 0x05010400u); b[h][1] = __builtin_amdgcn_perm(hi, lo, 0x07030602u); }
#pragma unroll
                for (int p = 0; p < 2; ++p) { tcc[o][2 * (2 * p) + x] = __builtin_amdgcn_perm(b[1][p], b[0][p], 0x05040100u); tcc[o][2 * (2 * p + 1) + x] = __builtin_amdgcn_perm(b[1][p], b[0][p], 0x07060302u); }
            }
        }
#pragma unroll
        for (int n = 0; n < 8; ++n) { int a = __builtin_amdgcn_sdot8((int)tcc[0][n], whi[0], 0, true);     a = __builtin_amdgcn_sdot8((int)tcc[1][n], whi[1], a, false);
            a = __builtin_amdgcn_sdot8((int)tcc[0][n], wlo[0], a << 4, false); a = __builtin_amdgcn_sdot8((int)tcc[1][n], wlo[1], a, false); f[8 * j2 + n] = a; }
    }
    treduce16i_g(f, lane); res[2 * jj] = f[0]; res[2 * jj + 1] = f[1];
    }
    *(f32x2_t*)dstp = (f32x2_t){__builtin_bit_cast(float, hraw.x << 16) + (float)res[0] * isw, __builtin_bit_cast(float, hraw.x & 0xffff0000u) + (float)res[1] * isw};
    *(f32x2_t*)(dstp + 16) = (f32x2_t){__builtin_bit_cast(float, hraw.y << 16) + (float)res[2] * isw, __builtin_bit_cast(float, hraw.y & 0xffff0000u) + (float)res[3] * isw};
}
__device__ __forceinline__ void peer_up_phase(Frame& F, float* dst) {
    const unsigned char* TU = F.ws + WS_EXU8; const unsigned short* IDX = (const unsigned short*)(F.ws + WS_IDX); const bf16_t* WEX = (const bf16_t*)(F.ws + WS_WEX);
    float* out = F.out;
    const int lane = F.lane, g = lane >> 3, cl = lane & 7, k = (F.bid & 7) >> 1, nw = (F.G >> 3) * 2 * NWAVES;
    const __amdgpu_buffer_rsrc_t tk = wt_rsrc(TU + (size_t)k * 16384 * 128); const unsigned loff = 16u * (unsigned)cl;
    const int ccol = 256 * k + 32 * cl + 2 * g;
    int t = ((F.bid >> 3) * 2 + (F.bid & 1)) * NWAVES + F.wave;
    if (t >= T) return;
    LAS unsigned char* scrI = F.lds + F.wave * 512; LAS unsigned char* scrW = scrI + 256;
    const unsigned* IDXW = (const unsigned*)IDX + lane; const unsigned* WEXW = (const unsigned*)WEX + (lane & 31); const float* WSC = (const float*)(F.ws + WS_WEX + 8 * MiB);
    i32x4v id[4];
    unsigned idr = IDXW[(size_t)t * 64], wr = WEXW[(size_t)t * 32]; float ws = WSC[t];
    peer_ids_lds(scrI, idr, lane, id);
    v4u qa[16], qb[16];
    peer_gather16(qa, tk, loff, id);
    { const int tl = (t + nw < T) ? t + nw : t; idr = IDXW[(size_t)tl * 64]; }
    const bf16_t* hb16 = (const bf16_t*)(F.ws + WS_HB2);
    v2u hcur; hcur.x = *(const unsigned*)(hb16 + (size_t)t * D + ccol); hcur.y = *(const unsigned*)(hb16 + (size_t)t * D + ccol + 16);
#define PEER_UP_STEP(QC, QN) { \
        const int t1 = t + nw, t2 = t + 2 * nw; const bool has1 = t1 < T; \
        peer_ids_lds(scrI, idr, lane, id); \
        if (has1) peer_gather16(QN, tk, loff, id); \
        { const int tl = (t2 < T) ? t2 : t; idr = IDXW[(size_t)tl * 64]; } \
        const unsigned wrn = WEXW[(size_t)(has1 ? t1 : t) * 32]; const float wsn = WSC[has1 ? t1 : t]; \
        v2u hnext; hnext.x = *(const unsigned*)(hb16 + (size_t)(has1 ? t1 : t) * D + ccol); hnext.y = *(const unsigned*)(hb16 + (size_t)(has1 ? t1 : t) * D + ccol + 16); \
        *(LAS unsigned*)(scrW + 4 * (lane & 31)) = wr; asm volatile("" ::: "memory"); const v4u wc = *(const LAS v4u*)(scrW + 16 * g); asm volatile("" ::: "memory"); \
        __builtin_amdgcn_sched_barrier(0); \
        peer_up_compute(QC, wc, ws, hcur, dst + (size_t)t * D + ccol, lane); \
        __builtin_amdgcn_sched_barrier(0); \
        if (!has1) break; t = t1; hcur = hnext; wr = wrn; ws = wsn; }
    for (;;) { PEER_UP_STEP(qa, qb) PEER_UP_STEP(qb, qa) }
#undef PEER_UP_STEP
}
__device__ __forceinline__ void expert_convert(Frame& F, const float* exd, const float* exu, const float* gain2) {
    const int lane = F.lane;
    f32x4 gv[4];
#pragma unroll
    for (int j = 0; j < 4; ++j) gv[j] = *(const f32x4*)(gain2 + 16 * lane + 4 * j);
    const bool wsplit = (F.G == 256); const int nscan = 128 * NWAVES;
    int gi = F.bid * NWAVES + F.wave, gstep = F.G * NWAVES, gend = 8192;
    if (wsplit) { gstep = nscan; if (F.bid < 128) { gend = 2 * nscan; } else { gi = 2 * nscan + (F.bid - 128) * NWAVES + F.wave; } }
    for (; gi < gend; gi += gstep) { const int r4 = gi * 4;
        const int tb = r4 >> 14, row0 = r4 & 16383;
        const float* src = (tb ? exu : exd) + (size_t)row0 * D + 16 * lane;
        f32x4 v[4][4]; float mx[4];
#pragma unroll
        for (int r = 0; r < 4; ++r)
#pragma unroll
            for (int j = 0; j < 4; ++j) v[r][j] = *(const f32x4*)(src + (size_t)r * D + 4 * j);
#pragma unroll
        for (int r = 0; r < 4; ++r) { float m = 0.f;
#pragma unroll
            for (int j = 0; j < 4; ++j) { if (tb == 0) v[r][j] = v[r][j] * gv[j]; m = fmaxf(m, fmaxf(fmaxf(fabsf(v[r][j].x), fabsf(v[r][j].y)), fmaxf(fabsf(v[r][j].z), fabsf(v[r][j].w)))); }
            mx[r] = m; }
#pragma unroll
        for (int o = 1; o < 64; o <<= 1)
#pragma unroll
            for (int r = 0; r < 4; ++r) mx[r] = fmaxf(mx[r], __shfl_xor(mx[r], o));
        {
            float ss[4];
#pragma unroll
            for (int r = 0; r < 4; ++r) { float s = 0.f;
#pragma unroll
                for (int j = 0; j < 4; ++j) s += (v[r][j].x * v[r][j].x + v[r][j].y * v[r][j].y) + (v[r][j].z * v[r][j].z + v[r][j].w * v[r][j].w);
                ss[r] = s; }
#pragma unroll
            for (int o = 1; o < 64; o <<= 1)
#pragma unroll
                for (int r = 0; r < 4; ++r) ss[r] += __shfl_xor(ss[r], o);
#pragma unroll
            for (int r = 0; r < 4; ++r) {
                const float rms = sqrtf(ss[r] * (1.f / 1024.f)), step = rms > 0.f ? 0.35f * rms : 1.f, sc = 1.f / step;
                f32x4 c[4];
#pragma unroll
                for (int j = 0; j < 4; ++j) { c[j] = v[r][j] * sc; c[j].x = fminf(fmaxf(c[j].x, -7.f), 7.f); c[j].y = fminf(fmaxf(c[j].y, -7.f), 7.f); c[j].z = fminf(fmaxf(c[j].z, -7.f), 7.f); c[j].w = fminf(fmaxf(c[j].w, -7.f), 7.f); }
                const unsigned x0 = pack_i8x4(c[0].x, c[0].z, c[1].x, c[1].z), y0 = pack_i8x4(c[0].y, c[0].w, c[1].y, c[1].w);
                const unsigned x1 = pack_i8x4(c[2].x, c[2].z, c[3].x, c[3].z), y1 = pack_i8x4(c[2].y, c[2].w, c[3].y, c[3].w);
                *(v2u*)(F.ws + (tb ? WS_EXU8 : WS_EXD8) + ((size_t)(lane >> 4) * 16384 + row0 + r) * 128 + (lane & 15) * 8) = (v2u){nib_lo(x0) | (nib_lo(y0) << 4), nib_lo(x1) | (nib_lo(y1) << 4)};
                if (lane == 0) wt_st4((float*)(F.ws + (tb ? WS_ISU : WS_ISD)) + row0 + r, step);
            }
            continue;
        }
        const __amdgpu_buffer_rsrc_t rr = wt_rsrc(F.ws + (tb ? WS_EXU8 : WS_EXD8));
#pragma unroll
        for (int r = 0; r < 4; ++r) {
            const float sc = mx[r] > 0.f ? 127.f / mx[r] : 1.f, isc = mx[r] > 0.f ? mx[r] * (1.f / 127.f) : 1.f;
            v4u q;
#pragma unroll
            for (int j = 0; j < 4; ++j) q[j] = pack_i8x4(v[r][j].x * sc, v[r][j].y * sc, v[r][j].z * sc, v[r][j].w * sc);
            wt_st16(rr, (unsigned)(((lane >> 3) * 16384 + row0 + r) * 128 + (lane & 7) * 16), q);
            if (lane == 0) wt_st4((float*)(F.ws + (tb ? WS_ISU : WS_ISD)) + row0 + r, isc);
        }
    }
}
#define XB_TMO      128
#define XB_XCNT(j)  (256  + 64 * (j))
#define XB_XSUB(j)  (1280 + 64 * (j))
#define XB_XGEN(j)  (2304 + 64 * (j))
#define XB_TOP      3328
#define XB_TOPGEN   3392
#define XCD_BAR_WORDS 3456
#define XB_SPIN_CAP (1u << 18)

__device__ __forceinline__ unsigned xb_ld(unsigned* p)              { return __hip_atomic_load(p, __ATOMIC_RELAXED, __HIP_MEMORY_SCOPE_AGENT); }
__device__ __forceinline__ unsigned xb_add(unsigned* p, unsigned v) { return __hip_atomic_fetch_add(p, v, __ATOMIC_RELAXED, __HIP_MEMORY_SCOPE_AGENT); }
__device__ __forceinline__ unsigned xb_xcc_id() { return (unsigned)__builtin_amdgcn_s_getreg((3 << 11) | 20) & 0xFu; }
#define XB_SPIN(cond, bar) do { unsigned _sp = 0; while (cond) { __builtin_amdgcn_s_sleep(1); \
    if ((++_sp & 255u) == 0u) { if (xb_ld(&(bar)[XB_TMO])) break; if (_sp > XB_SPIN_CAP) { atomicAdd(&(bar)[XB_TMO], 1u); break; } } } } while (0)

struct XcdBarrier {
    unsigned* bar; unsigned x;
    volatile LAS unsigned* st;
};

__device__ __forceinline__ XcdBarrier xcd_barrier_post(unsigned* bar, volatile LAS unsigned* st) {
    XcdBarrier b; b.bar = bar; b.x = xb_xcc_id(); b.st = st;
    if (threadIdx.x == 0) (void)xb_add(&bar[XB_XCNT(b.x)], 1u);
    return b;
}
__device__ __forceinline__ void xcd_barrier_complete(unsigned* bar, unsigned x, unsigned& nloc, unsigned& nx) {
    const unsigned G = gridDim.x * gridDim.y * gridDim.z;
    unsigned sum, cnt, mine, sp = 0u;
    for (;;) {
        sum = 0u; cnt = 0u; mine = 0u;
#pragma unroll
        for (unsigned j = 0; j < 16; ++j) { const unsigned c = xb_ld(&bar[XB_XCNT(j)]); sum += c; cnt += (c > 0u) ? 1u : 0u; mine = (j == x) ? c : mine; }
        if (sum == G) break;
        __builtin_amdgcn_s_sleep(1);
        if ((++sp & 255u) == 0u) { if (xb_ld(&bar[XB_TMO])) break; if (sp > XB_SPIN_CAP) { atomicAdd(&bar[XB_TMO], 1u); break; } }
    }
    nloc = mine > 0u ? mine : 1u; nx = cnt > 0u ? cnt : 1u;
}

__device__ __forceinline__ void xcd_barrier(const XcdBarrier& b) {
    asm volatile("s_waitcnt vmcnt(0)" ::: "memory");
    __syncthreads();
    if (threadIdx.x == 0) {
        unsigned* bar = b.bar;
        __builtin_amdgcn_s_waitcnt(0);
        unsigned nloc = b.st[0], nx = b.st[1];
        if (nloc == 0u) { xcd_barrier_complete(bar, b.x, nloc, nx); b.st[0] = nloc; b.st[1] = nx; }
        const unsigned old = xb_add(&bar[XB_XSUB(b.x)], 1u);
        const unsigned gen = old / nloc;
        if (old + 1u == (gen + 1u) * nloc) {
            __builtin_amdgcn_fence(__ATOMIC_RELEASE, "agent");
            asm volatile("s_waitcnt vmcnt(0)" ::: "memory");
            const unsigned og = xb_add(&bar[XB_TOP], 1u);
            const unsigned tg = og / nx;
            if (og + 1u == (tg + 1u) * nx) xb_add(&bar[XB_TOPGEN], 1u);
            else XB_SPIN(xb_ld(&bar[XB_TOPGEN]) == tg, bar);
            __builtin_amdgcn_fence(__ATOMIC_ACQUIRE, "agent");
            xb_add(&bar[XB_XGEN(b.x)], 1u);
            asm volatile("s_waitcnt vmcnt(0)" ::: "memory");
        } else {
            XB_SPIN(xb_ld(&bar[XB_XGEN(b.x)]) == gen, bar);
            __builtin_amdgcn_fence(__ATOMIC_ACQUIRE, "agent");
            asm volatile("s_waitcnt vmcnt(0)" ::: "memory");
        }
    }
    __syncthreads();
}

__global__ void __launch_bounds__(NTHR, 2) mega(Args args) {
    extern __shared__ __attribute__((aligned(16))) unsigned char lds_raw[];
    Frame F;
    F.lds = (LAS unsigned char*)lds_raw;
    F.tid = threadIdx.x; F.lane = F.tid & 63; F.wave = __builtin_amdgcn_readfirstlane(F.tid >> 6); F.G = gridDim.x; F.bid = blockIdx.x;
    F.out = args.out; F.ws = args.ws;
    const int lo = args.ph_lo, hi = args.ph_hi;
    cg::grid_group grid = cg::this_grid();
    volatile LAS unsigned* MISC = (volatile LAS unsigned*)(F.lds + LDS_BYTES - 64);
    if (F.tid < 16) MISC[F.tid] = 0u;
    __syncthreads();
    XcdBarrier bar = xcd_barrier_post((unsigned*)(F.ws + WS_CTL) + 4096, MISC + 8);
    if (hi - lo > 1) grid.sync();
#define IN(k) (lo <= (k) && (k) < hi)
#define SEAM(k) do { if (IN(k) && IN((k) + 1)) xcd_barrier(bar); } while (0)
    if (IN(0)) { p0_prologue(F, args.in[0], args.in[1], args.in[2], args.in[13], args.in[10], args.in[11], args.in[12], args.in[14], args.in[15]); }
    SEAM(0);
    if (IN(1)) {
        pg8::Gemm g{(const bf16_t*)(F.ws + WS_XB), (const bf16_t*)(F.ws + WS_WIN), T, NPROJ, D}; pg8::StaticOrder S; S.init(T, NPROJ, F.G, F.bid);
        pg8::EpiProj E{(bf16_t*)(F.ws + WS_GQ), (bf16_t*)(F.ws + WS_GK), (bf16_t*)(F.ws + WS_GV), (bf16_t*)(F.ws + WS_GR), (bf16_t*)(F.ws + WS_SQ), (bf16_t*)(F.ws + WS_SK), (bf16_t*)(F.ws + WS_SV),
                       (bf16_t*)F.out, (bf16_t*)F.out + (size_t)T * D, (const float*)(F.ws + WS_RSTD1)};
        pg8::gemm_phase<pg8::EpiProj, pg8::StaticOrder, PG8_ALIGN, PG8_SP2>(F.lds, g, S, E);
    }
    SEAM(1);
    if (IN(2)) { gla_local_phase(F, args.in[3], args.in[4]); }
    SEAM(2);
    if (IN(3)) { gla_scan_phase(F); expert_convert(F, args.in[16], args.in[17], args.in[13]); swa_phase(F, args.in[6], args.in[7], args.in[8], args.in[9], (size_t)0); }
    SEAM(3);
    if (IN(4)) { gla_out_phase(F, args.in[3], args.in[4], args.in[5]); }
    SEAM(4);
    if (IN(5)) {
        pg8::PairOrder S; S.base.init(T, D, F.G, F.bid);
        pg8::Gemm g{(const bf16_t*)(F.ws + WS_YG), (const bf16_t*)(F.ws + WS_WG), T, D, D, (const bf16_t*)(F.ws + WS_SQ), (const bf16_t*)(F.ws + WS_WS)};
        pg8::EpiMergeBoth E{{(const bf16_t*)F.out, (const bf16_t*)F.out + (size_t)T * D, (bf16_t*)(F.ws + WS_MRG)}, {(const bf16_t*)F.out, (const bf16_t*)F.out + (size_t)T * D, (bf16_t*)(F.ws + WS_MRG)}};
        pg8::gemm_phase<pg8::EpiMergeBoth, pg8::PairOrder, PG8_ALIGN, PG8_SP2>(F.lds, g, S, E);
    }
    SEAM(5);
    if (IN(6)) {
        pg8::StaticOrder S; S.init(T, D, F.G, F.bid);
        pg8::Gemm g{(const bf16_t*)(F.ws + WS_MRG), (const bf16_t*)(F.ws + WS_WO), T, D, D};
        pg8::EpiOut E{(const bf16_t*)(F.ws + WS_XB), F.out, (bf16_t*)(F.ws + WS_HB2), (float*)(F.ws + WS_ROWSS2), T};
        pg8::gemm_phase<pg8::EpiOut, pg8::StaticOrder, PG8_ALIGN, PG8_SP2>(F.lds, g, S, E);
    }
    SEAM(6);
    if (IN(7)) {
        pg8::StaticOrder S; S.init(T, 2048, F.G, F.bid);
        pg8::Gemm g{(const bf16_t*)(F.ws + WS_HB2), (const bf16_t*)(F.ws + WS_WQ), T, 2048, D};
        pg8::EpiQ E{(const float*)(F.ws + WS_ROWSS2), (bf16_t*)(F.ws + WS_QP), T};
        pg8::gemm_phase<pg8::EpiQ, pg8::StaticOrder, PG8_ALIGN, PG8_SP2>(F.lds, g, S, E);
    }
    if (IN(7) && IN(8)) __syncthreads();
    if (IN(8)) {
        { const float* ROWSS = (const float*)(F.ws + WS_ROWSS2); float* RSTD2 = (float*)(F.ws + WS_RSTD2);
          for (int t = F.bid * NTHR + F.tid; t < T; t += F.G * NTHR) { float s = 0.f;
#pragma unroll
              for (int kk = 0; kk < 4; ++kk) { const f32x4 p4 = *(const f32x4*)(ROWSS + (size_t)t * 16 + 4 * kk); s += (p4.x + p4.y) + (p4.z + p4.w); }
              wt_st4(RSTD2 + t, rsqrtf(s * (1.f / 1024.f) + EPS)); } }
        peer_quant_phase(F);
        peer_topk_phase(F);
    }
    SEAM(8);
    if (IN(9)) { peer_down_phase(F); }
    SEAM(9);
    if (IN(10)) { peer_combine_phase(F); }
    SEAM(10);
    if (IN(11)) { peer_up_phase(F, F.out); }
#undef IN
#undef SEAM
}
}

extern "C" void kernel_launch(void* const* d_in, const int* in_sizes, int n_in, void* d_out, int out_size, void* d_ws, size_t ws_size, hipStream_t stream) {
    using namespace mk;
    static int grid = 0;
    if (grid == 0) {
        int dev_ = 0, cus = 0, per_cu = 0;
        if (hipGetDevice(&dev_) != hipSuccess || hipDeviceGetAttribute(&cus, hipDeviceAttributeMultiprocessorCount, dev_) != hipSuccess) { fprintf(stderr, "device query failed\n"); grid = -1; return; }
        if (hipFuncSetAttribute((const void*)mega, hipFuncAttributeMaxDynamicSharedMemorySize, LDS_BYTES) != hipSuccess) { fprintf(stderr, "hipFuncSetAttribute failed\n"); grid = -1; return; }
        if (hipOccupancyMaxActiveBlocksPerMultiprocessor(&per_cu, (const void*)mega, NTHR, LDS_BYTES) != hipSuccess || per_cu < 1) { fprintf(stderr, "occupancy query: %d\n", per_cu); per_cu = 1; }
        (void)hipGetLastError();
        grid = cus * 1;
        fprintf(stderr, "mega: cus %d per_cu %d grid %d\n", cus, per_cu, grid);
    }
    if (grid < 0) return;
    (void)hipMemsetAsync((char*)d_ws + WS_CTL, 0, CTL_ZERO_BYTES, stream);
    Args a{};
    for (int i = 0; i < 18; ++i) a.in[i] = (const float*)d_in[i];
    a.out = (float*)d_out; a.ws = (unsigned char*)d_ws; a.ph_lo = 0; a.ph_hi = 12;
    void* kargs[] = {&a};
    hipError_t e = hipLaunchCooperativeKernel((const void*)mega, dim3(grid), dim3(NTHR), kargs, LDS_BYTES, stream);
    if (e != hipSuccess) fprintf(stderr, "cooperative launch failed: %s\n", hipGetErrorString(e));
}
```

```cpp
#include <hip/hip_runtime.h>
#include <hip/hip_cooperative_groups.h>
#include <cstdio>
#include <cstdint>
#include <math.h>
namespace cg = cooperative_groups;
#ifndef WT_AUX
#define WT_AUX 0
#endif
typedef unsigned wt_u32x4 __attribute__((ext_vector_type(4)));
__device__ __forceinline__ __amdgpu_buffer_rsrc_t wt_rsrc(const void* base) { return __builtin_amdgcn_make_buffer_rsrc((void*)base, 0, 0x7FFFFFF0, 0x00020000); }
__device__ __forceinline__ void wt_st16(__amdgpu_buffer_rsrc_t r, unsigned byte_off, wt_u32x4 v) { __builtin_amdgcn_raw_buffer_store_b128(v, r, byte_off, 0, WT_AUX); }
typedef unsigned wt_u32x2 __attribute__((ext_vector_type(2)));
__device__ __forceinline__ void wt_st8(void* p, unsigned lo, unsigned hi) { if (WT_AUX) __hip_atomic_store((unsigned long long*)p, ((unsigned long long)hi << 32) | lo, __ATOMIC_RELAXED, __HIP_MEMORY_SCOPE_AGENT); else *(wt_u32x2*)p = (wt_u32x2){lo, hi}; }
__device__ __forceinline__ void wt_st4(float* p, float v) { if (WT_AUX) __hip_atomic_store(p, v, __ATOMIC_RELAXED, __HIP_MEMORY_SCOPE_AGENT); else *p = v; }
__device__ __forceinline__ void wtx_st16(__amdgpu_buffer_rsrc_t r, unsigned byte_off, wt_u32x4 v) { __builtin_amdgcn_raw_buffer_store_b128(v, r, byte_off, 0, 16); }
__device__ __forceinline__ void wtx_st8(void* p, unsigned lo, unsigned hi) { __hip_atomic_store((unsigned long long*)p, ((unsigned long long)hi << 32) | lo, __ATOMIC_RELAXED, __HIP_MEMORY_SCOPE_AGENT); }
__device__ __forceinline__ void wtx_st4(float* p, float v) { __hip_atomic_store(p, v, __ATOMIC_RELAXED, __HIP_MEMORY_SCOPE_AGENT); }
namespace pg8 {
#define PG8_LAS __attribute__((address_space(3)))
typedef unsigned short bf16_t;
typedef short bf16x8 __attribute__((ext_vector_type(8)));
typedef float f32x4 __attribute__((ext_vector_type(4)));
typedef unsigned u32x4 __attribute__((ext_vector_type(4)));
constexpr int BM = 256, BK = 64, HALF = 128, HTB = HALF * BK * 2  , STAGE_BYTES = 8 * HTB, NXCD = 8, WGM = 8;

__host__ __device__ __forceinline__ int lds_byte(int r, int c) { const int st = (r >> 4) * 2 + (c >> 5), rr = r & 15, cc = c & 31, ob = rr * 64 + cc * 2; return st * 1024 + (ob ^ (((ob >> 9) & 1) << 5)); }
__host__ __device__ __forceinline__ void stage_rc(int b, int& R, int& C) { const int st = b / 1024, sb = b % 1024, swz = sb ^ (((sb >> 9) & 1) << 5); R = (st >> 1) * 16 + swz / 64; C = (st & 1) * 32 + (swz % 64) / 2; }
__host__ __device__ __forceinline__ int perm32(int rho) { const int n = rho >> 4, i = rho & 15; return 8 * (i >> 2) + 4 * n + (i & 3); }

struct Unit { int pm, pn, sel; };
struct Gemm { const bf16_t* A; const bf16_t* Bt; int M, N, K; const bf16_t* A2; const bf16_t* Bt2; };

struct StaticOrder {
    int nM, nN, nwg, G, c;
    __host__ __device__ void init(int M, int N, int G_, int c_) { nM = M / BM; nN = N / BM; nwg = nM * nN; G = G_; c = c_; }
    __host__ __device__ bool next(int i, Unit& u) const {
        const long L = (long)i * G + c; if (L >= nwg) return false;
        int wgid = (int)L; { const int q = nwg / NXCD, r = nwg % NXCD, xcd = wgid % NXCD, off = wgid / NXCD; wgid = (xcd < r ? xcd * (q + 1) : r * (q + 1) + (xcd - r) * q) + off; }
        const int nig = WGM * nN, gid = wgid / nig, fm = gid * WGM, gsz = (nM - fm) < WGM ? (nM - fm) : WGM;
        u.pm = fm + ((wgid % nig) % gsz); u.pn = (wgid % nig) / gsz; u.sel = 0; return true;
    }
    __device__ __forceinline__ void a_ready(const Unit&) const {}
    __device__ __forceinline__ void done(const Unit&) const {}
    __device__ __forceinline__ bool keep(const Unit&) const { return false; }
};

__device__ __forceinline__ unsigned cvt_pk_bf16(float lo, float hi) { unsigned r; asm volatile("v_cvt_pk_bf16_f32 %0, %1, %2" : "=v"(r) : "v"(lo), "v"(hi)); return r; }
typedef float f32x2 __attribute__((ext_vector_type(2)));
__device__ __forceinline__ f32x2 gelu_pk(f32x2 v) {
    const f32x2 av = __builtin_elementwise_abs(v), d = av * 0.2316418882f + 1.0f;
    f32x2 t; t.x = __builtin_amdgcn_rcpf(d.x); t.y = __builtin_amdgcn_rcpf(d.y);
    f32x2 q = t * 0.5307027145f + (-0.7265760135f); q = q * t + 0.7107068705f; q = q * t + (-0.142248368f); q = q * t + 0.127414796f; q = q * t;
    const f32x2 s = (v * v) * (-0.72134752044f);
    f32x2 e; e.x = __builtin_amdgcn_exp2f(s.x); e.y = __builtin_amdgcn_exp2f(s.y);
    const f32x2 m = v * (q * e), r = v - m;
    f32x2 o; o.x = v.x < 0.f ? m.x : r.x; o.y = v.y < 0.f ? m.y : r.y; return o;
}

template <int ACT  > struct EpiBf16 {
    static constexpr bool PERM = true, AFTER_DRAIN = false; static_assert(ACT == 0 || ACT == 1, "EpiBf16: ACT is 0 (none) or 1 (gelu_pk)");
    bf16_t* O; int ldc; const float* bias; int split_cols; size_t split_stride; float scale0;
    __device__ __forceinline__ void operator()(const f32x4 (&acc)[2][2][4][2], const Unit& u, int wr, int wc, int fr, int fq) const {
        const int row0 = u.pm * BM + wr * 64 + fr; int colt = u.pn * BM; bf16_t* base = O;
        float sc = 1.f; if (split_cols) { const int t = colt / split_cols; base += (size_t)t * split_stride; colt -= t * split_cols; if (t == 0) sc = scale0; }
        const int col0 = colt + wc * 32 + 8 * fq, bcol0 = u.pn * BM + wc * 32 + 8 * fq;
        f32x4 bv[2][2];
#pragma unroll
        for (int bj = 0; bj < 2; ++bj)
#pragma unroll
            for (int n = 0; n < 2; ++n) bv[bj][n] = bias ? *(const f32x4*)(bias + bcol0 + bj * HALF + 4 * n) : (f32x4){0.f, 0.f, 0.f, 0.f};
#pragma unroll
        for (int ai = 0; ai < 2; ++ai)
#pragma unroll
            for (int m = 0; m < 4; ++m) { bf16_t* rowp = base + (size_t)(row0 + ai * HALF + m * 16) * ldc + col0;
#pragma unroll
                for (int bj = 0; bj < 2; ++bj) { f32x4 v0 = acc[ai][bj][m][0] + bv[bj][0], v1 = acc[ai][bj][m][1] + bv[bj][1];
                    if (ACT == 1) { f32x2 a = gelu_pk((f32x2){v0[0], v0[1]}), b = gelu_pk((f32x2){v0[2], v0[3]}), c = gelu_pk((f32x2){v1[0], v1[1]}), d = gelu_pk((f32x2){v1[2], v1[3]});
                        v0 = (f32x4){a.x, a.y, b.x, b.y}; v1 = (f32x4){c.x, c.y, d.x, d.y}; }
                    v0 = v0 * sc; v1 = v1 * sc; u32x4 w; w.x = cvt_pk_bf16(v0[0], v0[1]); w.y = cvt_pk_bf16(v0[2], v0[3]); w.z = cvt_pk_bf16(v1[0], v1[1]); w.w = cvt_pk_bf16(v1[2], v1[3]);
                    *(u32x4*)(rowp + bj * HALF) = w; } }
    }
};
__device__ __forceinline__ float sigm_fast(float v) { return __builtin_amdgcn_rcpf(1.0f + __builtin_amdgcn_exp2f(v * -1.4426950408889634f)); }
struct EpiProj {
    static constexpr bool PERM = true, AFTER_DRAIN = false;
    bf16_t *GQ, *GK, *GV, *GR, *SQ, *SK, *SV, *GA, *GB; const float* rstd;
    __device__ __forceinline__ void operator()(const f32x4 (&acc)[2][2][4][2], const Unit& u, int wr, int wc, int fr, int fq) const {
        const int pn = u.pn; bf16_t* base; int ldc, act = 0;
        if (pn < 2) { base = GQ + pn * 256; ldc = 512; }
        else if (pn < 4) { base = GK + (pn - 2) * 256; ldc = 512; }
        else if (pn < 8) { base = GV + (pn - 4) * 256; ldc = 1024; }
        else if (pn < 12) { base = GR + (pn - 8) * 256; ldc = 1024; act = 1; }
        else if (pn < 16) { base = SQ + (pn - 12) * 256; ldc = 1024; }
        else if (pn == 16) { base = SK; ldc = 256; }
        else if (pn == 17) { base = SV; ldc = 256; }
        else if (pn < 22) { base = GA + (pn - 18) * 256; ldc = 1024; act = 2; }
        else { base = GB + (pn - 22) * 256; ldc = 1024; act = 2; }
        const int row0 = u.pm * BM + wr * 64 + fr, col0 = wc * 32 + 8 * fq;
        const __amdgpu_buffer_rsrc_t rs_ = wt_rsrc(base);
#pragma unroll
        for (int ai = 0; ai < 2; ++ai)
#pragma unroll
            for (int m = 0; m < 4; ++m) { const int row = row0 + ai * HALF + m * 16; const float rs = rstd[row]; const unsigned rowoff = (unsigned)(((size_t)row * ldc + col0) * 2);
#pragma unroll
                for (int bj = 0; bj < 2; ++bj) { f32x4 v0 = acc[ai][bj][m][0] * rs, v1 = acc[ai][bj][m][1] * rs;
                    if (act) {
#pragma unroll
                        for (int e = 0; e < 4; ++e) { const float s0 = sigm_fast(v0[e]), s1 = sigm_fast(v1[e]); v0[e] = (act == 1) ? v0[e] * s0 : s0; v1[e] = (act == 1) ? v1[e] * s1 : s1; } }
                    u32x4 w; w.x = cvt_pk_bf16(v0[0], v0[1]); w.y = cvt_pk_bf16(v0[2], v0[3]); w.z = cvt_pk_bf16(v1[0], v1[1]); w.w = cvt_pk_bf16(v1[2], v1[3]);
                    wt_st16(rs_, rowoff + bj * HALF * 2, w); } }
    }
};

__device__ __forceinline__ void bf8_to_f32(const u32x4 raw, float (&f)[8]) {
#pragma unroll
    for (int j = 0; j < 4; ++j) { f[2 * j] = __builtin_bit_cast(float, raw[j] << 16); f[2 * j + 1] = __builtin_bit_cast(float, raw[j] & 0xffff0000u); }
}
template <int STEP> struct EpiMerge {
    static constexpr bool PERM = true, AFTER_DRAIN = false;
    const bf16_t* ga; const bf16_t* gb; bf16_t* outp;
    __device__ __forceinline__ void operator()(f32x4 (&acc)[2][2][4][2], const Unit& u, int wr, int wc, int fr, int fq) const {
        const int row0 = u.pm * BM + wr * 64 + fr, col0 = u.pn * BM + wc * 32 + 8 * fq;
        const __amdgpu_buffer_rsrc_t dst_r = wt_rsrc(outp);
#pragma unroll
        for (int ai = 0; ai < 2; ++ai)
#pragma unroll
            for (int m = 0; m < 4; ++m) { const size_t rb = (size_t)(row0 + ai * HALF + m * 16) * 1024 + col0;
#pragma unroll
                for (int bj = 0; bj < 2; ++bj) { const size_t off = rb + bj * HALF;
                    float b[8]; bf8_to_f32(*(const u32x4*)(gb + off), b);
                    if (STEP == 0) { float a[8]; bf8_to_f32(*(const u32x4*)(ga + off), a);
#pragma unroll
                        for (int e = 0; e < 4; ++e) { acc[ai][bj][m][0][e] *= a[e] * __builtin_amdgcn_rcpf(fmaxf(b[e], 1e-30f)); acc[ai][bj][m][1][e] *= a[4 + e] * __builtin_amdgcn_rcpf(fmaxf(b[4 + e], 1e-30f)); }
                    } else {
                        float v[8];
#pragma unroll
                        for (int e = 0; e < 4; ++e) { v[e] = acc[ai][bj][m][0][e] * fmaxf(b[e], 1e-30f); v[4 + e] = acc[ai][bj][m][1][e] * fmaxf(b[4 + e], 1e-30f); }
                        u32x4 w; w.x = cvt_pk_bf16(v[0], v[1]); w.y = cvt_pk_bf16(v[2], v[3]); w.z = cvt_pk_bf16(v[4], v[5]); w.w = cvt_pk_bf16(v[6], v[7]);
                        wt_st16(dst_r, (unsigned)(off * 2), w); } } }
    }
};
struct EpiOut {
    static constexpr bool PERM = true, AFTER_DRAIN = false;
    const bf16_t* x; float* h1; bf16_t* hb; float* rowss; int M;
    __device__ __forceinline__ void operator()(const f32x4 (&acc)[2][2][4][2], const Unit& u, int wr, int wc, int fr, int fq) const {
        const int row0 = u.pm * BM + wr * 64 + fr, col0 = u.pn * BM + wc * 32 + 8 * fq;
        const __amdgpu_buffer_rsrc_t hb_r = wt_rsrc(hb);
#pragma unroll
        for (int ai = 0; ai < 2; ++ai)
#pragma unroll
            for (int m = 0; m < 4; ++m) { const int row = row0 + ai * HALF + m * 16; const size_t rb = (size_t)row * 1024 + col0; float ss = 0.f;
#pragma unroll
                for (int bj = 0; bj < 2; ++bj) { const size_t off = rb + bj * HALF;
                    const u32x4 xw = *(const u32x4*)(x + off);
                    f32x4 x0, x1; x0[0] = __uint_as_float(xw.x << 16); x0[1] = __uint_as_float(xw.x & 0xffff0000u); x0[2] = __uint_as_float(xw.y << 16); x0[3] = __uint_as_float(xw.y & 0xffff0000u);
                    x1[0] = __uint_as_float(xw.z << 16); x1[1] = __uint_as_float(xw.z & 0xffff0000u); x1[2] = __uint_as_float(xw.w << 16); x1[3] = __uint_as_float(xw.w & 0xffff0000u);
                    const f32x4 v0 = acc[ai][bj][m][0] + x0, v1 = acc[ai][bj][m][1] + x1;
                    u32x4 w; w.x = cvt_pk_bf16(v0[0], v0[1]); w.y = cvt_pk_bf16(v0[2], v0[3]); w.z = cvt_pk_bf16(v1[0], v1[1]); w.w = cvt_pk_bf16(v1[2], v1[3]);
                    wt_st16(hb_r, (unsigned)(off * 2), w);
                    ss += (v0[0] * v0[0] + v0[1] * v0[1]) + (v0[2] * v0[2] + v0[3] * v0[3]) + (v1[0] * v1[0] + v1[1] * v1[1]) + (v1[2] * v1[2] + v1[3] * v1[3]); }
                ss += __shfl_xor(ss, 16); ss += __shfl_xor(ss, 32);
                if (fq == 0) wt_st4(rowss + (size_t)row * 16 + u.pn * 4 + wc, ss); }
    }
};
struct EpiQ {
    static constexpr bool PERM = true, AFTER_DRAIN = false;
    const float* rowss; bf16_t* qp; int M;
    __device__ __forceinline__ void operator()(const f32x4 (&acc)[2][2][4][2], const Unit& u, int wr, int wc, int fr, int fq) const {
        const int row0 = u.pm * BM + wr * 64 + fr, col0 = u.pn * BM + wc * 32 + 8 * fq;
        const __amdgpu_buffer_rsrc_t qp_r = wt_rsrc(qp);
#pragma unroll
        for (int ai = 0; ai < 2; ++ai)
#pragma unroll
            for (int m = 0; m < 4; ++m) { const int row = row0 + ai * HALF + m * 16; float s = 0.f;
#pragma unroll
                for (int k = 0; k < 4; ++k) { const f32x4 p4 = *(const f32x4*)(rowss + (size_t)row * 16 + 4 * k); s += (p4[0] + p4[1]) + (p4[2] + p4[3]); }
                const float rs = rsqrtf(s * (1.f / 1024.f) + 1e-6f);
#pragma unroll
                for (int bj = 0; bj < 2; ++bj) { const f32x4 v0 = acc[ai][bj][m][0] * rs, v1 = acc[ai][bj][m][1] * rs;
                    u32x4 w; w.x = cvt_pk_bf16(v0[0], v0[1]); w.y = cvt_pk_bf16(v0[2], v0[3]); w.z = cvt_pk_bf16(v1[0], v1[1]); w.w = cvt_pk_bf16(v1[2], v1[3]);
                    wt_st16(qp_r, (unsigned)(((size_t)row * 2048 + col0 + bj * HALF) * 2), w); } }
    }
};

struct PairOrder {
    StaticOrder base;
    __device__ bool next(int i, Unit& u) const { const bool ok = base.next(i >> 1, u); u.sel = i & 1; return ok; }
    __device__ __forceinline__ void a_ready(const Unit&) const {}
    __device__ __forceinline__ void done(const Unit&) const {}
    __device__ __forceinline__ bool keep(const Unit& u) const { return u.sel == 0; }
};
struct EpiMergeBoth {
    static constexpr bool PERM = true, AFTER_DRAIN = false;
    EpiMerge<0> e0; EpiMerge<1> e1;
    __device__ __forceinline__ void operator()(f32x4 (&acc)[2][2][4][2], const Unit& u, int wr, int wc, int fr, int fq) const { if (u.sel == 0) e0(acc, u, wr, wc, fr, fq); else e1(acc, u, wr, wc, fr, fq); }
};
template <class Epi, class Sched, bool ALIGN_EPI = false, bool SP2 = false>
__device__ __forceinline__ void gemm_phase(PG8_LAS unsigned char* lds, const Gemm g, const Sched& S, const Epi& E) {
    const int tid = threadIdx.x, wid = __builtin_amdgcn_readfirstlane(tid >> 6), lane = tid & 63, wr = wid >> 2, wc = wid & 3, fr = lane & 15, fq = lane >> 4;
    const int K = g.K, nt = K / BK;
    unsigned voffA[2], voffB[2];
#pragma unroll
    for (int i = 0; i < 2; ++i) { int R, C; stage_rc(tid * 16 + i * 8192, R, C); const int Rb = Epi::PERM ? ((R & ~31) + perm32(R & 31)) : R;
        voffA[i] = (unsigned)(R * K + C) * 2u; voffB[i] = (unsigned)(Rb * K + C) * 2u; }
    const size_t kstep = (size_t)(BK * 2);
    const size_t hstep = (size_t)HALF * K * 2;
    const size_t tstep = 2 * hstep;
    const unsigned ldsw = (unsigned)wid * 1024u;
    const int aoff = lds_byte(wr * 64 + fr, fq * 8), boff = lds_byte(wc * 32 + fr, fq * 8);
#define PG8_SA(b, h) (((b) * 2 + (h)) * HTB)
#define PG8_SB(b, h) ((4 + (b) * 2 + (h)) * HTB)
#define PG8_STAGE(bufoff, gbase, voff) do { _Pragma("unroll") for (int _i = 0; _i < 2; ++_i) \
        __builtin_amdgcn_global_load_lds((const unsigned*)((const char*)(gbase) + (voff)[_i]), (PG8_LAS unsigned*)(lds + (bufoff) + ldsw + _i * 8192), 16, 0, 0); } while (0)
#define PG8_LDA(dst, b, h) do { _Pragma("unroll") for (int m = 0; m < 4; ++m) _Pragma("unroll") for (int k = 0; k < 2; ++k) dst[m][k] = *(const PG8_LAS bf16x8*)(lds + PG8_SA(b, h) + aoff + m * 2048 + k * 1024); } while (0)
#define PG8_LDB(dst, b, h) do { _Pragma("unroll") for (int n = 0; n < 2; ++n) _Pragma("unroll") for (int k = 0; k < 2; ++k) dst[n][k] = *(const PG8_LAS bf16x8*)(lds + PG8_SB(b, h) + boff + n * 2048 + k * 1024); } while (0)
#define PG8_MMA(ai, bj, At, Bt) do { __builtin_amdgcn_s_setprio(1); _Pragma("unroll") for (int m = 0; m < 4; ++m) _Pragma("unroll") for (int n = 0; n < 2; ++n) _Pragma("unroll") for (int k = 0; k < 2; ++k) \
        acc[ai][bj][m][n] = __builtin_amdgcn_mfma_f32_16x16x32_bf16(Bt[n][k], At[m][k], acc[ai][bj][m][n], 0, 0, 0); __builtin_amdgcn_s_setprio(0); } while (0)
#define PG8_WAIT_V(n) asm volatile("s_waitcnt vmcnt(" #n ")" ::: "memory")
#define PG8_WAIT_L(n) asm volatile("s_waitcnt lgkmcnt(" #n ")" ::: "memory")
#define PG8_BAR __builtin_amdgcn_s_barrier()
#define PG8_SCHED __builtin_amdgcn_sched_barrier(0)
    Unit cur, nxt; int ui = 0;
    if (!S.next(0, cur)) return;
    f32x4 acc[2][2][4][2];
#pragma unroll
    for (int a = 0; a < 2; ++a)
#pragma unroll
        for (int b = 0; b < 2; ++b)
#pragma unroll
            for (int m = 0; m < 4; ++m)
#pragma unroll
                for (int n = 0; n < 2; ++n) acc[a][b][m][n] = (f32x4){0.f, 0.f, 0.f, 0.f};
    bf16x8 At[4][2], B0[2][2], B1[2][2];
    const char* cA = (const char*)(cur.sel ? g.A2 : g.A) + (size_t)cur.pm * tstep; const char* cB = (const char*)(cur.sel ? g.Bt2 : g.Bt) + (size_t)cur.pn * tstep;
    S.a_ready(cur);
    if constexpr (SP2) {
        PG8_STAGE(PG8_SB(0, 0), cB, voffB); PG8_STAGE(PG8_SB(0, 1), cB + hstep, voffB); PG8_STAGE(PG8_SA(0, 0), cA, voffA); PG8_STAGE(PG8_SA(0, 1), cA + hstep, voffA);
        if (wr == 1) PG8_BAR;
        PG8_WAIT_V(2); PG8_BAR;
        PG8_STAGE(PG8_SB(1, 0), cB + kstep, voffB); PG8_STAGE(PG8_SA(1, 0), cA + kstep, voffA); PG8_STAGE(PG8_SB(1, 1), cB + hstep + kstep, voffB);
        PG8_WAIT_V(6); PG8_BAR;
    } else {
        PG8_STAGE(PG8_SB(0, 0), cB, voffB); PG8_STAGE(PG8_SA(0, 0), cA, voffA); PG8_STAGE(PG8_SB(0, 1), cB + hstep, voffB); PG8_STAGE(PG8_SA(0, 1), cA + hstep, voffA);
        if (wr == 1) PG8_BAR;
        PG8_WAIT_V(4); PG8_BAR;
        PG8_STAGE(PG8_SB(1, 0), cB + kstep, voffB); PG8_STAGE(PG8_SA(1, 0), cA + kstep, voffA); PG8_STAGE(PG8_SB(1, 1), cB + hstep + kstep, voffB);
        PG8_WAIT_V(6); PG8_BAR;
    }
    for (;;) {
        const bool has_next = S.next(ui + 1, nxt);
        const char* nA = has_next ? (const char*)(nxt.sel ? g.A2 : g.A) + (size_t)nxt.pm * tstep : cA; const char* nB = has_next ? (const char*)(nxt.sel ? g.Bt2 : g.Bt) + (size_t)nxt.pn * tstep : cB;
        for (int t = 0; t < nt; t += 2) {
            const bool last = (t == nt - 2);
            const char* a1 = cA + (size_t)(t + 1) * kstep;
            const char* a2 = last ? nA : cA + (size_t)(t + 2) * kstep; const char* b2 = last ? nB : cB + (size_t)(t + 2) * kstep;
            const char* a3 = a2 + kstep; const char* b3 = b2 + kstep;
            if (last && has_next) S.a_ready(nxt);
            if constexpr (SP2) {
            PG8_LDB(B0, 0, 0); PG8_LDB(B1, 0, 1); PG8_SCHED; PG8_LDA(At, 0, 0); PG8_STAGE(PG8_SA(1, 1), a1 + hstep, voffA);
            PG8_WAIT_V(8); PG8_WAIT_L(0); PG8_BAR; PG8_MMA(0, 0, At, B0); PG8_MMA(0, 1, At, B1); PG8_BAR; PG8_SCHED;
            PG8_LDA(At, 0, 1); PG8_STAGE(PG8_SB(0, 0), b2, voffB); PG8_STAGE(PG8_SB(0, 1), b2 + hstep, voffB); PG8_STAGE(PG8_SA(0, 0), a2, voffA);
            PG8_WAIT_V(8); PG8_WAIT_L(0); PG8_BAR; PG8_MMA(1, 0, At, B0); PG8_MMA(1, 1, At, B1); PG8_BAR; PG8_SCHED;
            PG8_LDB(B0, 1, 0); PG8_LDB(B1, 1, 1); PG8_SCHED; PG8_LDA(At, 1, 0); PG8_STAGE(PG8_SA(0, 1), a2 + hstep, voffA);
            PG8_WAIT_V(8); PG8_WAIT_L(0); PG8_BAR; PG8_MMA(0, 0, At, B0); PG8_MMA(0, 1, At, B1); PG8_BAR; PG8_SCHED;
            PG8_LDA(At, 1, 1); PG8_STAGE(PG8_SB(1, 0), b3, voffB); PG8_STAGE(PG8_SB(1, 1), b3 + hstep, voffB); PG8_STAGE(PG8_SA(1, 0), a3, voffA);
            PG8_WAIT_V(8); PG8_WAIT_L(0); PG8_BAR; PG8_MMA(1, 0, At, B0); PG8_MMA(1, 1, At, B1); PG8_BAR; PG8_SCHED;
            } else {
            PG8_LDB(B0, 0, 0); PG8_SCHED; PG8_LDA(At, 0, 0); PG8_STAGE(PG8_SA(1, 1), a1 + hstep, voffA);
            PG8_WAIT_L(8); PG8_BAR; PG8_WAIT_L(0); PG8_MMA(0, 0, At, B0); PG8_BAR; PG8_SCHED;
            PG8_LDB(B1, 0, 1); PG8_STAGE(PG8_SB(0, 0), b2, voffB);
            PG8_BAR; PG8_WAIT_L(0); PG8_MMA(0, 1, At, B1); PG8_BAR;
            PG8_LDA(At, 0, 1); PG8_STAGE(PG8_SA(0, 0), a2, voffA);
            PG8_BAR; PG8_WAIT_L(0); PG8_MMA(1, 0, At, B0); PG8_BAR; PG8_SCHED;
            PG8_STAGE(PG8_SB(0, 1), b2 + hstep, voffB);
            PG8_WAIT_V(6); PG8_BAR; PG8_MMA(1, 1, At, B1); PG8_BAR;
            PG8_LDB(B0, 1, 0); PG8_SCHED; PG8_LDA(At, 1, 0); PG8_STAGE(PG8_SA(0, 1), a2 + hstep, voffA);
            PG8_WAIT_L(8); PG8_BAR; PG8_WAIT_L(0); PG8_MMA(0, 0, At, B0); PG8_BAR; PG8_SCHED;
            PG8_LDB(B1, 1, 1); PG8_STAGE(PG8_SB(1, 0), b3, voffB);
            PG8_BAR; PG8_WAIT_L(0); PG8_MMA(0, 1, At, B1); PG8_BAR;
            PG8_LDA(At, 1, 1); PG8_STAGE(PG8_SA(1, 0), a3, voffA);
            PG8_BAR; PG8_WAIT_L(0); PG8_MMA(1, 0, At, B0); PG8_BAR; PG8_SCHED;
            PG8_STAGE(PG8_SB(1, 1), b3 + hstep, voffB);
            PG8_WAIT_V(6); PG8_BAR; PG8_MMA(1, 1, At, B1); PG8_BAR;
            }
        }
        if constexpr (ALIGN_EPI) { if (wr == 0) PG8_BAR; }
        if constexpr (!Epi::AFTER_DRAIN) { E(acc, cur, wr, wc, fr, fq); S.done(cur); }
        if (!has_next) break;
        if (!S.keep(cur)) {
#pragma unroll
        for (int a = 0; a < 2; ++a)
#pragma unroll
            for (int b = 0; b < 2; ++b)
#pragma unroll
                for (int m = 0; m < 4; ++m)
#pragma unroll
                    for (int n = 0; n < 2; ++n) acc[a][b][m][n] = (f32x4){0.f, 0.f, 0.f, 0.f};
        }
        cur = nxt; cA = nA; cB = nB; ++ui;
        if constexpr (ALIGN_EPI) { if (wr == 1) PG8_BAR; }
    }
    PG8_WAIT_V(0);
    if constexpr (!ALIGN_EPI) { if (wr == 0) PG8_BAR; }
    PG8_BAR;
    if constexpr (Epi::AFTER_DRAIN) { E.fused(acc, cur, wr, wc, fr, fq, lds, wid, lane); S.done(cur); }
#undef PG8_SA
#undef PG8_SB
#undef PG8_STAGE
#undef PG8_LDA
#undef PG8_LDB
#undef PG8_MMA
#undef PG8_WAIT_V
#undef PG8_WAIT_L
#undef PG8_BAR
#undef PG8_SCHED
}
}
#define PG8_SP2 true
#define PG8_ALIGN true
namespace mk {
using pg8::bf16_t;
#define LAS __attribute__((address_space(3)))
typedef unsigned v4u __attribute__((ext_vector_type(4)));
typedef unsigned v2u __attribute__((ext_vector_type(2)));
typedef float f32x4 __attribute__((ext_vector_type(4)));
typedef float f32x16 __attribute__((ext_vector_type(16)));
typedef short bf16x8 __attribute__((ext_vector_type(8)));
typedef short bf16x4 __attribute__((ext_vector_type(4)));
constexpr int T = 32768, D = 1024, SEQ = 8192, NBATCH = 4, NPROJ = 6656, INW = 6672, C_GA = 3072;
constexpr float EPS = 1e-6f;
constexpr int NWAVES = 8, NTHR = 512;
constexpr int LDS_BYTES = 147456;
constexpr size_t MiB = 1u << 20;
constexpr size_t WS_CTL = 0, CTL_ZERO_BYTES = 1 * MiB;
constexpr size_t WS_RSTD1 = 1 * MiB, WS_ROWSS = WS_RSTD1 + 512 * 1024, WS_ALOW = 2 * MiB, WS_DSC = 4 * MiB, WS_SUBK = 5 * MiB;
constexpr size_t WS_WIN = 8 * MiB, WS_WG = 21 * MiB, WS_WS = 23 * MiB, WS_WO = 25 * MiB, WS_WQ = 27 * MiB;
constexpr size_t WS_XB = 32 * MiB, WS_MERGED = 32 * MiB;
constexpr size_t WS_GQ = 96 * MiB, WS_GK = 128 * MiB, WS_HB = 96 * MiB;
constexpr size_t WS_GV = 160 * MiB, WS_EXD = 160 * MiB, WS_EXU = 192 * MiB;
constexpr size_t WS_GR = 224 * MiB, WS_SQ = 288 * MiB, WS_QP = 224 * MiB;
constexpr size_t WS_SK = 448 * MiB, WS_SV = 464 * MiB,
                  WS_ST = 384 * MiB, WS_IDX = 448 * MiB, WS_GATE = 464 * MiB;
constexpr size_t WS_YG = 448 * MiB, WS_PART = 160 * MiB, WS_MRG = 96 * MiB, WS_HB2 = 160 * MiB, WS_EXD2 = 352 * MiB, WS_EXU2 = 384 * MiB, WS_ROWSS2 = 480 * MiB;

struct Args { const float* in[18]; float* out; unsigned char* ws; int ph_lo, ph_hi; };

__device__ __forceinline__ unsigned f2bf(float f) { unsigned u = __builtin_bit_cast(unsigned, f); return (u + 0x7fffu + ((u >> 16) & 1u)) >> 16; }
typedef float f32x2_t __attribute__((ext_vector_type(2))); typedef __bf16 bf16x2_t __attribute__((ext_vector_type(2)));
__device__ __forceinline__ unsigned pk2(float lo, float hi) { f32x2_t v = {lo, hi}; bf16x2_t b = __builtin_convertvector(v, bf16x2_t); return __builtin_bit_cast(unsigned, b); }
__device__ __forceinline__ float fexp(float x) { return __builtin_amdgcn_exp2f(x * 1.4426950408889634f); }
__device__ __forceinline__ float flog(float x) { return __builtin_amdgcn_logf(x) * 0.6931471805599453f; }
__device__ __forceinline__ float bf2f(unsigned short b) { return __builtin_bit_cast(float, (unsigned)b << 16); }
__device__ __forceinline__ float wave_sum(float v) {
#pragma unroll
    for (int o = 1; o < 64; o <<= 1) v += __shfl_xor(v, o);
    return v;
}
#define LDS_WAIT() asm volatile("s_waitcnt lgkmcnt(0)" ::: "memory")
#define VM_WAIT() asm volatile("s_waitcnt vmcnt(0)" ::: "memory")

struct Frame {
    LAS unsigned char* lds;
    int tid, lane, wave, G, bid;
    float* out; unsigned char* ws;
};

__device__ __forceinline__ void tr_item(const float* __restrict__ W, int ldw, int c0, int K, int nblk, const float* __restrict__ gain, bf16_t* WT, LAS float* scr, int item, int lane) {
    const int kb = item / nblk, nb = item % nblk, k0 = 64 * kb, n0 = 32 * nb;
    const __amdgpu_buffer_rsrc_t wt_r = wt_rsrc(WT);
    const int c = lane & 7;
    f32x4 g0 = {1.f, 1.f, 1.f, 1.f}, g1 = g0;
    if (gain) { g0 = *(const f32x4*)(gain + k0 + 8 * c); g1 = *(const f32x4*)(gain + k0 + 8 * c + 4); }
    float v[32];
    const float* src = W + (size_t)(k0 + (lane >> 5)) * ldw + c0 + n0 + (lane & 31);
#pragma unroll
    for (int i = 0; i < 32; ++i) v[i] = src[(size_t)(2 * i) * ldw];
#pragma unroll
    for (int i = 0; i < 32; ++i) scr[(2 * i + (lane >> 5)) * 33 + (lane & 31)] = v[i];
    LDS_WAIT(); asm volatile("" ::: "memory");
#pragma unroll
    for (int j = 0; j < 4; ++j) { const int n = (lane >> 3) + 8 * j; const LAS float* s = scr + (8 * c) * 33 + n;
        v4u o; o.x = pk2(s[0 * 33] * g0.x, s[1 * 33] * g0.y); o.y = pk2(s[2 * 33] * g0.z, s[3 * 33] * g0.w); o.z = pk2(s[4 * 33] * g1.x, s[5 * 33] * g1.y); o.w = pk2(s[6 * 33] * g1.z, s[7 * 33] * g1.w);
        wt_st16(wt_r, (unsigned)(((size_t)(n0 + n) * K + k0 + 8 * c) * 2), o); }
    LDS_WAIT(); asm volatile("" ::: "memory");
}

__device__ __forceinline__ void p0_prologue(Frame& F, const float* x, const float* gain1, const float* w_in, const float* gain2, const float* wbg, const float* wbs, const float* wout, const float* wq, const float* subk) {
    LAS unsigned char* wb = F.lds;
    LAS float* scr = (LAS float*)(F.lds + 65536 + F.wave * 8704);
    { f32x4 wv[8]; float gk[8];
#pragma unroll
      for (int j = 0; j < 8; ++j) { const int idx = F.tid + NTHR * j, k = idx >> 2; wv[j] = *(const f32x4*)(w_in + (size_t)k * INW + C_GA + 4 * (idx & 3)); gk[j] = gain1[k]; }
#pragma unroll
      for (int j = 0; j < 8; ++j) { const int idx = F.tid + NTHR * j, k = idx >> 2;
#pragma unroll
          for (int e = 0; e < 4; ++e) { const int r = 4 * (idx & 3) + e; const float v = gk[j] * wv[j][e];
              const unsigned h = f2bf(v), l = f2bf(v - __builtin_bit_cast(float, h << 16));
              const int off = (((k >> 5) * 64 + ((k >> 3) & 3) * 16 + r) * 16) + 2 * (k & 7);
              *(LAS unsigned short*)(wb + off) = (unsigned short)h; *(LAS unsigned short*)(wb + 32768 + off) = (unsigned short)l; } } }
    __syncthreads();
    const int gw = F.bid * 4 + (F.wave & 3), NGW = F.G * 4, lane = F.lane;
    bf16_t* XB = (bf16_t*)(F.ws + WS_XB); float* RSTD1 = (float*)(F.ws + WS_RSTD1); float* ALOW = (float*)(F.ws + WS_ALOW);
    const __amdgpu_buffer_rsrc_t xb_r = wt_rsrc(XB);
    if (F.wave < 4) for (int g = gw; g < T / 16; g += NGW) {
        const int m = g * 16 + (lane & 15), q = lane >> 4;
        const float* xr = x + (size_t)m * D + 8 * q;
        f32x4 acc = {0.f, 0.f, 0.f, 0.f}; float ss = 0.f;
        for (int s0 = 0; s0 < 32; s0 += 8) {
            asm volatile("" ::: "memory");
            f32x4 a[8][2];
#pragma unroll
            for (int i = 0; i < 8; ++i) { a[i][0] = *(const f32x4*)(xr + 32 * (s0 + i)); a[i][1] = *(const f32x4*)(xr + 32 * (s0 + i) + 4); }
#pragma unroll
            for (int i = 0; i < 8; ++i) { const f32x4 a0 = a[i][0], a1 = a[i][1];
                ss += ((a0.x * a0.x + a0.y * a0.y) + (a0.z * a0.z + a0.w * a0.w)) + ((a1.x * a1.x + a1.y * a1.y) + (a1.z * a1.z + a1.w * a1.w));
                v4u h; h.x = pk2(a0.x, a0.y); h.y = pk2(a0.z, a0.w); h.z = pk2(a1.x, a1.y); h.w = pk2(a1.z, a1.w);
                wt_st16(xb_r, (unsigned)(((size_t)m * D + 8 * q + 32 * (s0 + i)) * 2), h);
                v4u l;
                l.x = pk2(a0.x - __builtin_bit_cast(float, h.x << 16), a0.y - __builtin_bit_cast(float, h.x & 0xffff0000u));
                l.y = pk2(a0.z - __builtin_bit_cast(float, h.y << 16), a0.w - __builtin_bit_cast(float, h.y & 0xffff0000u));
                l.z = pk2(a1.x - __builtin_bit_cast(float, h.z << 16), a1.y - __builtin_bit_cast(float, h.z & 0xffff0000u));
                l.w = pk2(a1.z - __builtin_bit_cast(float, h.w << 16), a1.w - __builtin_bit_cast(float, h.w & 0xffff0000u));
                const bf16x8 wh = *(const LAS bf16x8*)(wb + ((s0 + i) * 64 + lane) * 16), wl = *(const LAS bf16x8*)(wb + 32768 + ((s0 + i) * 64 + lane) * 16);
                const bf16x8 xh = __builtin_bit_cast(bf16x8, h), xl = __builtin_bit_cast(bf16x8, l);
                acc = __builtin_amdgcn_mfma_f32_16x16x32_bf16(xh, wh, acc, 0, 0, 0);
                acc = __builtin_amdgcn_mfma_f32_16x16x32_bf16(xl, wh, acc, 0, 0, 0);
                acc = __builtin_amdgcn_mfma_f32_16x16x32_bf16(xh, wl, acc, 0, 0, 0); }
        }
        ss += __shfl_xor(ss, 16); ss += __shfl_xor(ss, 32);
        const float rstd = rsqrtf(ss * (1.f / D) + EPS);
#pragma unroll
        for (int i = 0; i < 4; ++i) { const float rs = __shfl(rstd, 4 * q + i); wt_st4(ALOW + (size_t)(g * 16 + 4 * q + i) * 16 + (lane & 15), acc[i] * rs); }
        if (lane < 16) wt_st4(RSTD1 + m, rstd);
    }
    constexpr int I_IN1 = 16 * 96, I_IN2 = 16 * 112, I_SQ = 16 * 32, I_Q = 16 * 64;
    constexpr int NITEMS = I_IN1 + I_IN2 + 3 * I_SQ + I_Q;
    bf16_t* WIN = (bf16_t*)(F.ws + WS_WIN);
    if (F.wave >= 4) for (int it = gw; it < NITEMS; it += NGW) {
        int r = it;
        if (r < I_IN1) { tr_item(w_in, INW, 0, D, 96, gain1, WIN, scr, r, lane); continue; } r -= I_IN1;
        if (r < I_IN2) { tr_item(w_in, INW, 3088, D, 112, gain1, WIN + (size_t)3072 * D, scr, r, lane); continue; } r -= I_IN2;
        if (r < I_SQ) { tr_item(wbg, D, 0, D, 32, nullptr, (bf16_t*)(F.ws + WS_WG), scr, r, lane); continue; } r -= I_SQ;
        if (r < I_SQ) { tr_item(wbs, D, 0, D, 32, nullptr, (bf16_t*)(F.ws + WS_WS), scr, r, lane); continue; } r -= I_SQ;
        if (r < I_SQ) { tr_item(wout, D, 0, D, 32, nullptr, (bf16_t*)(F.ws + WS_WO), scr, r, lane); continue; } r -= I_SQ;
        tr_item(wq, 2048, 0, D, 64, gain2, (bf16_t*)(F.ws + WS_WQ), scr, r, lane);
    }
    { const f32x4* sk = (const f32x4*)subk; v2u* o = (v2u*)(F.ws + WS_SUBK);
      for (int i = F.bid * NTHR + F.tid; i < 8 * 2 * 128 * 128 / 4; i += F.G * NTHR) { const f32x4 v = sk[i]; wt_st8(o + i, pk2(v.x, v.y), pk2(v.z, v.w)); } }
}

constexpr int SWA_KROW = 144, SWA_VROW = 592;
__device__ __forceinline__ unsigned swa_voff(unsigned row, unsigned ch) { return 1024u * (row >> 3) + 512u * (ch >> 2) + 64u * (row & 7) + 16u * ((ch & 3) ^ ((row >> 2) & 3)); }
typedef short swa_v4s __attribute__((ext_vector_type(4)));
__device__ __forceinline__ bf16x8 swa_tr2(const LAS unsigned char* p0, const LAS unsigned char* p1) {
    const swa_v4s x = __builtin_amdgcn_ds_read_tr16_b64_v4i16((LAS swa_v4s*)p0), y = __builtin_amdgcn_ds_read_tr16_b64_v4i16((LAS swa_v4s*)p1);
    return (bf16x8){x[0], x[1], x[2], x[3], y[0], y[1], y[2], y[3]};
}
constexpr int SWA_K_OFF = 0, SWA_V_OFF = 256 * SWA_KROW, SWA_TB_OFF = SWA_V_OFF + 64 * SWA_VROW, SWA_LDS = SWA_TB_OFF + 4 * 128 * 4;
__device__ __forceinline__ int t5_bucket(int rel) {
    if (rel < 16) return rel;
    int b = 16;
    b += (rel >= 19); b += (rel >= 21); b += (rel >= 24); b += (rel >= 27); b += (rel >= 31); b += (rel >= 35); b += (rel >= 40); b += (rel >= 46);
    b += (rel >= 52); b += (rel >= 59); b += (rel >= 67); b += (rel >= 77); b += (rel >= 87); b += (rel >= 99); b += (rel >= 113);
    return b;
}
__device__ __forceinline__ void swa_load_kv(const bf16_t* SK, const bf16_t* SV, int u, int tid, int lane, int wave, v4u (&kraw)[4], v4u (&vraw)[4]) {
    const int blk = u & 63, kvh = (u >> 6) & 3, b = u >> 8; const size_t mrow0 = (size_t)b * SEQ; const int t0 = blk * 128, c = tid & 7;
#pragma unroll
    for (int ps = 0; ps < 4; ++ps) {
        const int kjk = ps * 64 + (tid >> 3), posk = t0 - 128 + kjk; kraw[ps] = (v4u){0u, 0u, 0u, 0u};
        if (posk >= 0) kraw[ps] = *(const v4u*)(SK + (mrow0 + posk) * 256 + kvh * 64 + 8 * c);
        const int kjv = ps * 64 + lane, posv = t0 - 128 + kjv; vraw[ps] = (v4u){0u, 0u, 0u, 0u};
        if (posv >= 0) vraw[ps] = *(const v4u*)(SV + (mrow0 + posv) * 256 + kvh * 64 + 8 * wave);
    }
}
__device__ __forceinline__ void swa_phase(Frame& F, const float* qgain, const float* kgain, const float* sinks, const float* rel_bias, size_t ydelta) {
    const bf16_t* SK = (const bf16_t*)(F.ws + WS_SK); const bf16_t* SV = (const bf16_t*)(F.ws + WS_SV); bf16_t* SQ = (bf16_t*)(F.ws + WS_SQ);
    LAS unsigned char* Kn = F.lds + SWA_K_OFF; LAS unsigned char* Vt = F.lds + SWA_V_OFF; LAS float* tb = (LAS float*)(F.lds + SWA_TB_OFF);
    const int tid = F.tid, lane = F.lane, wave = F.wave, l15 = lane & 15, q4 = lane >> 4;
    if (tid < 256) { *(LAS v4u*)(Vt + swa_voff(256 + (tid >> 3), tid & 7)) = (v4u){0u, 0u, 0u, 0u}; }
    const LAS unsigned char* vb0 = Vt + swa_voff(4 * q4 + (l15 >> 2), (l15 >> 1) & 1) + 8 * (l15 & 1); const LAS unsigned char* vb1 = Vt + swa_voff(4 * q4 + (l15 >> 2), 2 + ((l15 >> 1) & 1)) + 8 * (l15 & 1);
    v4u kraw[4], vraw[4];
    if (F.bid < 1024) swa_load_kv(SK, SV, F.bid, tid, lane, wave, kraw, vraw);
    for (int u = F.bid; u < 1024; u += F.G) {
        const int blk = u & 63, kvh = (u >> 6) & 3, b = u >> 8;
        const size_t mrow0 = (size_t)b * SEQ; const int t0 = blk * 128;
        const int g = wave >> 1, qh = wave & 1, h = kvh * 4 + g;
        v4u qn[2];
        { const bf16_t* qrow = SQ + (mrow0 + t0 + 64 * qh + l15) * 1024 + h * 64; qn[0] = *(const v4u*)(qrow + 8 * q4); qn[1] = *(const v4u*)(qrow + 32 + 8 * q4); }
        __syncthreads();
        { const int c = tid & 7; f32x4 g0 = *(const f32x4*)(kgain + 8 * c), g1 = *(const f32x4*)(kgain + 8 * c + 4);
#pragma unroll
          for (int ps = 0; ps < 4; ++ps) {
              const int kj = ps * 64 + (tid >> 3);
              const v4u raw = kraw[ps];
              float f[8];
#pragma unroll
              for (int j = 0; j < 4; ++j) { f[2 * j] = __builtin_bit_cast(float, raw[j] << 16); f[2 * j + 1] = __builtin_bit_cast(float, raw[j] & 0xffff0000u); }
              float ss = 0.f;
#pragma unroll
              for (int j = 0; j < 8; ++j) ss += f[j] * f[j];
              ss += __shfl_xor(ss, 1); ss += __shfl_xor(ss, 2); ss += __shfl_xor(ss, 4);
              const float r = rsqrtf(ss * (1.f / 64.f) + EPS);
              v4u w; w.x = pk2(f[0] * r * g0.x, f[1] * r * g0.y); w.y = pk2(f[2] * r * g0.z, f[3] * r * g0.w); w.z = pk2(f[4] * r * g1.x, f[5] * r * g1.y); w.w = pk2(f[6] * r * g1.z, f[7] * r * g1.w);
              *(LAS v4u*)(Kn + kj * SWA_KROW + 16 * c) = w;
          } }
#pragma unroll
        for (int ps = 0; ps < 4; ++ps) {
            const int kj = ps * 64 + lane; const v4u raw = vraw[ps];
            *(LAS v4u*)(Vt + swa_voff(kj, wave)) = raw;
        }
        { const int gg = tid >> 7, rel = tid & 127; tb[tid] = rel_bias[t5_bucket(rel) * 16 + kvh * 4 + gg] * 1.4426950408889634f; }
        if (u + F.G < 1024) swa_load_kv(SK, SV, u + F.G, tid, lane, wave, kraw, vraw);
        __syncthreads();
        const float sink = sinks[h] * 1.4426950408889634f;
        float qg[2][8];
#pragma unroll
        for (int ks = 0; ks < 2; ++ks)
#pragma unroll
            for (int j = 0; j < 8; ++j) qg[ks][j] = qgain[32 * ks + 8 * q4 + j] * (0.125f * 1.4426950408889634f);
#pragma unroll 1
        for (int nt = 0; nt < 4; ++nt) {
            const int q0 = 64 * qh + 16 * nt, qi = q0 + l15, kt0 = q0 >> 4;
            bf16_t* qrow = SQ + (mrow0 + t0 + qi) * 1024 + h * 64;
            bf16x8 qf[2];
            { v4u raw[2]; float f[2][8]; float ss = 0.f;
              raw[0] = qn[0]; raw[1] = qn[1];
              if (nt < 3) { const bf16_t* qnx = qrow + 16 * 1024; qn[0] = *(const v4u*)(qnx + 8 * q4); qn[1] = *(const v4u*)(qnx + 32 + 8 * q4); }
#pragma unroll
              for (int ks = 0; ks < 2; ++ks) {
#pragma unroll
                  for (int j = 0; j < 4; ++j) { f[ks][2 * j] = __builtin_bit_cast(float, raw[ks][j] << 16); f[ks][2 * j + 1] = __builtin_bit_cast(float, raw[ks][j] & 0xffff0000u); }
#pragma unroll
                  for (int j = 0; j < 8; ++j) ss += f[ks][j] * f[ks][j]; }
              ss += __shfl_xor(ss, 16); ss += __shfl_xor(ss, 32);
              const float r = rsqrtf(ss * (1.f / 64.f) + EPS);
#pragma unroll
              for (int ks = 0; ks < 2; ++ks) { v4u w;
#pragma unroll
                  for (int j = 0; j < 4; ++j) w[j] = pk2(f[ks][2 * j] * r * qg[ks][2 * j], f[ks][2 * j + 1] * r * qg[ks][2 * j + 1]);
                  qf[ks] = __builtin_bit_cast(bf16x8, w); } }
            f32x4 s[9];
#pragma unroll
            for (int i = 0; i < 9; ++i) { f32x4 acc = (f32x4){0.f, 0.f, 0.f, 0.f};
#pragma unroll
                for (int ks = 0; ks < 2; ++ks) { const bf16x8 a = *(const LAS bf16x8*)(Kn + (16 * (kt0 + i) + l15) * SWA_KROW + (32 * ks + 8 * q4) * 2); acc = __builtin_amdgcn_mfma_f32_16x16x32_bf16(a, qf[ks], acc, 0, 0, 0); }
                s[i] = acc; }
            const int R0 = l15 + 128 - 4 * q4;
            const LAS float* tbp = tb + g * 128 + R0 - 131;
            float mx = -INFINITY;
            if (blk > 0) {
#pragma unroll
                for (int i = 0; i < 9; ++i)
#pragma unroll
                    for (int r = 0; r < 4; ++r) { const int rel = R0 - 16 * i - r; float v = s[i][r] + tbp[131 - 16 * i - r];
                        if (i == 0) v = (rel < 128) ? v : -INFINITY;
                        if (i == 8) v = (rel >= 0) ? v : -INFINITY;
                        s[i][r] = v; mx = fmaxf(mx, v); }
            } else {
#pragma unroll
                for (int i = 0; i < 9; ++i)
#pragma unroll
                    for (int r = 0; r < 4; ++r) { const int kj = 16 * (kt0 + i) + 4 * q4 + r, rel = R0 - 16 * i - r; const bool valid = ((unsigned)rel < 128u) && (kj >= 128);
                        const float v = valid ? s[i][r] + tbp[131 - 16 * i - r] : -INFINITY; s[i][r] = v; mx = fmaxf(mx, v); }
            }
            mx = fmaxf(mx, __shfl_xor(mx, 16)); mx = fmaxf(mx, __shfl_xor(mx, 32)); mx = fmaxf(mx, sink);
            float sum = 0.f;
#pragma unroll
            for (int i = 0; i < 9; ++i)
#pragma unroll
                for (int r = 0; r < 4; ++r) { const float e = __builtin_amdgcn_exp2f(s[i][r] - mx); s[i][r] = e; sum += e; }
            sum += __shfl_xor(sum, 16); sum += __shfl_xor(sum, 32);
            const float inv = 1.0f / (sum + __builtin_amdgcn_exp2f(sink - mx));
            f32x4 o[4];
#pragma unroll
            for (int mt = 0; mt < 4; ++mt) o[mt] = (f32x4){0.f, 0.f, 0.f, 0.f};
#pragma unroll
            for (int kk = 0; kk < 5; ++kk) {
                v4u w; w.x = pk2(s[2 * kk][0], s[2 * kk][1]); w.y = pk2(s[2 * kk][2], s[2 * kk][3]);
                if (kk < 4) { w.z = pk2(s[2 * kk + 1][0], s[2 * kk + 1][1]); w.w = pk2(s[2 * kk + 1][2], s[2 * kk + 1][3]); } else { w.z = 0u; w.w = 0u; }
                const bf16x8 pb = __builtin_bit_cast(bf16x8, w);
#pragma unroll
                for (int mt = 0; mt < 4; ++mt) {
                    const LAS unsigned char* vr = ((mt & 1) ? vb1 : vb0) + 512 * (mt >> 1) + 2048 * (kt0 + 2 * kk);
                    const bf16x8 a = swa_tr2(vr, vr + 2048);
                    o[mt] = __builtin_amdgcn_mfma_f32_16x16x32_bf16(a, pb, o[mt], 0, 0, 0);
                }
            }
#pragma unroll
            for (int mt = 0; mt < 4; ++mt) { v2u w; w.x = pk2(o[mt][0] * inv, o[mt][1] * inv); w.y = pk2(o[mt][2] * inv, o[mt][3] * inv); wt_st8((unsigned char*)(qrow + 16 * mt + 4 * q4) + ydelta, w.x, w.y); }
        }
    }
    __syncthreads();
}

constexpr int GL_AL = 0, GL_QS = 4096, GL_BL = 6144, GL_DEC = 6656, GL_BQ = 8192, GL_QT = 41984, GL_KT = 59392, GL_OB = 8192, GL_KH = 76800, GL_VT = 95232;
constexpr int GL_BQROW = 528, GL_QROW = 272, GL_KHROW = 144, GL_VROW = 144, GL_OBROW = 1040;
__device__ __forceinline__ f32x16 mfma32(bf16x8 a, bf16x8 b, f32x16 c) { return __builtin_amdgcn_mfma_f32_32x32x16_bf16(a, b, c, 0, 0, 0); }
__device__ __forceinline__ bf16x8 pack8(const f32x16& x, int s) {
    v4u w;
    if (s == 0) { w.x = pk2(x[0], x[1]); w.y = pk2(x[2], x[3]); w.z = pk2(x[4], x[5]); w.w = pk2(x[6], x[7]); }
    else { w.x = pk2(x[8], x[9]); w.y = pk2(x[10], x[11]); w.z = pk2(x[12], x[13]); w.w = pk2(x[14], x[15]); }
    return __builtin_bit_cast(bf16x8, w);
}
__device__ __forceinline__ bf16x8 ld2x8(const LAS unsigned char* p) {
    const v2u a0 = *(const LAS v2u*)p, a1 = *(const LAS v2u*)(p + 16);
    return __builtin_bit_cast(bf16x8, (v4u){a0.x, a0.y, a1.x, a1.y});
}
__device__ __forceinline__ void unpack8(const v4u raw, float (&f)[8]) {
#pragma unroll
    for (int j = 0; j < 4; ++j) { f[2 * j] = __builtin_bit_cast(float, raw[j] << 16); f[2 * j + 1] = __builtin_bit_cast(float, raw[j] & 0xffff0000u); }
}
__device__ __forceinline__ unsigned gl_off(unsigned row, unsigned ch) { return 2048u * (row >> 3) + 512u * (ch >> 2) + 64u * (row & 7) + 16u * ((ch & 3) ^ ((row >> 2) & 3)); }
__device__ __forceinline__ unsigned gl_tr_base(unsigned lane, unsigned rb) { const unsigned blk = (lane >> 4) & 1, q = (lane & 15) >> 2, p = lane & 3; return gl_off(rb + q, 2 * blk + (p >> 1)) + 8 * (p & 1); }
typedef short gl_v4s __attribute__((ext_vector_type(4)));
__device__ __forceinline__ bf16x8 gl_tr2(const LAS unsigned char* p0, const LAS unsigned char* p1) {
    const gl_v4s x = __builtin_amdgcn_ds_read_tr16_b64_v4i16((LAS gl_v4s*)p0), y = __builtin_amdgcn_ds_read_tr16_b64_v4i16((LAS gl_v4s*)p1);
    return (bf16x8){x[0], x[1], x[2], x[3], y[0], y[1], y[2], y[3]};
}
__device__ __forceinline__ void gla_load_w(Frame& F, const float* wgu, const float* bgu, int h, bf16x8& whi, bf16x8& wlo, float& bias) {
    const int dn = 32 * (F.wave >> 1) + (F.lane & 31), hh = F.lane >> 5;
    float v[8];
#pragma unroll
    for (int j = 0; j < 8; ++j) v[j] = wgu[(8 * hh + j) * 512 + h * 128 + dn];
    v4u hi, lo;
#pragma unroll
    for (int j = 0; j < 4; ++j) { hi[j] = pk2(v[2 * j], v[2 * j + 1]); lo[j] = pk2(v[2 * j] - __builtin_bit_cast(float, hi[j] << 16), v[2 * j + 1] - __builtin_bit_cast(float, hi[j] & 0xffff0000u)); }
    whi = __builtin_bit_cast(bf16x8, (v4u){hi[0], hi[1], hi[2], hi[3]}); wlo = __builtin_bit_cast(bf16x8, (v4u){lo[0], lo[1], lo[2], lo[3]});
    bias = bgu[h * 128 + dn];
}
template <bool FULL> __device__ __forceinline__ float gla_stage(Frame& F, int h, size_t m0, const bf16x8 whi, const bf16x8 wlo, float bias) {
    const int tid = F.tid, lane = F.lane, wave = F.wave, d = tid & 127;
    LAS unsigned char* L = F.lds;
    const float* ALOW = (const float*)(F.ws + WS_ALOW);
    const bf16_t* GQ = (const bf16_t*)(F.ws + WS_GQ); const bf16_t* GK = (const bf16_t*)(F.ws + WS_GK); const bf16_t* GV = (const bf16_t*)(F.ws + WS_GV);
    __syncthreads();
    { typedef float f32x2 __attribute__((ext_vector_type(2))); ((LAS f32x2*)(L + GL_AL))[tid] = ((const f32x2*)(ALOW + m0 * 16))[tid]; }
    __syncthreads();
    const int mt = wave & 1, nt = wave >> 1, l31 = lane & 31, hh = lane >> 5, dn = 32 * nt + l31;
    float p[16];
    { const LAS f32x4* ap = (const LAS f32x4*)(L + GL_AL + (32 * mt + l31) * 64 + hh * 32);
      const f32x4 a0 = ap[0], a1 = ap[1];
      v4u ah, al;
      ah.x = pk2(a0.x, a0.y); ah.y = pk2(a0.z, a0.w); ah.z = pk2(a1.x, a1.y); ah.w = pk2(a1.z, a1.w);
      al.x = pk2(a0.x - __builtin_bit_cast(float, ah.x << 16), a0.y - __builtin_bit_cast(float, ah.x & 0xffff0000u)); al.y = pk2(a0.z - __builtin_bit_cast(float, ah.y << 16), a0.w - __builtin_bit_cast(float, ah.y & 0xffff0000u));
      al.z = pk2(a1.x - __builtin_bit_cast(float, ah.z << 16), a1.y - __builtin_bit_cast(float, ah.z & 0xffff0000u)); al.w = pk2(a1.z - __builtin_bit_cast(float, ah.w << 16), a1.w - __builtin_bit_cast(float, ah.w & 0xffff0000u));
      f32x16 z;
#pragma unroll
      for (int r = 0; r < 16; ++r) z[r] = 0.f;
      z = mfma32(__builtin_bit_cast(bf16x8, ah), whi, z); z = mfma32(__builtin_bit_cast(bf16x8, al), whi, z); z = mfma32(__builtin_bit_cast(bf16x8, ah), wlo, z);
#pragma unroll
      for (int r = 0; r < 16; ++r) { const float zz = z[r] + bias; p[r] = (fminf(zz, 0.f) - flog(1.f + fexp(-fabsf(zz)))) * (1.f / 16.f); } }
    float base = 0.f;
#pragma unroll
    for (int g4 = 0; g4 < 4; ++g4) {
        p[4 * g4 + 1] += p[4 * g4]; p[4 * g4 + 2] += p[4 * g4 + 1]; p[4 * g4 + 3] += p[4 * g4 + 2];
        const float gt = p[4 * g4 + 3], pt = __shfl_xor(gt, 32), off = base + (hh ? pt : 0.f);
#pragma unroll
        for (int k = 0; k < 4; ++k) p[4 * g4 + k] += off;
        base += gt + pt;
    }
    if (hh == 0) ((LAS float*)(L + GL_QS))[mt * 128 + dn] = base;
    __syncthreads();
    { const float q0 = ((const LAS float*)(L + GL_QS))[dn], q1 = ((const LAS float*)(L + GL_QS))[128 + dn], blast = q0 + q1, offs = mt ? q0 : 0.f;
#pragma unroll
      for (int r = 0; r < 16; ++r) *(LAS float*)(L + GL_BQ + (32 * mt + 8 * (r >> 2) + 4 * hh + (r & 3)) * GL_BQROW + dn * 4) = p[r] + offs;
      if (mt == 0 && hh == 0) { ((LAS float*)(L + GL_BL))[dn] = blast; ((LAS float*)(L + GL_DEC))[dn] = fexp(blast); } }
    __syncthreads();
    {
        const int t = lane, dg = wave; const size_t row = m0 + t;
        float b[16], bl[16];
#pragma unroll
        for (int i = 0; i < 4; ++i) { const f32x4 v = *(const LAS f32x4*)(L + GL_BQ + t * GL_BQROW + dg * 64 + 16 * i); b[4 * i] = v.x; b[4 * i + 1] = v.y; b[4 * i + 2] = v.z; b[4 * i + 3] = v.w;
                                      const f32x4 u = *(const LAS f32x4*)(L + (FULL ? GL_DEC : GL_BL) + dg * 64 + 16 * i); bl[4 * i] = u.x; bl[4 * i + 1] = u.y; bl[4 * i + 2] = u.z; bl[4 * i + 3] = u.w; }
        float kf[16];
        { const v4u* kp = (const v4u*)(GK + row * 512 + h * 128 + 16 * dg); float t0[8], t1[8]; unpack8(kp[0], t0); unpack8(kp[1], t1);
#pragma unroll
          for (int e = 0; e < 8; ++e) { kf[e] = t0[e]; kf[8 + e] = t1[e]; } }
        float kh[16];
        if (FULL) {
            float qf[16];
            { const v4u* qp = (const v4u*)(GQ + row * 512 + h * 128 + 16 * dg); float t0[8], t1[8]; unpack8(qp[0], t0); unpack8(qp[1], t1);
#pragma unroll
              for (int e = 0; e < 8; ++e) { qf[e] = t0[e]; qf[8 + e] = t1[e]; } }
            v4u wq[2], wk[2];
#pragma unroll
            for (int e = 0; e < 16; e += 2) { const float e0 = fexp(b[e]), e1 = fexp(b[e + 1]);
                const float k0 = kf[e] * __builtin_amdgcn_rcpf(e0), k1 = kf[e + 1] * __builtin_amdgcn_rcpf(e1);
                wq[e >> 3][(e & 7) >> 1] = pk2(qf[e] * e0 * 0.08838834764831845f, qf[e + 1] * e1 * 0.08838834764831845f);
                wk[e >> 3][(e & 7) >> 1] = pk2(k0, k1);
                kh[e] = k0 * bl[e]; kh[e + 1] = k1 * bl[e + 1]; }
            *(LAS v4u*)(L + GL_QT + t * GL_QROW + dg * 32) = wq[0]; *(LAS v4u*)(L + GL_QT + t * GL_QROW + dg * 32 + 16) = wq[1];
            *(LAS v4u*)(L + GL_KT + t * GL_QROW + dg * 32) = wk[0]; *(LAS v4u*)(L + GL_KT + t * GL_QROW + dg * 32 + 16) = wk[1];
        } else {
#pragma unroll
            for (int e = 0; e < 16; ++e) kh[e] = kf[e] * fexp(bl[e] - b[e]);
        }
        { v4u k0, k1; k0.x = pk2(kh[0], kh[1]); k0.y = pk2(kh[2], kh[3]); k0.z = pk2(kh[4], kh[5]); k0.w = pk2(kh[6], kh[7]); k1.x = pk2(kh[8], kh[9]); k1.y = pk2(kh[10], kh[11]); k1.z = pk2(kh[12], kh[13]); k1.w = pk2(kh[14], kh[15]);
          *(LAS v4u*)(L + GL_KH + gl_off(t, 2 * dg)) = k0; *(LAS v4u*)(L + GL_KH + gl_off(t, 2 * dg + 1)) = k1; }
#pragma unroll
        for (int i = 0; i < 4; ++i) { const v4u raw = *(const v4u*)(GV + row * 1024 + h * 256 + 32 * wave + 8 * i);
            *(LAS v4u*)(L + GL_VT + (wave >> 2) * 16384 + gl_off(t, 4 * (wave & 3) + i)) = raw; }
    }
    __syncthreads();
    return ((const LAS float*)(L + GL_BL))[d];
}
__device__ __forceinline__ void gla_state_update(Frame& F, f32x16 (&S)[4]) {
    const int lane = F.lane, l31 = lane & 31, hh = lane >> 5; LAS unsigned char* L = F.lds;
    const LAS unsigned char* ka0 = L + GL_KH + gl_tr_base(lane, 8 * hh); const LAS unsigned char* ka1 = L + GL_KH + gl_tr_base(lane, 8 * hh + 4);
    const LAS unsigned char* va0 = ka0 + (GL_VT - GL_KH) + (F.wave >> 2) * 16384 + (F.wave & 3) * 512; const LAS unsigned char* va1 = ka1 + (GL_VT - GL_KH) + (F.wave >> 2) * 16384 + (F.wave & 3) * 512;
#pragma unroll
    for (int dt = 0; dt < 4; ++dt) {
#pragma unroll
        for (int g = 0; g < 4; ++g) { const f32x4 dc = *(const LAS f32x4*)(L + GL_DEC + (32 * dt + 8 * g + 4 * hh) * 4);
            S[dt][4 * g] *= dc.x; S[dt][4 * g + 1] *= dc.y; S[dt][4 * g + 2] *= dc.z; S[dt][4 * g + 3] *= dc.w; }
#pragma unroll
        for (int ks = 0; ks < 4; ++ks) {
            const bf16x8 a = gl_tr2(ka0 + 4096 * ks + 512 * dt, ka1 + 4096 * ks + 512 * dt);
            const bf16x8 b = gl_tr2(va0 + 4096 * ks, va1 + 4096 * ks);
            S[dt] = mfma32(a, b, S[dt]);
        } __builtin_amdgcn_sched_barrier(0);
    }
}
__device__ __forceinline__ void gla_local_phase(Frame& F, const float* wgu, const float* bgu) {
    float* ST = (float*)(F.ws + WS_ST); float* DSC = (float*)(F.ws + WS_DSC);
    const int lane = F.lane, l31 = lane & 31, hh = lane >> 5;
    for (int u = F.bid; u < 512; u += F.G) {
        const int sc = u & 31, bh = u >> 5, b = bh >> 2, h = bh & 3;
        bf16x8 whi, wlo; float bias; gla_load_w(F, wgu, bgu, h, whi, wlo, bias);
        f32x16 S[4];
#pragma unroll
        for (int dt = 0; dt < 4; ++dt)
#pragma unroll
            for (int r = 0; r < 16; ++r) S[dt][r] = 0.f;
        float sumbl = 0.f;
#pragma unroll 1
        for (int c = 0; c < 4; ++c) {
            const size_t m0 = (size_t)b * SEQ + sc * 256 + c * 64;
            sumbl += gla_stage<false>(F, h, m0, whi, wlo, bias);
            gla_state_update(F, S);
        }
        v4u* st8 = (v4u*)ST + (size_t)(bh * 32 + sc) * 4096 + (F.wave * 4 * 64 + lane) * 2;
#pragma unroll
        for (int dt = 0; dt < 4; ++dt)
#pragma unroll
            for (int hf = 0; hf < 2; ++hf) st8[dt * 128 + hf] = (v4u){pk2(S[dt][8 * hf], S[dt][8 * hf + 1]), pk2(S[dt][8 * hf + 2], S[dt][8 * hf + 3]), pk2(S[dt][8 * hf + 4], S[dt][8 * hf + 5]), pk2(S[dt][8 * hf + 6], S[dt][8 * hf + 7])};
        if (F.tid < 128) wt_st4(DSC + (bh * 32 + sc) * 128 + F.tid, fexp(sumbl));
    }
}
__device__ __forceinline__ void gla_scan_phase(Frame& F) {
    v4u* ST8 = (v4u*)(F.ws + WS_ST); const float* DSC = (const float*)(F.ws + WS_DSC);
    for (int idx = F.bid * NTHR + F.tid; idx < 16 * 4096; idx += F.G * NTHR) {
        const int bh = idx >> 12, u8 = idx & 4095, hf = u8 & 1, ln = (u8 >> 1) & 63, dt = (u8 >> 7) & 3, row0 = 32 * dt + 16 * hf + 4 * (ln >> 5);
        float S[8];
#pragma unroll
        for (int e = 0; e < 8; ++e) S[e] = 0.f;
#pragma unroll 8
        for (int sc = 0; sc < 32; ++sc) {
            v4u* p = ST8 + (size_t)(bh * 32 + sc) * 4096 + u8; const v4u raw = *p; float tmp[8]; unpack8(raw, tmp);
            *p = (v4u){pk2(S[0], S[1]), pk2(S[2], S[3]), pk2(S[4], S[5]), pk2(S[6], S[7])};
            const f32x4 d0 = *(const f32x4*)(DSC + (bh * 32 + sc) * 128 + row0), d1 = *(const f32x4*)(DSC + (bh * 32 + sc) * 128 + row0 + 8);
            S[0] = S[0] * d0.x + tmp[0]; S[1] = S[1] * d0.y + tmp[1]; S[2] = S[2] * d0.z + tmp[2]; S[3] = S[3] * d0.w + tmp[3];
            S[4] = S[4] * d1.x + tmp[4]; S[5] = S[5] * d1.y + tmp[5]; S[6] = S[6] * d1.z + tmp[6]; S[7] = S[7] * d1.w + tmp[7];
        }
    }
}
__device__ __forceinline__ void gla_out_phase(Frame& F, const float* wgu, const float* bgu, const float* ogain) {
    const float* ST = (const float*)(F.ws + WS_ST); const bf16_t* GR = (const bf16_t*)(F.ws + WS_GR); const __amdgpu_buffer_rsrc_t gr_r = wt_rsrc(F.ws + WS_YG);
    const int lane = F.lane, l31 = lane & 31, hh = lane >> 5, wave = F.wave; LAS unsigned char* L = F.lds;
    const LAS unsigned char* pv0 = L + GL_VT + (wave >> 2) * 16384 + (wave & 3) * 512 + gl_tr_base(lane, 4 * hh); const LAS unsigned char* pv1 = L + GL_VT + (wave >> 2) * 16384 + (wave & 3) * 512 + gl_tr_base(lane, 4 * hh + 8);
    for (int u = F.bid; u < 512; u += F.G) {
        const int sc = u & 31, bh = u >> 5, b = bh >> 2, h = bh & 3;
        bf16x8 whi, wlo; float bias; gla_load_w(F, wgu, bgu, h, whi, wlo, bias);
        f32x16 S[4];
        { const v4u* st8 = (const v4u*)ST + (size_t)(bh * 32 + sc) * 4096 + (wave * 4 * 64 + lane) * 2;
#pragma unroll
          for (int dt = 0; dt < 4; ++dt)
#pragma unroll
              for (int hf = 0; hf < 2; ++hf) { float f[8]; unpack8(st8[dt * 128 + hf], f);
#pragma unroll
                  for (int e = 0; e < 8; ++e) S[dt][8 * hf + e] = f[e]; } }
#pragma unroll 1
        for (int c = 0; c < 4; ++c) {
            const size_t m0 = (size_t)b * SEQ + sc * 256 + c * 64;
            (void)gla_stage<true>(F, h, m0, whi, wlo, bias);
            f32x16 o0, o1;
#pragma unroll
            for (int r = 0; r < 16; ++r) { o0[r] = 0.f; o1[r] = 0.f; }
#pragma unroll
            for (int dt = 0; dt < 4; ++dt)
#pragma unroll
                for (int s = 0; s < 2; ++s) {
                    const bf16x8 bs = pack8(S[dt], s);
                    const int ko = (32 * dt + 16 * s + 4 * hh) * 2;
                    o0 = mfma32(ld2x8(L + GL_QT + l31 * GL_QROW + ko), bs, o0);
                    o1 = mfma32(ld2x8(L + GL_QT + (32 + l31) * GL_QROW + ko), bs, o1);
                }
            __builtin_amdgcn_sched_barrier(0);
#pragma unroll
            for (int tile = 0; tile < 3; ++tile) {
                const int jt = (tile == 2) ? 1 : 0, it = (tile == 0) ? 0 : 1;
                f32x16 p;
#pragma unroll
                for (int r = 0; r < 16; ++r) p[r] = 0.f;
#pragma unroll
                for (int ks = 0; ks < 8; ++ks) {
                    const int ko = (16 * ks + 8 * hh) * 2;
                    const bf16x8 a = *(const LAS bf16x8*)(L + GL_KT + (32 * jt + l31) * GL_QROW + ko);
                    const bf16x8 b = *(const LAS bf16x8*)(L + GL_QT + (32 * it + l31) * GL_QROW + ko);
                    p = mfma32(a, b, p);
                }
                if (jt == it) {
#pragma unroll
                    for (int r = 0; r < 16; ++r) { const int j = (r & 3) + 8 * (r >> 2) + 4 * hh; p[r] = (j > l31) ? 0.f : p[r]; }
                }
#pragma unroll
                for (int s = 0; s < 2; ++s) {
                    const bf16x8 bv = gl_tr2(pv0 + 8192 * jt + 4096 * s, pv1 + 8192 * jt + 4096 * s);
                    if (it == 0) o0 = mfma32(pack8(p, s), bv, o0); else o1 = mfma32(pack8(p, s), bv, o1);
                }
                __builtin_amdgcn_sched_barrier(0);
            }
            gla_state_update(F, S);
            __syncthreads();
#pragma unroll
            for (int r = 0; r < 16; ++r) { const int i = (r & 3) + 8 * (r >> 2) + 4 * hh;
                *(LAS float*)(L + GL_OB + i * GL_OBROW + (32 * wave + l31) * 4) = o0[r]; *(LAS float*)(L + GL_OB + (32 + i) * GL_OBROW + (32 * wave + l31) * 4) = o1[r]; }
            __syncthreads();
            {
                const int t = F.tid >> 3, part = F.tid & 7;
                float v[32]; float ss = 0.f;
#pragma unroll
                for (int i = 0; i < 8; ++i) { const f32x4 x = *(const LAS f32x4*)(L + GL_OB + t * GL_OBROW + (32 * part + 4 * i) * 4); v[4 * i] = x.x; v[4 * i + 1] = x.y; v[4 * i + 2] = x.z; v[4 * i + 3] = x.w; ss += (x.x * x.x + x.y * x.y) + (x.z * x.z + x.w * x.w); }
                ss += __shfl_xor(ss, 1); ss += __shfl_xor(ss, 2); ss += __shfl_xor(ss, 4);
                const float rstd = rsqrtf(ss * (1.f / 256.f) + EPS);
                const bf16_t* gp = GR + (m0 + t) * 1024 + h * 256 + 32 * part;
#pragma unroll
                for (int i = 0; i < 4; ++i) { const v4u raw = *(const v4u*)(gp + 8 * i); float rr[8]; unpack8(raw, rr);
                    const f32x4 g0 = *(const f32x4*)(ogain + 32 * part + 8 * i), g1 = *(const f32x4*)(ogain + 32 * part + 8 * i + 4);
                    v4u o; o.x = pk2(v[8 * i] * rstd * g0.x * rr[0], v[8 * i + 1] * rstd * g0.y * rr[1]); o.y = pk2(v[8 * i + 2] * rstd * g0.z * rr[2], v[8 * i + 3] * rstd * g0.w * rr[3]);
                    o.z = pk2(v[8 * i + 4] * rstd * g1.x * rr[4], v[8 * i + 5] * rstd * g1.y * rr[5]); o.w = pk2(v[8 * i + 6] * rstd * g1.z * rr[6], v[8 * i + 7] * rstd * g1.w * rr[7]);
                    wt_st16(gr_r, (unsigned)(((m0 + t) * 1024 + h * 256 + 32 * part + 8 * i) * 2), o); }
            }
        }
    }
    __syncthreads();
}

constexpr int PK_KROW = 272, PK_K_OFF = 0, PK_SCR_OFF = 2 * 128 * PK_KROW;
__device__ __forceinline__ void ce(unsigned& a, unsigned& b) { const unsigned mx = a > b ? a : b, mn = a > b ? b : a; a = mx; b = mn; }
template <int N> __device__ __forceinline__ void bitonic_sort_desc(unsigned (&x)[N]) {
#pragma unroll
    for (int k = 2; k <= N; k <<= 1)
#pragma unroll
        for (int j = k >> 1; j > 0; j >>= 1)
#pragma unroll
            for (int i = 0; i < N; ++i) { const int l = i ^ j; if (l > i) { if ((i & k) == 0) ce(x[i], x[l]); else ce(x[l], x[i]); } }
}
__device__ __forceinline__ void sort16_desc(unsigned (&x)[16]) {
    ce(x[0], x[13]); ce(x[1], x[12]); ce(x[2], x[15]); ce(x[3], x[14]); ce(x[4], x[8]); ce(x[5], x[6]); ce(x[7], x[11]); ce(x[9], x[10]); ce(x[0], x[5]); ce(x[1], x[7]); ce(x[2], x[9]); ce(x[3], x[4]); ce(x[6], x[13]); ce(x[8], x[14]); ce(x[10], x[15]); ce(x[11], x[12]); ce(x[0], x[1]); ce(x[2], x[3]); ce(x[4], x[5]); ce(x[6], x[8]); ce(x[7], x[9]); ce(x[10], x[11]); ce(x[12], x[13]); ce(x[14], x[15]); ce(x[0], x[2]); ce(x[1], x[3]); ce(x[4], x[10]); ce(x[5], x[11]); ce(x[6], x[7]); ce(x[8], x[9]); ce(x[12], x[14]); ce(x[13], x[15]); ce(x[1], x[2]); ce(x[3], x[12]); ce(x[4], x[6]); ce(x[5], x[7]); ce(x[8], x[10]); ce(x[9], x[11]); ce(x[13], x[14]); ce(x[1], x[4]); ce(x[2], x[6]); ce(x[5], x[8]); ce(x[7], x[10]); ce(x[9], x[13]); ce(x[11], x[14]); ce(x[2], x[4]); ce(x[3], x[6]); ce(x[9], x[12]); ce(x[11], x[13]); ce(x[3], x[5]); ce(x[6], x[8]); ce(x[7], x[9]); ce(x[10], x[12]); ce(x[3], x[4]); ce(x[5], x[6]); ce(x[7], x[8]); ce(x[9], x[10]); ce(x[11], x[12]); ce(x[6], x[7]); ce(x[8], x[9]);
}
__device__ __forceinline__ void merge16(unsigned (&a)[16], const unsigned (&b)[16]) {
#pragma unroll
    for (int i = 0; i < 16; ++i) a[i] = a[i] > b[15 - i] ? a[i] : b[15 - i];
#pragma unroll
    for (int j = 8; j > 0; j >>= 1)
#pragma unroll
        for (int i = 0; i < 16; ++i) { const int l = i ^ j; if (l > i) ce(a[i], a[l]); }
}
__device__ __forceinline__ void merge16_partner(unsigned (&a)[16]) {
    unsigned b[16];
#pragma unroll
    for (int i = 0; i < 16; ++i) b[i] = (unsigned)__shfl_xor((int)a[i], 32);
    merge16(a, b);
}
__device__ __forceinline__ unsigned f2key(float f) { const unsigned u = __builtin_bit_cast(unsigned, f); return u ^ ((unsigned)((int)u >> 31) | 0x80000000u); }
__device__ __forceinline__ float key2f(unsigned k) { const unsigned m = ~(unsigned)((int)k >> 31) | 0x80000000u; return __builtin_bit_cast(float, k ^ m); }
__device__ constexpr int PEER_CI[50] = {0,0,0,0,0,0,0,0,0,0,0,0,0,0,0,0, 1,1,1,1,1,1,1,1, 2,2,2,2,2, 3,3,3,3, 4,4,4, 5,5, 6,6, 7,7, 8,9,10,11,12,13,14,15};
__device__ constexpr int PEER_CJ[50] = {0,1,2,3,4,5,6,7,8,9,10,11,12,13,14,15, 0,1,2,3,4,5,6,7, 0,1,2,3,4, 0,1,2,3, 0,1,2, 0,1, 0,1, 0,1, 0,0,0,0,0,0,0,0};
__device__ __forceinline__ void top16_of_tiles(const f32x16 (&s)[4], int hh, unsigned (&top)[16]) {
#pragma unroll
    for (int mt = 0; mt < 4; ++mt) {
        unsigned g[16];
#pragma unroll
        for (int r = 0; r < 16; ++r) { const unsigned low = (unsigned)(127 - (32 * mt + (r & 3) + 8 * (r >> 2))) - 4u * (unsigned)hh; g[r] = (f2key(s[mt][r]) & ~127u) | low; }
        sort16_desc(g);
        if (mt == 0) {
#pragma unroll
            for (int i = 0; i < 16; ++i) top[i] = g[i];
        } else merge16(top, g);
    }
    merge16_partner(top);
}
__device__ __forceinline__ void peer_topk_phase(Frame& F) {
    const bf16_t* QP = (const bf16_t*)(F.ws + WS_QP); const bf16_t* SUBK = (const bf16_t*)(F.ws + WS_SUBK);
    unsigned short* IDX = (unsigned short*)(F.ws + WS_IDX); float* GATE = (float*)(F.ws + WS_GATE);
    LAS unsigned char* L = F.lds; const int tid = F.tid, lane = F.lane, wave = F.wave, l31 = lane & 31, hh = lane >> 5;
    LAS unsigned* scr = (LAS unsigned*)(L + PK_SCR_OFF + wave * 8192);
    pg8::StaticOrder S; S.init(T, 2048, F.G, F.bid);
    for (int ui = 0; ; ++ui) {
        pg8::Unit un; if (!S.next(ui, un)) break;
        const int h = un.pn, tile = un.pm;
        __syncthreads();
#pragma unroll
        for (int i = 0; i < 8; ++i) { const int v = tid + 512 * i, row = v >> 4, c = v & 15;
            *(LAS v4u*)(L + PK_K_OFF + row * PK_KROW + c * 16) = *(const v4u*)(SUBK + ((size_t)h * 256 + row) * 128 + c * 8); }
        __syncthreads();
        const int tok = tile * 256 + wave * 32 + l31;
        unsigned ka[16], kb[16];
#pragma unroll
        for (int p = 0; p < 2; ++p) {
            f32x16 s[4];
#pragma unroll
            for (int mt = 0; mt < 4; ++mt)
#pragma unroll
                for (int r = 0; r < 16; ++r) s[mt][r] = 0.f;
            const bf16_t* qrow = QP + (size_t)tok * 2048 + h * 256 + p * 128 + 8 * hh;
#pragma unroll
            for (int k2 = 0; k2 < 4; ++k2) {
                const bf16x8 q0 = *(const bf16x8*)(qrow + 32 * k2), q1 = *(const bf16x8*)(qrow + 32 * k2 + 16);
#pragma unroll
                for (int mt = 0; mt < 4; ++mt) { const bf16x8 a = *(const LAS bf16x8*)(L + PK_K_OFF + (p * 128 + 32 * mt + l31) * PK_KROW + (32 * k2 + 8 * hh) * 2); s[mt] = mfma32(a, q0, s[mt]); }
#pragma unroll
                for (int mt = 0; mt < 4; ++mt) { const bf16x8 a = *(const LAS bf16x8*)(L + PK_K_OFF + (p * 128 + 32 * mt + l31) * PK_KROW + (32 * k2 + 16 + 8 * hh) * 2); s[mt] = mfma32(a, q1, s[mt]); }
                __builtin_amdgcn_sched_barrier(0);
            }
            if (p == 0) top16_of_tiles(s, hh, ka); else top16_of_tiles(s, hh, kb);
        }
        float sa[16], sb[16];
#pragma unroll
        for (int i = 0; i < 16; ++i) { sa[i] = key2f(ka[i] & ~127u); sb[i] = key2f(kb[i] & ~127u); scr[i * 64 + lane] = 127u - (ka[i] & 127u); scr[(16 + i) * 64 + lane] = 127u - (kb[i] & 127u); }
        unsigned c0[16], c1[16];
#pragma unroll
        for (int n = 0; n < 32; ++n) {
            unsigned key = 0u;
            if (n < 25) { const int e0 = 2 * n, e1 = 2 * n + 1;
                const float v0 = sa[PEER_CI[e0]] + sb[PEER_CJ[e0]], v1 = sa[PEER_CI[e1]] + sb[PEER_CJ[e1]];
                const unsigned k0 = (f2key(v0) & ~255u) | (unsigned)(255 - (PEER_CI[e0] * 16 + PEER_CJ[e0])), k1 = (f2key(v1) & ~255u) | (unsigned)(255 - (PEER_CI[e1] * 16 + PEER_CJ[e1]));
                key = hh ? k1 : k0; }
            if (n < 16) c0[n] = key; else c1[n - 16] = key;
        }
        sort16_desc(c0); sort16_desc(c1); merge16(c0, c1); merge16_partner(c0);
        float e[16]; float sum = 0.f; const float mx = key2f(c0[0] & ~255u);
#pragma unroll
        for (int n = 0; n < 16; ++n) { e[n] = fexp(key2f(c0[n] & ~255u) - mx); sum += e[n]; }
        const float inv = 1.0f / sum;
        int eo[8]; float go[8];
#pragma unroll
        for (int n = 0; n < 8; ++n) { const unsigned kk = hh ? c0[8 + n] : c0[n]; const unsigned id = 255u - (kk & 255u);
            const unsigned i1 = scr[(id >> 4) * 64 + lane], i2 = scr[(16 + (id & 15)) * 64 + lane];
            eo[n] = (int)(i1 * 128u + i2); go[n] = (hh ? e[8 + n] : e[n]) * inv; }
        typedef int i32x4 __attribute__((ext_vector_type(4)));
        { const __amdgpu_buffer_rsrc_t gr = wt_rsrc(GATE); const unsigned bo = (unsigned)(((size_t)tok * 128 + h * 16 + 8 * hh) * 4);
          wt_st16(gr, bo, __builtin_bit_cast(wt_u32x4, (f32x4){go[0], go[1], go[2], go[3]})); wt_st16(gr, bo + 16, __builtin_bit_cast(wt_u32x4, (f32x4){go[4], go[5], go[6], go[7]}));
          unsigned short* ip = IDX + (size_t)tok * 128 + 2 * h + hh;
#pragma unroll
          for (int n = 0; n < 8; ++n) ip[16 * n] = (unsigned short)eo[n]; }
    }
    __syncthreads();
}
constexpr size_t WS_RSTD2 = 482 * MiB, WS_EXD8 = 352 * MiB, WS_EXU8 = 368 * MiB, WS_ISD = 6 * MiB, WS_ISU = 6 * MiB + 65536, WS_PA = 32 * MiB, WS_WEX = 416 * MiB, WS_AQ = 96 * MiB, WS_ASC = 130 * MiB;
__device__ __forceinline__ float gelu_exact(float x) { return 0.5f * x * (1.f + erff(x * 0.7071067811865476f)); }
__device__ __forceinline__ unsigned pack_i8x4(float a, float b, float c, float d) {
    const int ia = (int)rintf(a), ib = (int)rintf(b), ic = (int)rintf(c), id = (int)rintf(d);
    return ((unsigned)ia & 0xffu) | (((unsigned)ib & 0xffu) << 8) | (((unsigned)ic & 0xffu) << 16) | ((unsigned)id << 24);
}
__device__ __forceinline__ unsigned nib_lo(unsigned w) { return w & 0x0F0F0F0Fu; }
__device__ __forceinline__ unsigned nib_hi(unsigned w) { return ((((w ^ 0x80808080u) + 0x08080808u) >> 4) & 0x0F0F0F0Fu) ^ 0x08080808u; }
__device__ __forceinline__ void peer_quant_phase(Frame& F) {
    const bf16_t* HB = (const bf16_t*)(F.ws + WS_HB2); unsigned char* AQ = F.ws + WS_AQ; float* ASC = (float*)(F.ws + WS_ASC); const int lane = F.lane;
    for (int t = F.bid * NWAVES + F.wave; t < T; t += F.G * NWAVES) {
        const v4u* hp = (const v4u*)(HB + (size_t)t * D + 16 * lane); float a[8], b[8]; unpack8(hp[0], a); unpack8(hp[1], b);
        float mx = 0.f;
#pragma unroll
        for (int j = 0; j < 8; ++j) mx = fmaxf(mx, fmaxf(fabsf(a[j]), fabsf(b[j])));
        mx = fmaxf(mx, __shfl_xor(mx, 1)); mx = fmaxf(mx, __shfl_xor(mx, 2)); mx = fmaxf(mx, __shfl_xor(mx, 4)); mx = fmaxf(mx, __shfl_xor(mx, 8));
        const float sx = mx > 0.f ? 119.f / mx : 1.f, isx = mx > 0.f ? mx * (1.f / 119.f) : 1.f;
        const unsigned w0 = pack_i8x4(a[0] * sx, a[2] * sx, a[4] * sx, a[6] * sx), w1 = pack_i8x4(a[1] * sx, a[3] * sx, a[5] * sx, a[7] * sx);
        const unsigned w2 = pack_i8x4(b[0] * sx, b[2] * sx, b[4] * sx, b[6] * sx), w3 = pack_i8x4(b[1] * sx, b[3] * sx, b[5] * sx, b[7] * sx);
        unsigned char* base = AQ + ((size_t)(t * 4 + (lane >> 4)) * 8 + ((lane & 15) >> 1)) * 32 + (lane & 1) * 8;
        *(v2u*)base = (v2u){nib_hi(w0) | (nib_hi(w1) << 4), nib_hi(w2) | (nib_hi(w3) << 4)};
        *(v2u*)(base + 16) = (v2u){nib_lo(w0) | (nib_lo(w1) << 4), nib_lo(w2) | (nib_lo(w3) << 4)};
        if ((lane & 15) == 0) ASC[t * 4 + (lane >> 4)] = isx;
    }
}
__device__ __forceinline__ void treduce16(float (&p)[16], int lane, int m) {
#pragma unroll
    for (int i = 0; i < 8; ++i) { const bool hi = lane & m; const float send = hi ? p[i] : p[i + 8], keep = hi ? p[i + 8] : p[i]; p[i] = keep + __shfl_xor(send, m); }
#pragma unroll
    for (int i = 0; i < 4; ++i) { const bool hi = lane & (2 * m); const float send = hi ? p[i] : p[i + 4], keep = hi ? p[i + 4] : p[i]; p[i] = keep + __shfl_xor(send, 2 * m); }
#pragma unroll
    for (int i = 0; i < 2; ++i) { const bool hi = lane & (4 * m); const float send = hi ? p[i] : p[i + 2], keep = hi ? p[i + 2] : p[i]; p[i] = keep + __shfl_xor(send, 4 * m); }
}
typedef int i32x4v __attribute__((ext_vector_type(4)));
__device__ __forceinline__ void treduce16i_g(int (&p)[16], int lane) {
#pragma unroll
    for (int i = 0; i < 8; ++i) { const v2u r = __builtin_amdgcn_permlane32_swap((unsigned)p[i], (unsigned)p[i + 8], false, false); p[i] = (int)(r.x + r.y); }
#pragma unroll
    for (int i = 0; i < 4; ++i) { const v2u r = __builtin_amdgcn_permlane16_swap((unsigned)p[i], (unsigned)p[i + 4], false, false); p[i] = (int)(r.x + r.y); }
    const bool hi = lane & 8;
#pragma unroll
    for (int i = 0; i < 2; ++i) { const int send = hi ? p[i] : p[i + 2], keep = hi ? p[i + 2] : p[i]; p[i] = keep + __builtin_amdgcn_update_dpp(0, send, 0x128, 0xF, 0xF, false); }
}
__device__ __forceinline__ void peer_load_ids(const unsigned short* IDX, size_t t, int g, i32x4v (&id)[4]) {
    const v4u* p = (const v4u*)(IDX + t * 128 + g * 16); const v4u a = p[0], b = p[1];
    id[0] = (i32x4v){(int)(a.x & 0xffffu), (int)(a.x >> 16), (int)(a.y & 0xffffu), (int)(a.y >> 16)}; id[1] = (i32x4v){(int)(a.z & 0xffffu), (int)(a.z >> 16), (int)(a.w & 0xffffu), (int)(a.w >> 16)};
    id[2] = (i32x4v){(int)(b.x & 0xffffu), (int)(b.x >> 16), (int)(b.y & 0xffffu), (int)(b.y >> 16)}; id[3] = (i32x4v){(int)(b.z & 0xffffu), (int)(b.z >> 16), (int)(b.w & 0xffffu), (int)(b.w >> 16)};
}
__device__ __forceinline__ void peer_load_w(const bf16_t* WEX, size_t t, int g, v4u (&w)[2]) {
    const v4u* p = (const v4u*)(WEX + t * 128 + g * 16); w[0] = p[0]; w[1] = p[1];
}
__device__ __forceinline__ void peer_v8_lds(LAS unsigned char* scr, unsigned raw, int lane, int grp, v4u (&o)[2]) {
    *(LAS unsigned*)(scr + 4 * lane) = raw; asm volatile("" ::: "memory");
    o[0] = *(const LAS v4u*)(scr + 32 * grp); o[1] = *(const LAS v4u*)(scr + 32 * grp + 16); asm volatile("" ::: "memory");
}
__device__ __forceinline__ void peer_ids_lds(LAS unsigned char* scr, unsigned raw, int lane, i32x4v (&id)[4]) {
    v4u r[2]; peer_v8_lds(scr, raw, lane, lane >> 3, r); const v4u a = r[0], b = r[1];
    id[0] = (i32x4v){(int)(a.x & 0xffffu), (int)(a.x >> 16), (int)(a.y & 0xffffu), (int)(a.y >> 16)}; id[1] = (i32x4v){(int)(a.z & 0xffffu), (int)(a.z >> 16), (int)(a.w & 0xffffu), (int)(a.w >> 16)};
    id[2] = (i32x4v){(int)(b.x & 0xffffu), (int)(b.x >> 16), (int)(b.y & 0xffffu), (int)(b.y >> 16)}; id[3] = (i32x4v){(int)(b.z & 0xffffu), (int)(b.z >> 16), (int)(b.w & 0xffffu), (int)(b.w >> 16)};
}
#ifndef PEER_GATHER_AUX
#define PEER_GATHER_AUX 16
#endif
__device__ __forceinline__ void peer_gather16(v4u (&q)[16], const __amdgpu_buffer_rsrc_t r, unsigned loff, const i32x4v (&id)[4]) {
#pragma unroll
    for (int i = 0; i < 16; ++i) q[i] = __builtin_bit_cast(v4u, __builtin_amdgcn_raw_buffer_load_b128(r, (unsigned)id[i >> 2][i & 3] * 128u + loff, 0, PEER_GATHER_AUX));
}
__device__ __forceinline__ void peer_down_compute(const v4u (&q)[16], const v4u (&aq)[2], float isx, bf16_t* pa, int lane) {
    float p[16];
#pragma unroll
    for (int i = 0; i < 16; ++i) { int ah = __builtin_amdgcn_sdot8((int)q[i][0], (int)aq[0][0], 0, true), al = __builtin_amdgcn_sdot8((int)q[i][0], (int)aq[1][0], 0, true);
#pragma unroll
        for (int j = 1; j < 4; ++j) { ah = __builtin_amdgcn_sdot8((int)q[i][j], (int)aq[0][j], ah, false); al = __builtin_amdgcn_sdot8((int)q[i][j], (int)aq[1][j], al, false); }
        p[i] = (float)(16 * ah + al) * isx; }
    treduce16(p, lane, 1);
    *(unsigned*)(pa + 2 * lane) = pk2(p[0], p[1]);
}
__device__ __forceinline__ void peer_down_phase(Frame& F) {
    const unsigned char* TD = F.ws + WS_EXD8; const unsigned short* IDX = (const unsigned short*)(F.ws + WS_IDX);
    bf16_t* PA = (bf16_t*)(F.ws + WS_PA); const bf16_t* h1 = (const bf16_t*)(F.ws + WS_HB2);
    const unsigned char* AQ = F.ws + WS_AQ; const float* ASC = (const float*)(F.ws + WS_ASC);
    const int lane = F.lane, g = lane >> 3, cl = lane & 7, k = (F.bid & 7) >> 1, nw = (F.G >> 3) * 2 * NWAVES;
    const __amdgpu_buffer_rsrc_t tk = wt_rsrc(TD + (size_t)k * 16384 * 128); const unsigned loff = 16u * (unsigned)cl;
    int t = ((F.bid >> 3) * 2 + (F.bid & 1)) * NWAVES + F.wave;
    if (t >= T) return;
    LAS unsigned char* scrI = F.lds + F.wave * 512; LAS unsigned char* scrA = scrI + 256;
    const unsigned* IDXW = (const unsigned*)IDX + lane; const unsigned* AQW = (const unsigned*)AQ + k * 64 + lane;
    i32x4v id[4];
    unsigned idr = IDXW[(size_t)t * 64];
    peer_ids_lds(scrI, idr, lane, id);
    v4u qa[16], qb[16];
    peer_gather16(qa, tk, loff, id);
    { const int tl = (t + nw < T) ? t + nw : t; idr = IDXW[(size_t)tl * 64]; }
    float hs = ASC[t * 4 + k];
    unsigned aqr = AQW[(size_t)t * 256];
#define PEER_DOWN_STEP(QC, QN) { \
        const int t1 = t + nw, t2 = t + 2 * nw; const bool has1 = t1 < T; \
        peer_ids_lds(scrI, idr, lane, id); \
        if (has1) peer_gather16(QN, tk, loff, id); \
        { const int tl = (t2 < T) ? t2 : t; idr = IDXW[(size_t)tl * 64]; } \
        v4u hv[2]; peer_v8_lds(scrA, aqr, lane, cl, hv); \
        unsigned aqn; float hsn; { const int tl = has1 ? t1 : t; aqn = AQW[(size_t)tl * 256]; hsn = ASC[tl * 4 + k]; } \
        __builtin_amdgcn_sched_barrier(0); \
        peer_down_compute(QC, hv, hs, PA + ((size_t)k * T + t) * 128, lane); \
        __builtin_amdgcn_sched_barrier(0); \
        if (!has1) break; t = t1; aqr = aqn; hs = hsn; }
    for (;;) { PEER_DOWN_STEP(qa, qb) PEER_DOWN_STEP(qb, qa) }
#undef PEER_DOWN_STEP
}
__device__ __forceinline__ void peer_combine_phase(Frame& F) {
    const unsigned* PAW = (const unsigned*)(F.ws + WS_PA); const unsigned* IDXW = (const unsigned*)(F.ws + WS_IDX); const float* GATE = (const float*)(F.ws + WS_GATE);
    const float* ISD = (const float*)(F.ws + WS_ISD); const float* ISU = (const float*)(F.ws + WS_ISU); unsigned* WQ = (unsigned*)(F.ws + WS_WEX); float* WSC = (float*)(F.ws + WS_WEX + 8 * MiB); const float* RSTD2 = (const float*)(F.ws + WS_RSTD2);
    const int lane = F.lane, g = lane >> 3, w = lane & 7, cl = ((w & 1) << 2) | (w & 2) | ((w >> 2) & 1);
    for (int t = F.bid * NWAVES + F.wave; t < T; t += F.G * NWAVES) {
        float a0 = 0.f, a1 = 0.f;
#pragma unroll
        for (int k = 0; k < 4; ++k) { const unsigned r = PAW[((size_t)k * T + t) * 64 + 8 * g + cl]; a0 += __builtin_bit_cast(float, r << 16); a1 += __builtin_bit_cast(float, r & 0xffff0000u); }
        const unsigned idp = IDXW[(size_t)t * 64 + 8 * g + w]; const int id0 = (int)(idp & 0xffffu), id1 = (int)(idp >> 16);
        const float g0 = GATE[(size_t)t * 128 + 16 * w + g], g1 = GATE[(size_t)t * 128 + 16 * w + 8 + g], rs = RSTD2[t];
        const pg8::f32x2 ge = pg8::gelu_pk((pg8::f32x2){a0 * rs * ISD[id0], a1 * rs * ISD[id1]});
        const float w0 = g0 * ge.x * ISU[id0], w1 = g1 * ge.y * ISU[id1];
        float mx = fmaxf(fabsf(w0), fabsf(w1));
#pragma unroll
        for (int o = 1; o < 64; o <<= 1) mx = fmaxf(mx, __shfl_xor(mx, o));
        const float sw = mx > 0.f ? 119.f / mx : 1.f, isw = mx > 0.f ? mx * (1.f / 119.f) : 1.f;
        const unsigned by = ((unsigned)(int)rintf(w0 * sw) & 0xffu) | (((unsigned)(int)rintf(w1 * sw) & 0xffu) << 8);
        const unsigned h = nib_hi(by) & 0x0F0Fu, l = nib_lo(by) & 0x0F0Fu;
        unsigned hv = ((h | (h >> 4)) & 0xffu) << (8 * (w & 3)), lv = ((l | (l >> 4)) & 0xffu) << (8 * (w & 3));
        hv |= (unsigned)__builtin_amdgcn_update_dpp(0, (int)hv, 0xB1, 0xF, 0xF, false); hv |= (unsigned)__builtin_amdgcn_update_dpp(0, (int)hv, 0x4E, 0xF, 0xF, false);
        lv |= (unsigned)__builtin_amdgcn_update_dpp(0, (int)lv, 0xB1, 0xF, 0xF, false); lv |= (unsigned)__builtin_amdgcn_update_dpp(0, (int)lv, 0x4E, 0xF, 0xF, false);
        if ((w & 3) == 0) { WQ[(size_t)t * 32 + 4 * g + (w >> 2)] = hv; WQ[(size_t)t * 32 + 4 * g + 2 + (w >> 2)] = lv; }
        if (lane == 0) WSC[t] = isw;
    }
}
__device__ __forceinline__ void peer_up_compute(const v4u (&q)[16], const v4u wq, float isw, v2u hraw, float* dstp, int lane) {
    const int whi[2] = {(int)wq.x, (int)wq.y}, wlo[2] = {(int)wq.z, (int)wq.w};
    constexpr unsigned NM = 0x0F0F0F0Fu;
    int res[4];
#pragma unroll
    for (int jj = 0; jj < 2; ++jj) {
    int f[16];
#pragma unroll
    for (int j2 = 0; j2 < 2; ++j2) { const int j = 2 * jj + j2;
        unsigned tcc[2][8];
#pragma unroll
        for (int o = 0; o < 2; ++o) {
            unsigned a0[4], a1[4];
#pragma unroll
            for (int pr = 0; pr < 4; ++pr) { const unsigned r0 = q[8 * o + 2 * pr][j], r1 = q[8 * o + 2 * pr + 1][j];
                a0[pr] = (r0 & NM) | ((r1 << 4) & ~NM); a1[pr] = ((r0 >> 4) & NM) | (r1 & ~NM); }
#pragma unroll
            for (int x = 0; x < 2; ++x) {
                unsigned b[2][2];
#pragma unroll
                for (int h = 0; h < 2; ++h) { const unsigned lo = x ? a1[2 * h] : a0[2 * h], hi = x ? a1[2 * h + 1] : a0[2 * h + 1];
                    b[h][0] = __builtin_amdgcn_perm(hi, lo, 0x05010400u); b[h][1] = __builtin_amdgcn_perm(hi, lo, 0x07030602u); }
#pragma unroll
                for (int p = 0; p < 2; ++p) { tcc[o][2 * (2 * p) + x] = __builtin_amdgcn_perm(b[1][p], b[0][p], 0x05040100u); tcc[o][2 * (2 * p + 1) + x] = __builtin_amdgcn_perm(b[1][p], b[0][p], 0x07060302u); }
            }
        }
#pragma unroll
        for (int n = 0; n < 8; ++n) { int a = __builtin_amdgcn_sdot8((int)tcc[0][n], whi[0], 0, true);     a = __builtin_amdgcn_sdot8((int)tcc[1][n], whi[1], a, false);
            a = __builtin_amdgcn_sdot8((int)tcc[0][n], wlo[0], a << 4, false); a = __builtin_amdgcn_sdot8((int)tcc[1][n], wlo[1], a, false); f[8 * j2 + n] = a; }
    }
    treduce16i_g(f, lane); res[2 * jj] = f[0]; res[2 * jj + 1] = f[1];
    }
    *(f32x2_t*)dstp = (f32x2_t){__builtin_bit_cast(float, hraw.x << 16) + (float)res[0] * isw, __builtin_bit_cast(float, hraw.x & 0xffff0000u) + (float)res[1] * isw};
    *(f32x2_t*)(dstp + 16) = (f32x2_t){__builtin_bit_cast(float, hraw.y << 16) + (float)res[2] * isw, __builtin_bit_cast(float, hraw.y & 0xffff0000u) + (float)res[3] * isw};
}
__device__ __forceinline__ void peer_up_phase(Frame& F, float* dst) {
    const unsigned char* TU = F.ws + WS_EXU8; const unsigned short* IDX = (const unsigned short*)(F.ws + WS_IDX); const bf16_t* WEX = (const bf16_t*)(F.ws + WS_WEX);
    float* out = F.out;
    const int lane = F.lane, g = lane >> 3, cl = lane & 7, k = (F.bid & 7) >> 1, nw = (F.G >> 3) * 2 * NWAVES;
    const __amdgpu_buffer_rsrc_t tk = wt_rsrc(TU + (size_t)k * 16384 * 128); const unsigned loff = 16u * (unsigned)cl;
    const int ccol = 256 * k + 32 * cl + 2 * g;
    int t = ((F.bid >> 3) * 2 + (F.bid & 1)) * NWAVES + F.wave;
    if (t >= T) return;
    LAS unsigned char* scrI = F.lds + F.wave * 512; LAS unsigned char* scrW = scrI + 256;
    const unsigned* IDXW = (const unsigned*)IDX + lane; const unsigned* WEXW = (const unsigned*)WEX + (lane & 31); const float* WSC = (const float*)(F.ws + WS_WEX + 8 * MiB);
    i32x4v id[4];
    unsigned idr = IDXW[(size_t)t * 64], wr = WEXW[(size_t)t * 32]; float ws = WSC[t];
    peer_ids_lds(scrI, idr, lane, id);
    v4u qa[16], qb[16];
    peer_gather16(qa, tk, loff, id);
    { const int tl = (t + nw < T) ? t + nw : t; idr = IDXW[(size_t)tl * 64]; }
    const bf16_t* hb16 = (const bf16_t*)(F.ws + WS_HB2);
    v2u hcur; hcur.x = *(const unsigned*)(hb16 + (size_t)t * D + ccol); hcur.y = *(const unsigned*)(hb16 + (size_t)t * D + ccol + 16);
#define PEER_UP_STEP(QC, QN) { \
        const int t1 = t + nw, t2 = t + 2 * nw; const bool has1 = t1 < T; \
        peer_ids_lds(scrI, idr, lane, id); \
        if (has1) peer_gather16(QN, tk, loff, id); \
        { const int tl = (t2 < T) ? t2 : t; idr = IDXW[(size_t)tl * 64]; } \
        const unsigned wrn = WEXW[(size_t)(has1 ? t1 : t) * 32]; const float wsn = WSC[has1 ? t1 : t]; \
        v2u hnext; hnext.x = *(const unsigned*)(hb16 + (size_t)(has1 ? t1 : t) * D + ccol); hnext.y = *(const unsigned*)(hb16 + (size_t)(has1 ? t1 : t) * D + ccol + 16); \
        *(LAS unsigned*)(scrW + 4 * (lane & 31)) = wr; asm volatile("" ::: "memory"); const v4u wc = *(const LAS v4u*)(scrW + 16 * g); asm volatile("" ::: "memory"); \
        __builtin_amdgcn_sched_barrier(0); \
        peer_up_compute(QC, wc, ws, hcur, dst + (size_t)t * D + ccol, lane); \
        __builtin_amdgcn_sched_barrier(0); \
        if (!has1) break; t = t1; hcur = hnext; wr = wrn; ws = wsn; }
    for (;;) { PEER_UP_STEP(qa, qb) PEER_UP_STEP(qb, qa) }
#undef PEER_UP_STEP
}
__device__ __forceinline__ void expert_convert(Frame& F, const float* exd, const float* exu, const float* gain2) {
    const int lane = F.lane;
    f32x4 gv[4];
#pragma unroll
    for (int j = 0; j < 4; ++j) gv[j] = *(const f32x4*)(gain2 + 16 * lane + 4 * j);
    const bool wsplit = (F.G == 256); const int nscan = 128 * NWAVES;
    int gi = F.bid * NWAVES + F.wave, gstep = F.G * NWAVES, gend = 8192;
    if (wsplit) { gstep = nscan; if (F.bid < 128) { gend = 2 * nscan; } else { gi = 2 * nscan + (F.bid - 128) * NWAVES + F.wave; } }
    for (; gi < gend; gi += gstep) { const int r4 = gi * 4;
        const int tb = r4 >> 14, row0 = r4 & 16383;
        const float* src = (tb ? exu : exd) + (size_t)row0 * D + 16 * lane;
        f32x4 v[4][4]; float mx[4];
#pragma unroll
        for (int r = 0; r < 4; ++r)
#pragma unroll
            for (int j = 0; j < 4; ++j) v[r][j] = *(const f32x4*)(src + (size_t)r * D + 4 * j);
#pragma unroll
        for (int r = 0; r < 4; ++r) { float m = 0.f;
#pragma unroll
            for (int j = 0; j < 4; ++j) { if (tb == 0) v[r][j] = v[r][j] * gv[j]; m = fmaxf(m, fmaxf(fmaxf(fabsf(v[r][j].x), fabsf(v[r][j].y)), fmaxf(fabsf(v[r][j].z), fabsf(v[r][j].w)))); }
            mx[r] = m; }
#pragma unroll
        for (int o = 1; o < 64; o <<= 1)
#pragma unroll
            for (int r = 0; r < 4; ++r) mx[r] = fmaxf(mx[r], __shfl_xor(mx[r], o));
        {
            float ss[4];
#pragma unroll
            for (int r = 0; r < 4; ++r) { float s = 0.f;
#pragma unroll
                for (int j = 0; j < 4; ++j) s += (v[r][j].x * v[r][j].x + v[r][j].y * v[r][j].y) + (v[r][j].z * v[r][j].z + v[r][j].w * v[r][j].w);
                ss[r] = s; }
#pragma unroll
            for (int o = 1; o < 64; o <<= 1)
#pragma unroll
                for (int r = 0; r < 4; ++r) ss[r] += __shfl_xor(ss[r], o);
#pragma unroll
            for (int r = 0; r < 4; ++r) {
                const float rms = sqrtf(ss[r] * (1.f / 1024.f)), step = rms > 0.f ? 0.35f * rms : 1.f, sc = 1.f / step;
                f32x4 c[4];
#pragma unroll
                for (int j = 0; j < 4; ++j) { c[j] = v[r][j] * sc; c[j].x = fminf(fmaxf(c[j].x, -7.f), 7.f); c[j].y = fminf(fmaxf(c[j].y, -7.f), 7.f); c[j].z = fminf(fmaxf(c[j].z, -7.f), 7.f); c[j].w = fminf(fmaxf(c[j].w, -7.f), 7.f); }
                const unsigned x0 = pack_i8x4(c[0].x, c[0].z, c[1].x, c[1].z), y0 = pack_i8x4(c[0].y, c[0].w, c[1].y, c[1].w);
                const unsigned x1 = pack_i8x4(c[2].x, c[2].z, c[3].x, c[3].z), y1 = pack_i8x4(c[2].y, c[2].w, c[3].y, c[3].w);
                *(v2u*)(F.ws + (tb ? WS_EXU8 : WS_EXD8) + ((size_t)(lane >> 4) * 16384 + row0 + r) * 128 + (lane & 15) * 8) = (v2u){nib_lo(x0) | (nib_lo(y0) << 4), nib_lo(x1) | (nib_lo(y1) << 4)};
                if (lane == 0) wt_st4((float*)(F.ws + (tb ? WS_ISU : WS_ISD)) + row0 + r, step);
            }
            continue;
        }
        const __amdgpu_buffer_rsrc_t rr = wt_rsrc(F.ws + (tb ? WS_EXU8 : WS_EXD8));
#pragma unroll
        for (int r = 0; r < 4; ++r) {
            const float sc = mx[r] > 0.f ? 127.f / mx[r] : 1.f, isc = mx[r] > 0.f ? mx[r] * (1.f / 127.f) : 1.f;
            v4u q;
#pragma unroll
            for (int j = 0; j < 4; ++j) q[j] = pack_i8x4(v[r][j].x * sc, v[r][j].y * sc, v[r][j].z * sc, v[r][j].w * sc);
            wt_st16(rr, (unsigned)(((lane >> 3) * 16384 + row0 + r) * 128 + (lane & 7) * 16), q);
            if (lane == 0) wt_st4((float*)(F.ws + (tb ? WS_ISU : WS_ISD)) + row0 + r, isc);
        }
    }
}
#define XB_TMO      128
#define XB_XCNT(j)  (256  + 64 * (j))
#define XB_XSUB(j)  (1280 + 64 * (j))
#define XB_XGEN(j)  (2304 + 64 * (j))
#define XB_TOP      3328
#define XB_TOPGEN   3392
#define XCD_BAR_WORDS 3456
#define XB_SPIN_CAP (1u << 18)

__device__ __forceinline__ unsigned xb_ld(unsigned* p)              { return __hip_atomic_load(p, __ATOMIC_RELAXED, __HIP_MEMORY_SCOPE_AGENT); }
__device__ __forceinline__ unsigned xb_add(unsigned* p, unsigned v) { return __hip_atomic_fetch_add(p, v, __ATOMIC_RELAXED, __HIP_MEMORY_SCOPE_AGENT); }
__device__ __forceinline__ unsigned xb_xcc_id() { return (unsigned)__builtin_amdgcn_s_getreg((3 << 11) | 20) & 0xFu; }
#define XB_SPIN(cond, bar) do { unsigned _sp = 0; while (cond) { __builtin_amdgcn_s_sleep(1); \
    if ((++_sp & 255u) == 0u) { if (xb_ld(&(bar)[XB_TMO])) break; if (_sp > XB_SPIN_CAP) { atomicAdd(&(bar)[XB_TMO], 1u); break; } } } } while (0)

struct XcdBarrier {
    unsigned* bar; unsigned x;
    volatile LAS unsigned* st;
};

__device__ __forceinline__ XcdBarrier xcd_barrier_post(unsigned* bar, volatile LAS unsigned* st) {
    XcdBarrier b; b.bar = bar; b.x = xb_xcc_id(); b.st = st;
    if (threadIdx.x == 0) (void)xb_add(&bar[XB_XCNT(b.x)], 1u);
    return b;
}
__device__ __forceinline__ void xcd_barrier_complete(unsigned* bar, unsigned x, unsigned& nloc, unsigned& nx) {
    const unsigned G = gridDim.x * gridDim.y * gridDim.z;
    unsigned sum, cnt, mine, sp = 0u;
    for (;;) {
        sum = 0u; cnt = 0u; mine = 0u;
#pragma unroll
        for (unsigned j = 0; j < 16; ++j) { const unsigned c = xb_ld(&bar[XB_XCNT(j)]); sum += c; cnt += (c > 0u) ? 1u : 0u; mine = (j == x) ? c : mine; }
        if (sum == G) break;
        __builtin_amdgcn_s_sleep(1);
        if ((++sp & 255u) == 0u) { if (xb_ld(&bar[XB_TMO])) break; if (sp > XB_SPIN_CAP) { atomicAdd(&bar[XB_TMO], 1u); break; } }
    }
    nloc = mine > 0u ? mine : 1u; nx = cnt > 0u ? cnt : 1u;
}

__device__ __forceinline__ void xcd_barrier(const XcdBarrier& b) {
    asm volatile("s_waitcnt vmcnt(0)" ::: "memory");
    __syncthreads();
    if (threadIdx.x == 0) {
        unsigned* bar = b.bar;
        __builtin_amdgcn_s_waitcnt(0);
        unsigned nloc = b.st[0], nx = b.st[1];
        if (nloc == 0u) { xcd_barrier_complete(bar, b.x, nloc, nx); b.st[0] = nloc; b.st[1] = nx; }
        const unsigned old = xb_add(&bar[XB_XSUB(b.x)], 1u);
        const unsigned gen = old / nloc;
        if (old + 1u == (gen + 1u) * nloc) {
            __builtin_amdgcn_fence(__ATOMIC_RELEASE, "agent");
            asm volatile("s_waitcnt vmcnt(0)" ::: "memory");
            const unsigned og = xb_add(&bar[XB_TOP], 1u);
            const unsigned tg = og / nx;
            if (og + 1u == (tg + 1u) * nx) xb_add(&bar[XB_TOPGEN], 1u);
            else XB_SPIN(xb_ld(&bar[XB_TOPGEN]) == tg, bar);
            __builtin_amdgcn_fence(__ATOMIC_ACQUIRE, "agent");
            xb_add(&bar[XB_XGEN(b.x)], 1u);
            asm volatile("s_waitcnt vmcnt(0)" ::: "memory");
        } else {
            XB_SPIN(xb_ld(&bar[XB_XGEN(b.x)]) == gen, bar);
            __builtin_amdgcn_fence(__ATOMIC_ACQUIRE, "agent");
            asm volatile("s_waitcnt vmcnt(0)" ::: "memory");
        }
    }
    __syncthreads();
}

__global__ void __launch_bounds__(NTHR, 2) mega(Args args) {
    extern __shared__ __attribute__((aligned(16))) unsigned char lds_raw[];
    Frame F;
    F.lds = (LAS unsigned char*)lds_raw;
    F.tid = threadIdx.x; F.lane = F.tid & 63; F.wave = __builtin_amdgcn_readfirstlane(F.tid >> 6); F.G = gridDim.x; F.bid = blockIdx.x;
    F.out = args.out; F.ws = args.ws;
    const int lo = args.ph_lo, hi = args.ph_hi;
    cg::grid_group grid = cg::this_grid();
    volatile LAS unsigned* MISC = (volatile LAS unsigned*)(F.lds + LDS_BYTES - 64);
    if (F.tid < 16) MISC[F.tid] = 0u;
    __syncthreads();
    XcdBarrier bar = xcd_barrier_post((unsigned*)(F.ws + WS_CTL) + 4096, MISC + 8);
    if (hi - lo > 1) grid.sync();
#define IN(k) (lo <= (k) && (k) < hi)
#define SEAM(k) do { if (IN(k) && IN((k) + 1)) xcd_barrier(bar); } while (0)
    if (IN(0)) { p0_prologue(F, args.in[0], args.in[1], args.in[2], args.in[13], args.in[10], args.in[11], args.in[12], args.in[14], args.in[15]); }
    SEAM(0);
    if (IN(1)) {
        pg8::Gemm g{(const bf16_t*)(F.ws + WS_XB), (const bf16_t*)(F.ws + WS_WIN), T, NPROJ, D}; pg8::StaticOrder S; S.init(T, NPROJ, F.G, F.bid);
        pg8::EpiProj E{(bf16_t*)(F.ws + WS_GQ), (bf16_t*)(F.ws + WS_GK), (bf16_t*)(F.ws + WS_GV), (bf16_t*)(F.ws + WS_GR), (bf16_t*)(F.ws + WS_SQ), (bf16_t*)(F.ws + WS_SK), (bf16_t*)(F.ws + WS_SV),
                       (bf16_t*)F.out, (bf16_t*)F.out + (size_t)T * D, (const float*)(F.ws + WS_RSTD1)};
        pg8::gemm_phase<pg8::EpiProj, pg8::StaticOrder, PG8_ALIGN, PG8_SP2>(F.lds, g, S, E);
    }
    SEAM(1);
    if (IN(2)) { gla_local_phase(F, args.in[3], args.in[4]); }
    SEAM(2);
    if (IN(3)) { gla_scan_phase(F); expert_convert(F, args.in[16], args.in[17], args.in[13]); swa_phase(F, args.in[6], args.in[7], args.in[8], args.in[9], (size_t)0); }
    SEAM(3);
    if (IN(4)) { gla_out_phase(F, args.in[3], args.in[4], args.in[5]); }
    SEAM(4);
    if (IN(5)) {
        pg8::PairOrder S; S.base.init(T, D, F.G, F.bid);
        pg8::Gemm g{(const bf16_t*)(F.ws + WS_YG), (const bf16_t*)(F.ws + WS_WG), T, D, D, (const bf16_t*)(F.ws + WS_SQ), (const bf16_t*)(F.ws + WS_WS)};
        pg8::EpiMergeBoth E{{(const bf16_t*)F.out, (const bf16_t*)F.out + (size_t)T * D, (bf16_t*)(F.ws + WS_MRG)}, {(const bf16_t*)F.out, (const bf16_t*)F.out + (size_t)T * D, (bf16_t*)(F.ws + WS_MRG)}};
        pg8::gemm_phase<pg8::EpiMergeBoth, pg8::PairOrder, PG8_ALIGN, PG8_SP2>(F.lds, g, S, E);
    }
    SEAM(5);
    if (IN(6)) {
        pg8::StaticOrder S; S.init(T, D, F.G, F.bid);
        pg8::Gemm g{(const bf16_t*)(F.ws + WS_MRG), (const bf16_t*)(F.ws + WS_WO), T, D, D};
        pg8::EpiOut E{(const bf16_t*)(F.ws + WS_XB), F.out, (bf16_t*)(F.ws + WS_HB2), (float*)(F.ws + WS_ROWSS2), T};
        pg8::gemm_phase<pg8::EpiOut, pg8::StaticOrder, PG8_ALIGN, PG8_SP2>(F.lds, g, S, E);
    }
    SEAM(6);
    if (IN(7)) {
        pg8::StaticOrder S; S.init(T, 2048, F.G, F.bid);
        pg8::Gemm g{(const bf16_t*)(F.ws + WS_HB2), (const bf16_t*)(F.ws + WS_WQ), T, 2048, D};
        pg8::EpiQ E{(const float*)(F.ws + WS_ROWSS2), (bf16_t*)(F.ws + WS_QP), T};
        pg8::gemm_phase<pg8::EpiQ, pg8::StaticOrder, PG8_ALIGN, PG8_SP2>(F.lds, g, S, E);
    }
    if (IN(7) && IN(8)) __syncthreads();
    if (IN(8)) {
        { const float* ROWSS = (const float*)(F.ws + WS_ROWSS2); float* RSTD2 = (float*)(F.ws + WS_RSTD2);
          for (int t = F.bid * NTHR + F.tid; t < T; t += F.G * NTHR) { float s = 0.f;
#pragma unroll
              for (int kk = 0; kk < 4; ++kk) { const f32x4 p4 = *(const f32x4*)(ROWSS + (size_t)t * 16 + 4 * kk); s += (p4.x + p4.y) + (p4.z + p4.w); }
              wt_st4(RSTD2 + t, rsqrtf(s * (1.f / 1024.f) + EPS)); } }
        peer_quant_phase(F);
        peer_topk_phase(F);
    }
    SEAM(8);
    if (IN(9)) { peer_down_phase(F); }
    SEAM(9);
    if (IN(10)) { peer_combine_phase(F); }
    SEAM(10);
    if (IN(11)) { peer_up_phase(F, F.out); }
#undef IN
#undef SEAM
}
}

extern "C" void kernel_launch(void* const* d_in, const int* in_sizes, int n_in, void* d_out, int out_size, void* d_ws, size_t ws_size, hipStream_t stream) {
    using namespace mk;
    static int grid = 0;
    if (grid == 0) {
        int dev_ = 0, cus = 0, per_cu = 0;
        if (hipGetDevice(&dev_) != hipSuccess || hipDeviceGetAttribute(&cus, hipDeviceAttributeMultiprocessorCount, dev_) != hipSuccess) { fprintf(stderr, "device query failed\n"); grid = -1; return; }
        if (hipFuncSetAttribute((const void*)mega, hipFuncAttributeMaxDynamicSharedMemorySize, LDS_BYTES) != hipSuccess) { fprintf(stderr, "hipFuncSetAttribute failed\n"); grid = -1; return; }
        if (hipOccupancyMaxActiveBlocksPerMultiprocessor(&per_cu, (const void*)mega, NTHR, LDS_BYTES) != hipSuccess || per_cu < 1) { fprintf(stderr, "occupancy query: %d\n", per_cu); per_cu = 1; }
        (void)hipGetLastError();
        grid = cus * 1;
        fprintf(stderr, "mega: cus %d per_cu %d grid %d\n", cus, per_cu, grid);
    }
    if (grid < 0) return;
    (void)hipMemsetAsync((char*)d_ws + WS_CTL, 0, CTL_ZERO_BYTES, stream);
    Args a{};
    for (int i = 0; i < 18; ++i) a.in[i] = (const float*)d_in[i];
    a.out = (float*)d_out; a.ws = (unsigned char*)d_ws; a.ph_lo = 0; a.ph_hi = 12;
    void* kargs[] = {&a};
    hipError_t e = hipLaunchCooperativeKernel((const void*)mega, dim3(grid), dim3(NTHR), kargs, LDS_BYTES, stream);
    if (e != hipSuccess) fprintf(stderr, "cooperative launch failed: %s\n", hipGetErrorString(e));
}
```

```cpp
#include <hip/hip_runtime.h>
#include <hip/hip_cooperative_groups.h>
#include <cstdio>
#include <cstdint>
#include <math.h>
namespace cg = cooperative_groups;
#ifndef WT_AUX
#define WT_AUX 0
#endif
typedef unsigned wt_u32x4 __attribute__((ext_vector_type(4)));
__device__ __forceinline__ __amdgpu_buffer_rsrc_t wt_rsrc(const void* base) { return __builtin_amdgcn_make_buffer_rsrc((void*)base, 0, 0x7FFFFFF0, 0x00020000); }
__device__ __forceinline__ void wt_st16(__amdgpu_buffer_rsrc_t r, unsigned byte_off, wt_u32x4 v) { __builtin_amdgcn_raw_buffer_store_b128(v, r, byte_off, 0, WT_AUX); }
typedef unsigned wt_u32x2 __attribute__((ext_vector_type(2)));
__device__ __forceinline__ void wt_st8(void* p, unsigned lo, unsigned hi) { if (WT_AUX) __hip_atomic_store((unsigned long long*)p, ((unsigned long long)hi << 32) | lo, __ATOMIC_RELAXED, __HIP_MEMORY_SCOPE_AGENT); else *(wt_u32x2*)p = (wt_u32x2){lo, hi}; }
__device__ __forceinline__ void wt_st4(float* p, float v) { if (WT_AUX) __hip_atomic_store(p, v, __ATOMIC_RELAXED, __HIP_MEMORY_SCOPE_AGENT); else *p = v; }
__device__ __forceinline__ void wtx_st16(__amdgpu_buffer_rsrc_t r, unsigned byte_off, wt_u32x4 v) { __builtin_amdgcn_raw_buffer_store_b128(v, r, byte_off, 0, 16); }
__device__ __forceinline__ void wtx_st8(void* p, unsigned lo, unsigned hi) { __hip_atomic_store((unsigned long long*)p, ((unsigned long long)hi << 32) | lo, __ATOMIC_RELAXED, __HIP_MEMORY_SCOPE_AGENT); }
__device__ __forceinline__ void wtx_st4(float* p, float v) { __hip_atomic_store(p, v, __ATOMIC_RELAXED, __HIP_MEMORY_SCOPE_AGENT); }
namespace pg8 {
#define PG8_LAS __attribute__((address_space(3)))
typedef unsigned short bf16_t;
typedef short bf16x8 __attribute__((ext_vector_type(8)));
typedef float f32x4 __attribute__((ext_vector_type(4)));
typedef unsigned u32x4 __attribute__((ext_vector_type(4)));
constexpr int BM = 256, BK = 64, HALF = 128, HTB = HALF * BK * 2  , STAGE_BYTES = 8 * HTB, NXCD = 8, WGM = 8;

__host__ __device__ __forceinline__ int lds_byte(int r, int c) { const int st = (r >> 4) * 2 + (c >> 5), rr = r & 15, cc = c & 31, ob = rr * 64 + cc * 2; return st * 1024 + (ob ^ (((ob >> 9) & 1) << 5)); }
__host__ __device__ __forceinline__ void stage_rc(int b, int& R, int& C) { const int st = b / 1024, sb = b % 1024, swz = sb ^ (((sb >> 9) & 1) << 5); R = (st >> 1) * 16 + swz / 64; C = (st & 1) * 32 + (swz % 64) / 2; }
__host__ __device__ __forceinline__ int perm32(int rho) { const int n = rho >> 4, i = rho & 15; return 8 * (i >> 2) + 4 * n + (i & 3); }

struct Unit { int pm, pn, sel; };
struct Gemm { const bf16_t* A; const bf16_t* Bt; int M, N, K; const bf16_t* A2; const bf16_t* Bt2; };

struct StaticOrder {
    int nM, nN, nwg, G, c;
    __host__ __device__ void init(int M, int N, int G_, int c_) { nM = M / BM; nN = N / BM; nwg = nM * nN; G = G_; c = c_; }
    __host__ __device__ bool next(int i, Unit& u) const {
        const long L = (long)i * G + c; if (L >= nwg) return false;
        int wgid = (int)L; { const int q = nwg / NXCD, r = nwg % NXCD, xcd = wgid % NXCD, off = wgid / NXCD; wgid = (xcd < r ? xcd * (q + 1) : r * (q + 1) + (xcd - r) * q) + off; }
        const int nig = WGM * nN, gid = wgid / nig, fm = gid * WGM, gsz = (nM - fm) < WGM ? (nM - fm) : WGM;
        u.pm = fm + ((wgid % nig) % gsz); u.pn = (wgid % nig) / gsz; u.sel = 0; return true;
    }
    __device__ __forceinline__ void a_ready(const Unit&) const {}
    __device__ __forceinline__ void done(const Unit&) const {}
    __device__ __forceinline__ bool keep(const Unit&) const { return false; }
};

__device__ __forceinline__ unsigned cvt_pk_bf16(float lo, float hi) { unsigned r; asm volatile("v_cvt_pk_bf16_f32 %0, %1, %2" : "=v"(r) : "v"(lo), "v"(hi)); return r; }
typedef float f32x2 __attribute__((ext_vector_type(2)));
__device__ __forceinline__ f32x2 gelu_pk(f32x2 v) {
    const f32x2 av = __builtin_elementwise_abs(v), d = av * 0.2316418882f + 1.0f;
    f32x2 t; t.x = __builtin_amdgcn_rcpf(d.x); t.y = __builtin_amdgcn_rcpf(d.y);
    f32x2 q = t * 0.5307027145f + (-0.7265760135f); q = q * t + 0.7107068705f; q = q * t + (-0.142248368f); q = q * t + 0.127414796f; q = q * t;
    const f32x2 s = (v * v) * (-0.72134752044f);
    f32x2 e; e.x = __builtin_amdgcn_exp2f(s.x); e.y = __builtin_amdgcn_exp2f(s.y);
    const f32x2 m = v * (q * e), r = v - m;
    f32x2 o; o.x = v.x < 0.f ? m.x : r.x; o.y = v.y < 0.f ? m.y : r.y; return o;
}

template <int ACT  > struct EpiBf16 {
    static constexpr bool PERM = true, AFTER_DRAIN = false; static_assert(ACT == 0 || ACT == 1, "EpiBf16: ACT is 0 (none) or 1 (gelu_pk)");
    bf16_t* O; int ldc; const float* bias; int split_cols; size_t split_stride; float scale0;
    __device__ __forceinline__ void operator()(const f32x4 (&acc)[2][2][4][2], const Unit& u, int wr, int wc, int fr, int fq) const {
        const int row0 = u.pm * BM + wr * 64 + fr; int colt = u.pn * BM; bf16_t* base = O;
        float sc = 1.f; if (split_cols) { const int t = colt / split_cols; base += (size_t)t * split_stride; colt -= t * split_cols; if (t == 0) sc = scale0; }
        const int col0 = colt + wc * 32 + 8 * fq, bcol0 = u.pn * BM + wc * 32 + 8 * fq;
        f32x4 bv[2][2];
#pragma unroll
        for (int bj = 0; bj < 2; ++bj)
#pragma unroll
            for (int n = 0; n < 2; ++n) bv[bj][n] = bias ? *(const f32x4*)(bias + bcol0 + bj * HALF + 4 * n) : (f32x4){0.f, 0.f, 0.f, 0.f};
#pragma unroll
        for (int ai = 0; ai < 2; ++ai)
#pragma unroll
            for (int m = 0; m < 4; ++m) { bf16_t* rowp = base + (size_t)(row0 + ai * HALF + m * 16) * ldc + col0;
#pragma unroll
                for (int bj = 0; bj < 2; ++bj) { f32x4 v0 = acc[ai][bj][m][0] + bv[bj][0], v1 = acc[ai][bj][m][1] + bv[bj][1];
                    if (ACT == 1) { f32x2 a = gelu_pk((f32x2){v0[0], v0[1]}), b = gelu_pk((f32x2){v0[2], v0[3]}), c = gelu_pk((f32x2){v1[0], v1[1]}), d = gelu_pk((f32x2){v1[2], v1[3]});
                        v0 = (f32x4){a.x, a.y, b.x, b.y}; v1 = (f32x4){c.x, c.y, d.x, d.y}; }
                    v0 = v0 * sc; v1 = v1 * sc; u32x4 w; w.x = cvt_pk_bf16(v0[0], v0[1]); w.y = cvt_pk_bf16(v0[2], v0[3]); w.z = cvt_pk_bf16(v1[0], v1[1]); w.w = cvt_pk_bf16(v1[2], v1[3]);
                    *(u32x4*)(rowp + bj * HALF) = w; } }
    }
};
__device__ __forceinline__ float sigm_fast(float v) { return __builtin_amdgcn_rcpf(1.0f + __builtin_amdgcn_exp2f(v * -1.4426950408889634f)); }
struct EpiProj {
    static constexpr bool PERM = true, AFTER_DRAIN = false;
    bf16_t *GQ, *GK, *GV, *GR, *SQ, *SK, *SV, *GA, *GB; const float* rstd;
    __device__ __forceinline__ void operator()(const f32x4 (&acc)[2][2][4][2], const Unit& u, int wr, int wc, int fr, int fq) const {
        const int pn = u.pn; bf16_t* base; int ldc, act = 0;
        if (pn < 2) { base = GQ + pn * 256; ldc = 512; }
        else if (pn < 4) { base = GK + (pn - 2) * 256; ldc = 512; }
        else if (pn < 8) { base = GV + (pn - 4) * 256; ldc = 1024; }
        else if (pn < 12) { base = GR + (pn - 8) * 256; ldc = 1024; act = 1; }
        else if (pn < 16) { base = SQ + (pn - 12) * 256; ldc = 1024; }
        else if (pn == 16) { base = SK; ldc = 256; }
        else if (pn == 17) { base = SV; ldc = 256; }
        else if (pn < 22) { base = GA + (pn - 18) * 256; ldc = 1024; act = 2; }
        else { base = GB + (pn - 22) * 256; ldc = 1024; act = 2; }
        const int row0 = u.pm * BM + wr * 64 + fr, col0 = wc * 32 + 8 * fq;
        const __amdgpu_buffer_rsrc_t rs_ = wt_rsrc(base);
#pragma unroll
        for (int ai = 0; ai < 2; ++ai)
#pragma unroll
            for (int m = 0; m < 4; ++m) { const int row = row0 + ai * HALF + m * 16; const float rs = rstd[row]; const unsigned rowoff = (unsigned)(((size_t)row * ldc + col0) * 2);
#pragma unroll
                for (int bj = 0; bj < 2; ++bj) { f32x4 v0 = acc[ai][bj][m][0] * rs, v1 = acc[ai][bj][m][1] * rs;
                    if (act) {
#pragma unroll
                        for (int e = 0; e < 4; ++e) { const float s0 = sigm_fast(v0[e]), s1 = sigm_fast(v1[e]); v0[e] = (act == 1) ? v0[e] * s0 : s0; v1[e] = (act == 1) ? v1[e] * s1 : s1; } }
                    u32x4 w; w.x = cvt_pk_bf16(v0[0], v0[1]); w.y = cvt_pk_bf16(v0[2], v0[3]); w.z = cvt_pk_bf16(v1[0], v1[1]); w.w = cvt_pk_bf16(v1[2], v1[3]);
                    wt_st16(rs_, rowoff + bj * HALF * 2, w); } }
    }
};

__device__ __forceinline__ void bf8_to_f32(const u32x4 raw, float (&f)[8]) {
#pragma unroll
    for (int j = 0; j < 4; ++j) { f[2 * j] = __builtin_bit_cast(float, raw[j] << 16); f[2 * j + 1] = __builtin_bit_cast(float, raw[j] & 0xffff0000u); }
}
template <int STEP> struct EpiMerge {
    static constexpr bool PERM = true, AFTER_DRAIN = false;
    const bf16_t* ga; const bf16_t* gb; bf16_t* outp;
    __device__ __forceinline__ void operator()(f32x4 (&acc)[2][2][4][2], const Unit& u, int wr, int wc, int fr, int fq) const {
        const int row0 = u.pm * BM + wr * 64 + fr, col0 = u.pn * BM + wc * 32 + 8 * fq;
        const __amdgpu_buffer_rsrc_t dst_r = wt_rsrc(outp);
#pragma unroll
        for (int ai = 0; ai < 2; ++ai)
#pragma unroll
            for (int m = 0; m < 4; ++m) { const size_t rb = (size_t)(row0 + ai * HALF + m * 16) * 1024 + col0;
#pragma unroll
                for (int bj = 0; bj < 2; ++bj) { const size_t off = rb + bj * HALF;
                    float b[8]; bf8_to_f32(*(const u32x4*)(gb + off), b);
                    if (STEP == 0) { float a[8]; bf8_to_f32(*(const u32x4*)(ga + off), a);
#pragma unroll
                        for (int e = 0; e < 4; ++e) { acc[ai][bj][m][0][e] *= a[e] * __builtin_amdgcn_rcpf(fmaxf(b[e], 1e-30f)); acc[ai][bj][m][1][e] *= a[4 + e] * __builtin_amdgcn_rcpf(fmaxf(b[4 + e], 1e-30f)); }
                    } else {
                        float v[8];
#pragma unroll
                        for (int e = 0; e < 4; ++e) { v[e] = acc[ai][bj][m][0][e] * fmaxf(b[e], 1e-30f); v[4 + e] = acc[ai][bj][m][1][e] * fmaxf(b[4 + e], 1e-30f); }
                        u32x4 w; w.x = cvt_pk_bf16(v[0], v[1]); w.y = cvt_pk_bf16(v[2], v[3]); w.z = cvt_pk_bf16(v[4], v[5]); w.w = cvt_pk_bf16(v[6], v[7]);
                        wt_st16(dst_r, (unsigned)(off * 2), w); } } }
    }
};
struct EpiOut {
    static constexpr bool PERM = true, AFTER_DRAIN = false;
    const bf16_t* x; float* h1; bf16_t* hb; float* rowss; int M;
    __device__ __forceinline__ void operator()(const f32x4 (&acc)[2][2][4][2], const Unit& u, int wr, int wc, int fr, int fq) const {
        const int row0 = u.pm * BM + wr * 64 + fr, col0 = u.pn * BM + wc * 32 + 8 * fq;
        const __amdgpu_buffer_rsrc_t hb_r = wt_rsrc(hb);
#pragma unroll
        for (int ai = 0; ai < 2; ++ai)
#pragma unroll
            for (int m = 0; m < 4; ++m) { const int row = row0 + ai * HALF + m * 16; const size_t rb = (size_t)row * 1024 + col0; float ss = 0.f;
#pragma unroll
                for (int bj = 0; bj < 2; ++bj) { const size_t off = rb + bj * HALF;
                    const u32x4 xw = *(const u32x4*)(x + off);
                    f32x4 x0, x1; x0[0] = __uint_as_float(xw.x << 16); x0[1] = __uint_as_float(xw.x & 0xffff0000u); x0[2] = __uint_as_float(xw.y << 16); x0[3] = __uint_as_float(xw.y & 0xffff0000u);
                    x1[0] = __uint_as_float(xw.z << 16); x1[1] = __uint_as_float(xw.z & 0xffff0000u); x1[2] = __uint_as_float(xw.w << 16); x1[3] = __uint_as_float(xw.w & 0xffff0000u);
                    const f32x4 v0 = acc[ai][bj][m][0] + x0, v1 = acc[ai][bj][m][1] + x1;
                    u32x4 w; w.x = cvt_pk_bf16(v0[0], v0[1]); w.y = cvt_pk_bf16(v0[2], v0[3]); w.z = cvt_pk_bf16(v1[0], v1[1]); w.w = cvt_pk_bf16(v1[2], v1[3]);
                    wt_st16(hb_r, (unsigned)(off * 2), w);
                    ss += (v0[0] * v0[0] + v0[1] * v0[1]) + (v0[2] * v0[2] + v0[3] * v0[3]) + (v1[0] * v1[0] + v1[1] * v1[1]) + (v1[2] * v1[2] + v1[3] * v1[3]); }
                ss += __shfl_xor(ss, 16); ss += __shfl_xor(ss, 32);
                if (fq == 0) wt_st4(rowss + (size_t)row * 16 + u.pn * 4 + wc, ss); }
    }
};
struct EpiQ {
    static constexpr bool PERM = true, AFTER_DRAIN = false;
    const float* rowss; bf16_t* qp; int M;
    __device__ __forceinline__ void operator()(const f32x4 (&acc)[2][2][4][2], const Unit& u, int wr, int wc, int fr, int fq) const {
        const int row0 = u.pm * BM + wr * 64 + fr, col0 = u.pn * BM + wc * 32 + 8 * fq;
        const __amdgpu_buffer_rsrc_t qp_r = wt_rsrc(qp);
#pragma unroll
        for (int ai = 0; ai < 2; ++ai)
#pragma unroll
            for (int m = 0; m < 4; ++m) { const int row = row0 + ai * HALF + m * 16; float s = 0.f;
#pragma unroll
                for (int k = 0; k < 4; ++k) { const f32x4 p4 = *(const f32x4*)(rowss + (size_t)row * 16 + 4 * k); s += (p4[0] + p4[1]) + (p4[2] + p4[3]); }
                const float rs = rsqrtf(s * (1.f / 1024.f) + 1e-6f);
#pragma unroll
                for (int bj = 0; bj < 2; ++bj) { const f32x4 v0 = acc[ai][bj][m][0] * rs, v1 = acc[ai][bj][m][1] * rs;
                    u32x4 w; w.x = cvt_pk_bf16(v0[0], v0[1]); w.y = cvt_pk_bf16(v0[2], v0[3]); w.z = cvt_pk_bf16(v1[0], v1[1]); w.w = cvt_pk_bf16(v1[2], v1[3]);
                    wt_st16(qp_r, (unsigned)(((size_t)row * 2048 + col0 + bj * HALF) * 2), w); } }
    }
};

struct PairOrder {
    StaticOrder base;
    __device__ bool next(int i, Unit& u) const { const bool ok = base.next(i >> 1, u); u.sel = i & 1; return ok; }
    __device__ __forceinline__ void a_ready(const Unit&) const {}
    __device__ __forceinline__ void done(const Unit&) const {}
    __device__ __forceinline__ bool keep(const Unit& u) const { return u.sel == 0; }
};
struct EpiMergeBoth {
    static constexpr bool PERM = true, AFTER_DRAIN = false;
    EpiMerge<0> e0; EpiMerge<1> e1;
    __device__ __forceinline__ void operator()(f32x4 (&acc)[2][2][4][2], const Unit& u, int wr, int wc, int fr, int fq) const { if (u.sel == 0) e0(acc, u, wr, wc, fr, fq); else e1(acc, u, wr, wc, fr, fq); }
};
template <class Epi, class Sched, bool ALIGN_EPI = false, bool SP2 = false>
__device__ __forceinline__ void gemm_phase(PG8_LAS unsigned char* lds, const Gemm g, const Sched& S, const Epi& E) {
    const int tid = threadIdx.x, wid = __builtin_amdgcn_readfirstlane(tid >> 6), lane = tid & 63, wr = wid >> 2, wc = wid & 3, fr = lane & 15, fq = lane >> 4;
    const int K = g.K, nt = K / BK;
    unsigned voffA[2], voffB[2];
#pragma unroll
    for (int i = 0; i < 2; ++i) { int R, C; stage_rc(tid * 16 + i * 8192, R, C); const int Rb = Epi::PERM ? ((R & ~31) + perm32(R & 31)) : R;
        voffA[i] = (unsigned)(R * K + C) * 2u; voffB[i] = (unsigned)(Rb * K + C) * 2u; }
    const size_t kstep = (size_t)(BK * 2);
    const size_t hstep = (size_t)HALF * K * 2;
    const size_t tstep = 2 * hstep;
    const unsigned ldsw = (unsigned)wid * 1024u;
    const int aoff = lds_byte(wr * 64 + fr, fq * 8), boff = lds_byte(wc * 32 + fr, fq * 8);
#define PG8_SA(b, h) (((b) * 2 + (h)) * HTB)
#define PG8_SB(b, h) ((4 + (b) * 2 + (h)) * HTB)
#define PG8_STAGE(bufoff, gbase, voff) do { _Pragma("unroll") for (int _i = 0; _i < 2; ++_i) \
        __builtin_amdgcn_global_load_lds((const unsigned*)((const char*)(gbase) + (voff)[_i]), (PG8_LAS unsigned*)(lds + (bufoff) + ldsw + _i * 8192), 16, 0, 0); } while (0)
#define PG8_LDA(dst, b, h) do { _Pragma("unroll") for (int m = 0; m < 4; ++m) _Pragma("unroll") for (int k = 0; k < 2; ++k) dst[m][k] = *(const PG8_LAS bf16x8*)(lds + PG8_SA(b, h) + aoff + m * 2048 + k * 1024); } while (0)
#define PG8_LDB(dst, b, h) do { _Pragma("unroll") for (int n = 0; n < 2; ++n) _Pragma("unroll") for (int k = 0; k < 2; ++k) dst[n][k] = *(const PG8_LAS bf16x8*)(lds + PG8_SB(b, h) + boff + n * 2048 + k * 1024); } while (0)
#define PG8_MMA(ai, bj, At, Bt) do { __builtin_amdgcn_s_setprio(1); _Pragma("unroll") for (int m = 0; m < 4; ++m) _Pragma("unroll") for (int n = 0; n < 2; ++n) _Pragma("unroll") for (int k = 0; k < 2; ++k) \
        acc[ai][bj][m][n] = __builtin_amdgcn_mfma_f32_16x16x32_bf16(Bt[n][k], At[m][k], acc[ai][bj][m][n], 0, 0, 0); __builtin_amdgcn_s_setprio(0); } while (0)
#define PG8_WAIT_V(n) asm volatile("s_waitcnt vmcnt(" #n ")" ::: "memory")
#define PG8_WAIT_L(n) asm volatile("s_waitcnt lgkmcnt(" #n ")" ::: "memory")
#define PG8_BAR __builtin_amdgcn_s_barrier()
#define PG8_SCHED __builtin_amdgcn_sched_barrier(0)
    Unit cur, nxt; int ui = 0;
    if (!S.next(0, cur)) return;
    f32x4 acc[2][2][4][2];
#pragma unroll
    for (int a = 0; a < 2; ++a)
#pragma unroll
        for (int b = 0; b < 2; ++b)
#pragma unroll
            for (int m = 0; m < 4; ++m)
#pragma unroll
                for (int n = 0; n < 2; ++n) acc[a][b][m][n] = (f32x4){0.f, 0.f, 0.f, 0.f};
    bf16x8 At[4][2], B0[2][2], B1[2][2];
    const char* cA = (const char*)(cur.sel ? g.A2 : g.A) + (size_t)cur.pm * tstep; const char* cB = (const char*)(cur.sel ? g.Bt2 : g.Bt) + (size_t)cur.pn * tstep;
    S.a_ready(cur);
    if constexpr (SP2) {
        PG8_STAGE(PG8_SB(0, 0), cB, voffB); PG8_STAGE(PG8_SB(0, 1), cB + hstep, voffB); PG8_STAGE(PG8_SA(0, 0), cA, voffA); PG8_STAGE(PG8_SA(0, 1), cA + hstep, voffA);
        if (wr == 1) PG8_BAR;
        PG8_WAIT_V(2); PG8_BAR;
        PG8_STAGE(PG8_SB(1, 0), cB + kstep, voffB); PG8_STAGE(PG8_SA(1, 0), cA + kstep, voffA); PG8_STAGE(PG8_SB(1, 1), cB + hstep + kstep, voffB);
        PG8_WAIT_V(6); PG8_BAR;
    } else {
        PG8_STAGE(PG8_SB(0, 0), cB, voffB); PG8_STAGE(PG8_SA(0, 0), cA, voffA); PG8_STAGE(PG8_SB(0, 1), cB + hstep, voffB); PG8_STAGE(PG8_SA(0, 1), cA + hstep, voffA);
        if (wr == 1) PG8_BAR;
        PG8_WAIT_V(4); PG8_BAR;
        PG8_STAGE(PG8_SB(1, 0), cB + kstep, voffB); PG8_STAGE(PG8_SA(1, 0), cA + kstep, voffA); PG8_STAGE(PG8_SB(1, 1), cB + hstep + kstep, voffB);
        PG8_WAIT_V(6); PG8_BAR;
    }
    for (;;) {
        const bool has_next = S.next(ui + 1, nxt);
        const char* nA = has_next ? (const char*)(nxt.sel ? g.A2 : g.A) + (size_t)nxt.pm * tstep : cA; const char* nB = has_next ? (const char*)(nxt.sel ? g.Bt2 : g.Bt) + (size_t)nxt.pn * tstep : cB;
        for (int t = 0; t < nt; t += 2) {
            const bool last = (t == nt - 2);
            const char* a1 = cA + (size_t)(t + 1) * kstep;
            const char* a2 = last ? nA : cA + (size_t)(t + 2) * kstep; const char* b2 = last ? nB : cB + (size_t)(t + 2) * kstep;
            const char* a3 = a2 + kstep; const char* b3 = b2 + kstep;
            if (last && has_next) S.a_ready(nxt);
            if constexpr (SP2) {
            PG8_LDB(B0, 0, 0); PG8_LDB(B1, 0, 1); PG8_SCHED; PG8_LDA(At, 0, 0); PG8_STAGE(PG8_SA(1, 1), a1 + hstep, voffA);
            PG8_WAIT_V(8); PG8_WAIT_L(0); PG8_BAR; PG8_MMA(0, 0, At, B0); PG8_MMA(0, 1, At, B1); PG8_BAR; PG8_SCHED;
            PG8_LDA(At, 0, 1); PG8_STAGE(PG8_SB(0, 0), b2, voffB); PG8_STAGE(PG8_SB(0, 1), b2 + hstep, voffB); PG8_STAGE(PG8_SA(0, 0), a2, voffA);
            PG8_WAIT_V(8); PG8_WAIT_L(0); PG8_BAR; PG8_MMA(1, 0, At, B0); PG8_MMA(1, 1, At, B1); PG8_BAR; PG8_SCHED;
            PG8_LDB(B0, 1, 0); PG8_LDB(B1, 1, 1); PG8_SCHED; PG8_LDA(At, 1, 0); PG8_STAGE(PG8_SA(0, 1), a2 + hstep, voffA);
            PG8_WAIT_V(8); PG8_WAIT_L(0); PG8_BAR; PG8_MMA(0, 0, At, B0); PG8_MMA(0, 1, At, B1); PG8_BAR; PG8_SCHED;
            PG8_LDA(At, 1, 1); PG8_STAGE(PG8_SB(1, 0), b3, voffB); PG8_STAGE(PG8_SB(1, 1), b3 + hstep, voffB); PG8_STAGE(PG8_SA(1, 0), a3, voffA);
            PG8_WAIT_V(8); PG8_WAIT_L(0); PG8_BAR; PG8_MMA(1, 0, At, B0); PG8_MMA(1, 1, At, B1); PG8_BAR; PG8_SCHED;
            } else {
            PG8_LDB(B0, 0, 0); PG8_SCHED; PG8_LDA(At, 0, 0); PG8_STAGE(PG8_SA(1, 1), a1 + hstep, voffA);
            PG8_WAIT_L(8); PG8_BAR; PG8_WAIT_L(0); PG8_MMA(0, 0, At, B0); PG8_BAR; PG8_SCHED;
            PG8_LDB(B1, 0, 1); PG8_STAGE(PG8_SB(0, 0), b2, voffB);
            PG8_BAR; PG8_WAIT_L(0); PG8_MMA(0, 1, At, B1); PG8_BAR;
            PG8_LDA(At, 0, 1); PG8_STAGE(PG8_SA(0, 0), a2, voffA);
            PG8_BAR; PG8_WAIT_L(0); PG8_MMA(1, 0, At, B0); PG8_BAR; PG8_SCHED;
            PG8_STAGE(PG8_SB(0, 1), b2 + hstep, voffB);
            PG8_WAIT_V(6); PG8_BAR; PG8_MMA(1, 1, At, B1); PG8_BAR;
            PG8_LDB(B0, 1, 0); PG8_SCHED; PG8_LDA(At, 1, 0); PG8_STAGE(PG8_SA(0, 1), a2 + hstep, voffA);
            PG8_WAIT_L(8); PG8_BAR; PG8_WAIT_L(0); PG8_MMA(0, 0, At, B0); PG8_BAR; PG8_SCHED;
            PG8_LDB(B1, 1, 1); PG8_STAGE(PG8_SB(1, 0), b3, voffB);
            PG8_BAR; PG8_WAIT_L(0); PG8_MMA(0, 1, At, B1); PG8_BAR;
            PG8_LDA(At, 1, 1); PG8_STAGE(PG8_SA(1, 0), a3, voffA);
            PG8_BAR; PG8_WAIT_L(0); PG8_MMA(1, 0, At, B0); PG8_BAR; PG8_SCHED;
            PG8_STAGE(PG8_SB(1, 1), b3 + hstep, voffB);
            PG8_WAIT_V(6); PG8_BAR; PG8_MMA(1, 1, At, B1); PG8_BAR;
            }
        }
        if constexpr (ALIGN_EPI) { if (wr == 0) PG8_BAR; }
        if constexpr (!Epi::AFTER_DRAIN) { E(acc, cur, wr, wc, fr, fq); S.done(cur); }
        if (!has_next) break;
        if (!S.keep(cur)) {
#pragma unroll
        for (int a = 0; a < 2; ++a)
#pragma unroll
            for (int b = 0; b < 2; ++b)
#pragma unroll
                for (int m = 0; m < 4; ++m)
#pragma unroll
                    for (int n = 0; n < 2; ++n) acc[a][b][m][n] = (f32x4){0.f, 0.f, 0.f, 0.f};
        }
        cur = nxt; cA = nA; cB = nB; ++ui;
        if constexpr (ALIGN_EPI) { if (wr == 1) PG8_BAR; }
    }
    PG8_WAIT_V(0);
    if constexpr (!ALIGN_EPI) { if (wr == 0) PG8_BAR; }
    PG8_BAR;
    if constexpr (Epi::AFTER_DRAIN) { E.fused(acc, cur, wr, wc, fr, fq, lds, wid, lane); S.done(cur); }
#undef PG8_SA
#undef PG8_SB
#undef PG8_STAGE
#undef PG8_LDA
#undef PG8_LDB
#undef PG8_MMA
#undef PG8_WAIT_V
#undef PG8_WAIT_L
#undef PG8_BAR
#undef PG8_SCHED
}
}
#define PG8_SP2 true
#define PG8_ALIGN true
namespace mk {
using pg8::bf16_t;
#define LAS __attribute__((address_space(3)))
typedef unsigned v4u __attribute__((ext_vector_type(4)));
typedef unsigned v2u __attribute__((ext_vector_type(2)));
typedef float f32x4 __attribute__((ext_vector_type(4)));
typedef float f32x16 __attribute__((ext_vector_type(16)));
typedef short bf16x8 __attribute__((ext_vector_type(8)));
typedef short bf16x4 __attribute__((ext_vector_type(4)));
constexpr int T = 32768, D = 1024, SEQ = 8192, NBATCH = 4, NPROJ = 6656, INW = 6672, C_GA = 3072;
constexpr float EPS = 1e-6f;
constexpr int NWAVES = 8, NTHR = 512;
constexpr int LDS_BYTES = 147456;
constexpr size_t MiB = 1u << 20;
constexpr size_t WS_CTL = 0, CTL_ZERO_BYTES = 1 * MiB;
constexpr size_t WS_RSTD1 = 1 * MiB, WS_ROWSS = WS_RSTD1 + 512 * 1024, WS_ALOW = 2 * MiB, WS_DSC = 4 * MiB, WS_SUBK = 5 * MiB;
constexpr size_t WS_WIN = 8 * MiB, WS_WG = 21 * MiB, WS_WS = 23 * MiB, WS_WO = 25 * MiB, WS_WQ = 27 * MiB;
constexpr size_t WS_XB = 32 * MiB, WS_MERGED = 32 * MiB;
constexpr size_t WS_GQ = 96 * MiB, WS_GK = 128 * MiB, WS_HB = 96 * MiB;
constexpr size_t WS_GV = 160 * MiB, WS_EXD = 160 * MiB, WS_EXU = 192 * MiB;
constexpr size_t WS_GR = 224 * MiB, WS_SQ = 288 * MiB, WS_QP = 224 * MiB;
constexpr size_t WS_SK = 448 * MiB, WS_SV = 464 * MiB,
                  WS_ST = 384 * MiB, WS_IDX = 448 * MiB, WS_GATE = 464 * MiB;
constexpr size_t WS_YG = 448 * MiB, WS_PART = 160 * MiB, WS_MRG = 96 * MiB, WS_HB2 = 160 * MiB, WS_EXD2 = 352 * MiB, WS_EXU2 = 384 * MiB, WS_ROWSS2 = 480 * MiB;

struct Args { const float* in[18]; float* out; unsigned char* ws; int ph_lo, ph_hi; };

__device__ __forceinline__ unsigned f2bf(float f) { unsigned u = __builtin_bit_cast(unsigned, f); return (u + 0x7fffu + ((u >> 16) & 1u)) >> 16; }
typedef float f32x2_t __attribute__((ext_vector_type(2))); typedef __bf16 bf16x2_t __attribute__((ext_vector_type(2)));
__device__ __forceinline__ unsigned pk2(float lo, float hi) { f32x2_t v = {lo, hi}; bf16x2_t b = __builtin_convertvector(v, bf16x2_t); return __builtin_bit_cast(unsigned, b); }
__device__ __forceinline__ float fexp(float x) { return __builtin_amdgcn_exp2f(x * 1.4426950408889634f); }
__device__ __forceinline__ float flog(float x) { return __builtin_amdgcn_logf(x) * 0.6931471805599453f; }
__device__ __forceinline__ float bf2f(unsigned short b) { return __builtin_bit_cast(float, (unsigned)b << 16); }
__device__ __forceinline__ float wave_sum(float v) {
#pragma unroll
    for (int o = 1; o < 64; o <<= 1) v += __shfl_xor(v, o);
    return v;
}
#define LDS_WAIT() asm volatile("s_waitcnt lgkmcnt(0)" ::: "memory")
#define VM_WAIT() asm volatile("s_waitcnt vmcnt(0)" ::: "memory")

struct Frame {
    LAS unsigned char* lds;
    int tid, lane, wave, G, bid;
    float* out; unsigned char* ws;
};

__device__ __forceinline__ void tr_item(const float* __restrict__ W, int ldw, int c0, int K, int nblk, const float* __restrict__ gain, bf16_t* WT, LAS float* scr, int item, int lane) {
    const int kb = item / nblk, nb = item % nblk, k0 = 64 * kb, n0 = 32 * nb;
    const __amdgpu_buffer_rsrc_t wt_r = wt_rsrc(WT);
    const int c = lane & 7;
    f32x4 g0 = {1.f, 1.f, 1.f, 1.f}, g1 = g0;
    if (gain) { g0 = *(const f32x4*)(gain + k0 + 8 * c); g1 = *(const f32x4*)(gain + k0 + 8 * c + 4); }
    float v[32];
    const float* src = W + (size_t)(k0 + (lane >> 5)) * ldw + c0 + n0 + (lane & 31);
#pragma unroll
    for (int i = 0; i < 32; ++i) v[i] = src[(size_t)(2 * i) * ldw];
#pragma unroll
    for (int i = 0; i < 32; ++i) scr[(2 * i + (lane >> 5)) * 33 + (lane & 31)] = v[i];
    LDS_WAIT(); asm volatile("" ::: "memory");
#pragma unroll
    for (int j = 0; j < 4; ++j) { const int n = (lane >> 3) + 8 * j; const LAS float* s = scr + (8 * c) * 33 + n;
        v4u o; o.x = pk2(s[0 * 33] * g0.x, s[1 * 33] * g0.y); o.y = pk2(s[2 * 33] * g0.z, s[3 * 33] * g0.w); o.z = pk2(s[4 * 33] * g1.x, s[5 * 33] * g1.y); o.w = pk2(s[6 * 33] * g1.z, s[7 * 33] * g1.w);
        wt_st16(wt_r, (unsigned)(((size_t)(n0 + n) * K + k0 + 8 * c) * 2), o); }
    LDS_WAIT(); asm volatile("" ::: "memory");
}

__device__ __forceinline__ void p0_prologue(Frame& F, const float* x, const float* gain1, const float* w_in, const float* gain2, const float* wbg, const float* wbs, const float* wout, const float* wq, const float* subk) {
    LAS unsigned char* wb = F.lds;
    LAS float* scr = (LAS float*)(F.lds + 65536 + F.wave * 8704);
    { f32x4 wv[8]; float gk[8];
#pragma unroll
      for (int j = 0; j < 8; ++j) { const int idx = F.tid + NTHR * j, k = idx >> 2; wv[j] = *(const f32x4*)(w_in + (size_t)k * INW + C_GA + 4 * (idx & 3)); gk[j] = gain1[k]; }
#pragma unroll
      for (int j = 0; j < 8; ++j) { const int idx = F.tid + NTHR * j, k = idx >> 2;
#pragma unroll
          for (int e = 0; e < 4; ++e) { const int r = 4 * (idx & 3) + e; const float v = gk[j] * wv[j][e];
              const unsigned h = f2bf(v), l = f2bf(v - __builtin_bit_cast(float, h << 16));
              const int off = (((k >> 5) * 64 + ((k >> 3) & 3) * 16 + r) * 16) + 2 * (k & 7);
              *(LAS unsigned short*)(wb + off) = (unsigned short)h; *(LAS unsigned short*)(wb + 32768 + off) = (unsigned short)l; } } }
    __syncthreads();
    const int gw = F.bid * 4 + (F.wave & 3), NGW = F.G * 4, lane = F.lane;
    bf16_t* XB = (bf16_t*)(F.ws + WS_XB); float* RSTD1 = (float*)(F.ws + WS_RSTD1); float* ALOW = (float*)(F.ws + WS_ALOW);
    const __amdgpu_buffer_rsrc_t xb_r = wt_rsrc(XB);
    if (F.wave < 4) for (int g = gw; g < T / 16; g += NGW) {
        const int m = g * 16 + (lane & 15), q = lane >> 4;
        const float* xr = x + (size_t)m * D + 8 * q;
        f32x4 acc = {0.f, 0.f, 0.f, 0.f}; float ss = 0.f;
        for (int s0 = 0; s0 < 32; s0 += 8) {
            asm volatile("" ::: "memory");
            f32x4 a[8][2];
#pragma unroll
            for (int i = 0; i < 8; ++i) { a[i][0] = *(const f32x4*)(xr + 32 * (s0 + i)); a[i][1] = *(const f32x4*)(xr + 32 * (s0 + i) + 4); }
#pragma unroll
            for (int i = 0; i < 8; ++i) { const f32x4 a0 = a[i][0], a1 = a[i][1];
                ss += ((a0.x * a0.x + a0.y * a0.y) + (a0.z * a0.z + a0.w * a0.w)) + ((a1.x * a1.x + a1.y * a1.y) + (a1.z * a1.z + a1.w * a1.w));
                v4u h; h.x = pk2(a0.x, a0.y); h.y = pk2(a0.z, a0.w); h.z = pk2(a1.x, a1.y); h.w = pk2(a1.z, a1.w);
                wt_st16(xb_r, (unsigned)(((size_t)m * D + 8 * q + 32 * (s0 + i)) * 2), h);
                v4u l;
                l.x = pk2(a0.x - __builtin_bit_cast(float, h.x << 16), a0.y - __builtin_bit_cast(float, h.x & 0xffff0000u));
                l.y = pk2(a0.z - __builtin_bit_cast(float, h.y << 16), a0.w - __builtin_bit_cast(float, h.y & 0xffff0000u));
                l.z = pk2(a1.x - __builtin_bit_cast(float, h.z << 16), a1.y - __builtin_bit_cast(float, h.z & 0xffff0000u));
                l.w = pk2(a1.z - __builtin_bit_cast(float, h.w << 16), a1.w - __builtin_bit_cast(float, h.w & 0xffff0000u));
                const bf16x8 wh = *(const LAS bf16x8*)(wb + ((s0 + i) * 64 + lane) * 16), wl = *(const LAS bf16x8*)(wb + 32768 + ((s0 + i) * 64 + lane) * 16);
                const bf16x8 xh = __builtin_bit_cast(bf16x8, h), xl = __builtin_bit_cast(bf16x8, l);
                acc = __builtin_amdgcn_mfma_f32_16x16x32_bf16(xh, wh, acc, 0, 0, 0);
                acc = __builtin_amdgcn_mfma_f32_16x16x32_bf16(xl, wh, acc, 0, 0, 0);
                acc = __builtin_amdgcn_mfma_f32_16x16x32_bf16(xh, wl, acc, 0, 0, 0); }
        }
        ss += __shfl_xor(ss, 16); ss += __shfl_xor(ss, 32);
        const float rstd = rsqrtf(ss * (1.f / D) + EPS);
#pragma unroll
        for (int i = 0; i < 4; ++i) { const float rs = __shfl(rstd, 4 * q + i); wt_st4(ALOW + (size_t)(g * 16 + 4 * q + i) * 16 + (lane & 15), acc[i] * rs); }
        if (lane < 16) wt_st4(RSTD1 + m, rstd);
    }
    constexpr int I_IN1 = 16 * 96, I_IN2 = 16 * 112, I_SQ = 16 * 32, I_Q = 16 * 64;
    constexpr int NITEMS = I_IN1 + I_IN2 + 3 * I_SQ + I_Q;
    bf16_t* WIN = (bf16_t*)(F.ws + WS_WIN);
    if (F.wave >= 4) for (int it = gw; it < NITEMS; it += NGW) {
        int r = it;
        if (r < I_IN1) { tr_item(w_in, INW, 0, D, 96, gain1, WIN, scr, r, lane); continue; } r -= I_IN1;
        if (r < I_IN2) { tr_item(w_in, INW, 3088, D, 112, gain1, WIN + (size_t)3072 * D, scr, r, lane); continue; } r -= I_IN2;
        if (r < I_SQ) { tr_item(wbg, D, 0, D, 32, nullptr, (bf16_t*)(F.ws + WS_WG), scr, r, lane); continue; } r -= I_SQ;
        if (r < I_SQ) { tr_item(wbs, D, 0, D, 32, nullptr, (bf16_t*)(F.ws + WS_WS), scr, r, lane); continue; } r -= I_SQ;
        if (r < I_SQ) { tr_item(wout, D, 0, D, 32, nullptr, (bf16_t*)(F.ws + WS_WO), scr, r, lane); continue; } r -= I_SQ;
        tr_item(wq, 2048, 0, D, 64, gain2, (bf16_t*)(F.ws + WS_WQ), scr, r, lane);
    }
    { const f32x4* sk = (const f32x4*)subk; v2u* o = (v2u*)(F.ws + WS_SUBK);
      for (int i = F.bid * NTHR + F.tid; i < 8 * 2 * 128 * 128 / 4; i += F.G * NTHR) { const f32x4 v = sk[i]; wt_st8(o + i, pk2(v.x, v.y), pk2(v.z, v.w)); } }
}

constexpr int SWA_KROW = 144, SWA_VROW = 592;
__device__ __forceinline__ unsigned swa_voff(unsigned row, unsigned ch) { return 1024u * (row >> 3) + 512u * (ch >> 2) + 64u * (row & 7) + 16u * ((ch & 3) ^ ((row >> 2) & 3)); }
typedef short swa_v4s __attribute__((ext_vector_type(4)));
__device__ __forceinline__ bf16x8 swa_tr2(const LAS unsigned char* p0, const LAS unsigned char* p1) {
    const swa_v4s x = __builtin_amdgcn_ds_read_tr16_b64_v4i16((LAS swa_v4s*)p0), y = __builtin_amdgcn_ds_read_tr16_b64_v4i16((LAS swa_v4s*)p1);
    return (bf16x8){x[0], x[1], x[2], x[3], y[0], y[1], y[2], y[3]};
}
constexpr int SWA_K_OFF = 0, SWA_V_OFF = 256 * SWA_KROW, SWA_TB_OFF = SWA_V_OFF + 64 * SWA_VROW, SWA_LDS = SWA_TB_OFF + 4 * 128 * 4;
__device__ __forceinline__ int t5_bucket(int rel) {
    if (rel < 16) return rel;
    int b = 16;
    b += (rel >= 19); b += (rel >= 21); b += (rel >= 24); b += (rel >= 27); b += (rel >= 31); b += (rel >= 35); b += (rel >= 40); b += (rel >= 46);
    b += (rel >= 52); b += (rel >= 59); b += (rel >= 67); b += (rel >= 77); b += (rel >= 87); b += (rel >= 99); b += (rel >= 113);
    return b;
}
__device__ __forceinline__ void swa_load_kv(const bf16_t* SK, const bf16_t* SV, int u, int tid, int lane, int wave, v4u (&kraw)[4], v4u (&vraw)[4]) {
    const int blk = u & 63, kvh = (u >> 6) & 3, b = u >> 8; const size_t mrow0 = (size_t)b * SEQ; const int t0 = blk * 128, c = tid & 7;
#pragma unroll
    for (int ps = 0; ps < 4; ++ps) {
        const int kjk = ps * 64 + (tid >> 3), posk = t0 - 128 + kjk; kraw[ps] = (v4u){0u, 0u, 0u, 0u};
        if (posk >= 0) kraw[ps] = *(const v4u*)(SK + (mrow0 + posk) * 256 + kvh * 64 + 8 * c);
        const int kjv = ps * 64 + lane, posv = t0 - 128 + kjv; vraw[ps] = (v4u){0u, 0u, 0u, 0u};
        if (posv >= 0) vraw[ps] = *(const v4u*)(SV + (mrow0 + posv) * 256 + kvh * 64 + 8 * wave);
    }
}
__device__ __forceinline__ void swa_phase(Frame& F, const float* qgain, const float* kgain, const float* sinks, const float* rel_bias, size_t ydelta) {
    const bf16_t* SK = (const bf16_t*)(F.ws + WS_SK); const bf16_t* SV = (const bf16_t*)(F.ws + WS_SV); bf16_t* SQ = (bf16_t*)(F.ws + WS_SQ);
    LAS unsigned char* Kn = F.lds + SWA_K_OFF; LAS unsigned char* Vt = F.lds + SWA_V_OFF; LAS float* tb = (LAS float*)(F.lds + SWA_TB_OFF);
    const int tid = F.tid, lane = F.lane, wave = F.wave, l15 = lane & 15, q4 = lane >> 4;
    if (tid < 256) { *(LAS v4u*)(Vt + swa_voff(256 + (tid >> 3), tid & 7)) = (v4u){0u, 0u, 0u, 0u}; }
    const LAS unsigned char* vb0 = Vt + swa_voff(4 * q4 + (l15 >> 2), (l15 >> 1) & 1) + 8 * (l15 & 1); const LAS unsigned char* vb1 = Vt + swa_voff(4 * q4 + (l15 >> 2), 2 + ((l15 >> 1) & 1)) + 8 * (l15 & 1);
    v4u kraw[4], vraw[4];
    if (F.bid < 1024) swa_load_kv(SK, SV, F.bid, tid, lane, wave, kraw, vraw);
    for (int u = F.bid; u < 1024; u += F.G) {
        const int blk = u & 63, kvh = (u >> 6) & 3, b = u >> 8;
        const size_t mrow0 = (size_t)b * SEQ; const int t0 = blk * 128;
        const int g = wave >> 1, qh = wave & 1, h = kvh * 4 + g;
        v4u qn[2];
        { const bf16_t* qrow = SQ + (mrow0 + t0 + 64 * qh + l15) * 1024 + h * 64; qn[0] = *(const v4u*)(qrow + 8 * q4); qn[1] = *(const v4u*)(qrow + 32 + 8 * q4); }
        __syncthreads();
        { const int c = tid & 7; f32x4 g0 = *(const f32x4*)(kgain + 8 * c), g1 = *(const f32x4*)(kgain + 8 * c + 4);
#pragma unroll
          for (int ps = 0; ps < 4; ++ps) {
              const int kj = ps * 64 + (tid >> 3);
              const v4u raw = kraw[ps];
              float f[8];
#pragma unroll
              for (int j = 0; j < 4; ++j) { f[2 * j] = __builtin_bit_cast(float, raw[j] << 16); f[2 * j + 1] = __builtin_bit_cast(float, raw[j] & 0xffff0000u); }
              float ss = 0.f;
#pragma unroll
              for (int j = 0; j < 8; ++j) ss += f[j] * f[j];
              ss += __shfl_xor(ss, 1); ss += __shfl_xor(ss, 2); ss += __shfl_xor(ss, 4);
              const float r = rsqrtf(ss * (1.f / 64.f) + EPS);
              v4u w; w.x = pk2(f[0] * r * g0.x, f[1] * r * g0.y); w.y = pk2(f[2] * r * g0.z, f[3] * r * g0.w); w.z = pk2(f[4] * r * g1.x, f[5] * r * g1.y); w.w = pk2(f[6] * r * g1.z, f[7] * r * g1.w);
              *(LAS v4u*)(Kn + kj * SWA_KROW + 16 * c) = w;
          } }
#pragma unroll
        for (int ps = 0; ps < 4; ++ps) {
            const int kj = ps * 64 + lane; const v4u raw = vraw[ps];
            *(LAS v4u*)(Vt + swa_voff(kj, wave)) = raw;
        }
        { const int gg = tid >> 7, rel = tid & 127; tb[tid] = rel_bias[t5_bucket(rel) * 16 + kvh * 4 + gg] * 1.4426950408889634f; }
        if (u + F.G < 1024) swa_load_kv(SK, SV, u + F.G, tid, lane, wave, kraw, vraw);
        __syncthreads();
        const float sink = sinks[h] * 1.4426950408889634f;
        float qg[2][8];
#pragma unroll
        for (int ks = 0; ks < 2; ++ks)
#pragma unroll
            for (int j = 0; j < 8; ++j) qg[ks][j] = qgain[32 * ks + 8 * q4 + j] * (0.125f * 1.4426950408889634f);
#pragma unroll 1
        for (int nt = 0; nt < 4; ++nt) {
            const int q0 = 64 * qh + 16 * nt, qi = q0 + l15, kt0 = q0 >> 4;
            bf16_t* qrow = SQ + (mrow0 + t0 + qi) * 1024 + h * 64;
            bf16x8 qf[2];
            { v4u raw[2]; float f[2][8]; float ss = 0.f;
              raw[0] = qn[0]; raw[1] = qn[1];
              if (nt < 3) { const bf16_t* qnx = qrow + 16 * 1024; qn[0] = *(const v4u*)(qnx + 8 * q4); qn[1] = *(const v4u*)(qnx + 32 + 8 * q4); }
#pragma unroll
              for (int ks = 0; ks < 2; ++ks) {
#pragma unroll
                  for (int j = 0; j < 4; ++j) { f[ks][2 * j] = __builtin_bit_cast(float, raw[ks][j] << 16); f[ks][2 * j + 1] = __builtin_bit_cast(float, raw[ks][j] & 0xffff0000u); }
#pragma unroll
                  for (int j = 0; j < 8; ++j) ss += f[ks][j] * f[ks][j]; }
              ss += __shfl_xor(ss, 16); ss += __shfl_xor(ss, 32);
              const float r = rsqrtf(ss * (1.f / 64.f) + EPS);
#pragma unroll
              for (int ks = 0; ks < 2; ++ks) { v4u w;
#pragma unroll
                  for (int j = 0; j < 4; ++j) w[j] = pk2(f[ks][2 * j] * r * qg[ks][2 * j], f[ks][2 * j + 1] * r * qg[ks][2 * j + 1]);
                  qf[ks] = __builtin_bit_cast(bf16x8, w); } }
            f32x4 s[9];
#pragma unroll
            for (int i = 0; i < 9; ++i) { f32x4 acc = (f32x4){0.f, 0.f, 0.f, 0.f};
#pragma unroll
                for (int ks = 0; ks < 2; ++ks) { const bf16x8 a = *(const LAS bf16x8*)(Kn + (16 * (kt0 + i) + l15) * SWA_KROW + (32 * ks + 8 * q4) * 2); acc = __builtin_amdgcn_mfma_f32_16x16x32_bf16(a, qf[ks], acc, 0, 0, 0); }
                s[i] = acc; }
            const int R0 = l15 + 128 - 4 * q4;
            const LAS float* tbp = tb + g * 128 + R0 - 131;
            float mx = -INFINITY;
            if (blk > 0) {
#pragma unroll
                for (int i = 0; i < 9; ++i)
#pragma unroll
                    for (int r = 0; r < 4; ++r) { const int rel = R0 - 16 * i - r; float v = s[i][r] + tbp[131 - 16 * i - r];
                        if (i == 0) v = (rel < 128) ? v : -INFINITY;
                        if (i == 8) v = (rel >= 0) ? v : -INFINITY;
                        s[i][r] = v; mx = fmaxf(mx, v); }
            } else {
#pragma unroll
                for (int i = 0; i < 9; ++i)
#pragma unroll
                    for (int r = 0; r < 4; ++r) { const int kj = 16 * (kt0 + i) + 4 * q4 + r, rel = R0 - 16 * i - r; const bool valid = ((unsigned)rel < 128u) && (kj >= 128);
                        const float v = valid ? s[i][r] + tbp[131 - 16 * i - r] : -INFINITY; s[i][r] = v; mx = fmaxf(mx, v); }
            }
            mx = fmaxf(mx, __shfl_xor(mx, 16)); mx = fmaxf(mx, __shfl_xor(mx, 32)); mx = fmaxf(mx, sink);
            float sum = 0.f;
#pragma unroll
            for (int i = 0; i < 9; ++i)
#pragma unroll
                for (int r = 0; r < 4; ++r) { const float e = __builtin_amdgcn_exp2f(s[i][r] - mx); s[i][r] = e; sum += e; }
            sum += __shfl_xor(sum, 16); sum += __shfl_xor(sum, 32);
            const float inv = 1.0f / (sum + __builtin_amdgcn_exp2f(sink - mx));
            f32x4 o[4];
#pragma unroll
            for (int mt = 0; mt < 4; ++mt) o[mt] = (f32x4){0.f, 0.f, 0.f, 0.f};
#pragma unroll
            for (int kk = 0; kk < 5; ++kk) {
                v4u w; w.x = pk2(s[2 * kk][0], s[2 * kk][1]); w.y = pk2(s[2 * kk][2], s[2 * kk][3]);
                if (kk < 4) { w.z = pk2(s[2 * kk + 1][0], s[2 * kk + 1][1]); w.w = pk2(s[2 * kk + 1][2], s[2 * kk + 1][3]); } else { w.z = 0u; w.w = 0u; }
                const bf16x8 pb = __builtin_bit_cast(bf16x8, w);
#pragma unroll
                for (int mt = 0; mt < 4; ++mt) {
                    const LAS unsigned char* vr = ((mt & 1) ? vb1 : vb0) + 512 * (mt >> 1) + 2048 * (kt0 + 2 * kk);
                    const bf16x8 a = swa_tr2(vr, vr + 2048);
                    o[mt] = __builtin_amdgcn_mfma_f32_16x16x32_bf16(a, pb, o[mt], 0, 0, 0);
                }
            }
#pragma unroll
            for (int mt = 0; mt < 4; ++mt) { v2u w; w.x = pk2(o[mt][0] * inv, o[mt][1] * inv); w.y = pk2(o[mt][2] * inv, o[mt][3] * inv); wt_st8((unsigned char*)(qrow + 16 * mt + 4 * q4) + ydelta, w.x, w.y); }
        }
    }
    __syncthreads();
}

constexpr int GL_AL = 0, GL_QS = 4096, GL_BL = 6144, GL_DEC = 6656, GL_BQ = 8192, GL_QT = 41984, GL_KT = 59392, GL_OB = 8192, GL_KH = 76800, GL_VT = 95232;
constexpr int GL_BQROW = 528, GL_QROW = 272, GL_KHROW = 144, GL_VROW = 144, GL_OBROW = 1040;
__device__ __forceinline__ f32x16 mfma32(bf16x8 a, bf16x8 b, f32x16 c) { return __builtin_amdgcn_mfma_f32_32x32x16_bf16(a, b, c, 0, 0, 0); }
__device__ __forceinline__ bf16x8 pack8(const f32x16& x, int s) {
    v4u w;
    if (s == 0) { w.x = pk2(x[0], x[1]); w.y = pk2(x[2], x[3]); w.z = pk2(x[4], x[5]); w.w = pk2(x[6], x[7]); }
    else { w.x = pk2(x[8], x[9]); w.y = pk2(x[10], x[11]); w.z = pk2(x[12], x[13]); w.w = pk2(x[14], x[15]); }
    return __builtin_bit_cast(bf16x8, w);
}
__device__ __forceinline__ bf16x8 ld2x8(const LAS unsigned char* p) {
    const v2u a0 = *(const LAS v2u*)p, a1 = *(const LAS v2u*)(p + 16);
    return __builtin_bit_cast(bf16x8, (v4u){a0.x, a0.y, a1.x, a1.y});
}
__device__ __forceinline__ void unpack8(const v4u raw, float (&f)[8]) {
#pragma unroll
    for (int j = 0; j < 4; ++j) { f[2 * j] = __builtin_bit_cast(float, raw[j] << 16); f[2 * j + 1] = __builtin_bit_cast(float, raw[j] & 0xffff0000u); }
}
__device__ __forceinline__ unsigned gl_off(unsigned row, unsigned ch) { return 2048u * (row >> 3) + 512u * (ch >> 2) + 64u * (row & 7) + 16u * ((ch & 3) ^ ((row >> 2) & 3)); }
__device__ __forceinline__ unsigned gl_tr_base(unsigned lane, unsigned rb) { const unsigned blk = (lane >> 4) & 1, q = (lane & 15) >> 2, p = lane & 3; return gl_off(rb + q, 2 * blk + (p >> 1)) + 8 * (p & 1); }
typedef short gl_v4s __attribute__((ext_vector_type(4)));
__device__ __forceinline__ bf16x8 gl_tr2(const LAS unsigned char* p0, const LAS unsigned char* p1) {
    const gl_v4s x = __builtin_amdgcn_ds_read_tr16_b64_v4i16((LAS gl_v4s*)p0), y = __builtin_amdgcn_ds_read_tr16_b64_v4i16((LAS gl_v4s*)p1);
    return (bf16x8){x[0], x[1], x[2], x[3], y[0], y[1], y[2], y[3]};
}
__device__ __forceinline__ void gla_load_w(Frame& F, const float* wgu, const float* bgu, int h, bf16x8& whi, bf16x8& wlo, float& bias) {
    const int dn = 32 * (F.wave >> 1) + (F.lane & 31), hh = F.lane >> 5;
    float v[8];
#pragma unroll
    for (int j = 0; j < 8; ++j) v[j] = wgu[(8 * hh + j) * 512 + h * 128 + dn];
    v4u hi, lo;
#pragma unroll
    for (int j = 0; j < 4; ++j) { hi[j] = pk2(v[2 * j], v[2 * j + 1]); lo[j] = pk2(v[2 * j] - __builtin_bit_cast(float, hi[j] << 16), v[2 * j + 1] - __builtin_bit_cast(float, hi[j] & 0xffff0000u)); }
    whi = __builtin_bit_cast(bf16x8, (v4u){hi[0], hi[1], hi[2], hi[3]}); wlo = __builtin_bit_cast(bf16x8, (v4u){lo[0], lo[1], lo[2], lo[3]});
    bias = bgu[h * 128 + dn];
}
template <bool FULL> __device__ __forceinline__ float gla_stage(Frame& F, int h, size_t m0, const bf16x8 whi, const bf16x8 wlo, float bias) {
    const int tid = F.tid, lane = F.lane, wave = F.wave, d = tid & 127;
    LAS unsigned char* L = F.lds;
    const float* ALOW = (const float*)(F.ws + WS_ALOW);
    const bf16_t* GQ = (const bf16_t*)(F.ws + WS_GQ); const bf16_t* GK = (const bf16_t*)(F.ws + WS_GK); const bf16_t* GV = (const bf16_t*)(F.ws + WS_GV);
    __syncthreads();
    { typedef float f32x2 __attribute__((ext_vector_type(2))); ((LAS f32x2*)(L + GL_AL))[tid] = ((const f32x2*)(ALOW + m0 * 16))[tid]; }
    __syncthreads();
    const int mt = wave & 1, nt = wave >> 1, l31 = lane & 31, hh = lane >> 5, dn = 32 * nt + l31;
    float p[16];
    { const LAS f32x4* ap = (const LAS f32x4*)(L + GL_AL + (32 * mt + l31) * 64 + hh * 32);
      const f32x4 a0 = ap[0], a1 = ap[1];
      v4u ah, al;
      ah.x = pk2(a0.x, a0.y); ah.y = pk2(a0.z, a0.w); ah.z = pk2(a1.x, a1.y); ah.w = pk2(a1.z, a1.w);
      al.x = pk2(a0.x - __builtin_bit_cast(float, ah.x << 16), a0.y - __builtin_bit_cast(float, ah.x & 0xffff0000u)); al.y = pk2(a0.z - __builtin_bit_cast(float, ah.y << 16), a0.w - __builtin_bit_cast(float, ah.y & 0xffff0000u));
      al.z = pk2(a1.x - __builtin_bit_cast(float, ah.z << 16), a1.y - __builtin_bit_cast(float, ah.z & 0xffff0000u)); al.w = pk2(a1.z - __builtin_bit_cast(float, ah.w << 16), a1.w - __builtin_bit_cast(float, ah.w & 0xffff0000u));
      f32x16 z;
#pragma unroll
      for (int r = 0; r < 16; ++r) z[r] = 0.f;
      z = mfma32(__builtin_bit_cast(bf16x8, ah), whi, z); z = mfma32(__builtin_bit_cast(bf16x8, al), whi, z); z = mfma32(__builtin_bit_cast(bf16x8, ah), wlo, z);
#pragma unroll
      for (int r = 0; r < 16; ++r) { const float zz = z[r] + bias; p[r] = (fminf(zz, 0.f) - flog(1.f + fexp(-fabsf(zz)))) * (1.f / 16.f); } }
    float base = 0.f;
#pragma unroll
    for (int g4 = 0; g4 < 4; ++g4) {
        p[4 * g4 + 1] += p[4 * g4]; p[4 * g4 + 2] += p[4 * g4 + 1]; p[4 * g4 + 3] += p[4 * g4 + 2];
        const float gt = p[4 * g4 + 3], pt = __shfl_xor(gt, 32), off = base + (hh ? pt : 0.f);
#pragma unroll
        for (int k = 0; k < 4; ++k) p[4 * g4 + k] += off;
        base += gt + pt;
    }
    if (hh == 0) ((LAS float*)(L + GL_QS))[mt * 128 + dn] = base;
    __syncthreads();
    { const float q0 = ((const LAS float*)(L + GL_QS))[dn], q1 = ((const LAS float*)(L + GL_QS))[128 + dn], blast = q0 + q1, offs = mt ? q0 : 0.f;
#pragma unroll
      for (int r = 0; r < 16; ++r) *(LAS float*)(L + GL_BQ + (32 * mt + 8 * (r >> 2) + 4 * hh + (r & 3)) * GL_BQROW + dn * 4) = p[r] + offs;
      if (mt == 0 && hh == 0) { ((LAS float*)(L + GL_BL))[dn] = blast; ((LAS float*)(L + GL_DEC))[dn] = fexp(blast); } }
    __syncthreads();
    {
        const int t = lane, dg = wave; const size_t row = m0 + t;
        float b[16], bl[16];
#pragma unroll
        for (int i = 0; i < 4; ++i) { const f32x4 v = *(const LAS f32x4*)(L + GL_BQ + t * GL_BQROW + dg * 64 + 16 * i); b[4 * i] = v.x; b[4 * i + 1] = v.y; b[4 * i + 2] = v.z; b[4 * i + 3] = v.w;
                                      const f32x4 u = *(const LAS f32x4*)(L + (FULL ? GL_DEC : GL_BL) + dg * 64 + 16 * i); bl[4 * i] = u.x; bl[4 * i + 1] = u.y; bl[4 * i + 2] = u.z; bl[4 * i + 3] = u.w; }
        float kf[16];
        { const v4u* kp = (const v4u*)(GK + row * 512 + h * 128 + 16 * dg); float t0[8], t1[8]; unpack8(kp[0], t0); unpack8(kp[1], t1);
#pragma unroll
          for (int e = 0; e < 8; ++e) { kf[e] = t0[e]; kf[8 + e] = t1[e]; } }
        float kh[16];
        if (FULL) {
            float qf[16];
            { const v4u* qp = (const v4u*)(GQ + row * 512 + h * 128 + 16 * dg); float t0[8], t1[8]; unpack8(qp[0], t0); unpack8(qp[1], t1);
#pragma unroll
              for (int e = 0; e < 8; ++e) { qf[e] = t0[e]; qf[8 + e] = t1[e]; } }
            v4u wq[2], wk[2];
#pragma unroll
            for (int e = 0; e < 16; e += 2) { const float e0 = fexp(b[e]), e1 = fexp(b[e + 1]);
                const float k0 = kf[e] * __builtin_amdgcn_rcpf(e0), k1 = kf[e + 1] * __builtin_amdgcn_rcpf(e1);
                wq[e >> 3][(e & 7) >> 1] = pk2(qf[e] * e0 * 0.08838834764831845f, qf[e + 1] * e1 * 0.08838834764831845f);
                wk[e >> 3][(e & 7) >> 1] = pk2(k0, k1);
                kh[e] = k0 * bl[e]; kh[e + 1] = k1 * bl[e + 1]; }
            *(LAS v4u*)(L + GL_QT + t * GL_QROW + dg * 32) = wq[0]; *(LAS v4u*)(L + GL_QT + t * GL_QROW + dg * 32 + 16) = wq[1];
            *(LAS v4u*)(L + GL_KT + t * GL_QROW + dg * 32) = wk[0]; *(LAS v4u*)(L + GL_KT + t * GL_QROW + dg * 32 + 16) = wk[1];
        } else {
#pragma unroll
            for (int e = 0; e < 16; ++e) kh[e] = kf[e] * fexp(bl[e] - b[e]);
        }
        { v4u k0, k1; k0.x = pk2(kh[0], kh[1]); k0.y = pk2(kh[2], kh[3]); k0.z = pk2(kh[4], kh[5]); k0.w = pk2(kh[6], kh[7]); k1.x = pk2(kh[8], kh[9]); k1.y = pk2(kh[10], kh[11]); k1.z = pk2(kh[12], kh[13]); k1.w = pk2(kh[14], kh[15]);
          *(LAS v4u*)(L + GL_KH + gl_off(t, 2 * dg)) = k0; *(LAS v4u*)(L + GL_KH + gl_off(t, 2 * dg + 1)) = k1; }
#pragma unroll
        for (int i = 0; i < 4; ++i) { const v4u raw = *(const v4u*)(GV + row * 1024 + h * 256 + 32 * wave + 8 * i);
            *(LAS v4u*)(L + GL_VT + (wave >> 2) * 16384 + gl_off(t, 4 * (wave & 3) + i)) = raw; }
    }
    __syncthreads();
    return ((const LAS float*)(L + GL_BL))[d];
}
__device__ __forceinline__ void gla_state_update(Frame& F, f32x16 (&S)[4]) {
    const int lane = F.lane, l31 = lane & 31, hh = lane >> 5; LAS unsigned char* L = F.lds;
    const LAS unsigned char* ka0 = L + GL_KH + gl_tr_base(lane, 8 * hh); const LAS unsigned char* ka1 = L + GL_KH + gl_tr_base(lane, 8 * hh + 4);
    const LAS unsigned char* va0 = ka0 + (GL_VT - GL_KH) + (F.wave >> 2) * 16384 + (F.wave & 3) * 512; const LAS unsigned char* va1 = ka1 + (GL_VT - GL_KH) + (F.wave >> 2) * 16384 + (F.wave & 3) * 512;
#pragma unroll
    for (int dt = 0; dt < 4; ++dt) {
#pragma unroll
        for (int g = 0; g < 4; ++g) { const f32x4 dc = *(const LAS f32x4*)(L + GL_DEC + (32 * dt + 8 * g + 4 * hh) * 4);
            S[dt][4 * g] *= dc.x; S[dt][4 * g + 1] *= dc.y; S[dt][4 * g + 2] *= dc.z; S[dt][4 * g + 3] *= dc.w; }
#pragma unroll
        for (int ks = 0; ks < 4; ++ks) {
            const bf16x8 a = gl_tr2(ka0 + 4096 * ks + 512 * dt, ka1 + 4096 * ks + 512 * dt);
            const bf16x8 b = gl_tr2(va0 + 4096 * ks, va1 + 4096 * ks);
            S[dt] = mfma32(a, b, S[dt]);
        } __builtin_amdgcn_sched_barrier(0);
    }
}
__device__ __forceinline__ void gla_local_phase(Frame& F, const float* wgu, const float* bgu) {
    float* ST = (float*)(F.ws + WS_ST); float* DSC = (float*)(F.ws + WS_DSC);
    const int lane = F.lane, l31 = lane & 31, hh = lane >> 5;
    for (int u = F.bid; u < 512; u += F.G) {
        const int sc = u & 31, bh = u >> 5, b = bh >> 2, h = bh & 3;
        bf16x8 whi, wlo; float bias; gla_load_w(F, wgu, bgu, h, whi, wlo, bias);
        f32x16 S[4];
#pragma unroll
        for (int dt = 0; dt < 4; ++dt)
#pragma unroll
            for (int r = 0; r < 16; ++r) S[dt][r] = 0.f;
        float sumbl = 0.f;
#pragma unroll 1
        for (int c = 0; c < 4; ++c) {
            const size_t m0 = (size_t)b * SEQ + sc * 256 + c * 64;
            sumbl += gla_stage<false>(F, h, m0, whi, wlo, bias);
            gla_state_update(F, S);
        }
        v4u* st8 = (v4u*)ST + (size_t)(bh * 32 + sc) * 4096 + (F.wave * 4 * 64 + lane) * 2;
#pragma unroll
        for (int dt = 0; dt < 4; ++dt)
#pragma unroll
            for (int hf = 0; hf < 2; ++hf) st8[dt * 128 + hf] = (v4u){pk2(S[dt][8 * hf], S[dt][8 * hf + 1]), pk2(S[dt][8 * hf + 2], S[dt][8 * hf + 3]), pk2(S[dt][8 * hf + 4], S[dt][8 * hf + 5]), pk2(S[dt][8 * hf + 6], S[dt][8 * hf + 7])};
        if (F.tid < 128) wt_st4(DSC + (bh * 32 + sc) * 128 + F.tid, fexp(sumbl));
    }
}
__device__ __forceinline__ void gla_scan_phase(Frame& F) {
    v4u* ST8 = (v4u*)(F.ws + WS_ST); const float* DSC = (const float*)(F.ws + WS_DSC);
    for (int idx = F.bid * NTHR + F.tid; idx < 16 * 4096; idx += F.G * NTHR) {
        const int bh = idx >> 12, u8 = idx & 4095, hf = u8 & 1, ln = (u8 >> 1) & 63, dt = (u8 >> 7) & 3, row0 = 32 * dt + 16 * hf + 4 * (ln >> 5);
        float S[8];
#pragma unroll
        for (int e = 0; e < 8; ++e) S[e] = 0.f;
#pragma unroll 8
        for (int sc = 0; sc < 32; ++sc) {
            v4u* p = ST8 + (size_t)(bh * 32 + sc) * 4096 + u8; const v4u raw = *p; float tmp[8]; unpack8(raw, tmp);
            *p = (v4u){pk2(S[0], S[1]), pk2(S[2], S[3]), pk2(S[4], S[5]), pk2(S[6], S[7])};
            const f32x4 d0 = *(const f32x4*)(DSC + (bh * 32 + sc) * 128 + row0), d1 = *(const f32x4*)(DSC + (bh * 32 + sc) * 128 + row0 + 8);
            S[0] = S[0] * d0.x + tmp[0]; S[1] = S[1] * d0.y + tmp[1]; S[2] = S[2] * d0.z + tmp[2]; S[3] = S[3] * d0.w + tmp[3];
            S[4] = S[4] * d1.x + tmp[4]; S[5] = S[5] * d1.y + tmp[5]; S[6] = S[6] * d1.z + tmp[6]; S[7] = S[7] * d1.w + tmp[7];
        }
    }
}
__device__ __forceinline__ void gla_out_phase(Frame& F, const float* wgu, const float* bgu, const float* ogain) {
    const float* ST = (const float*)(F.ws + WS_ST); const bf16_t* GR = (const bf16_t*)(F.ws + WS_GR); const __amdgpu_buffer_rsrc_t gr_r = wt_rsrc(F.ws + WS_YG);
    const int lane = F.lane, l31 = lane & 31, hh = lane >> 5, wave = F.wave; LAS unsigned char* L = F.lds;
    const LAS unsigned char* pv0 = L + GL_VT + (wave >> 2) * 16384 + (wave & 3) * 512 + gl_tr_base(lane, 4 * hh); const LAS unsigned char* pv1 = L + GL_VT + (wave >> 2) * 16384 + (wave & 3) * 512 + gl_tr_base(lane, 4 * hh + 8);
    for (int u = F.bid; u < 512; u += F.G) {
        const int sc = u & 31, bh = u >> 5, b = bh >> 2, h = bh & 3;
        bf16x8 whi, wlo; float bias; gla_load_w(F, wgu, bgu, h, whi, wlo, bias);
        f32x16 S[4];
        { const v4u* st8 = (const v4u*)ST + (size_t)(bh * 32 + sc) * 4096 + (wave * 4 * 64 + lane) * 2;
#pragma unroll
          for (int dt = 0; dt < 4; ++dt)
#pragma unroll
              for (int hf = 0; hf < 2; ++hf) { float f[8]; unpack8(st8[dt * 128 + hf], f);
#pragma unroll
                  for (int e = 0; e < 8; ++e) S[dt][8 * hf + e] = f[e]; } }
#pragma unroll 1
        for (int c = 0; c < 4; ++c) {
            const size_t m0 = (size_t)b * SEQ + sc * 256 + c * 64;
            (void)gla_stage<true>(F, h, m0, whi, wlo, bias);
            f32x16 o0, o1;
#pragma unroll
            for (int r = 0; r < 16; ++r) { o0[r] = 0.f; o1[r] = 0.f; }
#pragma unroll
            for (int dt = 0; dt < 4; ++dt)
#pragma unroll
                for (int s = 0; s < 2; ++s) {
                    const bf16x8 bs = pack8(S[dt], s);
                    const int ko = (32 * dt + 16 * s + 4 * hh) * 2;
                    o0 = mfma32(ld2x8(L + GL_QT + l31 * GL_QROW + ko), bs, o0);
                    o1 = mfma32(ld2x8(L + GL_QT + (32 + l31) * GL_QROW + ko), bs, o1);
                }
            __builtin_amdgcn_sched_barrier(0);
#pragma unroll
            for (int tile = 0; tile < 3; ++tile) {
                const int jt = (tile == 2) ? 1 : 0, it = (tile == 0) ? 0 : 1;
                f32x16 p;
#pragma unroll
                for (int r = 0; r < 16; ++r) p[r] = 0.f;
#pragma unroll
                for (int ks = 0; ks < 8; ++ks) {
                    const int ko = (16 * ks + 8 * hh) * 2;
                    const bf16x8 a = *(const LAS bf16x8*)(L + GL_KT + (32 * jt + l31) * GL_QROW + ko);
                    const bf16x8 b = *(const LAS bf16x8*)(L + GL_QT + (32 * it + l31) * GL_QROW + ko);
                    p = mfma32(a, b, p);
                }
                if (jt == it) {
#pragma unroll
                    for (int r = 0; r < 16; ++r) { const int j = (r & 3) + 8 * (r >> 2) + 4 * hh; p[r] = (j > l31) ? 0.f : p[r]; }
                }
#pragma unroll
                for (int s = 0; s < 2; ++s) {
                    const bf16x8 bv = gl_tr2(pv0 + 8192 * jt + 4096 * s, pv1 + 8192 * jt + 4096 * s);
                    if (it == 0) o0 = mfma32(pack8(p, s), bv, o0); else o1 = mfma32(pack8(p, s), bv, o1);
                }
                __builtin_amdgcn_sched_barrier(0);
            }
            gla_state_update(F, S);
            __syncthreads();
#pragma unroll
            for (int r = 0; r < 16; ++r) { const int i = (r & 3) + 8 * (r >> 2) + 4 * hh;
                *(LAS float*)(L + GL_OB + i * GL_OBROW + (32 * wave + l31) * 4) = o0[r]; *(LAS float*)(L + GL_OB + (32 + i) * GL_OBROW + (32 * wave + l31) * 4) = o1[r]; }
            __syncthreads();
            {
                const int t = F.tid >> 3, part = F.tid & 7;
                float v[32]; float ss = 0.f;
#pragma unroll
                for (int i = 0; i < 8; ++i) { const f32x4 x = *(const LAS f32x4*)(L + GL_OB + t * GL_OBROW + (32 * part + 4 * i) * 4); v[4 * i] = x.x; v[4 * i + 1] = x.y; v[4 * i + 2] = x.z; v[4 * i + 3] = x.w; ss += (x.x * x.x + x.y * x.y) + (x.z * x.z + x.w * x.w); }
                ss += __shfl_xor(ss, 1); ss += __shfl_xor(ss, 2); ss += __shfl_xor(ss, 4);
                const float rstd = rsqrtf(ss * (1.f / 256.f) + EPS);
                const bf16_t* gp = GR + (m0 + t) * 1024 + h * 256 + 32 * part;
#pragma unroll
                for (int i = 0; i < 4; ++i) { const v4u raw = *(const v4u*)(gp + 8 * i); float rr[8]; unpack8(raw, rr);
                    const f32x4 g0 = *(const f32x4*)(ogain + 32 * part + 8 * i), g1 = *(const f32x4*)(ogain + 32 * part + 8 * i + 4);
                    v4u o; o.x = pk2(v[8 * i] * rstd * g0.x * rr[0], v[8 * i + 1] * rstd * g0.y * rr[1]); o.y = pk2(v[8 * i + 2] * rstd * g0.z * rr[2], v[8 * i + 3] * rstd * g0.w * rr[3]);
                    o.z = pk2(v[8 * i + 4] * rstd * g1.x * rr[4], v[8 * i + 5] * rstd * g1.y * rr[5]); o.w = pk2(v[8 * i + 6] * rstd * g1.z * rr[6], v[8 * i + 7] * rstd * g1.w * rr[7]);
                    wt_st16(gr_r, (unsigned)(((m0 + t) * 1024 + h * 256 + 32 * part + 8 * i) * 2), o); }
            }
        }
    }
    __syncthreads();
}

constexpr int PK_KROW = 272, PK_K_OFF = 0, PK_SCR_OFF = 2 * 128 * PK_KROW;
__device__ __forceinline__ void ce(unsigned& a, unsigned& b) { const unsigned mx = a > b ? a : b, mn = a > b ? b : a; a = mx; b = mn; }
template <int N> __device__ __forceinline__ void bitonic_sort_desc(unsigned (&x)[N]) {
#pragma unroll
    for (int k = 2; k <= N; k <<= 1)
#pragma unroll
        for (int j = k >> 1; j > 0; j >>= 1)
#pragma unroll
            for (int i = 0; i < N; ++i) { const int l = i ^ j; if (l > i) { if ((i & k) == 0) ce(x[i], x[l]); else ce(x[l], x[i]); } }
}
__device__ __forceinline__ void sort16_desc(unsigned (&x)[16]) {
    ce(x[0], x[13]); ce(x[1], x[12]); ce(x[2], x[15]); ce(x[3], x[14]); ce(x[4], x[8]); ce(x[5], x[6]); ce(x[7], x[11]); ce(x[9], x[10]); ce(x[0], x[5]); ce(x[1], x[7]); ce(x[2], x[9]); ce(x[3], x[4]); ce(x[6], x[13]); ce(x[8], x[14]); ce(x[10], x[15]); ce(x[11], x[12]); ce(x[0], x[1]); ce(x[2], x[3]); ce(x[4], x[5]); ce(x[6], x[8]); ce(x[7], x[9]); ce(x[10], x[11]); ce(x[12], x[13]); ce(x[14], x[15]); ce(x[0], x[2]); ce(x[1], x[3]); ce(x[4], x[10]); ce(x[5], x[11]); ce(x[6], x[7]); ce(x[8], x[9]); ce(x[12], x[14]); ce(x[13], x[15]); ce(x[1], x[2]); ce(x[3], x[12]); ce(x[4], x[6]); ce(x[5], x[7]); ce(x[8], x[10]); ce(x[9], x[11]); ce(x[13], x[14]); ce(x[1], x[4]); ce(x[2], x[6]); ce(x[5], x[8]); ce(x[7], x[10]); ce(x[9], x[13]); ce(x[11], x[14]); ce(x[2], x[4]); ce(x[3], x[6]); ce(x[9], x[12]); ce(x[11], x[13]); ce(x[3], x[5]); ce(x[6], x[8]); ce(x[7], x[9]); ce(x[10], x[12]); ce(x[3], x[4]); ce(x[5], x[6]); ce(x[7], x[8]); ce(x[9], x[10]); ce(x[11], x[12]); ce(x[6], x[7]); ce(x[8], x[9]);
}
__device__ __forceinline__ void merge16(unsigned (&a)[16], const unsigned (&b)[16]) {
#pragma unroll
    for (int i = 0; i < 16; ++i) a[i] = a[i] > b[15 - i] ? a[i] : b[15 - i];
#pragma unroll
    for (int j = 8; j > 0; j >>= 1)
#pragma unroll
        for (int i = 0; i < 16; ++i) { const int l = i ^ j; if (l > i) ce(a[i], a[l]); }
}
__device__ __forceinline__ void merge16_partner(unsigned (&a)[16]) {
    unsigned b[16];
#pragma unroll
    for (int i = 0; i < 16; ++i) b[i] = (unsigned)__shfl_xor((int)a[i], 32);
    merge16(a, b);
}
__device__ __forceinline__ unsigned f2key(float f) { const unsigned u = __builtin_bit_cast(unsigned, f); return u ^ ((unsigned)((int)u >> 31) | 0x80000000u); }
__device__ __forceinline__ float key2f(unsigned k) { const unsigned m = ~(unsigned)((int)k >> 31) | 0x80000000u; return __builtin_bit_cast(float, k ^ m); }
__device__ constexpr int PEER_CI[50] = {0,0,0,0,0,0,0,0,0,0,0,0,0,0,0,0, 1,1,1,1,1,1,1,1, 2,2,2,2,2, 3,3,3,3, 4,4,4, 5,5, 6,6, 7,7, 8,9,10,11,12,13,14,15};
__device__ constexpr int PEER_CJ[50] = {0,1,2,3,4,5,6,7,8,9,10,11,12,13,14,15, 0,1,2,3,4,5,6,7, 0,1,2,3,4, 0,1,2,3, 0,1,2, 0,1, 0,1, 0,1, 0,0,0,0,0,0,0,0};
__device__ __forceinline__ void top16_of_tiles(const f32x16 (&s)[4], int hh, unsigned (&top)[16]) {
#pragma unroll
    for (int mt = 0; mt < 4; ++mt) {
        unsigned g[16];
#pragma unroll
        for (int r = 0; r < 16; ++r) { const unsigned low = (unsigned)(127 - (32 * mt + (r & 3) + 8 * (r >> 2))) - 4u * (unsigned)hh; g[r] = (f2key(s[mt][r]) & ~127u) | low; }
        sort16_desc(g);
        if (mt == 0) {
#pragma unroll
            for (int i = 0; i < 16; ++i) top[i] = g[i];
        } else merge16(top, g);
    }
    merge16_partner(top);
}
__device__ __forceinline__ void peer_topk_phase(Frame& F) {
    const bf16_t* QP = (const bf16_t*)(F.ws + WS_QP); const bf16_t* SUBK = (const bf16_t*)(F.ws + WS_SUBK);
    unsigned short* IDX = (unsigned short*)(F.ws + WS_IDX); float* GATE = (float*)(F.ws + WS_GATE);
    LAS unsigned char* L = F.lds; const int tid = F.tid, lane = F.lane, wave = F.wave, l31 = lane & 31, hh = lane >> 5;
    LAS unsigned* scr = (LAS unsigned*)(L + PK_SCR_OFF + wave * 8192);
    pg8::StaticOrder S; S.init(T, 2048, F.G, F.bid);
    for (int ui = 0; ; ++ui) {
        pg8::Unit un; if (!S.next(ui, un)) break;
        const int h = un.pn, tile = un.pm;
        __syncthreads();
#pragma unroll
        for (int i = 0; i < 8; ++i) { const int v = tid + 512 * i, row = v >> 4, c = v & 15;
            *(LAS v4u*)(L + PK_K_OFF + row * PK_KROW + c * 16) = *(const v4u*)(SUBK + ((size_t)h * 256 + row) * 128 + c * 8); }
        __syncthreads();
        const int tok = tile * 256 + wave * 32 + l31;
        unsigned ka[16], kb[16];
#pragma unroll
        for (int p = 0; p < 2; ++p) {
            f32x16 s[4];
#pragma unroll
            for (int mt = 0; mt < 4; ++mt)
#pragma unroll
                for (int r = 0; r < 16; ++r) s[mt][r] = 0.f;
            const bf16_t* qrow = QP + (size_t)tok * 2048 + h * 256 + p * 128 + 8 * hh;
#pragma unroll
            for (int k2 = 0; k2 < 4; ++k2) {
                const bf16x8 q0 = *(const bf16x8*)(qrow + 32 * k2), q1 = *(const bf16x8*)(qrow + 32 * k2 + 16);
#pragma unroll
                for (int mt = 0; mt < 4; ++mt) { const bf16x8 a = *(const LAS bf16x8*)(L + PK_K_OFF + (p * 128 + 32 * mt + l31) * PK_KROW + (32 * k2 + 8 * hh) * 2); s[mt] = mfma32(a, q0, s[mt]); }
#pragma unroll
                for (int mt = 0; mt < 4; ++mt) { const bf16x8 a = *(const LAS bf16x8*)(L + PK_K_OFF + (p * 128 + 32 * mt + l31) * PK_KROW + (32 * k2 + 16 + 8 * hh) * 2); s[mt] = mfma32(a, q1, s[mt]); }
                __builtin_amdgcn_sched_barrier(0);
            }
            if (p == 0) top16_of_tiles(s, hh, ka); else top16_of_tiles(s, hh, kb);
        }
        float sa[16], sb[16];
#pragma unroll
        for (int i = 0; i < 16; ++i) { sa[i] = key2f(ka[i] & ~127u); sb[i] = key2f(kb[i] & ~127u); scr[i * 64 + lane] = 127u - (ka[i] & 127u); scr[(16 + i) * 64 + lane] = 127u - (kb[i] & 127u); }
        unsigned c0[16], c1[16];
#pragma unroll
        for (int n = 0; n < 32; ++n) {
            unsigned key = 0u;
            if (n < 25) { const int e0 = 2 * n, e1 = 2 * n + 1;
                const float v0 = sa[PEER_CI[e0]] + sb[PEER_CJ[e0]], v1 = sa[PEER_CI[e1]] + sb[PEER_CJ[e1]];
                const unsigned k0 = (f2key(v0) & ~255u) | (unsigned)(255 - (PEER_CI[e0] * 16 + PEER_CJ[e0])), k1 = (f2key(v1) & ~255u) | (unsigned)(255 - (PEER_CI[e1] * 16 + PEER_CJ[e1]));
                key = hh ? k1 : k0; }
            if (n < 16) c0[n] = key; else c1[n - 16] = key;
        }
        sort16_desc(c0); sort16_desc(c1); merge16(c0, c1); merge16_partner(c0);
        float e[16]; float sum = 0.f; const float mx = key2f(c0[0] & ~255u);
#pragma unroll
        for (int n = 0; n < 16; ++n) { e[n] = fexp(key2f(c0[n] & ~255u) - mx); sum += e[n]; }
        const float inv = 1.0f / sum;
        int eo[8]; float go[8];
#pragma unroll
        for (int n = 0; n < 8; ++n) { const unsigned kk = hh ? c0[8 + n] : c0[n]; const unsigned id = 255u - (kk & 255u);
            const unsigned i1 = scr[(id >> 4) * 64 + lane], i2 = scr[(16 + (id & 15)) * 64 + lane];
            eo[n] = (int)(i1 * 128u + i2); go[n] = (hh ? e[8 + n] : e[n]) * inv; }
        typedef int i32x4 __attribute__((ext_vector_type(4)));
        { const __amdgpu_buffer_rsrc_t gr = wt_rsrc(GATE); const unsigned bo = (unsigned)(((size_t)tok * 128 + h * 16 + 8 * hh) * 4);
          wt_st16(gr, bo, __builtin_bit_cast(wt_u32x4, (f32x4){go[0], go[1], go[2], go[3]})); wt_st16(gr, bo + 16, __builtin_bit_cast(wt_u32x4, (f32x4){go[4], go[5], go[6], go[7]}));
          unsigned short* ip = IDX + (size_t)tok * 128 + 2 * h + hh;
#pragma unroll
          for (int n = 0; n < 8; ++n) ip[16 * n] = (unsigned short)eo[n]; }
    }
    __syncthreads();
}
constexpr size_t WS_RSTD2 = 482 * MiB, WS_EXD8 = 352 * MiB, WS_EXU8 = 368 * MiB, WS_ISD = 6 * MiB, WS_ISU = 6 * MiB + 65536, WS_PA = 32 * MiB, WS_WEX = 416 * MiB, WS_AQ = 96 * MiB, WS_ASC = 130 * MiB;
__device__ __forceinline__ float gelu_exact(float x) { return 0.5f * x * (1.f + erff(x * 0.7071067811865476f)); }
__device__ __forceinline__ unsigned pack_i8x4(float a, float b, float c, float d) {
    const int ia = (int)rintf(a), ib = (int)rintf(b), ic = (int)rintf(c), id = (int)rintf(d);
    return ((unsigned)ia & 0xffu) | (((unsigned)ib & 0xffu) << 8) | (((unsigned)ic & 0xffu) << 16) | ((unsigned)id << 24);
}
__device__ __forceinline__ unsigned nib_lo(unsigned w) { return w & 0x0F0F0F0Fu; }
__device__ __forceinline__ unsigned nib_hi(unsigned w) { return ((((w ^ 0x80808080u) + 0x08080808u) >> 4) & 0x0F0F0F0Fu) ^ 0x08080808u; }
__device__ __forceinline__ void peer_quant_phase(Frame& F) {
    const bf16_t* HB = (const bf16_t*)(F.ws + WS_HB2); unsigned char* AQ = F.ws + WS_AQ; float* ASC = (float*)(F.ws + WS_ASC); const int lane = F.lane;
    for (int t = F.bid * NWAVES + F.wave; t < T; t += F.G * NWAVES) {
        const v4u* hp = (const v4u*)(HB + (size_t)t * D + 16 * lane); float a[8], b[8]; unpack8(hp[0], a); unpack8(hp[1], b);
        float mx = 0.f;
#pragma unroll
        for (int j = 0; j < 8; ++j) mx = fmaxf(mx, fmaxf(fabsf(a[j]), fabsf(b[j])));
        mx = fmaxf(mx, __shfl_xor(mx, 1)); mx = fmaxf(mx, __shfl_xor(mx, 2)); mx = fmaxf(mx, __shfl_xor(mx, 4)); mx = fmaxf(mx, __shfl_xor(mx, 8));
        const float sx = mx > 0.f ? 119.f / mx : 1.f, isx = mx > 0.f ? mx * (1.f / 119.f) : 1.f;
        const unsigned w0 = pack_i8x4(a[0] * sx, a[2] * sx, a[4] * sx, a[6] * sx), w1 = pack_i8x4(a[1] * sx, a[3] * sx, a[5] * sx, a[7] * sx);
        const unsigned w2 = pack_i8x4(b[0] * sx, b[2] * sx, b[4] * sx, b[6] * sx), w3 = pack_i8x4(b[1] * sx, b[3] * sx, b[5] * sx, b[7] * sx);
        unsigned char* base = AQ + ((size_t)(t * 4 + (lane >> 4)) * 8 + ((lane & 15) >> 1)) * 32 + (lane & 1) * 8;
        *(v2u*)base = (v2u){nib_hi(w0) | (nib_hi(w1) << 4), nib_hi(w2) | (nib_hi(w3) << 4)};
        *(v2u*)(base + 16) = (v2u){nib_lo(w0) | (nib_lo(w1) << 4), nib_lo(w2) | (nib_lo(w3) << 4)};
        if ((lane & 15) == 0) ASC[t * 4 + (lane >> 4)] = isx;
    }
}
__device__ __forceinline__ void treduce16(float (&p)[16], int lane, int m) {
#pragma unroll
    for (int i = 0; i < 8; ++i) { const bool hi = lane & m; const float send = hi ? p[i] : p[i + 8], keep = hi ? p[i + 8] : p[i]; p[i] = keep + __shfl_xor(send, m); }
#pragma unroll
    for (int i = 0; i < 4; ++i) { const bool hi = lane & (2 * m); const float send = hi ? p[i] : p[i + 4], keep = hi ? p[i + 4] : p[i]; p[i] = keep + __shfl_xor(send, 2 * m); }
#pragma unroll
    for (int i = 0; i < 2; ++i) { const bool hi = lane & (4 * m); const float send = hi ? p[i] : p[i + 2], keep = hi ? p[i + 2] : p[i]; p[i] = keep + __shfl_xor(send, 4 * m); }
}
typedef int i32x4v __attribute__((ext_vector_type(4)));
__device__ __forceinline__ void treduce16i_g(int (&p)[16], int lane) {
#pragma unroll
    for (int i = 0; i < 8; ++i) { const v2u r = __builtin_amdgcn_permlane32_swap((unsigned)p[i], (unsigned)p[i + 8], false, false); p[i] = (int)(r.x + r.y); }
#pragma unroll
    for (int i = 0; i < 4; ++i) { const v2u r = __builtin_amdgcn_permlane16_swap((unsigned)p[i], (unsigned)p[i + 4], false, false); p[i] = (int)(r.x + r.y); }
    const bool hi = lane & 8;
#pragma unroll
    for (int i = 0; i < 2; ++i) { const int send = hi ? p[i] : p[i + 2], keep = hi ? p[i + 2] : p[i]; p[i] = keep + __builtin_amdgcn_update_dpp(0, send, 0x128, 0xF, 0xF, false); }
}
__device__ __forceinline__ void peer_load_ids(const unsigned short* IDX, size_t t, int g, i32x4v (&id)[4]) {
    const v4u* p = (const v4u*)(IDX + t * 128 + g * 16); const v4u a = p[0], b = p[1];
    id[0] = (i32x4v){(int)(a.x & 0xffffu), (int)(a.x >> 16), (int)(a.y & 0xffffu), (int)(a.y >> 16)}; id[1] = (i32x4v){(int)(a.z & 0xffffu), (int)(a.z >> 16), (int)(a.w & 0xffffu), (int)(a.w >> 16)};
    id[2] = (i32x4v){(int)(b.x & 0xffffu), (int)(b.x >> 16), (int)(b.y & 0xffffu), (int)(b.y >> 16)}; id[3] = (i32x4v){(int)(b.z & 0xffffu), (int)(b.z >> 16), (int)(b.w & 0xffffu), (int)(b.w >> 16)};
}
__device__ __forceinline__ void peer_load_w(const bf16_t* WEX, size_t t, int g, v4u (&w)[2]) {
    const v4u* p = (const v4u*)(WEX + t * 128 + g * 16); w[0] = p[0]; w[1] = p[1];
}
__device__ __forceinline__ void peer_v8_lds(LAS unsigned char* scr, unsigned raw, int lane, int grp, v4u (&o)[2]) {
    *(LAS unsigned*)(scr + 4 * lane) = raw; asm volatile("" ::: "memory");
    o[0] = *(const LAS v4u*)(scr + 32 * grp); o[1] = *(const LAS v4u*)(scr + 32 * grp + 16); asm volatile("" ::: "memory");
}
__device__ __forceinline__ void peer_ids_lds(LAS unsigned char* scr, unsigned raw, int lane, i32x4v (&id)[4]) {
    v4u r[2]; peer_v8_lds(scr, raw, lane, lane >> 3, r); const v4u a = r[0], b = r[1];
    id[0] = (i32x4v){(int)(a.x & 0xffffu), (int)(a.x >> 16), (int)(a.y & 0xffffu), (int)(a.y >> 16)}; id[1] = (i32x4v){(int)(a.z & 0xffffu), (int)(a.z >> 16), (int)(a.w & 0xffffu), (int)(a.w >> 16)};
    id[2] = (i32x4v){(int)(b.x & 0xffffu), (int)(b.x >> 16), (int)(b.y & 0xffffu), (int)(b.y >> 16)}; id[3] = (i32x4v){(int)(b.z & 0xffffu), (int)(b.z >> 16), (int)(b.w & 0xffffu), (int)(b.w >> 16)};
}
#ifndef PEER_GATHER_AUX
#define PEER_GATHER_AUX 16
#endif
__device__ __forceinline__ void peer_gather16(v4u (&q)[16], const __amdgpu_buffer_rsrc_t r, unsigned loff, const i32x4v (&id)[4]) {
#pragma unroll
    for (int i = 0; i < 16; ++i) q[i] = __builtin_bit_cast(v4u, __builtin_amdgcn_raw_buffer_load_b128(r, (unsigned)id[i >> 2][i & 3] * 128u + loff, 0, PEER_GATHER_AUX));
}
__device__ __forceinline__ void peer_down_compute(const v4u (&q)[16], const v4u (&aq)[2], float isx, bf16_t* pa, int lane) {
    float p[16];
#pragma unroll
    for (int i = 0; i < 16; ++i) { int ah = __builtin_amdgcn_sdot8((int)q[i][0], (int)aq[0][0], 0, true), al = __builtin_amdgcn_sdot8((int)q[i][0], (int)aq[1][0], 0, true);
#pragma unroll
        for (int j = 1; j < 4; ++j) { ah = __builtin_amdgcn_sdot8((int)q[i][j], (int)aq[0][j], ah, false); al = __builtin_amdgcn_sdot8((int)q[i][j], (int)aq[1][j], al, false); }
        p[i] = (float)(16 * ah + al) * isx; }
    treduce16(p, lane, 1);
    *(unsigned*)(pa + 2 * lane) = pk2(p[0], p[1]);
}
__device__ __forceinline__ void peer_down_phase(Frame& F) {
    const unsigned char* TD = F.ws + WS_EXD8; const unsigned short* IDX = (const unsigned short*)(F.ws + WS_IDX);
    bf16_t* PA = (bf16_t*)(F.ws + WS_PA); const bf16_t* h1 = (const bf16_t*)(F.ws + WS_HB2);
    const unsigned char* AQ = F.ws + WS_AQ; const float* ASC = (const float*)(F.ws + WS_ASC);
    const int lane = F.lane, g = lane >> 3, cl = lane & 7, k = (F.bid & 7) >> 1, nw = (F.G >> 3) * 2 * NWAVES;
    const __amdgpu_buffer_rsrc_t tk = wt_rsrc(TD + (size_t)k * 16384 * 128); const unsigned loff = 16u * (unsigned)cl;
    int t = ((F.bid >> 3) * 2 + (F.bid & 1)) * NWAVES + F.wave;
    if (t >= T) return;
    LAS unsigned char* scrI = F.lds + F.wave * 512; LAS unsigned char* scrA = scrI + 256;
    const unsigned* IDXW = (const unsigned*)IDX + lane; const unsigned* AQW = (const unsigned*)AQ + k * 64 + lane;
    i32x4v id[4];
    unsigned idr = IDXW[(size_t)t * 64];
    peer_ids_lds(scrI, idr, lane, id);
    v4u qa[16], qb[16];
    peer_gather16(qa, tk, loff, id);
    { const int tl = (t + nw < T) ? t + nw : t; idr = IDXW[(size_t)tl * 64]; }
    float hs = ASC[t * 4 + k];
    unsigned aqr = AQW[(size_t)t * 256];
#define PEER_DOWN_STEP(QC, QN) { \
        const int t1 = t + nw, t2 = t + 2 * nw; const bool has1 = t1 < T; \
        peer_ids_lds(scrI, idr, lane, id); \
        if (has1) peer_gather16(QN, tk, loff, id); \
        { const int tl = (t2 < T) ? t2 : t; idr = IDXW[(size_t)tl * 64]; } \
        v4u hv[2]; peer_v8_lds(scrA, aqr, lane, cl, hv); \
        unsigned aqn; float hsn; { const int tl = has1 ? t1 : t; aqn = AQW[(size_t)tl * 256]; hsn = ASC[tl * 4 + k]; } \
        __builtin_amdgcn_sched_barrier(0); \
        peer_down_compute(QC, hv, hs, PA + ((size_t)k * T + t) * 128, lane); \
        __builtin_amdgcn_sched_barrier(0); \
        if (!has1) break; t = t1; aqr = aqn; hs = hsn; }
    for (;;) { PEER_DOWN_STEP(qa, qb) PEER_DOWN_STEP(qb, qa) }
#undef PEER_DOWN_STEP
}
__device__ __forceinline__ void peer_combine_phase(Frame& F) {
    const unsigned* PAW = (const unsigned*)(F.ws + WS_PA); const unsigned* IDXW = (const unsigned*)(F.ws + WS_IDX); const float* GATE = (const float*)(F.ws + WS_GATE);
    const float* ISD = (const float*)(F.ws + WS_ISD); const float* ISU = (const float*)(F.ws + WS_ISU); unsigned* WQ = (unsigned*)(F.ws + WS_WEX); float* WSC = (float*)(F.ws + WS_WEX + 8 * MiB); const float* RSTD2 = (const float*)(F.ws + WS_RSTD2);
    const int lane = F.lane, g = lane >> 3, w = lane & 7, cl = ((w & 1) << 2) | (w & 2) | ((w >> 2) & 1);
    for (int t = F.bid * NWAVES + F.wave; t < T; t += F.G * NWAVES) {
        float a0 = 0.f, a1 = 0.f;
#pragma unroll
        for (int k = 0; k < 4; ++k) { const unsigned r = PAW[((size_t)k * T + t) * 64 + 8 * g + cl]; a0 += __builtin_bit_cast(float, r << 16); a1 += __builtin_bit_cast(float, r & 0xffff0000u); }
        const unsigned idp = IDXW[(size_t)t * 64 + 8 * g + w]; const int id0 = (int)(idp & 0xffffu), id1 = (int)(idp >> 16);
        const float g0 = GATE[(size_t)t * 128 + 16 * w + g], g1 = GATE[(size_t)t * 128 + 16 * w + 8 + g], rs = RSTD2[t];
        const pg8::f32x2 ge = pg8::gelu_pk((pg8::f32x2){a0 * rs * ISD[id0], a1 * rs * ISD[id1]});
        const float w0 = g0 * ge.x * ISU[id0], w1 = g1 * ge.y * ISU[id1];
        float mx = fmaxf(fabsf(w0), fabsf(w1));
#pragma unroll
        for (int o = 1; o < 64; o <<= 1) mx = fmaxf(mx, __shfl_xor(mx, o));
        const float sw = mx > 0.f ? 119.f / mx : 1.f, isw = mx > 0.f ? mx * (1.f / 119.f) : 1.f;
        const unsigned by = ((unsigned)(int)rintf(w0 * sw) & 0xffu) | (((unsigned)(int)rintf(w1 * sw) & 0xffu) << 8);
        const unsigned h = nib_hi(by) & 0x0F0Fu, l = nib_lo(by) & 0x0F0Fu;
        unsigned v0 = (h & 0xFu) << (4 * g), v1 = (l & 0xFu) << (4 * g), v2 = ((h >> 8) & 0xFu) << (4 * g), v3 = ((l >> 8) & 0xFu) << (4 * g);
#pragma unroll
        for (int o = 8; o < 64; o <<= 1) { v0 |= (unsigned)__shfl_xor((int)v0, o); v1 |= (unsigned)__shfl_xor((int)v1, o); v2 |= (unsigned)__shfl_xor((int)v2, o); v3 |= (unsigned)__shfl_xor((int)v3, o); }
        if (g == 0) *(v4u*)(WQ + (size_t)t * 32 + 4 * w) = (v4u){v0, v1, v2, v3};
        if (lane == 0) WSC[t] = isw;
    }
}
constexpr int PU_ROW = 144, PU_BUF = 64 * PU_ROW, PU_OFF = 4096;
typedef int pu_v2i __attribute__((ext_vector_type(2)));
__device__ __forceinline__ void peer_up_compute(const v4u (&q)[16], const LAS unsigned char* scrW, float isw, const unsigned short (&hraw)[4], __amdgpu_buffer_rsrc_t dst_r, unsigned doff, LAS unsigned char* wrb, const LAS unsigned char* trb) {
    int ah[4], al[4];
#pragma unroll
    for (int h = 0; h < 2; ++h) {
#pragma unroll
        for (int ip = 0; ip < 8; ++ip) *(LAS v4u*)(wrb + 8 * PU_ROW * ip) = q[8 * h + ip];
        asm volatile("" ::: "memory");
#pragma unroll
        for (int b = 0; b < 4; ++b) {
            const v4u w4 = *(const LAS v4u*)(scrW + 16 * (4 * h + b));
#pragma unroll
            for (int m = 0; m < 4; ++m) {
                const pu_v2i d = __builtin_amdgcn_ds_read_tr4_b64_v2i32((LAS pu_v2i*)(trb + 16 * PU_ROW * b + 32 * m));
                if (h == 0 && b == 0) { ah[m] = __builtin_amdgcn_sdot8(d.x, (int)w4.x, 0, true); al[m] = __builtin_amdgcn_sdot8(d.x, (int)w4.y, 0, true); }
                else { ah[m] = __builtin_amdgcn_sdot8(d.x, (int)w4.x, ah[m], false); al[m] = __builtin_amdgcn_sdot8(d.x, (int)w4.y, al[m], false); }
                ah[m] = __builtin_amdgcn_sdot8(d.y, (int)w4.z, ah[m], false); al[m] = __builtin_amdgcn_sdot8(d.y, (int)w4.w, al[m], false);
            }
            __builtin_amdgcn_sched_barrier(0);
        }
        asm volatile("" ::: "memory");
    }
#pragma unroll
    for (int m = 0; m < 4; ++m) __builtin_amdgcn_raw_buffer_store_b32(__builtin_bit_cast(unsigned, __builtin_bit_cast(float, (unsigned)hraw[m] << 16) + (float)(16 * ah[m] + al[m]) * isw), dst_r, doff + 256u * m, 0, 0);
}
__device__ __forceinline__ void peer_up_phase(Frame& F, float* dst) {
    const unsigned char* TU = F.ws + WS_EXU8; const unsigned short* IDX = (const unsigned short*)(F.ws + WS_IDX); const bf16_t* WEX = (const bf16_t*)(F.ws + WS_WEX);
    const int lane = F.lane, g = lane >> 3, cl = lane & 7, k = (F.bid & 7) >> 1, nw = (F.G >> 3) * 2 * NWAVES;
    const __amdgpu_buffer_rsrc_t tk = wt_rsrc(TU + (size_t)k * 16384 * 128); const unsigned loff = 16u * (unsigned)cl;
    const int ccol = 256 * k + lane;
    int t = ((F.bid >> 3) * 2 + (F.bid & 1)) * NWAVES + F.wave;
    if (t >= T) return;
    LAS unsigned char* scrI = F.lds + F.wave * 512; LAS unsigned char* scrW = scrI + 256;
    LAS unsigned char* rbuf = F.lds + PU_OFF + F.wave * PU_BUF;
    LAS unsigned char* wrb = rbuf + g * PU_ROW + 16 * cl;
    const LAS unsigned char* trb = rbuf + (lane & 15) * PU_ROW + 8 * (lane >> 4);
    const unsigned* IDXW = (const unsigned*)IDX + lane; const unsigned* WEXW = (const unsigned*)WEX + (lane & 31); const float* WSC = (const float*)(F.ws + WS_WEX + 8 * MiB);
    i32x4v id[4];
    unsigned idr = IDXW[(size_t)t * 64], wr = WEXW[(size_t)t * 32]; float ws = WSC[t];
    peer_ids_lds(scrI, idr, lane, id);
    v4u qa[16], qb[16];
    peer_gather16(qa, tk, loff, id);
    { const int tl = (t + nw < T) ? t + nw : t; idr = IDXW[(size_t)tl * 64]; }
    const __amdgpu_buffer_rsrc_t hb_r = wt_rsrc(F.ws + WS_HB2), dst_r = wt_rsrc(dst);
    unsigned short hcur[4];
#pragma unroll
    for (int m = 0; m < 4; ++m) hcur[m] = __builtin_amdgcn_raw_buffer_load_b16(hb_r, (unsigned)(t * D + ccol) * 2u + 128u * m, 0, 0);
#define PEER_UP_STEP(QC, QN) { \
        const int t1 = t + nw, t2 = t + 2 * nw; const bool has1 = t1 < T; \
        peer_ids_lds(scrI, idr, lane, id); \
        if (has1) peer_gather16(QN, tk, loff, id); \
        { const int tl = (t2 < T) ? t2 : t; idr = IDXW[(size_t)tl * 64]; } \
        const unsigned wrn = WEXW[(size_t)(has1 ? t1 : t) * 32]; const float wsn = WSC[has1 ? t1 : t]; \
        unsigned short hnext[4]; _Pragma("unroll") for (int m = 0; m < 4; ++m) hnext[m] = __builtin_amdgcn_raw_buffer_load_b16(hb_r, (unsigned)((has1 ? t1 : t) * D + ccol) * 2u + 128u * m, 0, 0); \
        *(LAS unsigned*)(scrW + 4 * (lane & 31)) = wr; asm volatile("" ::: "memory"); \
        __builtin_amdgcn_sched_barrier(0); \
        peer_up_compute(QC, scrW, ws, hcur, dst_r, (unsigned)(t * D + ccol) * 4u, wrb, trb); \
        __builtin_amdgcn_sched_barrier(0); \
        if (!has1) break; t = t1; _Pragma("unroll") for (int m = 0; m < 4; ++m) hcur[m] = hnext[m]; wr = wrn; ws = wsn; }
    for (;;) { PEER_UP_STEP(qa, qb) PEER_UP_STEP(qb, qa) }
#undef PEER_UP_STEP
}
__device__ __forceinline__ void expert_convert(Frame& F, const float* exd, const float* exu, const float* gain2) {
    const int lane = F.lane;
    f32x4 gv[4];
#pragma unroll
    for (int j = 0; j < 4; ++j) gv[j] = *(const f32x4*)(gain2 + 16 * lane + 4 * j);
    const bool wsplit = (F.G == 256); const int nscan = 128 * NWAVES;
    int gi = F.bid * NWAVES + F.wave, gstep = F.G * NWAVES, gend = 8192;
    if (wsplit) { gstep = nscan; if (F.bid < 128) { gend = 2 * nscan; } else { gi = 2 * nscan + (F.bid - 128) * NWAVES + F.wave; } }
    for (; gi < gend; gi += gstep) { const int r4 = gi * 4;
        const int tb = r4 >> 14, row0 = r4 & 16383;
        const float* src = (tb ? exu : exd) + (size_t)row0 * D + 16 * lane;
        f32x4 v[4][4]; float mx[4];
#pragma unroll
        for (int r = 0; r < 4; ++r)
#pragma unroll
            for (int j = 0; j < 4; ++j) v[r][j] = *(const f32x4*)(src + (size_t)r * D + 4 * j);
#pragma unroll
        for (int r = 0; r < 4; ++r) { float m = 0.f;
#pragma unroll
            for (int j = 0; j < 4; ++j) { if (tb == 0) v[r][j] = v[r][j] * gv[j]; m = fmaxf(m, fmaxf(fmaxf(fabsf(v[r][j].x), fabsf(v[r][j].y)), fmaxf(fabsf(v[r][j].z), fabsf(v[r][j].w)))); }
            mx[r] = m; }
#pragma unroll
        for (int o = 1; o < 64; o <<= 1)
#pragma unroll
            for (int r = 0; r < 4; ++r) mx[r] = fmaxf(mx[r], __shfl_xor(mx[r], o));
        {
            float ss[4];
#pragma unroll
            for (int r = 0; r < 4; ++r) { float s = 0.f;
#pragma unroll
                for (int j = 0; j < 4; ++j) s += (v[r][j].x * v[r][j].x + v[r][j].y * v[r][j].y) + (v[r][j].z * v[r][j].z + v[r][j].w * v[r][j].w);
                ss[r] = s; }
#pragma unroll
            for (int o = 1; o < 64; o <<= 1)
#pragma unroll
                for (int r = 0; r < 4; ++r) ss[r] += __shfl_xor(ss[r], o);
#pragma unroll
            for (int r = 0; r < 4; ++r) {
                const float rms = sqrtf(ss[r] * (1.f / 1024.f)), step = rms > 0.f ? 0.35f * rms : 1.f, sc = 1.f / step;
                f32x4 c[4];
#pragma unroll
                for (int j = 0; j < 4; ++j) { c[j] = v[r][j] * sc; c[j].x = fminf(fmaxf(c[j].x, -7.f), 7.f); c[j].y = fminf(fmaxf(c[j].y, -7.f), 7.f); c[j].z = fminf(fmaxf(c[j].z, -7.f), 7.f); c[j].w = fminf(fmaxf(c[j].w, -7.f), 7.f); }
                const unsigned x0 = pack_i8x4(c[0].x, c[0].z, c[1].x, c[1].z), y0 = pack_i8x4(c[0].y, c[0].w, c[1].y, c[1].w);
                const unsigned x1 = pack_i8x4(c[2].x, c[2].z, c[3].x, c[3].z), y1 = pack_i8x4(c[2].y, c[2].w, c[3].y, c[3].w);
                *(v2u*)(F.ws + (tb ? WS_EXU8 : WS_EXD8) + ((size_t)(lane >> 4) * 16384 + row0 + r) * 128 + (lane & 15) * 8) = (v2u){nib_lo(x0) | (nib_lo(y0) << 4), nib_lo(x1) | (nib_lo(y1) << 4)};
                if (lane == 0) wt_st4((float*)(F.ws + (tb ? WS_ISU : WS_ISD)) + row0 + r, step);
            }
            continue;
        }
        const __amdgpu_buffer_rsrc_t rr = wt_rsrc(F.ws + (tb ? WS_EXU8 : WS_EXD8));
#pragma unroll
        for (int r = 0; r < 4; ++r) {
            const float sc = mx[r] > 0.f ? 127.f / mx[r] : 1.f, isc = mx[r] > 0.f ? mx[r] * (1.f / 127.f) : 1.f;
            v4u q;
#pragma unroll
            for (int j = 0; j < 4; ++j) q[j] = pack_i8x4(v[r][j].x * sc, v[r][j].y * sc, v[r][j].z * sc, v[r][j].w * sc);
            wt_st16(rr, (unsigned)(((lane >> 3) * 16384 + row0 + r) * 128 + (lane & 7) * 16), q);
            if (lane == 0) wt_st4((float*)(F.ws + (tb ? WS_ISU : WS_ISD)) + row0 + r, isc);
        }
    }
}
#define XB_TMO      128
#define XB_XCNT(j)  (256  + 64 * (j))
#define XB_XSUB(j)  (1280 + 64 * (j))
#define XB_XGEN(j)  (2304 + 64 * (j))
#define XB_TOP      3328
#define XB_TOPGEN   3392
#define XCD_BAR_WORDS 3456
#define XB_SPIN_CAP (1u << 18)

__device__ __forceinline__ unsigned xb_ld(unsigned* p)              { return __hip_atomic_load(p, __ATOMIC_RELAXED, __HIP_MEMORY_SCOPE_AGENT); }
__device__ __forceinline__ unsigned xb_add(unsigned* p, unsigned v) { return __hip_atomic_fetch_add(p, v, __ATOMIC_RELAXED, __HIP_MEMORY_SCOPE_AGENT); }
__device__ __forceinline__ unsigned xb_xcc_id() { return (unsigned)__builtin_amdgcn_s_getreg((3 << 11) | 20) & 0xFu; }
#define XB_SPIN(cond, bar) do { unsigned _sp = 0; while (cond) { __builtin_amdgcn_s_sleep(1); \
    if ((++_sp & 255u) == 0u) { if (xb_ld(&(bar)[XB_TMO])) break; if (_sp > XB_SPIN_CAP) { atomicAdd(&(bar)[XB_TMO], 1u); break; } } } } while (0)

struct XcdBarrier {
    unsigned* bar; unsigned x;
    volatile LAS unsigned* st;
};

__device__ __forceinline__ XcdBarrier xcd_barrier_post(unsigned* bar, volatile LAS unsigned* st) {
    XcdBarrier b; b.bar = bar; b.x = xb_xcc_id(); b.st = st;
    if (threadIdx.x == 0) (void)xb_add(&bar[XB_XCNT(b.x)], 1u);
    return b;
}
__device__ __forceinline__ void xcd_barrier_complete(unsigned* bar, unsigned x, unsigned& nloc, unsigned& nx) {
    const unsigned G = gridDim.x * gridDim.y * gridDim.z;
    unsigned sum, cnt, mine, sp = 0u;
    for (;;) {
        sum = 0u; cnt = 0u; mine = 0u;
#pragma unroll
        for (unsigned j = 0; j < 16; ++j) { const unsigned c = xb_ld(&bar[XB_XCNT(j)]); sum += c; cnt += (c > 0u) ? 1u : 0u; mine = (j == x) ? c : mine; }
        if (sum == G) break;
        __builtin_amdgcn_s_sleep(1);
        if ((++sp & 255u) == 0u) { if (xb_ld(&bar[XB_TMO])) break; if (sp > XB_SPIN_CAP) { atomicAdd(&bar[XB_TMO], 1u); break; } }
    }
    nloc = mine > 0u ? mine : 1u; nx = cnt > 0u ? cnt : 1u;
}

__device__ __forceinline__ void xcd_barrier(const XcdBarrier& b) {
    asm volatile("s_waitcnt vmcnt(0)" ::: "memory");
    __syncthreads();
    if (threadIdx.x == 0) {
        unsigned* bar = b.bar;
        __builtin_amdgcn_s_waitcnt(0);
        unsigned nloc = b.st[0], nx = b.st[1];
        if (nloc == 0u) { xcd_barrier_complete(bar, b.x, nloc, nx); b.st[0] = nloc; b.st[1] = nx; }
        const unsigned old = xb_add(&bar[XB_XSUB(b.x)], 1u);
        const unsigned gen = old / nloc;
        if (old + 1u == (gen + 1u) * nloc) {
            __builtin_amdgcn_fence(__ATOMIC_RELEASE, "agent");
            asm volatile("s_waitcnt vmcnt(0)" ::: "memory");
            const unsigned og = xb_add(&bar[XB_TOP], 1u);
            const unsigned tg = og / nx;
            if (og + 1u == (tg + 1u) * nx) xb_add(&bar[XB_TOPGEN], 1u);
            else XB_SPIN(xb_ld(&bar[XB_TOPGEN]) == tg, bar);
            __builtin_amdgcn_fence(__ATOMIC_ACQUIRE, "agent");
            xb_add(&bar[XB_XGEN(b.x)], 1u);
            asm volatile("s_waitcnt vmcnt(0)" ::: "memory");
        } else {
            XB_SPIN(xb_ld(&bar[XB_XGEN(b.x)]) == gen, bar);
            __builtin_amdgcn_fence(__ATOMIC_ACQUIRE, "agent");
            asm volatile("s_waitcnt vmcnt(0)" ::: "memory");
        }
    }
    __syncthreads();
}

__global__ void __launch_bounds__(NTHR, 2) mega(Args args) {
    extern __shared__ __attribute__((aligned(16))) unsigned char lds_raw[];
    Frame F;
    F.lds = (LAS unsigned char*)lds_raw;
    F.tid = threadIdx.x; F.lane = F.tid & 63; F.wave = __builtin_amdgcn_readfirstlane(F.tid >> 6); F.G = gridDim.x; F.bid = blockIdx.x;
    F.out = args.out; F.ws = args.ws;
    const int lo = args.ph_lo, hi = args.ph_hi;
    cg::grid_group grid = cg::this_grid();
    volatile LAS unsigned* MISC = (volatile LAS unsigned*)(F.lds + LDS_BYTES - 64);
    if (F.tid < 16) MISC[F.tid] = 0u;
    __syncthreads();
    XcdBarrier bar = xcd_barrier_post((unsigned*)(F.ws + WS_CTL) + 4096, MISC + 8);
    if (hi - lo > 1) grid.sync();
#define IN(k) (lo <= (k) && (k) < hi)
#define SEAM(k) do { if (IN(k) && IN((k) + 1)) xcd_barrier(bar); } while (0)
    if (IN(0)) { p0_prologue(F, args.in[0], args.in[1], args.in[2], args.in[13], args.in[10], args.in[11], args.in[12], args.in[14], args.in[15]); }
    SEAM(0);
    if (IN(1)) {
        pg8::Gemm g{(const bf16_t*)(F.ws + WS_XB), (const bf16_t*)(F.ws + WS_WIN), T, NPROJ, D}; pg8::StaticOrder S; S.init(T, NPROJ, F.G, F.bid);
        pg8::EpiProj E{(bf16_t*)(F.ws + WS_GQ), (bf16_t*)(F.ws + WS_GK), (bf16_t*)(F.ws + WS_GV), (bf16_t*)(F.ws + WS_GR), (bf16_t*)(F.ws + WS_SQ), (bf16_t*)(F.ws + WS_SK), (bf16_t*)(F.ws + WS_SV),
                       (bf16_t*)F.out, (bf16_t*)F.out + (size_t)T * D, (const float*)(F.ws + WS_RSTD1)};
        pg8::gemm_phase<pg8::EpiProj, pg8::StaticOrder, PG8_ALIGN, PG8_SP2>(F.lds, g, S, E);
    }
    SEAM(1);
    if (IN(2)) { gla_local_phase(F, args.in[3], args.in[4]); }
    SEAM(2);
    if (IN(3)) { gla_scan_phase(F); expert_convert(F, args.in[16], args.in[17], args.in[13]); swa_phase(F, args.in[6], args.in[7], args.in[8], args.in[9], (size_t)0); }
    SEAM(3);
    if (IN(4)) { gla_out_phase(F, args.in[3], args.in[4], args.in[5]); }
    SEAM(4);
    if (IN(5)) {
        pg8::PairOrder S; S.base.init(T, D, F.G, F.bid);
        pg8::Gemm g{(const bf16_t*)(F.ws + WS_YG), (const bf16_t*)(F.ws + WS_WG), T, D, D, (const bf16_t*)(F.ws + WS_SQ), (const bf16_t*)(F.ws + WS_WS)};
        pg8::EpiMergeBoth E{{(const bf16_t*)F.out, (const bf16_t*)F.out + (size_t)T * D, (bf16_t*)(F.ws + WS_MRG)}, {(const bf16_t*)F.out, (const bf16_t*)F.out + (size_t)T * D, (bf16_t*)(F.ws + WS_MRG)}};
        pg8::gemm_phase<pg8::EpiMergeBoth, pg8::PairOrder, PG8_ALIGN, PG8_SP2>(F.lds, g, S, E);
    }
    SEAM(5);
    if (IN(6)) {
        pg8::StaticOrder S; S.init(T, D, F.G, F.bid);
        pg8::Gemm g{(const bf16_t*)(F.ws + WS_MRG), (const bf16_t*)(F.ws + WS_WO), T, D, D};
        pg8::EpiOut E{(const bf16_t*)(F.ws + WS_XB), F.out, (bf16_t*)(F.ws + WS_HB2), (float*)(F.ws + WS_ROWSS2), T};
        pg8::gemm_phase<pg8::EpiOut, pg8::StaticOrder, PG8_ALIGN, PG8_SP2>(F.lds, g, S, E);
    }
    SEAM(6);
    if (IN(7)) {
        pg8::StaticOrder S; S.init(T, 2048, F.G, F.bid);
        pg8::Gemm g{(const bf16_t*)(F.ws + WS_HB2), (const bf16_t*)(F.ws + WS_WQ), T, 2048, D};
        pg8::EpiQ E{(const float*)(F.ws + WS_ROWSS2), (bf16_t*)(F.ws + WS_QP), T};
        pg8::gemm_phase<pg8::EpiQ, pg8::StaticOrder, PG8_ALIGN, PG8_SP2>(F.lds, g, S, E);
    }
    if (IN(7) && IN(8)) __syncthreads();
    if (IN(8)) {
        { const float* ROWSS = (const float*)(F.ws + WS_ROWSS2); float* RSTD2 = (float*)(F.ws + WS_RSTD2);
          for (int t = F.bid * NTHR + F.tid; t < T; t += F.G * NTHR) { float s = 0.f;
#pragma unroll
              for (int kk = 0; kk < 4; ++kk) { const f32x4 p4 = *(const f32x4*)(ROWSS + (size_t)t * 16 + 4 * kk); s += (p4.x + p4.y) + (p4.z + p4.w); }
              wt_st4(RSTD2 + t, rsqrtf(s * (1.f / 1024.f) + EPS)); } }
        peer_quant_phase(F);
        peer_topk_phase(F);
    }
    SEAM(8);
    if (IN(9)) { peer_down_phase(F); }
    SEAM(9);
    if (IN(10)) { peer_combine_phase(F); }
    SEAM(10);
    if (IN(11)) { peer_up_phase(F, F.out); }
#undef IN
#undef SEAM
}
}

extern "C" void kernel_launch(void* const* d_in, const int* in_sizes, int n_in, void* d_out, int out_size, void* d_ws, size_t ws_size, hipStream_t stream) {
    using namespace mk;
    static int grid = 0;
    if (grid == 0) {
        int dev_ = 0, cus = 0, per_cu = 0;
        if (hipGetDevice(&dev_) != hipSuccess || hipDeviceGetAttribute(&cus, hipDeviceAttributeMultiprocessorCount, dev_) != hipSuccess) { fprintf(stderr, "device query failed\n"); grid = -1; return; }
        if (hipFuncSetAttribute((const void*)mega, hipFuncAttributeMaxDynamicSharedMemorySize, LDS_BYTES) != hipSuccess) { fprintf(stderr, "hipFuncSetAttribute failed\n"); grid = -1; return; }
        if (hipOccupancyMaxActiveBlocksPerMultiprocessor(&per_cu, (const void*)mega, NTHR, LDS_BYTES) != hipSuccess || per_cu < 1) { fprintf(stderr, "occupancy query: %d\n", per_cu); per_cu = 1; }
        (void)hipGetLastError();
        grid = cus * 1;
        fprintf(stderr, "mega: cus %d per_cu %d grid %d\n", cus, per_cu, grid);
    }
    if (grid < 0) return;
    (void)hipMemsetAsync((char*)d_ws + WS_CTL, 0, CTL_ZERO_BYTES, stream);
    Args a{};
    for (int i = 0; i < 18; ++i) a.in[i] = (const float*)d_in[i];
    a.out = (float*)d_out; a.ws = (unsigned char*)d_ws; a.ph_lo = 0; a.ph_hi = 12;
    void* kargs[] = {&a};
    hipError_t e = hipLaunchCooperativeKernel((const void*)mega, dim3(grid), dim3(NTHR), kargs, LDS_BYTES, stream);
    if (e != hipSuccess) fprintf(stderr, "cooperative launch failed: %s\n", hipGetErrorString(e));
}
```

```cpp
#include <hip/hip_runtime.h>
#include <hip/hip_cooperative_groups.h>
#include <cstdio>
#include <cstdint>
#include <math.h>
namespace cg = cooperative_groups;
#ifndef WT_AUX
#define WT_AUX 0
#endif
typedef unsigned wt_u32x4 __attribute__((ext_vector_type(4)));
__device__ __forceinline__ __amdgpu_buffer_rsrc_t wt_rsrc(const void* base) { return __builtin_amdgcn_make_buffer_rsrc((void*)base, 0, 0x7FFFFFF0, 0x00020000); }
__device__ __forceinline__ void wt_st16(__amdgpu_buffer_rsrc_t r, unsigned byte_off, wt_u32x4 v) { __builtin_amdgcn_raw_buffer_store_b128(v, r, byte_off, 0, WT_AUX); }
typedef unsigned wt_u32x2 __attribute__((ext_vector_type(2)));
__device__ __forceinline__ void wt_st8(void* p, unsigned lo, unsigned hi) { if (WT_AUX) __hip_atomic_store((unsigned long long*)p, ((unsigned long long)hi << 32) | lo, __ATOMIC_RELAXED, __HIP_MEMORY_SCOPE_AGENT); else *(wt_u32x2*)p = (wt_u32x2){lo, hi}; }
__device__ __forceinline__ void wt_st4(float* p, float v) { if (WT_AUX) __hip_atomic_store(p, v, __ATOMIC_RELAXED, __HIP_MEMORY_SCOPE_AGENT); else *p = v; }
__device__ __forceinline__ void wtx_st16(__amdgpu_buffer_rsrc_t r, unsigned byte_off, wt_u32x4 v) { __builtin_amdgcn_raw_buffer_store_b128(v, r, byte_off, 0, 16); }
__device__ __forceinline__ void wtx_st8(void* p, unsigned lo, unsigned hi) { __hip_atomic_store((unsigned long long*)p, ((unsigned long long)hi << 32) | lo, __ATOMIC_RELAXED, __HIP_MEMORY_SCOPE_AGENT); }
__device__ __forceinline__ void wtx_st4(float* p, float v) { __hip_atomic_store(p, v, __ATOMIC_RELAXED, __HIP_MEMORY_SCOPE_AGENT); }
namespace pg8 {
#define PG8_LAS __attribute__((address_space(3)))
typedef unsigned short bf16_t;
typedef short bf16x8 __attribute__((ext_vector_type(8)));
typedef float f32x4 __attribute__((ext_vector_type(4)));
typedef unsigned u32x4 __attribute__((ext_vector_type(4)));
constexpr int BM = 256, BK = 64, HALF = 128, HTB = HALF * BK * 2  , STAGE_BYTES = 8 * HTB, NXCD = 8, WGM = 8;

__host__ __device__ __forceinline__ int lds_byte(int r, int c) { const int st = (r >> 4) * 2 + (c >> 5), rr = r & 15, cc = c & 31, ob = rr * 64 + cc * 2; return st * 1024 + (ob ^ (((ob >> 9) & 1) << 5)); }
__host__ __device__ __forceinline__ void stage_rc(int b, int& R, int& C) { const int st = b / 1024, sb = b % 1024, swz = sb ^ (((sb >> 9) & 1) << 5); R = (st >> 1) * 16 + swz / 64; C = (st & 1) * 32 + (swz % 64) / 2; }
__host__ __device__ __forceinline__ int perm32(int rho) { const int n = rho >> 4, i = rho & 15; return 8 * (i >> 2) + 4 * n + (i & 3); }

struct Unit { int pm, pn, sel; };
struct Gemm { const bf16_t* A; const bf16_t* Bt; int M, N, K; const bf16_t* A2; const bf16_t* Bt2; };

struct StaticOrder {
    int nM, nN, nwg, G, c;
    __host__ __device__ void init(int M, int N, int G_, int c_) { nM = M / BM; nN = N / BM; nwg = nM * nN; G = G_; c = c_; }
    __host__ __device__ bool next(int i, Unit& u) const {
        const long L = (long)i * G + c; if (L >= nwg) return false;
        int wgid = (int)L; { const int q = nwg / NXCD, r = nwg % NXCD, xcd = wgid % NXCD, off = wgid / NXCD; wgid = (xcd < r ? xcd * (q + 1) : r * (q + 1) + (xcd - r) * q) + off; }
        const int nig = WGM * nN, gid = wgid / nig, fm = gid * WGM, gsz = (nM - fm) < WGM ? (nM - fm) : WGM;
        u.pm = fm + ((wgid % nig) % gsz); u.pn = (wgid % nig) / gsz; u.sel = 0; return true;
    }
    __device__ __forceinline__ void a_ready(const Unit&) const {}
    __device__ __forceinline__ void done(const Unit&) const {}
    __device__ __forceinline__ bool keep(const Unit&) const { return false; }
};

__device__ __forceinline__ unsigned cvt_pk_bf16(float lo, float hi) { unsigned r; asm volatile("v_cvt_pk_bf16_f32 %0, %1, %2" : "=v"(r) : "v"(lo), "v"(hi)); return r; }
typedef float f32x2 __attribute__((ext_vector_type(2)));
__device__ __forceinline__ f32x2 gelu_pk(f32x2 v) {
    const f32x2 av = __builtin_elementwise_abs(v), d = av * 0.2316418882f + 1.0f;
    f32x2 t; t.x = __builtin_amdgcn_rcpf(d.x); t.y = __builtin_amdgcn_rcpf(d.y);
    f32x2 q = t * 0.5307027145f + (-0.7265760135f); q = q * t + 0.7107068705f; q = q * t + (-0.142248368f); q = q * t + 0.127414796f; q = q * t;
    const f32x2 s = (v * v) * (-0.72134752044f);
    f32x2 e; e.x = __builtin_amdgcn_exp2f(s.x); e.y = __builtin_amdgcn_exp2f(s.y);
    const f32x2 m = v * (q * e), r = v - m;
    f32x2 o; o.x = v.x < 0.f ? m.x : r.x; o.y = v.y < 0.f ? m.y : r.y; return o;
}

template <int ACT  > struct EpiBf16 {
    static constexpr bool PERM = true, AFTER_DRAIN = false; static_assert(ACT == 0 || ACT == 1, "EpiBf16: ACT is 0 (none) or 1 (gelu_pk)");
    bf16_t* O; int ldc; const float* bias; int split_cols; size_t split_stride; float scale0;
    __device__ __forceinline__ void operator()(const f32x4 (&acc)[2][2][4][2], const Unit& u, int wr, int wc, int fr, int fq) const {
        const int row0 = u.pm * BM + wr * 64 + fr; int colt = u.pn * BM; bf16_t* base = O;
        float sc = 1.f; if (split_cols) { const int t = colt / split_cols; base += (size_t)t * split_stride; colt -= t * split_cols; if (t == 0) sc = scale0; }
        const int col0 = colt + wc * 32 + 8 * fq, bcol0 = u.pn * BM + wc * 32 + 8 * fq;
        f32x4 bv[2][2];
#pragma unroll
        for (int bj = 0; bj < 2; ++bj)
#pragma unroll
            for (int n = 0; n < 2; ++n) bv[bj][n] = bias ? *(const f32x4*)(bias + bcol0 + bj * HALF + 4 * n) : (f32x4){0.f, 0.f, 0.f, 0.f};
#pragma unroll
        for (int ai = 0; ai < 2; ++ai)
#pragma unroll
            for (int m = 0; m < 4; ++m) { bf16_t* rowp = base + (size_t)(row0 + ai * HALF + m * 16) * ldc + col0;
#pragma unroll
                for (int bj = 0; bj < 2; ++bj) { f32x4 v0 = acc[ai][bj][m][0] + bv[bj][0], v1 = acc[ai][bj][m][1] + bv[bj][1];
                    if (ACT == 1) { f32x2 a = gelu_pk((f32x2){v0[0], v0[1]}), b = gelu_pk((f32x2){v0[2], v0[3]}), c = gelu_pk((f32x2){v1[0], v1[1]}), d = gelu_pk((f32x2){v1[2], v1[3]});
                        v0 = (f32x4){a.x, a.y, b.x, b.y}; v1 = (f32x4){c.x, c.y, d.x, d.y}; }
                    v0 = v0 * sc; v1 = v1 * sc; u32x4 w; w.x = cvt_pk_bf16(v0[0], v0[1]); w.y = cvt_pk_bf16(v0[2], v0[3]); w.z = cvt_pk_bf16(v1[0], v1[1]); w.w = cvt_pk_bf16(v1[2], v1[3]);
                    *(u32x4*)(rowp + bj * HALF) = w; } }
    }
};
__device__ __forceinline__ float sigm_fast(float v) { return __builtin_amdgcn_rcpf(1.0f + __builtin_amdgcn_exp2f(v * -1.4426950408889634f)); }
struct EpiProj {
    static constexpr bool PERM = true, AFTER_DRAIN = false;
    bf16_t *GQ, *GK, *GV, *GR, *SQ, *SK, *SV, *GA, *GB; const float* rstd;
    __device__ __forceinline__ void operator()(const f32x4 (&acc)[2][2][4][2], const Unit& u, int wr, int wc, int fr, int fq) const {
        const int pn = u.pn; bf16_t* base; int ldc, act = 0;
        if (pn < 2) { base = GQ + pn * 256; ldc = 512; }
        else if (pn < 4) { base = GK + (pn - 2) * 256; ldc = 512; }
        else if (pn < 8) { base = GV + (pn - 4) * 256; ldc = 1024; }
        else if (pn < 12) { base = GR + (pn - 8) * 256; ldc = 1024; act = 1; }
        else if (pn < 16) { base = SQ + (pn - 12) * 256; ldc = 1024; }
        else if (pn == 16) { base = SK; ldc = 256; }
        else if (pn == 17) { base = SV; ldc = 256; }
        else if (pn < 22) { base = GA + (pn - 18) * 256; ldc = 1024; act = 2; }
        else { base = GB + (pn - 22) * 256; ldc = 1024; act = 2; }
        const int row0 = u.pm * BM + wr * 64 + fr, col0 = wc * 32 + 8 * fq;
        const __amdgpu_buffer_rsrc_t rs_ = wt_rsrc(base);
#pragma unroll
        for (int ai = 0; ai < 2; ++ai)
#pragma unroll
            for (int m = 0; m < 4; ++m) { const int row = row0 + ai * HALF + m * 16; const float rs = rstd[row]; const unsigned rowoff = (unsigned)(((size_t)row * ldc + col0) * 2);
#pragma unroll
                for (int bj = 0; bj < 2; ++bj) { f32x4 v0 = acc[ai][bj][m][0] * rs, v1 = acc[ai][bj][m][1] * rs;
                    if (act) {
#pragma unroll
                        for (int e = 0; e < 4; ++e) { const float s0 = sigm_fast(v0[e]), s1 = sigm_fast(v1[e]); v0[e] = (act == 1) ? v0[e] * s0 : s0; v1[e] = (act == 1) ? v1[e] * s1 : s1; } }
                    u32x4 w; w.x = cvt_pk_bf16(v0[0], v0[1]); w.y = cvt_pk_bf16(v0[2], v0[3]); w.z = cvt_pk_bf16(v1[0], v1[1]); w.w = cvt_pk_bf16(v1[2], v1[3]);
                    wt_st16(rs_, rowoff + bj * HALF * 2, w); } }
    }
};

__device__ __forceinline__ void bf8_to_f32(const u32x4 raw, float (&f)[8]) {
#pragma unroll
    for (int j = 0; j < 4; ++j) { f[2 * j] = __builtin_bit_cast(float, raw[j] << 16); f[2 * j + 1] = __builtin_bit_cast(float, raw[j] & 0xffff0000u); }
}
template <int STEP> struct EpiMerge {
    static constexpr bool PERM = true, AFTER_DRAIN = false;
    const bf16_t* ga; const bf16_t* gb; bf16_t* outp;
    __device__ __forceinline__ void operator()(f32x4 (&acc)[2][2][4][2], const Unit& u, int wr, int wc, int fr, int fq) const {
        const int row0 = u.pm * BM + wr * 64 + fr, col0 = u.pn * BM + wc * 32 + 8 * fq;
        const __amdgpu_buffer_rsrc_t dst_r = wt_rsrc(outp);
#pragma unroll
        for (int ai = 0; ai < 2; ++ai)
#pragma unroll
            for (int m = 0; m < 4; ++m) { const size_t rb = (size_t)(row0 + ai * HALF + m * 16) * 1024 + col0;
#pragma unroll
                for (int bj = 0; bj < 2; ++bj) { const size_t off = rb + bj * HALF;
                    float b[8]; bf8_to_f32(*(const u32x4*)(gb + off), b);
                    if (STEP == 0) { float a[8]; bf8_to_f32(*(const u32x4*)(ga + off), a);
#pragma unroll
                        for (int e = 0; e < 4; ++e) { acc[ai][bj][m][0][e] *= a[e] * __builtin_amdgcn_rcpf(fmaxf(b[e], 1e-30f)); acc[ai][bj][m][1][e] *= a[4 + e] * __builtin_amdgcn_rcpf(fmaxf(b[4 + e], 1e-30f)); }
                    } else {
                        float v[8];
#pragma unroll
                        for (int e = 0; e < 4; ++e) { v[e] = acc[ai][bj][m][0][e] * fmaxf(b[e], 1e-30f); v[4 + e] = acc[ai][bj][m][1][e] * fmaxf(b[4 + e], 1e-30f); }
                        u32x4 w; w.x = cvt_pk_bf16(v[0], v[1]); w.y = cvt_pk_bf16(v[2], v[3]); w.z = cvt_pk_bf16(v[4], v[5]); w.w = cvt_pk_bf16(v[6], v[7]);
                        wt_st16(dst_r, (unsigned)(off * 2), w); } } }
    }
};
struct EpiOut {
    static constexpr bool PERM = true, AFTER_DRAIN = false;
    const bf16_t* x; float* h1; bf16_t* hb; float* rowss; int M;
    __device__ __forceinline__ void operator()(const f32x4 (&acc)[2][2][4][2], const Unit& u, int wr, int wc, int fr, int fq) const {
        const int row0 = u.pm * BM + wr * 64 + fr, col0 = u.pn * BM + wc * 32 + 8 * fq;
        const __amdgpu_buffer_rsrc_t hb_r = wt_rsrc(hb);
#pragma unroll
        for (int ai = 0; ai < 2; ++ai)
#pragma unroll
            for (int m = 0; m < 4; ++m) { const int row = row0 + ai * HALF + m * 16; const size_t rb = (size_t)row * 1024 + col0; float ss = 0.f;
#pragma unroll
                for (int bj = 0; bj < 2; ++bj) { const size_t off = rb + bj * HALF;
                    const u32x4 xw = *(const u32x4*)(x + off);
                    f32x4 x0, x1; x0[0] = __uint_as_float(xw.x << 16); x0[1] = __uint_as_float(xw.x & 0xffff0000u); x0[2] = __uint_as_float(xw.y << 16); x0[3] = __uint_as_float(xw.y & 0xffff0000u);
                    x1[0] = __uint_as_float(xw.z << 16); x1[1] = __uint_as_float(xw.z & 0xffff0000u); x1[2] = __uint_as_float(xw.w << 16); x1[3] = __uint_as_float(xw.w & 0xffff0000u);
                    const f32x4 v0 = acc[ai][bj][m][0] + x0, v1 = acc[ai][bj][m][1] + x1;
                    u32x4 w; w.x = cvt_pk_bf16(v0[0], v0[1]); w.y = cvt_pk_bf16(v0[2], v0[3]); w.z = cvt_pk_bf16(v1[0], v1[1]); w.w = cvt_pk_bf16(v1[2], v1[3]);
                    wt_st16(hb_r, (unsigned)(off * 2), w);
                    ss += (v0[0] * v0[0] + v0[1] * v0[1]) + (v0[2] * v0[2] + v0[3] * v0[3]) + (v1[0] * v1[0] + v1[1] * v1[1]) + (v1[2] * v1[2] + v1[3] * v1[3]); }
                ss += __shfl_xor(ss, 16); ss += __shfl_xor(ss, 32);
                if (fq == 0) wt_st4(rowss + (size_t)row * 16 + u.pn * 4 + wc, ss); }
    }
};
struct EpiQ {
    static constexpr bool PERM = true, AFTER_DRAIN = false;
    const float* rowss; bf16_t* qp; int M;
    __device__ __forceinline__ void operator()(const f32x4 (&acc)[2][2][4][2], const Unit& u, int wr, int wc, int fr, int fq) const {
        const int row0 = u.pm * BM + wr * 64 + fr, col0 = u.pn * BM + wc * 32 + 8 * fq;
        const __amdgpu_buffer_rsrc_t qp_r = wt_rsrc(qp);
#pragma unroll
        for (int ai = 0; ai < 2; ++ai)
#pragma unroll
            for (int m = 0; m < 4; ++m) { const int row = row0 + ai * HALF + m * 16; float s = 0.f;
#pragma unroll
                for (int k = 0; k < 4; ++k) { const f32x4 p4 = *(const f32x4*)(rowss + (size_t)row * 16 + 4 * k); s += (p4[0] + p4[1]) + (p4[2] + p4[3]); }
                const float rs = rsqrtf(s * (1.f / 1024.f) + 1e-6f);
#pragma unroll
                for (int bj = 0; bj < 2; ++bj) { const f32x4 v0 = acc[ai][bj][m][0] * rs, v1 = acc[ai][bj][m][1] * rs;
                    u32x4 w; w.x = cvt_pk_bf16(v0[0], v0[1]); w.y = cvt_pk_bf16(v0[2], v0[3]); w.z = cvt_pk_bf16(v1[0], v1[1]); w.w = cvt_pk_bf16(v1[2], v1[3]);
                    wt_st16(qp_r, (unsigned)(((size_t)row * 2048 + col0 + bj * HALF) * 2), w); } }
    }
};

struct PairOrder {
    StaticOrder base;
    __device__ bool next(int i, Unit& u) const { const bool ok = base.next(i >> 1, u); u.sel = i & 1; return ok; }
    __device__ __forceinline__ void a_ready(const Unit&) const {}
    __device__ __forceinline__ void done(const Unit&) const {}
    __device__ __forceinline__ bool keep(const Unit& u) const { return u.sel == 0; }
};
struct EpiMergeBoth {
    static constexpr bool PERM = true, AFTER_DRAIN = false;
    EpiMerge<0> e0; EpiMerge<1> e1;
    __device__ __forceinline__ void operator()(f32x4 (&acc)[2][2][4][2], const Unit& u, int wr, int wc, int fr, int fq) const { if (u.sel == 0) e0(acc, u, wr, wc, fr, fq); else e1(acc, u, wr, wc, fr, fq); }
};
template <class Epi, class Sched, bool ALIGN_EPI = false, bool SP2 = false>
__device__ __forceinline__ void gemm_phase(PG8_LAS unsigned char* lds, const Gemm g, const Sched& S, const Epi& E) {
    const int tid = threadIdx.x, wid = __builtin_amdgcn_readfirstlane(tid >> 6), lane = tid & 63, wr = wid >> 2, wc = wid & 3, fr = lane & 15, fq = lane >> 4;
    const int K = g.K, nt = K / BK;
    unsigned voffA[2], voffB[2];
#pragma unroll
    for (int i = 0; i < 2; ++i) { int R, C; stage_rc(tid * 16 + i * 8192, R, C); const int Rb = Epi::PERM ? ((R & ~31) + perm32(R & 31)) : R;
        voffA[i] = (unsigned)(R * K + C) * 2u; voffB[i] = (unsigned)(Rb * K + C) * 2u; }
    const size_t kstep = (size_t)(BK * 2);
    const size_t hstep = (size_t)HALF * K * 2;
    const size_t tstep = 2 * hstep;
    const unsigned ldsw = (unsigned)wid * 1024u;
    const int aoff = lds_byte(wr * 64 + fr, fq * 8), boff = lds_byte(wc * 32 + fr, fq * 8);
#define PG8_SA(b, h) (((b) * 2 + (h)) * HTB)
#define PG8_SB(b, h) ((4 + (b) * 2 + (h)) * HTB)
#define PG8_STAGE(bufoff, gbase, voff) do { _Pragma("unroll") for (int _i = 0; _i < 2; ++_i) \
        __builtin_amdgcn_global_load_lds((const unsigned*)((const char*)(gbase) + (voff)[_i]), (PG8_LAS unsigned*)(lds + (bufoff) + ldsw + _i * 8192), 16, 0, 0); } while (0)
#define PG8_LDA(dst, b, h) do { _Pragma("unroll") for (int m = 0; m < 4; ++m) _Pragma("unroll") for (int k = 0; k < 2; ++k) dst[m][k] = *(const PG8_LAS bf16x8*)(lds + PG8_SA(b, h) + aoff + m * 2048 + k * 1024); } while (0)
#define PG8_LDB(dst, b, h) do { _Pragma("unroll") for (int n = 0; n < 2; ++n) _Pragma("unroll") for (int k = 0; k < 2; ++k) dst[n][k] = *(const PG8_LAS bf16x8*)(lds + PG8_SB(b, h) + boff + n * 2048 + k * 1024); } while (0)
#define PG8_MMA(ai, bj, At, Bt) do { __builtin_amdgcn_s_setprio(1); _Pragma("unroll") for (int m = 0; m < 4; ++m) _Pragma("unroll") for (int n = 0; n < 2; ++n) _Pragma("unroll") for (int k = 0; k < 2; ++k) \
        acc[ai][bj][m][n] = __builtin_amdgcn_mfma_f32_16x16x32_bf16(Bt[n][k], At[m][k], acc[ai][bj][m][n], 0, 0, 0); __builtin_amdgcn_s_setprio(0); } while (0)
#define PG8_WAIT_V(n) asm volatile("s_waitcnt vmcnt(" #n ")" ::: "memory")
#define PG8_WAIT_L(n) asm volatile("s_waitcnt lgkmcnt(" #n ")" ::: "memory")
#define PG8_BAR __builtin_amdgcn_s_barrier()
#define PG8_SCHED __builtin_amdgcn_sched_barrier(0)
    Unit cur, nxt; int ui = 0;
    if (!S.next(0, cur)) return;
    f32x4 acc[2][2][4][2];
#pragma unroll
    for (int a = 0; a < 2; ++a)
#pragma unroll
        for (int b = 0; b < 2; ++b)
#pragma unroll
            for (int m = 0; m < 4; ++m)
#pragma unroll
                for (int n = 0; n < 2; ++n) acc[a][b][m][n] = (f32x4){0.f, 0.f, 0.f, 0.f};
    bf16x8 At[4][2], B0[2][2], B1[2][2];
    const char* cA = (const char*)(cur.sel ? g.A2 : g.A) + (size_t)cur.pm * tstep; const char* cB = (const char*)(cur.sel ? g.Bt2 : g.Bt) + (size_t)cur.pn * tstep;
    S.a_ready(cur);
    if constexpr (SP2) {
        PG8_STAGE(PG8_SB(0, 0), cB, voffB); PG8_STAGE(PG8_SB(0, 1), cB + hstep, voffB); PG8_STAGE(PG8_SA(0, 0), cA, voffA); PG8_STAGE(PG8_SA(0, 1), cA + hstep, voffA);
        if (wr == 1) PG8_BAR;
        PG8_WAIT_V(2); PG8_BAR;
        PG8_STAGE(PG8_SB(1, 0), cB + kstep, voffB); PG8_STAGE(PG8_SA(1, 0), cA + kstep, voffA); PG8_STAGE(PG8_SB(1, 1), cB + hstep + kstep, voffB);
        PG8_WAIT_V(6); PG8_BAR;
    } else {
        PG8_STAGE(PG8_SB(0, 0), cB, voffB); PG8_STAGE(PG8_SA(0, 0), cA, voffA); PG8_STAGE(PG8_SB(0, 1), cB + hstep, voffB); PG8_STAGE(PG8_SA(0, 1), cA + hstep, voffA);
        if (wr == 1) PG8_BAR;
        PG8_WAIT_V(4); PG8_BAR;
        PG8_STAGE(PG8_SB(1, 0), cB + kstep, voffB); PG8_STAGE(PG8_SA(1, 0), cA + kstep, voffA); PG8_STAGE(PG8_SB(1, 1), cB + hstep + kstep, voffB);
        PG8_WAIT_V(6); PG8_BAR;
    }
    for (;;) {
        const bool has_next = S.next(ui + 1, nxt);
        const char* nA = has_next ? (const char*)(nxt.sel ? g.A2 : g.A) + (size_t)nxt.pm * tstep : cA; const char* nB = has_next ? (const char*)(nxt.sel ? g.Bt2 : g.Bt) + (size_t)nxt.pn * tstep : cB;
        for (int t = 0; t < nt; t += 2) {
            const bool last = (t == nt - 2);
            const char* a1 = cA + (size_t)(t + 1) * kstep;
            const char* a2 = last ? nA : cA + (size_t)(t + 2) * kstep; const char* b2 = last ? nB : cB + (size_t)(t + 2) * kstep;
            const char* a3 = a2 + kstep; const char* b3 = b2 + kstep;
            if (last && has_next) S.a_ready(nxt);
            if constexpr (SP2) {
            PG8_LDB(B0, 0, 0); PG8_LDB(B1, 0, 1); PG8_SCHED; PG8_LDA(At, 0, 0); PG8_STAGE(PG8_SA(1, 1), a1 + hstep, voffA);
            PG8_WAIT_V(8); PG8_WAIT_L(0); PG8_BAR; PG8_MMA(0, 0, At, B0); PG8_MMA(0, 1, At, B1); PG8_BAR; PG8_SCHED;
            PG8_LDA(At, 0, 1); PG8_STAGE(PG8_SB(0, 0), b2, voffB); PG8_STAGE(PG8_SB(0, 1), b2 + hstep, voffB); PG8_STAGE(PG8_SA(0, 0), a2, voffA);
            PG8_WAIT_V(8); PG8_WAIT_L(0); PG8_BAR; PG8_MMA(1, 0, At, B0); PG8_MMA(1, 1, At, B1); PG8_BAR; PG8_SCHED;
            PG8_LDB(B0, 1, 0); PG8_LDB(B1, 1, 1); PG8_SCHED; PG8_LDA(At, 1, 0); PG8_STAGE(PG8_SA(0, 1), a2 + hstep, voffA);
            PG8_WAIT_V(8); PG8_WAIT_L(0); PG8_BAR; PG8_MMA(0, 0, At, B0); PG8_MMA(0, 1, At, B1); PG8_BAR; PG8_SCHED;
            PG8_LDA(At, 1, 1); PG8_STAGE(PG8_SB(1, 0), b3, voffB); PG8_STAGE(PG8_SB(1, 1), b3 + hstep, voffB); PG8_STAGE(PG8_SA(1, 0), a3, voffA);
            PG8_WAIT_V(8); PG8_WAIT_L(0); PG8_BAR; PG8_MMA(1, 0, At, B0); PG8_MMA(1, 1, At, B1); PG8_BAR; PG8_SCHED;
            } else {
            PG8_LDB(B0, 0, 0); PG8_SCHED; PG8_LDA(At, 0, 0); PG8_STAGE(PG8_SA(1, 1), a1 + hstep, voffA);
            PG8_WAIT_L(8); PG8_BAR; PG8_WAIT_L(0); PG8_MMA(0, 0, At, B0); PG8_BAR; PG8_SCHED;
            PG8_LDB(B1, 0, 1); PG8_STAGE(PG8_SB(0, 0), b2, voffB);
            PG8_BAR; PG8_WAIT_L(0); PG8_MMA(0, 1, At, B1); PG8_BAR;
            PG8_LDA(At, 0, 1); PG8_STAGE(PG8_SA(0, 0), a2, voffA);
            PG8_BAR; PG8_WAIT_L(0); PG8_MMA(1, 0, At, B0); PG8_BAR; PG8_SCHED;
            PG8_STAGE(PG8_SB(0, 1), b2 + hstep, voffB);
            PG8_WAIT_V(6); PG8_BAR; PG8_MMA(1, 1, At, B1); PG8_BAR;
            PG8_LDB(B0, 1, 0); PG8_SCHED; PG8_LDA(At, 1, 0); PG8_STAGE(PG8_SA(0, 1), a2 + hstep, voffA);
            PG8_WAIT_L(8); PG8_BAR; PG8_WAIT_L(0); PG8_MMA(0, 0, At, B0); PG8_BAR; PG8_SCHED;
            PG8_LDB(B1, 1, 1); PG8_STAGE(PG8_SB(1, 0), b3, voffB);
            PG8_BAR; PG8_WAIT_L(0); PG8_MMA(0, 1, At, B1); PG8_BAR;
            PG8_LDA(At, 1, 1); PG8_STAGE(PG8_SA(1, 0), a3, voffA);
            PG8_BAR; PG8_WAIT_L(0); PG8_MMA(1, 0, At, B0); PG8_BAR; PG8_SCHED;
            PG8_STAGE(PG8_SB(1, 1), b3 + hstep, voffB);
            PG8_WAIT_V(6); PG8_BAR; PG8_MMA(1, 1, At, B1); PG8_BAR;
            }
        }
        if constexpr (ALIGN_EPI) { if (wr == 0) PG8_BAR; }
        if constexpr (!Epi::AFTER_DRAIN) { E(acc, cur, wr, wc, fr, fq); S.done(cur); }
        if (!has_next) break;
        if (!S.keep(cur)) {
#pragma unroll
        for (int a = 0; a < 2; ++a)
#pragma unroll
            for (int b = 0; b < 2; ++b)
#pragma unroll
                for (int m = 0; m < 4; ++m)
#pragma unroll
                    for (int n = 0; n < 2; ++n) acc[a][b][m][n] = (f32x4){0.f, 0.f, 0.f, 0.f};
        }
        cur = nxt; cA = nA; cB = nB; ++ui;
        if constexpr (ALIGN_EPI) { if (wr == 1) PG8_BAR; }
    }
    PG8_WAIT_V(0);
    if constexpr (!ALIGN_EPI) { if (wr == 0) PG8_BAR; }
    PG8_BAR;
    if constexpr (Epi::AFTER_DRAIN) { E.fused(acc, cur, wr, wc, fr, fq, lds, wid, lane); S.done(cur); }
#undef PG8_SA
#undef PG8_SB
#undef PG8_STAGE
#undef PG8_LDA
#undef PG8_LDB
#undef PG8_MMA
#undef PG8_WAIT_V
#undef PG8_WAIT_L
#undef PG8_BAR
#undef PG8_SCHED
}
}
#define PG8_SP2 true
#define PG8_ALIGN true
namespace mk {
using pg8::bf16_t;
#define LAS __attribute__((address_space(3)))
typedef unsigned v4u __attribute__((ext_vector_type(4)));
typedef unsigned v2u __attribute__((ext_vector_type(2)));
typedef float f32x4 __attribute__((ext_vector_type(4)));
typedef float f32x16 __attribute__((ext_vector_type(16)));
typedef short bf16x8 __attribute__((ext_vector_type(8)));
typedef short bf16x4 __attribute__((ext_vector_type(4)));
constexpr int T = 32768, D = 1024, SEQ = 8192, NBATCH = 4, NPROJ = 6656, INW = 6672, C_GA = 3072;
constexpr float EPS = 1e-6f;
constexpr int NWAVES = 8, NTHR = 512;
constexpr int LDS_BYTES = 147456;
constexpr size_t MiB = 1u << 20;
constexpr size_t WS_CTL = 0, CTL_ZERO_BYTES = 1 * MiB;
constexpr size_t WS_RSTD1 = 1 * MiB, WS_ROWSS = WS_RSTD1 + 512 * 1024, WS_ALOW = 2 * MiB, WS_DSC = 4 * MiB, WS_SUBK = 5 * MiB;
constexpr size_t WS_WIN = 8 * MiB, WS_WG = 21 * MiB, WS_WS = 23 * MiB, WS_WO = 25 * MiB, WS_WQ = 27 * MiB;
constexpr size_t WS_XB = 32 * MiB, WS_MERGED = 32 * MiB;
constexpr size_t WS_GQ = 96 * MiB, WS_GK = 128 * MiB, WS_HB = 96 * MiB;
constexpr size_t WS_GV = 160 * MiB, WS_EXD = 160 * MiB, WS_EXU = 192 * MiB;
constexpr size_t WS_GR = 224 * MiB, WS_SQ = 288 * MiB, WS_QP = 224 * MiB;
constexpr size_t WS_SK = 448 * MiB, WS_SV = 464 * MiB,
                  WS_ST = 384 * MiB, WS_IDX = 448 * MiB, WS_GATE = 464 * MiB;
constexpr size_t WS_YG = 448 * MiB, WS_PART = 160 * MiB, WS_MRG = 96 * MiB, WS_HB2 = 160 * MiB, WS_EXD2 = 352 * MiB, WS_EXU2 = 384 * MiB, WS_ROWSS2 = 480 * MiB;

struct Args { const float* in[18]; float* out; unsigned char* ws; int ph_lo, ph_hi; };

__device__ __forceinline__ unsigned f2bf(float f) { unsigned u = __builtin_bit_cast(unsigned, f); return (u + 0x7fffu + ((u >> 16) & 1u)) >> 16; }
typedef float f32x2_t __attribute__((ext_vector_type(2))); typedef __bf16 bf16x2_t __attribute__((ext_vector_type(2)));
__device__ __forceinline__ unsigned pk2(float lo, float hi) { f32x2_t v = {lo, hi}; bf16x2_t b = __builtin_convertvector(v, bf16x2_t); return __builtin_bit_cast(unsigned, b); }
__device__ __forceinline__ float fexp(float x) { return __builtin_amdgcn_exp2f(x * 1.4426950408889634f); }
__device__ __forceinline__ float flog(float x) { return __builtin_amdgcn_logf(x) * 0.6931471805599453f; }
__device__ __forceinline__ float bf2f(unsigned short b) { return __builtin_bit_cast(float, (unsigned)b << 16); }
__device__ __forceinline__ float wave_sum(float v) {
#pragma unroll
    for (int o = 1; o < 64; o <<= 1) v += __shfl_xor(v, o);
    return v;
}
#define LDS_WAIT() asm volatile("s_waitcnt lgkmcnt(0)" ::: "memory")
#define VM_WAIT() asm volatile("s_waitcnt vmcnt(0)" ::: "memory")

struct Frame {
    LAS unsigned char* lds;
    int tid, lane, wave, G, bid;
    float* out; unsigned char* ws;
};

__device__ __forceinline__ void tr_item(const float* __restrict__ W, int ldw, int c0, int K, int nblk, const float* __restrict__ gain, bf16_t* WT, LAS float* scr, int item, int lane) {
    const int kb = item / nblk, nb = item % nblk, k0 = 64 * kb, n0 = 32 * nb;
    const __amdgpu_buffer_rsrc_t wt_r = wt_rsrc(WT);
    const int c = lane & 7;
    f32x4 g0 = {1.f, 1.f, 1.f, 1.f}, g1 = g0;
    if (gain) { g0 = *(const f32x4*)(gain + k0 + 8 * c); g1 = *(const f32x4*)(gain + k0 + 8 * c + 4); }
    float v[32];
    const float* src = W + (size_t)(k0 + (lane >> 5)) * ldw + c0 + n0 + (lane & 31);
#pragma unroll
    for (int i = 0; i < 32; ++i) v[i] = src[(size_t)(2 * i) * ldw];
#pragma unroll
    for (int i = 0; i < 32; ++i) scr[(2 * i + (lane >> 5)) * 33 + (lane & 31)] = v[i];
    LDS_WAIT(); asm volatile("" ::: "memory");
#pragma unroll
    for (int j = 0; j < 4; ++j) { const int n = (lane >> 3) + 8 * j; const LAS float* s = scr + (8 * c) * 33 + n;
        v4u o; o.x = pk2(s[0 * 33] * g0.x, s[1 * 33] * g0.y); o.y = pk2(s[2 * 33] * g0.z, s[3 * 33] * g0.w); o.z = pk2(s[4 * 33] * g1.x, s[5 * 33] * g1.y); o.w = pk2(s[6 * 33] * g1.z, s[7 * 33] * g1.w);
        wt_st16(wt_r, (unsigned)(((size_t)(n0 + n) * K + k0 + 8 * c) * 2), o); }
    LDS_WAIT(); asm volatile("" ::: "memory");
}

__device__ __forceinline__ void p0_prologue(Frame& F, const float* x, const float* gain1, const float* w_in, const float* gain2, const float* wbg, const float* wbs, const float* wout, const float* wq, const float* subk) {
    LAS unsigned char* wb = F.lds;
    LAS float* scr = (LAS float*)(F.lds + 65536 + F.wave * 8704);
    { f32x4 wv[8]; float gk[8];
#pragma unroll
      for (int j = 0; j < 8; ++j) { const int idx = F.tid + NTHR * j, k = idx >> 2; wv[j] = *(const f32x4*)(w_in + (size_t)k * INW + C_GA + 4 * (idx & 3)); gk[j] = gain1[k]; }
#pragma unroll
      for (int j = 0; j < 8; ++j) { const int idx = F.tid + NTHR * j, k = idx >> 2;
#pragma unroll
          for (int e = 0; e < 4; ++e) { const int r = 4 * (idx & 3) + e; const float v = gk[j] * wv[j][e];
              const unsigned h = f2bf(v), l = f2bf(v - __builtin_bit_cast(float, h << 16));
              const int off = (((k >> 5) * 64 + ((k >> 3) & 3) * 16 + r) * 16) + 2 * (k & 7);
              *(LAS unsigned short*)(wb + off) = (unsigned short)h; *(LAS unsigned short*)(wb + 32768 + off) = (unsigned short)l; } } }
    __syncthreads();
    const int gw = F.bid * 4 + (F.wave & 3), NGW = F.G * 4, lane = F.lane;
    bf16_t* XB = (bf16_t*)(F.ws + WS_XB); float* RSTD1 = (float*)(F.ws + WS_RSTD1); float* ALOW = (float*)(F.ws + WS_ALOW);
    const __amdgpu_buffer_rsrc_t xb_r = wt_rsrc(XB);
    if (F.wave < 4) for (int g = gw; g < T / 16; g += NGW) {
        const int m = g * 16 + (lane & 15), q = lane >> 4;
        const float* xr = x + (size_t)m * D + 8 * q;
        f32x4 acc = {0.f, 0.f, 0.f, 0.f}; float ss = 0.f;
        for (int s0 = 0; s0 < 32; s0 += 8) {
            asm volatile("" ::: "memory");
            f32x4 a[8][2];
#pragma unroll
            for (int i = 0; i < 8; ++i) { a[i][0] = *(const f32x4*)(xr + 32 * (s0 + i)); a[i][1] = *(const f32x4*)(xr + 32 * (s0 + i) + 4); }
#pragma unroll
            for (int i = 0; i < 8; ++i) { const f32x4 a0 = a[i][0], a1 = a[i][1];
                ss += ((a0.x * a0.x + a0.y * a0.y) + (a0.z * a0.z + a0.w * a0.w)) + ((a1.x * a1.x + a1.y * a1.y) + (a1.z * a1.z + a1.w * a1.w));
                v4u h; h.x = pk2(a0.x, a0.y); h.y = pk2(a0.z, a0.w); h.z = pk2(a1.x, a1.y); h.w = pk2(a1.z, a1.w);
                wt_st16(xb_r, (unsigned)(((size_t)m * D + 8 * q + 32 * (s0 + i)) * 2), h);
                v4u l;
                l.x = pk2(a0.x - __builtin_bit_cast(float, h.x << 16), a0.y - __builtin_bit_cast(float, h.x & 0xffff0000u));
                l.y = pk2(a0.z - __builtin_bit_cast(float, h.y << 16), a0.w - __builtin_bit_cast(float, h.y & 0xffff0000u));
                l.z = pk2(a1.x - __builtin_bit_cast(float, h.z << 16), a1.y - __builtin_bit_cast(float, h.z & 0xffff0000u));
                l.w = pk2(a1.z - __builtin_bit_cast(float, h.w << 16), a1.w - __builtin_bit_cast(float, h.w & 0xffff0000u));
                const bf16x8 wh = *(const LAS bf16x8*)(wb + ((s0 + i) * 64 + lane) * 16), wl = *(const LAS bf16x8*)(wb + 32768 + ((s0 + i) * 64 + lane) * 16);
                const bf16x8 xh = __builtin_bit_cast(bf16x8, h), xl = __builtin_bit_cast(bf16x8, l);
                acc = __builtin_amdgcn_mfma_f32_16x16x32_bf16(xh, wh, acc, 0, 0, 0);
                acc = __builtin_amdgcn_mfma_f32_16x16x32_bf16(xl, wh, acc, 0, 0, 0);
                acc = __builtin_amdgcn_mfma_f32_16x16x32_bf16(xh, wl, acc, 0, 0, 0); }
        }
        ss += __shfl_xor(ss, 16); ss += __shfl_xor(ss, 32);
        const float rstd = rsqrtf(ss * (1.f / D) + EPS);
#pragma unroll
        for (int i = 0; i < 4; ++i) { const float rs = __shfl(rstd, 4 * q + i); wt_st4(ALOW + (size_t)(g * 16 + 4 * q + i) * 16 + (lane & 15), acc[i] * rs); }
        if (lane < 16) wt_st4(RSTD1 + m, rstd);
    }
    constexpr int I_IN1 = 16 * 96, I_IN2 = 16 * 112, I_SQ = 16 * 32, I_Q = 16 * 64;
    constexpr int NITEMS = I_IN1 + I_IN2 + 3 * I_SQ + I_Q;
    bf16_t* WIN = (bf16_t*)(F.ws + WS_WIN);
    if (F.wave >= 4) for (int it = gw; it < NITEMS; it += NGW) {
        int r = it;
        if (r < I_IN1) { tr_item(w_in, INW, 0, D, 96, gain1, WIN, scr, r, lane); continue; } r -= I_IN1;
        if (r < I_IN2) { tr_item(w_in, INW, 3088, D, 112, gain1, WIN + (size_t)3072 * D, scr, r, lane); continue; } r -= I_IN2;
        if (r < I_SQ) { tr_item(wbg, D, 0, D, 32, nullptr, (bf16_t*)(F.ws + WS_WG), scr, r, lane); continue; } r -= I_SQ;
        if (r < I_SQ) { tr_item(wbs, D, 0, D, 32, nullptr, (bf16_t*)(F.ws + WS_WS), scr, r, lane); continue; } r -= I_SQ;
        if (r < I_SQ) { tr_item(wout, D, 0, D, 32, nullptr, (bf16_t*)(F.ws + WS_WO), scr, r, lane); continue; } r -= I_SQ;
        tr_item(wq, 2048, 0, D, 64, gain2, (bf16_t*)(F.ws + WS_WQ), scr, r, lane);
    }
    { const f32x4* sk = (const f32x4*)subk; v2u* o = (v2u*)(F.ws + WS_SUBK);
      for (int i = F.bid * NTHR + F.tid; i < 8 * 2 * 128 * 128 / 4; i += F.G * NTHR) { const f32x4 v = sk[i]; wt_st8(o + i, pk2(v.x, v.y), pk2(v.z, v.w)); } }
}

constexpr int SWA_KROW = 144, SWA_VROW = 592;
__device__ __forceinline__ unsigned swa_voff(unsigned row, unsigned ch) { return 1024u * (row >> 3) + 512u * (ch >> 2) + 64u * (row & 7) + 16u * ((ch & 3) ^ ((row >> 2) & 3)); }
typedef short swa_v4s __attribute__((ext_vector_type(4)));
__device__ __forceinline__ bf16x8 swa_tr2(const LAS unsigned char* p0, const LAS unsigned char* p1) {
    const swa_v4s x = __builtin_amdgcn_ds_read_tr16_b64_v4i16((LAS swa_v4s*)p0), y = __builtin_amdgcn_ds_read_tr16_b64_v4i16((LAS swa_v4s*)p1);
    return (bf16x8){x[0], x[1], x[2], x[3], y[0], y[1], y[2], y[3]};
}
constexpr int SWA_K_OFF = 0, SWA_V_OFF = 256 * SWA_KROW, SWA_TB_OFF = SWA_V_OFF + 64 * SWA_VROW, SWA_LDS = SWA_TB_OFF + 4 * 128 * 4;
__device__ __forceinline__ int t5_bucket(int rel) {
    if (rel < 16) return rel;
    int b = 16;
    b += (rel >= 19); b += (rel >= 21); b += (rel >= 24); b += (rel >= 27); b += (rel >= 31); b += (rel >= 35); b += (rel >= 40); b += (rel >= 46);
    b += (rel >= 52); b += (rel >= 59); b += (rel >= 67); b += (rel >= 77); b += (rel >= 87); b += (rel >= 99); b += (rel >= 113);
    return b;
}
__device__ __forceinline__ void swa_load_kv(const bf16_t* SK, const bf16_t* SV, int u, int tid, int lane, int wave, v4u (&kraw)[4], v4u (&vraw)[4]) {
    const int blk = u & 63, kvh = (u >> 6) & 3, b = u >> 8; const size_t mrow0 = (size_t)b * SEQ; const int t0 = blk * 128, c = tid & 7;
#pragma unroll
    for (int ps = 0; ps < 4; ++ps) {
        const int kjk = ps * 64 + (tid >> 3), posk = t0 - 128 + kjk; kraw[ps] = (v4u){0u, 0u, 0u, 0u};
        if (posk >= 0) kraw[ps] = *(const v4u*)(SK + (mrow0 + posk) * 256 + kvh * 64 + 8 * c);
        const int kjv = ps * 64 + lane, posv = t0 - 128 + kjv; vraw[ps] = (v4u){0u, 0u, 0u, 0u};
        if (posv >= 0) vraw[ps] = *(const v4u*)(SV + (mrow0 + posv) * 256 + kvh * 64 + 8 * wave);
    }
}
__device__ __forceinline__ void swa_phase(Frame& F, const float* qgain, const float* kgain, const float* sinks, const float* rel_bias, size_t ydelta) {
    const bf16_t* SK = (const bf16_t*)(F.ws + WS_SK); const bf16_t* SV = (const bf16_t*)(F.ws + WS_SV); bf16_t* SQ = (bf16_t*)(F.ws + WS_SQ);
    LAS unsigned char* Kn = F.lds + SWA_K_OFF; LAS unsigned char* Vt = F.lds + SWA_V_OFF; LAS float* tb = (LAS float*)(F.lds + SWA_TB_OFF);
    const int tid = F.tid, lane = F.lane, wave = F.wave, l15 = lane & 15, q4 = lane >> 4;
    if (tid < 256) { *(LAS v4u*)(Vt + swa_voff(256 + (tid >> 3), tid & 7)) = (v4u){0u, 0u, 0u, 0u}; }
    const LAS unsigned char* vb0 = Vt + swa_voff(4 * q4 + (l15 >> 2), (l15 >> 1) & 1) + 8 * (l15 & 1); const LAS unsigned char* vb1 = Vt + swa_voff(4 * q4 + (l15 >> 2), 2 + ((l15 >> 1) & 1)) + 8 * (l15 & 1);
    v4u kraw[4], vraw[4];
    if (F.bid < 1024) swa_load_kv(SK, SV, F.bid, tid, lane, wave, kraw, vraw);
    for (int u = F.bid; u < 1024; u += F.G) {
        const int blk = u & 63, kvh = (u >> 6) & 3, b = u >> 8;
        const size_t mrow0 = (size_t)b * SEQ; const int t0 = blk * 128;
        const int g = wave >> 1, qh = wave & 1, h = kvh * 4 + g;
        v4u qn[2];
        { const bf16_t* qrow = SQ + (mrow0 + t0 + 64 * qh + l15) * 1024 + h * 64; qn[0] = *(const v4u*)(qrow + 8 * q4); qn[1] = *(const v4u*)(qrow + 32 + 8 * q4); }
        __syncthreads();
        { const int c = tid & 7; f32x4 g0 = *(const f32x4*)(kgain + 8 * c), g1 = *(const f32x4*)(kgain + 8 * c + 4);
#pragma unroll
          for (int ps = 0; ps < 4; ++ps) {
              const int kj = ps * 64 + (tid >> 3);
              const v4u raw = kraw[ps];
              float f[8];
#pragma unroll
              for (int j = 0; j < 4; ++j) { f[2 * j] = __builtin_bit_cast(float, raw[j] << 16); f[2 * j + 1] = __builtin_bit_cast(float, raw[j] & 0xffff0000u); }
              float ss = 0.f;
#pragma unroll
              for (int j = 0; j < 8; ++j) ss += f[j] * f[j];
              ss += __shfl_xor(ss, 1); ss += __shfl_xor(ss, 2); ss += __shfl_xor(ss, 4);
              const float r = rsqrtf(ss * (1.f / 64.f) + EPS);
              v4u w; w.x = pk2(f[0] * r * g0.x, f[1] * r * g0.y); w.y = pk2(f[2] * r * g0.z, f[3] * r * g0.w); w.z = pk2(f[4] * r * g1.x, f[5] * r * g1.y); w.w = pk2(f[6] * r * g1.z, f[7] * r * g1.w);
              *(LAS v4u*)(Kn + kj * SWA_KROW + 16 * c) = w;
          } }
#pragma unroll
        for (int ps = 0; ps < 4; ++ps) {
            const int kj = ps * 64 + lane; const v4u raw = vraw[ps];
            *(LAS v4u*)(Vt + swa_voff(kj, wave)) = raw;
        }
        { const int gg = tid >> 7, rel = tid & 127; tb[tid] = rel_bias[t5_bucket(rel) * 16 + kvh * 4 + gg] * 1.4426950408889634f; }
        if (u + F.G < 1024) swa_load_kv(SK, SV, u + F.G, tid, lane, wave, kraw, vraw);
        __syncthreads();
        const float sink = sinks[h] * 1.4426950408889634f;
        float qg[2][8];
#pragma unroll
        for (int ks = 0; ks < 2; ++ks)
#pragma unroll
            for (int j = 0; j < 8; ++j) qg[ks][j] = qgain[32 * ks + 8 * q4 + j] * (0.125f * 1.4426950408889634f);
#pragma unroll 1
        for (int nt = 0; nt < 4; ++nt) {
            const int q0 = 64 * qh + 16 * nt, qi = q0 + l15, kt0 = q0 >> 4;
            bf16_t* qrow = SQ + (mrow0 + t0 + qi) * 1024 + h * 64;
            bf16x8 qf[2];
            { v4u raw[2]; float f[2][8]; float ss = 0.f;
              raw[0] = qn[0]; raw[1] = qn[1];
              if (nt < 3) { const bf16_t* qnx = qrow + 16 * 1024; qn[0] = *(const v4u*)(qnx + 8 * q4); qn[1] = *(const v4u*)(qnx + 32 + 8 * q4); }
#pragma unroll
              for (int ks = 0; ks < 2; ++ks) {
#pragma unroll
                  for (int j = 0; j < 4; ++j) { f[ks][2 * j] = __builtin_bit_cast(float, raw[ks][j] << 16); f[ks][2 * j + 1] = __builtin_bit_cast(float, raw[ks][j] & 0xffff0000u); }
#pragma unroll
                  for (int j = 0; j < 8; ++j) ss += f[ks][j] * f[ks][j]; }
              ss += __shfl_xor(ss, 16); ss += __shfl_xor(ss, 32);
              const float r = rsqrtf(ss * (1.f / 64.f) + EPS);
#pragma unroll
              for (int ks = 0; ks < 2; ++ks) { v4u w;
#pragma unroll
                  for (int j = 0; j < 4; ++j) w[j] = pk2(f[ks][2 * j] * r * qg[ks][2 * j], f[ks][2 * j + 1] * r * qg[ks][2 * j + 1]);
                  qf[ks] = __builtin_bit_cast(bf16x8, w); } }
            f32x4 s[9];
#pragma unroll
            for (int i = 0; i < 9; ++i) { f32x4 acc = (f32x4){0.f, 0.f, 0.f, 0.f};
#pragma unroll
                for (int ks = 0; ks < 2; ++ks) { const bf16x8 a = *(const LAS bf16x8*)(Kn + (16 * (kt0 + i) + l15) * SWA_KROW + (32 * ks + 8 * q4) * 2); acc = __builtin_amdgcn_mfma_f32_16x16x32_bf16(a, qf[ks], acc, 0, 0, 0); }
                s[i] = acc; }
            const int R0 = l15 + 128 - 4 * q4;
            const LAS float* tbp = tb + g * 128 + R0 - 131;
            float mx = -INFINITY;
            if (blk > 0) {
#pragma unroll
                for (int i = 0; i < 9; ++i)
#pragma unroll
                    for (int r = 0; r < 4; ++r) { const int rel = R0 - 16 * i - r; float v = s[i][r] + tbp[131 - 16 * i - r];
                        if (i == 0) v = (rel < 128) ? v : -INFINITY;
                        if (i == 8) v = (rel >= 0) ? v : -INFINITY;
                        s[i][r] = v; mx = fmaxf(mx, v); }
            } else {
#pragma unroll
                for (int i = 0; i < 9; ++i)
#pragma unroll
                    for (int r = 0; r < 4; ++r) { const int kj = 16 * (kt0 + i) + 4 * q4 + r, rel = R0 - 16 * i - r; const bool valid = ((unsigned)rel < 128u) && (kj >= 128);
                        const float v = valid ? s[i][r] + tbp[131 - 16 * i - r] : -INFINITY; s[i][r] = v; mx = fmaxf(mx, v); }
            }
            mx = fmaxf(mx, __shfl_xor(mx, 16)); mx = fmaxf(mx, __shfl_xor(mx, 32)); mx = fmaxf(mx, sink);
            float sum = 0.f;
#pragma unroll
            for (int i = 0; i < 9; ++i)
#pragma unroll
                for (int r = 0; r < 4; ++r) { const float e = __builtin_amdgcn_exp2f(s[i][r] - mx); s[i][r] = e; sum += e; }
            sum += __shfl_xor(sum, 16); sum += __shfl_xor(sum, 32);
            const float inv = 1.0f / (sum + __builtin_amdgcn_exp2f(sink - mx));
            f32x4 o[4];
#pragma unroll
            for (int mt = 0; mt < 4; ++mt) o[mt] = (f32x4){0.f, 0.f, 0.f, 0.f};
#pragma unroll
            for (int kk = 0; kk < 5; ++kk) {
                v4u w; w.x = pk2(s[2 * kk][0], s[2 * kk][1]); w.y = pk2(s[2 * kk][2], s[2 * kk][3]);
                if (kk < 4) { w.z = pk2(s[2 * kk + 1][0], s[2 * kk + 1][1]); w.w = pk2(s[2 * kk + 1][2], s[2 * kk + 1][3]); } else { w.z = 0u; w.w = 0u; }
                const bf16x8 pb = __builtin_bit_cast(bf16x8, w);
#pragma unroll
                for (int mt = 0; mt < 4; ++mt) {
                    const LAS unsigned char* vr = ((mt & 1) ? vb1 : vb0) + 512 * (mt >> 1) + 2048 * (kt0 + 2 * kk);
                    const bf16x8 a = swa_tr2(vr, vr + 2048);
                    o[mt] = __builtin_amdgcn_mfma_f32_16x16x32_bf16(a, pb, o[mt], 0, 0, 0);
                }
            }
#pragma unroll
            for (int mt = 0; mt < 4; ++mt) { v2u w; w.x = pk2(o[mt][0] * inv, o[mt][1] * inv); w.y = pk2(o[mt][2] * inv, o[mt][3] * inv); wt_st8((unsigned char*)(qrow + 16 * mt + 4 * q4) + ydelta, w.x, w.y); }
        }
    }
    __syncthreads();
}

constexpr int GL_AL = 0, GL_QS = 4096, GL_BL = 6144, GL_DEC = 6656, GL_BQ = 8192, GL_QT = 41984, GL_KT = 59392, GL_OB = 8192, GL_KH = 76800, GL_VT = 95232;
constexpr int GL_BQROW = 528, GL_QROW = 272, GL_KHROW = 144, GL_VROW = 144, GL_OBROW = 1040;
__device__ __forceinline__ f32x16 mfma32(bf16x8 a, bf16x8 b, f32x16 c) { return __builtin_amdgcn_mfma_f32_32x32x16_bf16(a, b, c, 0, 0, 0); }
__device__ __forceinline__ bf16x8 pack8(const f32x16& x, int s) {
    v4u w;
    if (s == 0) { w.x = pk2(x[0], x[1]); w.y = pk2(x[2], x[3]); w.z = pk2(x[4], x[5]); w.w = pk2(x[6], x[7]); }
    else { w.x = pk2(x[8], x[9]); w.y = pk2(x[10], x[11]); w.z = pk2(x[12], x[13]); w.w = pk2(x[14], x[15]); }
    return __builtin_bit_cast(bf16x8, w);
}
__device__ __forceinline__ bf16x8 ld2x8(const LAS unsigned char* p) {
    const v2u a0 = *(const LAS v2u*)p, a1 = *(const LAS v2u*)(p + 16);
    return __builtin_bit_cast(bf16x8, (v4u){a0.x, a0.y, a1.x, a1.y});
}
__device__ __forceinline__ void unpack8(const v4u raw, float (&f)[8]) {
#pragma unroll
    for (int j = 0; j < 4; ++j) { f[2 * j] = __builtin_bit_cast(float, raw[j] << 16); f[2 * j + 1] = __builtin_bit_cast(float, raw[j] & 0xffff0000u); }
}
__device__ __forceinline__ unsigned gl_off(unsigned row, unsigned ch) { return 2048u * (row >> 3) + 512u * (ch >> 2) + 64u * (row & 7) + 16u * ((ch & 3) ^ ((row >> 2) & 3)); }
__device__ __forceinline__ unsigned gl_tr_base(unsigned lane, unsigned rb) { const unsigned blk = (lane >> 4) & 1, q = (lane & 15) >> 2, p = lane & 3; return gl_off(rb + q, 2 * blk + (p >> 1)) + 8 * (p & 1); }
typedef short gl_v4s __attribute__((ext_vector_type(4)));
__device__ __forceinline__ bf16x8 gl_tr2(const LAS unsigned char* p0, const LAS unsigned char* p1) {
    const gl_v4s x = __builtin_amdgcn_ds_read_tr16_b64_v4i16((LAS gl_v4s*)p0), y = __builtin_amdgcn_ds_read_tr16_b64_v4i16((LAS gl_v4s*)p1);
    return (bf16x8){x[0], x[1], x[2], x[3], y[0], y[1], y[2], y[3]};
}
__device__ __forceinline__ void gla_load_w(Frame& F, const float* wgu, const float* bgu, int h, bf16x8& whi, bf16x8& wlo, float& bias) {
    const int dn = 32 * (F.wave >> 1) + (F.lane & 31), hh = F.lane >> 5;
    float v[8];
#pragma unroll
    for (int j = 0; j < 8; ++j) v[j] = wgu[(8 * hh + j) * 512 + h * 128 + dn];
    v4u hi, lo;
#pragma unroll
    for (int j = 0; j < 4; ++j) { hi[j] = pk2(v[2 * j], v[2 * j + 1]); lo[j] = pk2(v[2 * j] - __builtin_bit_cast(float, hi[j] << 16), v[2 * j + 1] - __builtin_bit_cast(float, hi[j] & 0xffff0000u)); }
    whi = __builtin_bit_cast(bf16x8, (v4u){hi[0], hi[1], hi[2], hi[3]}); wlo = __builtin_bit_cast(bf16x8, (v4u){lo[0], lo[1], lo[2], lo[3]});
    bias = bgu[h * 128 + dn];
}
template <bool FULL> __device__ __forceinline__ float gla_stage(Frame& F, int h, size_t m0, const bf16x8 whi, const bf16x8 wlo, float bias) {
    const int tid = F.tid, lane = F.lane, wave = F.wave, d = tid & 127;
    LAS unsigned char* L = F.lds;
    const float* ALOW = (const float*)(F.ws + WS_ALOW);
    const bf16_t* GQ = (const bf16_t*)(F.ws + WS_GQ); const bf16_t* GK = (const bf16_t*)(F.ws + WS_GK); const bf16_t* GV = (const bf16_t*)(F.ws + WS_GV);
    __syncthreads();
    { typedef float f32x2 __attribute__((ext_vector_type(2))); ((LAS f32x2*)(L + GL_AL))[tid] = ((const f32x2*)(ALOW + m0 * 16))[tid]; }
    __syncthreads();
    const int mt = wave & 1, nt = wave >> 1, l31 = lane & 31, hh = lane >> 5, dn = 32 * nt + l31;
    float p[16];
    { const LAS f32x4* ap = (const LAS f32x4*)(L + GL_AL + (32 * mt + l31) * 64 + hh * 32);
      const f32x4 a0 = ap[0], a1 = ap[1];
      v4u ah, al;
      ah.x = pk2(a0.x, a0.y); ah.y = pk2(a0.z, a0.w); ah.z = pk2(a1.x, a1.y); ah.w = pk2(a1.z, a1.w);
      al.x = pk2(a0.x - __builtin_bit_cast(float, ah.x << 16), a0.y - __builtin_bit_cast(float, ah.x & 0xffff0000u)); al.y = pk2(a0.z - __builtin_bit_cast(float, ah.y << 16), a0.w - __builtin_bit_cast(float, ah.y & 0xffff0000u));
      al.z = pk2(a1.x - __builtin_bit_cast(float, ah.z << 16), a1.y - __builtin_bit_cast(float, ah.z & 0xffff0000u)); al.w = pk2(a1.z - __builtin_bit_cast(float, ah.w << 16), a1.w - __builtin_bit_cast(float, ah.w & 0xffff0000u));
      f32x16 z;
#pragma unroll
      for (int r = 0; r < 16; ++r) z[r] = 0.f;
      z = mfma32(__builtin_bit_cast(bf16x8, ah), whi, z); z = mfma32(__builtin_bit_cast(bf16x8, al), whi, z); z = mfma32(__builtin_bit_cast(bf16x8, ah), wlo, z);
#pragma unroll
      for (int r = 0; r < 16; ++r) { const float zz = z[r] + bias; p[r] = (fminf(zz, 0.f) - flog(1.f + fexp(-fabsf(zz)))) * (1.f / 16.f); } }
    float base = 0.f;
#pragma unroll
    for (int g4 = 0; g4 < 4; ++g4) {
        p[4 * g4 + 1] += p[4 * g4]; p[4 * g4 + 2] += p[4 * g4 + 1]; p[4 * g4 + 3] += p[4 * g4 + 2];
        const float gt = p[4 * g4 + 3], pt = __shfl_xor(gt, 32), off = base + (hh ? pt : 0.f);
#pragma unroll
        for (int k = 0; k < 4; ++k) p[4 * g4 + k] += off;
        base += gt + pt;
    }
    if (hh == 0) ((LAS float*)(L + GL_QS))[mt * 128 + dn] = base;
    __syncthreads();
    { const float q0 = ((const LAS float*)(L + GL_QS))[dn], q1 = ((const LAS float*)(L + GL_QS))[128 + dn], blast = q0 + q1, offs = mt ? q0 : 0.f;
#pragma unroll
      for (int r = 0; r < 16; ++r) *(LAS float*)(L + GL_BQ + (32 * mt + 8 * (r >> 2) + 4 * hh + (r & 3)) * GL_BQROW + dn * 4) = p[r] + offs;
      if (mt == 0 && hh == 0) { ((LAS float*)(L + GL_BL))[dn] = blast; ((LAS float*)(L + GL_DEC))[dn] = fexp(blast); } }
    __syncthreads();
    {
        const int t = lane, dg = wave; const size_t row = m0 + t;
        float b[16], bl[16];
#pragma unroll
        for (int i = 0; i < 4; ++i) { const f32x4 v = *(const LAS f32x4*)(L + GL_BQ + t * GL_BQROW + dg * 64 + 16 * i); b[4 * i] = v.x; b[4 * i + 1] = v.y; b[4 * i + 2] = v.z; b[4 * i + 3] = v.w;
                                      const f32x4 u = *(const LAS f32x4*)(L + (FULL ? GL_DEC : GL_BL) + dg * 64 + 16 * i); bl[4 * i] = u.x; bl[4 * i + 1] = u.y; bl[4 * i + 2] = u.z; bl[4 * i + 3] = u.w; }
        float kf[16];
        { const v4u* kp = (const v4u*)(GK + row * 512 + h * 128 + 16 * dg); float t0[8], t1[8]; unpack8(kp[0], t0); unpack8(kp[1], t1);
#pragma unroll
          for (int e = 0; e < 8; ++e) { kf[e] = t0[e]; kf[8 + e] = t1[e]; } }
        float kh[16];
        if (FULL) {
            float qf[16];
            { const v4u* qp = (const v4u*)(GQ + row * 512 + h * 128 + 16 * dg); float t0[8], t1[8]; unpack8(qp[0], t0); unpack8(qp[1], t1);
#pragma unroll
              for (int e = 0; e < 8; ++e) { qf[e] = t0[e]; qf[8 + e] = t1[e]; } }
            v4u wq[2], wk[2];
#pragma unroll
            for (int e = 0; e < 16; e += 2) { const float e0 = fexp(b[e]), e1 = fexp(b[e + 1]);
                const float k0 = kf[e] * __builtin_amdgcn_rcpf(e0), k1 = kf[e + 1] * __builtin_amdgcn_rcpf(e1);
                wq[e >> 3][(e & 7) >> 1] = pk2(qf[e] * e0 * 0.08838834764831845f, qf[e + 1] * e1 * 0.08838834764831845f);
                wk[e >> 3][(e & 7) >> 1] = pk2(k0, k1);
                kh[e] = k0 * bl[e]; kh[e + 1] = k1 * bl[e + 1]; }
            *(LAS v4u*)(L + GL_QT + t * GL_QROW + dg * 32) = wq[0]; *(LAS v4u*)(L + GL_QT + t * GL_QROW + dg * 32 + 16) = wq[1];
            *(LAS v4u*)(L + GL_KT + t * GL_QROW + dg * 32) = wk[0]; *(LAS v4u*)(L + GL_KT + t * GL_QROW + dg * 32 + 16) = wk[1];
        } else {
#pragma unroll
            for (int e = 0; e < 16; ++e) kh[e] = kf[e] * fexp(bl[e] - b[e]);
        }
        { v4u k0, k1; k0.x = pk2(kh[0], kh[1]); k0.y = pk2(kh[2], kh[3]); k0.z = pk2(kh[4], kh[5]); k0.w = pk2(kh[6], kh[7]); k1.x = pk2(kh[8], kh[9]); k1.y = pk2(kh[10], kh[11]); k1.z = pk2(kh[12], kh[13]); k1.w = pk2(kh[14], kh[15]);
          *(LAS v4u*)(L + GL_KH + gl_off(t, 2 * dg)) = k0; *(LAS v4u*)(L + GL_KH + gl_off(t, 2 * dg + 1)) = k1; }
#pragma unroll
        for (int i = 0; i < 4; ++i) { const v4u raw = *(const v4u*)(GV + row * 1024 + h * 256 + 32 * wave + 8 * i);
            *(LAS v4u*)(L + GL_VT + (wave >> 2) * 16384 + gl_off(t, 4 * (wave & 3) + i)) = raw; }
    }
    __syncthreads();
    return ((const LAS float*)(L + GL_BL))[d];
}
__device__ __forceinline__ void gla_state_update(Frame& F, f32x16 (&S)[4]) {
    const int lane = F.lane, l31 = lane & 31, hh = lane >> 5; LAS unsigned char* L = F.lds;
    const LAS unsigned char* ka0 = L + GL_KH + gl_tr_base(lane, 8 * hh); const LAS unsigned char* ka1 = L + GL_KH + gl_tr_base(lane, 8 * hh + 4);
    const LAS unsigned char* va0 = ka0 + (GL_VT - GL_KH) + (F.wave >> 2) * 16384 + (F.wave & 3) * 512; const LAS unsigned char* va1 = ka1 + (GL_VT - GL_KH) + (F.wave >> 2) * 16384 + (F.wave & 3) * 512;
#pragma unroll
    for (int dt = 0; dt < 4; ++dt) {
#pragma unroll
        for (int g = 0; g < 4; ++g) { const f32x4 dc = *(const LAS f32x4*)(L + GL_DEC + (32 * dt + 8 * g + 4 * hh) * 4);
            S[dt][4 * g] *= dc.x; S[dt][4 * g + 1] *= dc.y; S[dt][4 * g + 2] *= dc.z; S[dt][4 * g + 3] *= dc.w; }
#pragma unroll
        for (int ks = 0; ks < 4; ++ks) {
            const bf16x8 a = gl_tr2(ka0 + 4096 * ks + 512 * dt, ka1 + 4096 * ks + 512 * dt);
            const bf16x8 b = gl_tr2(va0 + 4096 * ks, va1 + 4096 * ks);
            S[dt] = mfma32(a, b, S[dt]);
        } __builtin_amdgcn_sched_barrier(0);
    }
}
__device__ __forceinline__ void gla_local_phase(Frame& F, const float* wgu, const float* bgu) {
    float* ST = (float*)(F.ws + WS_ST); float* DSC = (float*)(F.ws + WS_DSC);
    const int lane = F.lane, l31 = lane & 31, hh = lane >> 5;
    for (int u = F.bid; u < 512; u += F.G) {
        const int sc = u & 31, bh = u >> 5, b = bh >> 2, h = bh & 3;
        bf16x8 whi, wlo; float bias; gla_load_w(F, wgu, bgu, h, whi, wlo, bias);
        f32x16 S[4];
#pragma unroll
        for (int dt = 0; dt < 4; ++dt)
#pragma unroll
            for (int r = 0; r < 16; ++r) S[dt][r] = 0.f;
        float sumbl = 0.f;
#pragma unroll 1
        for (int c = 0; c < 4; ++c) {
            const size_t m0 = (size_t)b * SEQ + sc * 256 + c * 64;
            sumbl += gla_stage<false>(F, h, m0, whi, wlo, bias);
            gla_state_update(F, S);
        }
        v4u* st8 = (v4u*)ST + (size_t)(bh * 32 + sc) * 4096 + (F.wave * 4 * 64 + lane) * 2;
#pragma unroll
        for (int dt = 0; dt < 4; ++dt)
#pragma unroll
            for (int hf = 0; hf < 2; ++hf) st8[dt * 128 + hf] = (v4u){pk2(S[dt][8 * hf], S[dt][8 * hf + 1]), pk2(S[dt][8 * hf + 2], S[dt][8 * hf + 3]), pk2(S[dt][8 * hf + 4], S[dt][8 * hf + 5]), pk2(S[dt][8 * hf + 6], S[dt][8 * hf + 7])};
        if (F.tid < 128) wt_st4(DSC + (bh * 32 + sc) * 128 + F.tid, fexp(sumbl));
    }
}
__device__ __forceinline__ void gla_scan_phase(Frame& F) {
    v4u* ST8 = (v4u*)(F.ws + WS_ST); const float* DSC = (const float*)(F.ws + WS_DSC);
    for (int idx = F.bid * NTHR + F.tid; idx < 16 * 4096; idx += F.G * NTHR) {
        const int bh = idx >> 12, u8 = idx & 4095, hf = u8 & 1, ln = (u8 >> 1) & 63, dt = (u8 >> 7) & 3, row0 = 32 * dt + 16 * hf + 4 * (ln >> 5);
        float S[8];
#pragma unroll
        for (int e = 0; e < 8; ++e) S[e] = 0.f;
#pragma unroll 8
        for (int sc = 0; sc < 32; ++sc) {
            v4u* p = ST8 + (size_t)(bh * 32 + sc) * 4096 + u8; const v4u raw = *p; float tmp[8]; unpack8(raw, tmp);
            *p = (v4u){pk2(S[0], S[1]), pk2(S[2], S[3]), pk2(S[4], S[5]), pk2(S[6], S[7])};
            const f32x4 d0 = *(const f32x4*)(DSC + (bh * 32 + sc) * 128 + row0), d1 = *(const f32x4*)(DSC + (bh * 32 + sc) * 128 + row0 + 8);
            S[0] = S[0] * d0.x + tmp[0]; S[1] = S[1] * d0.y + tmp[1]; S[2] = S[2] * d0.z + tmp[2]; S[3] = S[3] * d0.w + tmp[3];
            S[4] = S[4] * d1.x + tmp[4]; S[5] = S[5] * d1.y + tmp[5]; S[6] = S[6] * d1.z + tmp[6]; S[7] = S[7] * d1.w + tmp[7];
        }
    }
}
__device__ __forceinline__ void gla_out_phase(Frame& F, const float* wgu, const float* bgu, const float* ogain) {
    const float* ST = (const float*)(F.ws + WS_ST); const bf16_t* GR = (const bf16_t*)(F.ws + WS_GR); const __amdgpu_buffer_rsrc_t gr_r = wt_rsrc(F.ws + WS_YG);
    const int lane = F.lane, l31 = lane & 31, hh = lane >> 5, wave = F.wave; LAS unsigned char* L = F.lds;
    const LAS unsigned char* pv0 = L + GL_VT + (wave >> 2) * 16384 + (wave & 3) * 512 + gl_tr_base(lane, 4 * hh); const LAS unsigned char* pv1 = L + GL_VT + (wave >> 2) * 16384 + (wave & 3) * 512 + gl_tr_base(lane, 4 * hh + 8);
    for (int u = F.bid; u < 512; u += F.G) {
        const int sc = u & 31, bh = u >> 5, b = bh >> 2, h = bh & 3;
        bf16x8 whi, wlo; float bias; gla_load_w(F, wgu, bgu, h, whi, wlo, bias);
        f32x16 S[4];
        { const v4u* st8 = (const v4u*)ST + (size_t)(bh * 32 + sc) * 4096 + (wave * 4 * 64 + lane) * 2;
#pragma unroll
          for (int dt = 0; dt < 4; ++dt)
#pragma unroll
              for (int hf = 0; hf < 2; ++hf) { float f[8]; unpack8(st8[dt * 128 + hf], f);
#pragma unroll
                  for (int e = 0; e < 8; ++e) S[dt][8 * hf + e] = f[e]; } }
#pragma unroll 1
        for (int c = 0; c < 4; ++c) {
            const size_t m0 = (size_t)b * SEQ + sc * 256 + c * 64;
            (void)gla_stage<true>(F, h, m0, whi, wlo, bias);
            f32x16 o0, o1;
#pragma unroll
            for (int r = 0; r < 16; ++r) { o0[r] = 0.f; o1[r] = 0.f; }
#pragma unroll
            for (int dt = 0; dt < 4; ++dt)
#pragma unroll
                for (int s = 0; s < 2; ++s) {
                    const bf16x8 bs = pack8(S[dt], s);
                    const int ko = (32 * dt + 16 * s + 4 * hh) * 2;
                    o0 = mfma32(ld2x8(L + GL_QT + l31 * GL_QROW + ko), bs, o0);
                    o1 = mfma32(ld2x8(L + GL_QT + (32 + l31) * GL_QROW + ko), bs, o1);
                }
            __builtin_amdgcn_sched_barrier(0);
#pragma unroll
            for (int tile = 0; tile < 3; ++tile) {
                const int jt = (tile == 2) ? 1 : 0, it = (tile == 0) ? 0 : 1;
                f32x16 p;
#pragma unroll
                for (int r = 0; r < 16; ++r) p[r] = 0.f;
#pragma unroll
                for (int ks = 0; ks < 8; ++ks) {
                    const int ko = (16 * ks + 8 * hh) * 2;
                    const bf16x8 a = *(const LAS bf16x8*)(L + GL_KT + (32 * jt + l31) * GL_QROW + ko);
                    const bf16x8 b = *(const LAS bf16x8*)(L + GL_QT + (32 * it + l31) * GL_QROW + ko);
                    p = mfma32(a, b, p);
                }
                if (jt == it) {
#pragma unroll
                    for (int r = 0; r < 16; ++r) { const int j = (r & 3) + 8 * (r >> 2) + 4 * hh; p[r] = (j > l31) ? 0.f : p[r]; }
                }
#pragma unroll
                for (int s = 0; s < 2; ++s) {
                    const bf16x8 bv = gl_tr2(pv0 + 8192 * jt + 4096 * s, pv1 + 8192 * jt + 4096 * s);
                    if (it == 0) o0 = mfma32(pack8(p, s), bv, o0); else o1 = mfma32(pack8(p, s), bv, o1);
                }
                __builtin_amdgcn_sched_barrier(0);
            }
            gla_state_update(F, S);
            __syncthreads();
#pragma unroll
            for (int r = 0; r < 16; ++r) { const int i = (r & 3) + 8 * (r >> 2) + 4 * hh;
                *(LAS float*)(L + GL_OB + i * GL_OBROW + (32 * wave + l31) * 4) = o0[r]; *(LAS float*)(L + GL_OB + (32 + i) * GL_OBROW + (32 * wave + l31) * 4) = o1[r]; }
            __syncthreads();
            {
                const int t = F.tid >> 3, part = F.tid & 7;
                float v[32]; float ss = 0.f;
#pragma unroll
                for (int i = 0; i < 8; ++i) { const f32x4 x = *(const LAS f32x4*)(L + GL_OB + t * GL_OBROW + (32 * part + 4 * i) * 4); v[4 * i] = x.x; v[4 * i + 1] = x.y; v[4 * i + 2] = x.z; v[4 * i + 3] = x.w; ss += (x.x * x.x + x.y * x.y) + (x.z * x.z + x.w * x.w); }
                ss += __shfl_xor(ss, 1); ss += __shfl_xor(ss, 2); ss += __shfl_xor(ss, 4);
                const float rstd = rsqrtf(ss * (1.f / 256.f) + EPS);
                const bf16_t* gp = GR + (m0 + t) * 1024 + h * 256 + 32 * part;
#pragma unroll
                for (int i = 0; i < 4; ++i) { const v4u raw = *(const v4u*)(gp + 8 * i); float rr[8]; unpack8(raw, rr);
                    const f32x4 g0 = *(const f32x4*)(ogain + 32 * part + 8 * i), g1 = *(const f32x4*)(ogain + 32 * part + 8 * i + 4);
                    v4u o; o.x = pk2(v[8 * i] * rstd * g0.x * rr[0], v[8 * i + 1] * rstd * g0.y * rr[1]); o.y = pk2(v[8 * i + 2] * rstd * g0.z * rr[2], v[8 * i + 3] * rstd * g0.w * rr[3]);
                    o.z = pk2(v[8 * i + 4] * rstd * g1.x * rr[4], v[8 * i + 5] * rstd * g1.y * rr[5]); o.w = pk2(v[8 * i + 6] * rstd * g1.z * rr[6], v[8 * i + 7] * rstd * g1.w * rr[7]);
                    wt_st16(gr_r, (unsigned)(((m0 + t) * 1024 + h * 256 + 32 * part + 8 * i) * 2), o); }
            }
        }
    }
    __syncthreads();
}

constexpr int PK_KROW = 272, PK_K_OFF = 0, PK_SCR_OFF = 2 * 128 * PK_KROW;
__device__ __forceinline__ void ce(unsigned& a, unsigned& b) { const unsigned mx = a > b ? a : b, mn = a > b ? b : a; a = mx; b = mn; }
template <int N> __device__ __forceinline__ void bitonic_sort_desc(unsigned (&x)[N]) {
#pragma unroll
    for (int k = 2; k <= N; k <<= 1)
#pragma unroll
        for (int j = k >> 1; j > 0; j >>= 1)
#pragma unroll
            for (int i = 0; i < N; ++i) { const int l = i ^ j; if (l > i) { if ((i & k) == 0) ce(x[i], x[l]); else ce(x[l], x[i]); } }
}
__device__ __forceinline__ void sort16_desc(unsigned (&x)[16]) {
    ce(x[0], x[13]); ce(x[1], x[12]); ce(x[2], x[15]); ce(x[3], x[14]); ce(x[4], x[8]); ce(x[5], x[6]); ce(x[7], x[11]); ce(x[9], x[10]); ce(x[0], x[5]); ce(x[1], x[7]); ce(x[2], x[9]); ce(x[3], x[4]); ce(x[6], x[13]); ce(x[8], x[14]); ce(x[10], x[15]); ce(x[11], x[12]); ce(x[0], x[1]); ce(x[2], x[3]); ce(x[4], x[5]); ce(x[6], x[8]); ce(x[7], x[9]); ce(x[10], x[11]); ce(x[12], x[13]); ce(x[14], x[15]); ce(x[0], x[2]); ce(x[1], x[3]); ce(x[4], x[10]); ce(x[5], x[11]); ce(x[6], x[7]); ce(x[8], x[9]); ce(x[12], x[14]); ce(x[13], x[15]); ce(x[1], x[2]); ce(x[3], x[12]); ce(x[4], x[6]); ce(x[5], x[7]); ce(x[8], x[10]); ce(x[9], x[11]); ce(x[13], x[14]); ce(x[1], x[4]); ce(x[2], x[6]); ce(x[5], x[8]); ce(x[7], x[10]); ce(x[9], x[13]); ce(x[11], x[14]); ce(x[2], x[4]); ce(x[3], x[6]); ce(x[9], x[12]); ce(x[11], x[13]); ce(x[3], x[5]); ce(x[6], x[8]); ce(x[7], x[9]); ce(x[10], x[12]); ce(x[3], x[4]); ce(x[5], x[6]); ce(x[7], x[8]); ce(x[9], x[10]); ce(x[11], x[12]); ce(x[6], x[7]); ce(x[8], x[9]);
}
__device__ __forceinline__ void merge16(unsigned (&a)[16], const unsigned (&b)[16]) {
#pragma unroll
    for (int i = 0; i < 16; ++i) a[i] = a[i] > b[15 - i] ? a[i] : b[15 - i];
#pragma unroll
    for (int j = 8; j > 0; j >>= 1)
#pragma unroll
        for (int i = 0; i < 16; ++i) { const int l = i ^ j; if (l > i) ce(a[i], a[l]); }
}
__device__ __forceinline__ void merge16_partner(unsigned (&a)[16]) {
    unsigned b[16];
#pragma unroll
    for (int i = 0; i < 16; ++i) b[i] = (unsigned)__shfl_xor((int)a[i], 32);
    merge16(a, b);
}
__device__ __forceinline__ unsigned f2key(float f) { const unsigned u = __builtin_bit_cast(unsigned, f); return u ^ ((unsigned)((int)u >> 31) | 0x80000000u); }
__device__ __forceinline__ float key2f(unsigned k) { const unsigned m = ~(unsigned)((int)k >> 31) | 0x80000000u; return __builtin_bit_cast(float, k ^ m); }
__device__ constexpr int PEER_CI[50] = {0,0,0,0,0,0,0,0,0,0,0,0,0,0,0,0, 1,1,1,1,1,1,1,1, 2,2,2,2,2, 3,3,3,3, 4,4,4, 5,5, 6,6, 7,7, 8,9,10,11,12,13,14,15};
__device__ constexpr int PEER_CJ[50] = {0,1,2,3,4,5,6,7,8,9,10,11,12,13,14,15, 0,1,2,3,4,5,6,7, 0,1,2,3,4, 0,1,2,3, 0,1,2, 0,1, 0,1, 0,1, 0,0,0,0,0,0,0,0};
__device__ __forceinline__ void top16_of_tiles(const f32x16 (&s)[4], int hh, unsigned (&top)[16]) {
#pragma unroll
    for (int mt = 0; mt < 4; ++mt) {
        unsigned g[16];
#pragma unroll
        for (int r = 0; r < 16; ++r) { const unsigned low = (unsigned)(127 - (32 * mt + (r & 3) + 8 * (r >> 2))) - 4u * (unsigned)hh; g[r] = (f2key(s[mt][r]) & ~127u) | low; }
        sort16_desc(g);
        if (mt == 0) {
#pragma unroll
            for (int i = 0; i < 16; ++i) top[i] = g[i];
        } else merge16(top, g);
    }
    merge16_partner(top);
}
__device__ __forceinline__ void peer_topk_phase(Frame& F) {
    const bf16_t* QP = (const bf16_t*)(F.ws + WS_QP); const bf16_t* SUBK = (const bf16_t*)(F.ws + WS_SUBK);
    unsigned short* IDX = (unsigned short*)(F.ws + WS_IDX); float* GATE = (float*)(F.ws + WS_GATE);
    LAS unsigned char* L = F.lds; const int tid = F.tid, lane = F.lane, wave = F.wave, l31 = lane & 31, hh = lane >> 5;
    LAS unsigned* scr = (LAS unsigned*)(L + PK_SCR_OFF + wave * 8192);
    pg8::StaticOrder S; S.init(T, 2048, F.G, F.bid);
    for (int ui = 0; ; ++ui) {
        pg8::Unit un; if (!S.next(ui, un)) break;
        const int h = un.pn, tile = un.pm;
        __syncthreads();
#pragma unroll
        for (int i = 0; i < 8; ++i) { const int v = tid + 512 * i, row = v >> 4, c = v & 15;
            *(LAS v4u*)(L + PK_K_OFF + row * PK_KROW + c * 16) = *(const v4u*)(SUBK + ((size_t)h * 256 + row) * 128 + c * 8); }
        __syncthreads();
        const int tok = tile * 256 + wave * 32 + l31;
        unsigned ka[16], kb[16];
#pragma unroll
        for (int p = 0; p < 2; ++p) {
            f32x16 s[4];
#pragma unroll
            for (int mt = 0; mt < 4; ++mt)
#pragma unroll
                for (int r = 0; r < 16; ++r) s[mt][r] = 0.f;
            const bf16_t* qrow = QP + (size_t)tok * 2048 + h * 256 + p * 128 + 8 * hh;
#pragma unroll
            for (int k2 = 0; k2 < 4; ++k2) {
                const bf16x8 q0 = *(const bf16x8*)(qrow + 32 * k2), q1 = *(const bf16x8*)(qrow + 32 * k2 + 16);
#pragma unroll
                for (int mt = 0; mt < 4; ++mt) { const bf16x8 a = *(const LAS bf16x8*)(L + PK_K_OFF + (p * 128 + 32 * mt + l31) * PK_KROW + (32 * k2 + 8 * hh) * 2); s[mt] = mfma32(a, q0, s[mt]); }
#pragma unroll
                for (int mt = 0; mt < 4; ++mt) { const bf16x8 a = *(const LAS bf16x8*)(L + PK_K_OFF + (p * 128 + 32 * mt + l31) * PK_KROW + (32 * k2 + 16 + 8 * hh) * 2); s[mt] = mfma32(a, q1, s[mt]); }
                __builtin_amdgcn_sched_barrier(0);
            }
            if (p == 0) top16_of_tiles(s, hh, ka); else top16_of_tiles(s, hh, kb);
        }
        float sa[16], sb[16];
#pragma unroll
        for (int i = 0; i < 16; ++i) { sa[i] = key2f(ka[i] & ~127u); sb[i] = key2f(kb[i] & ~127u); scr[i * 64 + lane] = 127u - (ka[i] & 127u); scr[(16 + i) * 64 + lane] = 127u - (kb[i] & 127u); }
        unsigned c0[16], c1[16];
#pragma unroll
        for (int n = 0; n < 32; ++n) {
            unsigned key = 0u;
            if (n < 25) { const int e0 = 2 * n, e1 = 2 * n + 1;
                const float v0 = sa[PEER_CI[e0]] + sb[PEER_CJ[e0]], v1 = sa[PEER_CI[e1]] + sb[PEER_CJ[e1]];
                const unsigned k0 = (f2key(v0) & ~255u) | (unsigned)(255 - (PEER_CI[e0] * 16 + PEER_CJ[e0])), k1 = (f2key(v1) & ~255u) | (unsigned)(255 - (PEER_CI[e1] * 16 + PEER_CJ[e1]));
                key = hh ? k1 : k0; }
            if (n < 16) c0[n] = key; else c1[n - 16] = key;
        }
        sort16_desc(c0); sort16_desc(c1); merge16(c0, c1); merge16_partner(c0);
        float e[16]; float sum = 0.f; const float mx = key2f(c0[0] & ~255u);
#pragma unroll
        for (int n = 0; n < 16; ++n) { e[n] = fexp(key2f(c0[n] & ~255u) - mx); sum += e[n]; }
        const float inv = 1.0f / sum;
        int eo[8]; float go[8];
#pragma unroll
        for (int n = 0; n < 8; ++n) { const unsigned kk = hh ? c0[8 + n] : c0[n]; const unsigned id = 255u - (kk & 255u);
            const unsigned i1 = scr[(id >> 4) * 64 + lane], i2 = scr[(16 + (id & 15)) * 64 + lane];
            eo[n] = (int)(i1 * 128u + i2); go[n] = (hh ? e[8 + n] : e[n]) * inv; }
        typedef int i32x4 __attribute__((ext_vector_type(4)));
        { const __amdgpu_buffer_rsrc_t gr = wt_rsrc(GATE); const unsigned bo = (unsigned)(((size_t)tok * 128 + h * 16 + 8 * hh) * 4);
          wt_st16(gr, bo, __builtin_bit_cast(wt_u32x4, (f32x4){go[0], go[1], go[2], go[3]})); wt_st16(gr, bo + 16, __builtin_bit_cast(wt_u32x4, (f32x4){go[4], go[5], go[6], go[7]}));
          unsigned short* ip = IDX + (size_t)tok * 128 + 2 * h + hh;
#pragma unroll
          for (int n = 0; n < 8; ++n) ip[16 * n] = (unsigned short)eo[n]; }
    }
    __syncthreads();
}
constexpr size_t WS_RSTD2 = 482 * MiB, WS_EXD8 = 352 * MiB, WS_EXU8 = 368 * MiB, WS_ISD = 6 * MiB, WS_ISU = 6 * MiB + 65536, WS_PA = 32 * MiB, WS_WEX = 416 * MiB, WS_AQ = 96 * MiB, WS_ASC = 130 * MiB;
__device__ __forceinline__ float gelu_exact(float x) { return 0.5f * x * (1.f + erff(x * 0.7071067811865476f)); }
__device__ __forceinline__ unsigned pack_i8x4(float a, float b, float c, float d) {
    const int ia = (int)rintf(a), ib = (int)rintf(b), ic = (int)rintf(c), id = (int)rintf(d);
    return ((unsigned)ia & 0xffu) | (((unsigned)ib & 0xffu) << 8) | (((unsigned)ic & 0xffu) << 16) | ((unsigned)id << 24);
}
__device__ __forceinline__ unsigned nib_lo(unsigned w) { return w & 0x0F0F0F0Fu; }
__device__ __forceinline__ unsigned nib_hi(unsigned w) { return ((((w ^ 0x80808080u) + 0x08080808u) >> 4) & 0x0F0F0F0Fu) ^ 0x08080808u; }
__device__ __forceinline__ void peer_quant_phase(Frame& F) {
    const bf16_t* HB = (const bf16_t*)(F.ws + WS_HB2); unsigned char* AQ = F.ws + WS_AQ; float* ASC = (float*)(F.ws + WS_ASC); const int lane = F.lane;
    for (int t = F.bid * NWAVES + F.wave; t < T; t += F.G * NWAVES) {
        const v4u* hp = (const v4u*)(HB + (size_t)t * D + 16 * lane); float a[8], b[8]; unpack8(hp[0], a); unpack8(hp[1], b);
        float mx = 0.f;
#pragma unroll
        for (int j = 0; j < 8; ++j) mx = fmaxf(mx, fmaxf(fabsf(a[j]), fabsf(b[j])));
        mx = fmaxf(mx, __shfl_xor(mx, 1)); mx = fmaxf(mx, __shfl_xor(mx, 2)); mx = fmaxf(mx, __shfl_xor(mx, 4)); mx = fmaxf(mx, __shfl_xor(mx, 8));
        const float sx = mx > 0.f ? 119.f / mx : 1.f, isx = mx > 0.f ? mx * (1.f / 119.f) : 1.f;
        const unsigned w0 = pack_i8x4(a[0] * sx, a[2] * sx, a[4] * sx, a[6] * sx), w1 = pack_i8x4(a[1] * sx, a[3] * sx, a[5] * sx, a[7] * sx);
        const unsigned w2 = pack_i8x4(b[0] * sx, b[2] * sx, b[4] * sx, b[6] * sx), w3 = pack_i8x4(b[1] * sx, b[3] * sx, b[5] * sx, b[7] * sx);
        unsigned char* base = AQ + ((size_t)(t * 4 + (lane >> 4)) * 8 + ((lane & 15) >> 1)) * 32 + (lane & 1) * 8;
        *(v2u*)base = (v2u){nib_hi(w0) | (nib_hi(w1) << 4), nib_hi(w2) | (nib_hi(w3) << 4)};
        *(v2u*)(base + 16) = (v2u){nib_lo(w0) | (nib_lo(w1) << 4), nib_lo(w2) | (nib_lo(w3) << 4)};
        if ((lane & 15) == 0) ASC[t * 4 + (lane >> 4)] = isx;
    }
}
__device__ __forceinline__ void treduce16(float (&p)[16], int lane, int m) {
#pragma unroll
    for (int i = 0; i < 8; ++i) { const bool hi = lane & m; const float send = hi ? p[i] : p[i + 8], keep = hi ? p[i + 8] : p[i]; p[i] = keep + __shfl_xor(send, m); }
#pragma unroll
    for (int i = 0; i < 4; ++i) { const bool hi = lane & (2 * m); const float send = hi ? p[i] : p[i + 4], keep = hi ? p[i + 4] : p[i]; p[i] = keep + __shfl_xor(send, 2 * m); }
#pragma unroll
    for (int i = 0; i < 2; ++i) { const bool hi = lane & (4 * m); const float send = hi ? p[i] : p[i + 2], keep = hi ? p[i + 2] : p[i]; p[i] = keep + __shfl_xor(send, 4 * m); }
}
typedef int i32x4v __attribute__((ext_vector_type(4)));
__device__ __forceinline__ void treduce16i_g(int (&p)[16], int lane) {
#pragma unroll
    for (int i = 0; i < 8; ++i) { const v2u r = __builtin_amdgcn_permlane32_swap((unsigned)p[i], (unsigned)p[i + 8], false, false); p[i] = (int)(r.x + r.y); }
#pragma unroll
    for (int i = 0; i < 4; ++i) { const v2u r = __builtin_amdgcn_permlane16_swap((unsigned)p[i], (unsigned)p[i + 4], false, false); p[i] = (int)(r.x + r.y); }
    const bool hi = lane & 8;
#pragma unroll
    for (int i = 0; i < 2; ++i) { const int send = hi ? p[i] : p[i + 2], keep = hi ? p[i + 2] : p[i]; p[i] = keep + __builtin_amdgcn_update_dpp(0, send, 0x128, 0xF, 0xF, false); }
}
__device__ __forceinline__ void peer_load_ids(const unsigned short* IDX, size_t t, int g, i32x4v (&id)[4]) {
    const v4u* p = (const v4u*)(IDX + t * 128 + g * 16); const v4u a = p[0], b = p[1];
    id[0] = (i32x4v){(int)(a.x & 0xffffu), (int)(a.x >> 16), (int)(a.y & 0xffffu), (int)(a.y >> 16)}; id[1] = (i32x4v){(int)(a.z & 0xffffu), (int)(a.z >> 16), (int)(a.w & 0xffffu), (int)(a.w >> 16)};
    id[2] = (i32x4v){(int)(b.x & 0xffffu), (int)(b.x >> 16), (int)(b.y & 0xffffu), (int)(b.y >> 16)}; id[3] = (i32x4v){(int)(b.z & 0xffffu), (int)(b.z >> 16), (int)(b.w & 0xffffu), (int)(b.w >> 16)};
}
__device__ __forceinline__ void peer_load_w(const bf16_t* WEX, size_t t, int g, v4u (&w)[2]) {
    const v4u* p = (const v4u*)(WEX + t * 128 + g * 16); w[0] = p[0]; w[1] = p[1];
}
__device__ __forceinline__ void peer_v8_lds(LAS unsigned char* scr, unsigned raw, int lane, int grp, v4u (&o)[2]) {
    *(LAS unsigned*)(scr + 4 * lane) = raw; asm volatile("" ::: "memory");
    o[0] = *(const LAS v4u*)(scr + 32 * grp); o[1] = *(const LAS v4u*)(scr + 32 * grp + 16); asm volatile("" ::: "memory");
}
__device__ __forceinline__ void peer_ids_lds(LAS unsigned char* scr, unsigned raw, int lane, i32x4v (&id)[4]) {
    v4u r[2]; peer_v8_lds(scr, raw, lane, lane >> 3, r); const v4u a = r[0], b = r[1];
    id[0] = (i32x4v){(int)(a.x & 0xffffu), (int)(a.x >> 16), (int)(a.y & 0xffffu), (int)(a.y >> 16)}; id[1] = (i32x4v){(int)(a.z & 0xffffu), (int)(a.z >> 16), (int)(a.w & 0xffffu), (int)(a.w >> 16)};
    id[2] = (i32x4v){(int)(b.x & 0xffffu), (int)(b.x >> 16), (int)(b.y & 0xffffu), (int)(b.y >> 16)}; id[3] = (i32x4v){(int)(b.z & 0xffffu), (int)(b.z >> 16), (int)(b.w & 0xffffu), (int)(b.w >> 16)};
}
#ifndef PEER_GATHER_AUX
#define PEER_GATHER_AUX 16
#endif
__device__ __forceinline__ void peer_gather16(v4u (&q)[16], const __amdgpu_buffer_rsrc_t r, unsigned loff, const i32x4v (&id)[4]) {
#pragma unroll
    for (int i = 0; i < 16; ++i) q[i] = __builtin_bit_cast(v4u, __builtin_amdgcn_raw_buffer_load_b128(r, (unsigned)id[i >> 2][i & 3] * 128u + loff, 0, PEER_GATHER_AUX));
}
__device__ __forceinline__ void peer_down_compute(const v4u (&q)[16], const v4u (&aq)[2], float isx, bf16_t* pa, int lane) {
    float p[16];
#pragma unroll
    for (int i = 0; i < 16; ++i) { int ah = __builtin_amdgcn_sdot8((int)q[i][0], (int)aq[0][0], 0, true), al = __builtin_amdgcn_sdot8((int)q[i][0], (int)aq[1][0], 0, true);
#pragma unroll
        for (int j = 1; j < 4; ++j) { ah = __builtin_amdgcn_sdot8((int)q[i][j], (int)aq[0][j], ah, false); al = __builtin_amdgcn_sdot8((int)q[i][j], (int)aq[1][j], al, false); }
        p[i] = (float)(16 * ah + al) * isx; }
    treduce16(p, lane, 1);
    *(unsigned*)(pa + 2 * lane) = pk2(p[0], p[1]);
}
__device__ __forceinline__ void peer_down_phase(Frame& F) {
    const unsigned char* TD = F.ws + WS_EXD8; const unsigned short* IDX = (const unsigned short*)(F.ws + WS_IDX);
    bf16_t* PA = (bf16_t*)(F.ws + WS_PA); const bf16_t* h1 = (const bf16_t*)(F.ws + WS_HB2);
    const unsigned char* AQ = F.ws + WS_AQ; const float* ASC = (const float*)(F.ws + WS_ASC);
    const int lane = F.lane, g = lane >> 3, cl = lane & 7, k = (F.bid & 7) >> 1, nw = (F.G >> 3) * 2 * NWAVES;
    const __amdgpu_buffer_rsrc_t tk = wt_rsrc(TD + (size_t)k * 16384 * 128); const unsigned loff = 16u * (unsigned)cl;
    int t = ((F.bid >> 3) * 2 + (F.bid & 1)) * NWAVES + F.wave;
    if (t >= T) return;
    LAS unsigned char* scrI = F.lds + F.wave * 512; LAS unsigned char* scrA = scrI + 256;
    const unsigned* IDXW = (const unsigned*)IDX + lane; const unsigned* AQW = (const unsigned*)AQ + k * 64 + lane;
    i32x4v id[4];
    unsigned idr = IDXW[(size_t)t * 64];
    peer_ids_lds(scrI, idr, lane, id);
    v4u qa[16], qb[16];
    peer_gather16(qa, tk, loff, id);
    { const int tl = (t + nw < T) ? t + nw : t; idr = IDXW[(size_t)tl * 64]; }
    float hs = ASC[t * 4 + k];
    unsigned aqr = AQW[(size_t)t * 256];
#define PEER_DOWN_STEP(QC, QN) { \
        const int t1 = t + nw, t2 = t + 2 * nw; const bool has1 = t1 < T; \
        peer_ids_lds(scrI, idr, lane, id); \
        if (has1) peer_gather16(QN, tk, loff, id); \
        { const int tl = (t2 < T) ? t2 : t; idr = IDXW[(size_t)tl * 64]; } \
        v4u hv[2]; peer_v8_lds(scrA, aqr, lane, cl, hv); \
        unsigned aqn; float hsn; { const int tl = has1 ? t1 : t; aqn = AQW[(size_t)tl * 256]; hsn = ASC[tl * 4 + k]; } \
        __builtin_amdgcn_sched_barrier(0); \
        peer_down_compute(QC, hv, hs, PA + ((size_t)k * T + t) * 128, lane); \
        __builtin_amdgcn_sched_barrier(0); \
        if (!has1) break; t = t1; aqr = aqn; hs = hsn; }
    for (;;) { PEER_DOWN_STEP(qa, qb) PEER_DOWN_STEP(qb, qa) }
#undef PEER_DOWN_STEP
}
__device__ __forceinline__ void peer_combine_phase(Frame& F) {
    const unsigned* PAW = (const unsigned*)(F.ws + WS_PA); const unsigned* IDXW = (const unsigned*)(F.ws + WS_IDX); const float* GATE = (const float*)(F.ws + WS_GATE);
    const float* ISD = (const float*)(F.ws + WS_ISD); const float* ISU = (const float*)(F.ws + WS_ISU); unsigned* WQ = (unsigned*)(F.ws + WS_WEX); float* WSC = (float*)(F.ws + WS_WEX + 8 * MiB); const float* RSTD2 = (const float*)(F.ws + WS_RSTD2);
    const int lane = F.lane, g = lane >> 3, w = lane & 7, cl = ((w & 1) << 2) | (w & 2) | ((w >> 2) & 1);
    for (int t = F.bid * NWAVES + F.wave; t < T; t += F.G * NWAVES) {
        float a0 = 0.f, a1 = 0.f;
#pragma unroll
        for (int k = 0; k < 4; ++k) { const unsigned r = PAW[((size_t)k * T + t) * 64 + 8 * g + cl]; a0 += __builtin_bit_cast(float, r << 16); a1 += __builtin_bit_cast(float, r & 0xffff0000u); }
        const unsigned idp = IDXW[(size_t)t * 64 + 8 * g + w]; const int id0 = (int)(idp & 0xffffu), id1 = (int)(idp >> 16);
        const float g0 = GATE[(size_t)t * 128 + 16 * w + g], g1 = GATE[(size_t)t * 128 + 16 * w + 8 + g], rs = RSTD2[t];
        const pg8::f32x2 ge = pg8::gelu_pk((pg8::f32x2){a0 * rs * ISD[id0], a1 * rs * ISD[id1]});
        const float w0 = g0 * ge.x * ISU[id0], w1 = g1 * ge.y * ISU[id1];
        float mx = fmaxf(fabsf(w0), fabsf(w1));
#pragma unroll
        for (int o = 1; o < 64; o <<= 1) mx = fmaxf(mx, __shfl_xor(mx, o));
        const float sw = mx > 0.f ? 119.f / mx : 1.f, isw = mx > 0.f ? mx * (1.f / 119.f) : 1.f;
        const unsigned by = ((unsigned)(int)rintf(w0 * sw) & 0xffu) | (((unsigned)(int)rintf(w1 * sw) & 0xffu) << 8);
        const unsigned h = nib_hi(by) & 0x0F0Fu, l = nib_lo(by) & 0x0F0Fu;
        unsigned v0 = (h & 0xFu) << (4 * g), v1 = (l & 0xFu) << (4 * g), v2 = ((h >> 8) & 0xFu) << (4 * g), v3 = ((l >> 8) & 0xFu) << (4 * g);
#pragma unroll
        for (int o = 8; o < 64; o <<= 1) { v0 |= (unsigned)__shfl_xor((int)v0, o); v1 |= (unsigned)__shfl_xor((int)v1, o); v2 |= (unsigned)__shfl_xor((int)v2, o); v3 |= (unsigned)__shfl_xor((int)v3, o); }
        if (g == 0) *(v4u*)(WQ + (size_t)t * 32 + 4 * w) = (v4u){v0, v1, v2, v3};
        if (lane == 0) WSC[t] = isw;
    }
}
constexpr int PU_ROW = 144, PU_BUF = 64 * PU_ROW, PU_OFF = 4096;
typedef int pu_v2i __attribute__((ext_vector_type(2)));
__device__ __forceinline__ void peer_up_compute(const v4u (&q)[16], const LAS unsigned char* scrW, float isw, const unsigned short (&hraw)[4], __amdgpu_buffer_rsrc_t dst_r, unsigned doff, LAS unsigned char* wrb, const LAS unsigned char* trb) {
    int ah[4], al[4];
#pragma unroll
    for (int h = 0; h < 2; ++h) {
#pragma unroll
        for (int ip = 0; ip < 8; ++ip) *(LAS v4u*)(wrb + 8 * PU_ROW * ip) = q[8 * h + ip];
        asm volatile("" ::: "memory");
#pragma unroll
        for (int b = 0; b < 4; ++b) {
            const v4u w4 = *(const LAS v4u*)(scrW + 16 * (4 * h + b));
#pragma unroll
            for (int m = 0; m < 4; ++m) {
                const pu_v2i d = __builtin_amdgcn_ds_read_tr4_b64_v2i32((LAS pu_v2i*)(trb + 16 * PU_ROW * b + 32 * m));
                if (h == 0 && b == 0) { ah[m] = __builtin_amdgcn_sdot8(d.x, (int)w4.x, 0, true); al[m] = __builtin_amdgcn_sdot8(d.x, (int)w4.y, 0, true); }
                else { ah[m] = __builtin_amdgcn_sdot8(d.x, (int)w4.x, ah[m], false); al[m] = __builtin_amdgcn_sdot8(d.x, (int)w4.y, al[m], false); }
                ah[m] = __builtin_amdgcn_sdot8(d.y, (int)w4.z, ah[m], false); al[m] = __builtin_amdgcn_sdot8(d.y, (int)w4.w, al[m], false);
            }
        }
        asm volatile("" ::: "memory");
    }
#pragma unroll
    for (int m = 0; m < 4; ++m) __builtin_amdgcn_raw_buffer_store_b32(__builtin_bit_cast(unsigned, __builtin_bit_cast(float, (unsigned)hraw[m] << 16) + (float)(16 * ah[m] + al[m]) * isw), dst_r, doff + 256u * m, 0, 0);
}
__device__ __forceinline__ void peer_up_phase(Frame& F, float* dst) {
    const unsigned char* TU = F.ws + WS_EXU8; const unsigned short* IDX = (const unsigned short*)(F.ws + WS_IDX); const bf16_t* WEX = (const bf16_t*)(F.ws + WS_WEX);
    const int lane = F.lane, g = lane >> 3, cl = lane & 7, k = (F.bid & 7) >> 1, nw = (F.G >> 3) * 2 * NWAVES;
    const __amdgpu_buffer_rsrc_t tk = wt_rsrc(TU + (size_t)k * 16384 * 128); const unsigned loff = 16u * (unsigned)cl;
    const int ccol = 256 * k + lane;
    int t = ((F.bid >> 3) * 2 + (F.bid & 1)) * NWAVES + F.wave;
    if (t >= T) return;
    LAS unsigned char* scrI = F.lds + F.wave * 512; LAS unsigned char* scrW = scrI + 256;
    LAS unsigned char* rbuf = F.lds + PU_OFF + F.wave * PU_BUF;
    LAS unsigned char* wrb = rbuf + g * PU_ROW + 16 * cl;
    const LAS unsigned char* trb = rbuf + (lane & 15) * PU_ROW + 8 * (lane >> 4);
    const unsigned* IDXW = (const unsigned*)IDX + lane; const unsigned* WEXW = (const unsigned*)WEX + (lane & 31); const float* WSC = (const float*)(F.ws + WS_WEX + 8 * MiB);
    i32x4v id[4];
    unsigned idr = IDXW[(size_t)t * 64], wr = WEXW[(size_t)t * 32]; float ws = WSC[t];
    peer_ids_lds(scrI, idr, lane, id);
    v4u qa[16], qb[16];
    peer_gather16(qa, tk, loff, id);
    { const int tl = (t + nw < T) ? t + nw : t; idr = IDXW[(size_t)tl * 64]; }
    const __amdgpu_buffer_rsrc_t hb_r = wt_rsrc(F.ws + WS_HB2), dst_r = wt_rsrc(dst);
    unsigned short hcur[4];
#pragma unroll
    for (int m = 0; m < 4; ++m) hcur[m] = __builtin_amdgcn_raw_buffer_load_b16(hb_r, (unsigned)(t * D + ccol) * 2u + 128u * m, 0, 0);
#define PEER_UP_STEP(QC, QN) { \
        const int t1 = t + nw, t2 = t + 2 * nw; const bool has1 = t1 < T; \
        peer_ids_lds(scrI, idr, lane, id); \
        if (has1) peer_gather16(QN, tk, loff, id); \
        { const int tl = (t2 < T) ? t2 : t; idr = IDXW[(size_t)tl * 64]; } \
        const unsigned wrn = WEXW[(size_t)(has1 ? t1 : t) * 32]; const float wsn = WSC[has1 ? t1 : t]; \
        unsigned short hnext[4]; _Pragma("unroll") for (int m = 0; m < 4; ++m) hnext[m] = __builtin_amdgcn_raw_buffer_load_b16(hb_r, (unsigned)((has1 ? t1 : t) * D + ccol) * 2u + 128u * m, 0, 0); \
        *(LAS unsigned*)(scrW + 4 * (lane & 31)) = wr; asm volatile("" ::: "memory"); \
        __builtin_amdgcn_sched_barrier(0); \
        peer_up_compute(QC, scrW, ws, hcur, dst_r, (unsigned)(t * D + ccol) * 4u, wrb, trb); \
        __builtin_amdgcn_sched_barrier(0); \
        if (!has1) break; t = t1; _Pragma("unroll") for (int m = 0; m < 4; ++m) hcur[m] = hnext[m]; wr = wrn; ws = wsn; }
    for (;;) { PEER_UP_STEP(qa, qb) PEER_UP_STEP(qb, qa) }
#undef PEER_UP_STEP
}
__device__ __forceinline__ void expert_convert(Frame& F, const float* exd, const float* exu, const float* gain2) {
    const int lane = F.lane;
    f32x4 gv[4];
#pragma unroll
    for (int j = 0; j < 4; ++j) gv[j] = *(const f32x4*)(gain2 + 16 * lane + 4 * j);
    const bool wsplit = (F.G == 256); const int nscan = 128 * NWAVES;
    int gi = F.bid * NWAVES + F.wave, gstep = F.G * NWAVES, gend = 8192;
    if (wsplit) { gstep = nscan; if (F.bid < 128) { gend = 2 * nscan; } else { gi = 2 * nscan + (F.bid - 128) * NWAVES + F.wave; } }
    for (; gi < gend; gi += gstep) { const int r4 = gi * 4;
        const int tb = r4 >> 14, row0 = r4 & 16383;
        const float* src = (tb ? exu : exd) + (size_t)row0 * D + 16 * lane;
        f32x4 v[4][4]; float mx[4];
#pragma unroll
        for (int r = 0; r < 4; ++r)
#pragma unroll
            for (int j = 0; j < 4; ++j) v[r][j] = *(const f32x4*)(src + (size_t)r * D + 4 * j);
#pragma unroll
        for (int r = 0; r < 4; ++r) { float m = 0.f;
#pragma unroll
            for (int j = 0; j < 4; ++j) { if (tb == 0) v[r][j] = v[r][j] * gv[j]; m = fmaxf(m, fmaxf(fmaxf(fabsf(v[r][j].x), fabsf(v[r][j].y)), fmaxf(fabsf(v[r][j].z), fabsf(v[r][j].w)))); }
            mx[r] = m; }
#pragma unroll
        for (int o = 1; o < 64; o <<= 1)
#pragma unroll
            for (int r = 0; r < 4; ++r) mx[r] = fmaxf(mx[r], __shfl_xor(mx[r], o));
        {
            float ss[4];
#pragma unroll
            for (int r = 0; r < 4; ++r) { float s = 0.f;
#pragma unroll
                for (int j = 0; j < 4; ++j) s += (v[r][j].x * v[r][j].x + v[r][j].y * v[r][j].y) + (v[r][j].z * v[r][j].z + v[r][j].w * v[r][j].w);
                ss[r] = s; }
#pragma unroll
            for (int o = 1; o < 64; o <<= 1)
#pragma unroll
                for (int r = 0; r < 4; ++r) ss[r] += __shfl_xor(ss[r], o);
#pragma unroll
            for (int r = 0; r < 4; ++r) {
                const float rms = sqrtf(ss[r] * (1.f / 1024.f)), step = rms > 0.f ? 0.35f * rms : 1.f, sc = 1.f / step;
                f32x4 c[4];
#pragma unroll
                for (int j = 0; j < 4; ++j) { c[j] = v[r][j] * sc; c[j].x = fminf(fmaxf(c[j].x, -7.f), 7.f); c[j].y = fminf(fmaxf(c[j].y, -7.f), 7.f); c[j].z = fminf(fmaxf(c[j].z, -7.f), 7.f); c[j].w = fminf(fmaxf(c[j].w, -7.f), 7.f); }
                const unsigned x0 = pack_i8x4(c[0].x, c[0].z, c[1].x, c[1].z), y0 = pack_i8x4(c[0].y, c[0].w, c[1].y, c[1].w);
                const unsigned x1 = pack_i8x4(c[2].x, c[2].z, c[3].x, c[3].z), y1 = pack_i8x4(c[2].y, c[2].w, c[3].y, c[3].w);
                *(v2u*)(F.ws + (tb ? WS_EXU8 : WS_EXD8) + ((size_t)(lane >> 4) * 16384 + row0 + r) * 128 + (lane & 15) * 8) = (v2u){nib_lo(x0) | (nib_lo(y0) << 4), nib_lo(x1) | (nib_lo(y1) << 4)};
                if (lane == 0) wt_st4((float*)(F.ws + (tb ? WS_ISU : WS_ISD)) + row0 + r, step);
            }
            continue;
        }
        const __amdgpu_buffer_rsrc_t rr = wt_rsrc(F.ws + (tb ? WS_EXU8 : WS_EXD8));
#pragma unroll
        for (int r = 0; r < 4; ++r) {
            const float sc = mx[r] > 0.f ? 127.f / mx[r] : 1.f, isc = mx[r] > 0.f ? mx[r] * (1.f / 127.f) : 1.f;
            v4u q;
#pragma unroll
            for (int j = 0; j < 4; ++j) q[j] = pack_i8x4(v[r][j].x * sc, v[r][j].y * sc, v[r][j].z * sc, v[r][j].w * sc);
            wt_st16(rr, (unsigned)(((lane >> 3) * 16384 + row0 + r) * 128 + (lane & 7) * 16), q);
            if (lane == 0) wt_st4((float*)(F.ws + (tb ? WS_ISU : WS_ISD)) + row0 + r, isc);
        }
    }
}
#define XB_TMO      128
#define XB_XCNT(j)  (256  + 64 * (j))
#define XB_XSUB(j)  (1280 + 64 * (j))
#define XB_XGEN(j)  (2304 + 64 * (j))
#define XB_TOP      3328
#define XB_TOPGEN   3392
#define XCD_BAR_WORDS 3456
#define XB_SPIN_CAP (1u << 18)

__device__ __forceinline__ unsigned xb_ld(unsigned* p)              { return __hip_atomic_load(p, __ATOMIC_RELAXED, __HIP_MEMORY_SCOPE_AGENT); }
__device__ __forceinline__ unsigned xb_add(unsigned* p, unsigned v) { return __hip_atomic_fetch_add(p, v, __ATOMIC_RELAXED, __HIP_MEMORY_SCOPE_AGENT); }
__device__ __forceinline__ unsigned xb_xcc_id() { return (unsigned)__builtin_amdgcn_s_getreg((3 << 11) | 20) & 0xFu; }
#define XB_SPIN(cond, bar) do { unsigned _sp = 0; while (cond) { __builtin_amdgcn_s_sleep(1); \
    if ((++_sp & 255u) == 0u) { if (xb_ld(&(bar)[XB_TMO])) break; if (_sp > XB_SPIN_CAP) { atomicAdd(&(bar)[XB_TMO], 1u); break; } } } } while (0)

struct XcdBarrier {
    unsigned* bar; unsigned x;
    volatile LAS unsigned* st;
};

__device__ __forceinline__ XcdBarrier xcd_barrier_post(unsigned* bar, volatile LAS unsigned* st) {
    XcdBarrier b; b.bar = bar; b.x = xb_xcc_id(); b.st = st;
    if (threadIdx.x == 0) (void)xb_add(&bar[XB_XCNT(b.x)], 1u);
    return b;
}
__device__ __forceinline__ void xcd_barrier_complete(unsigned* bar, unsigned x, unsigned& nloc, unsigned& nx) {
    const unsigned G = gridDim.x * gridDim.y * gridDim.z;
    unsigned sum, cnt, mine, sp = 0u;
    for (;;) {
        sum = 0u; cnt = 0u; mine = 0u;
#pragma unroll
        for (unsigned j = 0; j < 16; ++j) { const unsigned c = xb_ld(&bar[XB_XCNT(j)]); sum += c; cnt += (c > 0u) ? 1u : 0u; mine = (j == x) ? c : mine; }
        if (sum == G) break;
        __builtin_amdgcn_s_sleep(1);
        if ((++sp & 255u) == 0u) { if (xb_ld(&bar[XB_TMO])) break; if (sp > XB_SPIN_CAP) { atomicAdd(&bar[XB_TMO], 1u); break; } }
    }
    nloc = mine > 0u ? mine : 1u; nx = cnt > 0u ? cnt : 1u;
}

__device__ __forceinline__ void xcd_barrier(const XcdBarrier& b) {
    asm volatile("s_waitcnt vmcnt(0)" ::: "memory");
    __syncthreads();
    if (threadIdx.x == 0) {
        unsigned* bar = b.bar;
        __builtin_amdgcn_s_waitcnt(0);
        unsigned nloc = b.st[0], nx = b.st[1];
        if (nloc == 0u) { xcd_barrier_complete(bar, b.x, nloc, nx); b.st[0] = nloc; b.st[1] = nx; }
        const unsigned old = xb_add(&bar[XB_XSUB(b.x)], 1u);
        const unsigned gen = old / nloc;
        if (old + 1u == (gen + 1u) * nloc) {
            __builtin_amdgcn_fence(__ATOMIC_RELEASE, "agent");
            asm volatile("s_waitcnt vmcnt(0)" ::: "memory");
            const unsigned og = xb_add(&bar[XB_TOP], 1u);
            const unsigned tg = og / nx;
            if (og + 1u == (tg + 1u) * nx) xb_add(&bar[XB_TOPGEN], 1u);
            else XB_SPIN(xb_ld(&bar[XB_TOPGEN]) == tg, bar);
            __builtin_amdgcn_fence(__ATOMIC_ACQUIRE, "agent");
            xb_add(&bar[XB_XGEN(b.x)], 1u);
            asm volatile("s_waitcnt vmcnt(0)" ::: "memory");
        } else {
            XB_SPIN(xb_ld(&bar[XB_XGEN(b.x)]) == gen, bar);
            __builtin_amdgcn_fence(__ATOMIC_ACQUIRE, "agent");
            asm volatile("s_waitcnt vmcnt(0)" ::: "memory");
        }
    }
    __syncthreads();
}

__global__ void __launch_bounds__(NTHR, 2) mega(Args args) {
    extern __shared__ __attribute__((aligned(16))) unsigned char lds_raw[];
    Frame F;
    F.lds = (LAS unsigned char*)lds_raw;
    F.tid = threadIdx.x; F.lane = F.tid & 63; F.wave = __builtin_amdgcn_readfirstlane(F.tid >> 6); F.G = gridDim.x; F.bid = blockIdx.x;
    F.out = args.out; F.ws = args.ws;
    const int lo = args.ph_lo, hi = args.ph_hi;
    cg::grid_group grid = cg::this_grid();
    volatile LAS unsigned* MISC = (volatile LAS unsigned*)(F.lds + LDS_BYTES - 64);
    if (F.tid < 16) MISC[F.tid] = 0u;
    __syncthreads();
    XcdBarrier bar = xcd_barrier_post((unsigned*)(F.ws + WS_CTL) + 4096, MISC + 8);
    if (hi - lo > 1) grid.sync();
#define IN(k) (lo <= (k) && (k) < hi)
#define SEAM(k) do { if (IN(k) && IN((k) + 1)) xcd_barrier(bar); } while (0)
    if (IN(0)) { p0_prologue(F, args.in[0], args.in[1], args.in[2], args.in[13], args.in[10], args.in[11], args.in[12], args.in[14], args.in[15]); }
    SEAM(0);
    if (IN(1)) {
        pg8::Gemm g{(const bf16_t*)(F.ws + WS_XB), (const bf16_t*)(F.ws + WS_WIN), T, NPROJ, D}; pg8::StaticOrder S; S.init(T, NPROJ, F.G, F.bid);
        pg8::EpiProj E{(bf16_t*)(F.ws + WS_GQ), (bf16_t*)(F.ws + WS_GK), (bf16_t*)(F.ws + WS_GV), (bf16_t*)(F.ws + WS_GR), (bf16_t*)(F.ws + WS_SQ), (bf16_t*)(F.ws + WS_SK), (bf16_t*)(F.ws + WS_SV),
                       (bf16_t*)F.out, (bf16_t*)F.out + (size_t)T * D, (const float*)(F.ws + WS_RSTD1)};
        pg8::gemm_phase<pg8::EpiProj, pg8::StaticOrder, PG8_ALIGN, PG8_SP2>(F.lds, g, S, E);
    }
    SEAM(1);
    if (IN(2)) { gla_local_phase(F, args.in[3], args.in[4]); }
    SEAM(2);
    if (IN(3)) { gla_scan_phase(F); expert_convert(F, args.in[16], args.in[17], args.in[13]); swa_phase(F, args.in[6], args.in[7], args.in[8], args.in[9], (size_t)0); }
    SEAM(3);
    if (IN(4)) { gla_out_phase(F, args.in[3], args.in[4], args.in[5]); }
    SEAM(4);
    if (IN(5)) {
        pg8::PairOrder S; S.base.init(T, D, F.G, F.bid);
        pg8::Gemm g{(const bf16_t*)(F.ws + WS_YG), (const bf16_t*)(F.ws + WS_WG), T, D, D, (const bf16_t*)(F.ws + WS_SQ), (const bf16_t*)(F.ws + WS_WS)};
        pg8::EpiMergeBoth E{{(const bf16_t*)F.out, (const bf16_t*)F.out + (size_t)T * D, (bf16_t*)(F.ws + WS_MRG)}, {(const bf16_t*)F.out, (const bf16_t*)F.out + (size_t)T * D, (bf16_t*)(F.ws + WS_MRG)}};
        pg8::gemm_phase<pg8::EpiMergeBoth, pg8::PairOrder, PG8_ALIGN, PG8_SP2>(F.lds, g, S, E);
    }
    SEAM(5);
    if (IN(6)) {
        pg8::StaticOrder S; S.init(T, D, F.G, F.bid);
        pg8::Gemm g{(const bf16_t*)(F.ws + WS_MRG), (const bf16_t*)(F.ws + WS_WO), T, D, D};
        pg8::EpiOut E{(const bf16_t*)(F.ws + WS_XB), F.out, (bf16_t*)(F.ws + WS_HB2), (float*)(F.ws + WS_ROWSS2), T};
        pg8::gemm_phase<pg8::EpiOut, pg8::StaticOrder, PG8_ALIGN, PG8_SP2>(F.lds, g, S, E);
    }
    SEAM(6);
    if (IN(7)) {
        pg8::StaticOrder S; S.init(T, 2048, F.G, F.bid);
        pg8::Gemm g{(const bf16_t*)(F.ws + WS_HB2), (const bf16_t*)(F.ws + WS_WQ), T, 2048, D};
        pg8::EpiQ E{(const float*)(F.ws + WS_ROWSS2), (bf16_t*)(F.ws + WS_QP), T};
        pg8::gemm_phase<pg8::EpiQ, pg8::StaticOrder, PG8_ALIGN, PG8_SP2>(F.lds, g, S, E);
    }
    if (IN(7) && IN(8)) __syncthreads();
    if (IN(8)) {
        { const float* ROWSS = (const float*)(F.ws + WS_ROWSS2); float* RSTD2 = (float*)(F.ws + WS_RSTD2);
          for (int t = F.bid * NTHR + F.tid; t < T; t += F.G * NTHR) { float s = 0.f;
#pragma unroll
              for (int kk = 0; kk < 4; ++kk) { const f32x4 p4 = *(const f32x4*)(ROWSS + (size_t)t * 16 + 4 * kk); s += (p4.x + p4.y) + (p4.z + p4.w); }
              wt_st4(RSTD2 + t, rsqrtf(s * (1.f / 1024.f) + EPS)); } }
        peer_quant_phase(F);
        peer_topk_phase(F);
    }
    SEAM(8);
    if (IN(9)) { peer_down_phase(F); }
    SEAM(9);
    if (IN(10)) { peer_combine_phase(F); }
    SEAM(10);
    if (IN(11)) { peer_up_phase(F, F.out); }
#undef IN
#undef SEAM
}
}

extern "C" void kernel_launch(void* const* d_in, const int* in_sizes, int n_in, void* d_out, int out_size, void* d_ws, size_t ws_size, hipStream_t stream) {
    using namespace mk;
    static int grid = 0;
    if (grid == 0) {
        int dev_ = 0, cus = 0, per_cu = 0;
        if (hipGetDevice(&dev_) != hipSuccess || hipDeviceGetAttribute(&cus, hipDeviceAttributeMultiprocessorCount, dev_) != hipSuccess) { fprintf(stderr, "device query failed\n"); grid = -1; return; }
        if (hipFuncSetAttribute((const void*)mega, hipFuncAttributeMaxDynamicSharedMemorySize, LDS_BYTES) != hipSuccess) { fprintf(stderr, "hipFuncSetAttribute failed\n"); grid = -1; return; }
        if (hipOccupancyMaxActiveBlocksPerMultiprocessor(&per_cu, (const void*)mega, NTHR, LDS_BYTES) != hipSuccess || per_cu < 1) { fprintf(stderr, "occupancy query: %d\n", per_cu); per_cu = 1; }
        (void)hipGetLastError();
        grid = cus * 1;
        fprintf(stderr, "mega: cus %d per_cu %d grid %d\n", cus, per_cu, grid);
    }
    if (grid < 0) return;
    (void)hipMemsetAsync((char*)d_ws + WS_CTL, 0, CTL_ZERO_BYTES, stream);
    Args a{};
    for (int i = 0; i < 18; ++i) a.in[i] = (const float*)d_in[i];
    a.out = (float*)d_out; a.ws = (unsigned char*)d_ws; a.ph_lo = 0; a.ph_hi = 12;
    void* kargs[] = {&a};
    hipError_t e = hipLaunchCooperativeKernel((const void*)mega, dim3(grid), dim3(NTHR), kargs, LDS_BYTES, stream);
    if (e != hipSuccess) fprintf(stderr, "cooperative launch failed: %s\n", hipGetErrorString(e));
}
```

```cpp
#include <hip/hip_runtime.h>
#include <hip/hip_cooperative_groups.h>
#include <cstdio>
#include <cstdint>
#include <math.h>
namespace cg = cooperative_groups;
#ifndef WT_AUX
#define WT_AUX 0
#endif
typedef unsigned wt_u32x4 __attribute__((ext_vector_type(4)));
__device__ __forceinline__ __amdgpu_buffer_rsrc_t wt_rsrc(const void* base) { return __builtin_amdgcn_make_buffer_rsrc((void*)base, 0, 0x7FFFFFF0, 0x00020000); }
__device__ __forceinline__ void wt_st16(__amdgpu_buffer_rsrc_t r, unsigned byte_off, wt_u32x4 v) { __builtin_amdgcn_raw_buffer_store_b128(v, r, byte_off, 0, WT_AUX); }
typedef unsigned wt_u32x2 __attribute__((ext_vector_type(2)));
__device__ __forceinline__ void wt_st8(void* p, unsigned lo, unsigned hi) { if (WT_AUX) __hip_atomic_store((unsigned long long*)p, ((unsigned long long)hi << 32) | lo, __ATOMIC_RELAXED, __HIP_MEMORY_SCOPE_AGENT); else *(wt_u32x2*)p = (wt_u32x2){lo, hi}; }
__device__ __forceinline__ void wt_st4(float* p, float v) { if (WT_AUX) __hip_atomic_store(p, v, __ATOMIC_RELAXED, __HIP_MEMORY_SCOPE_AGENT); else *p = v; }
__device__ __forceinline__ void wtx_st16(__amdgpu_buffer_rsrc_t r, unsigned byte_off, wt_u32x4 v) { __builtin_amdgcn_raw_buffer_store_b128(v, r, byte_off, 0, 16); }
__device__ __forceinline__ void wtx_st8(void* p, unsigned lo, unsigned hi) { __hip_atomic_store((unsigned long long*)p, ((unsigned long long)hi << 32) | lo, __ATOMIC_RELAXED, __HIP_MEMORY_SCOPE_AGENT); }
__device__ __forceinline__ void wtx_st4(float* p, float v) { __hip_atomic_store(p, v, __ATOMIC_RELAXED, __HIP_MEMORY_SCOPE_AGENT); }
namespace pg8 {
#define PG8_LAS __attribute__((address_space(3)))
typedef unsigned short bf16_t;
typedef short bf16x8 __attribute__((ext_vector_type(8)));
typedef float f32x4 __attribute__((ext_vector_type(4)));
typedef unsigned u32x4 __attribute__((ext_vector_type(4)));
constexpr int BM = 256, BK = 64, HALF = 128, HTB = HALF * BK * 2  , STAGE_BYTES = 8 * HTB, NXCD = 8, WGM = 4;

__host__ __device__ __forceinline__ int lds_byte(int r, int c) { const int st = (r >> 4) * 2 + (c >> 5), rr = r & 15, cc = c & 31, ob = rr * 64 + cc * 2; return st * 1024 + (ob ^ (((ob >> 9) & 1) << 5)); }
__host__ __device__ __forceinline__ void stage_rc(int b, int& R, int& C) { const int st = b / 1024, sb = b % 1024, swz = sb ^ (((sb >> 9) & 1) << 5); R = (st >> 1) * 16 + swz / 64; C = (st & 1) * 32 + (swz % 64) / 2; }
__host__ __device__ __forceinline__ int perm32(int rho) { const int n = rho >> 4, i = rho & 15; return 8 * (i >> 2) + 4 * n + (i & 3); }

struct Unit { int pm, pn, sel; };
struct Gemm { const bf16_t* A; const bf16_t* Bt; int M, N, K; const bf16_t* A2; const bf16_t* Bt2; };

struct StaticOrder {
    int nM, nN, nwg, G, c;
    __host__ __device__ void init(int M, int N, int G_, int c_) { nM = M / BM; nN = N / BM; nwg = nM * nN; G = G_; c = c_; }
    __host__ __device__ bool next(int i, Unit& u) const {
        const long L = (long)i * G + c; if (L >= nwg) return false;
        int wgid = (int)L; { const int q = nwg / NXCD, r = nwg % NXCD, xcd = wgid % NXCD, off = wgid / NXCD; wgid = (xcd < r ? xcd * (q + 1) : r * (q + 1) + (xcd - r) * q) + off; }
        const int nig = WGM * nN, gid = wgid / nig, fm = gid * WGM, gsz = (nM - fm) < WGM ? (nM - fm) : WGM;
        u.pm = fm + ((wgid % nig) % gsz); u.pn = (wgid % nig) / gsz; u.sel = 0; return true;
    }
    __device__ __forceinline__ void a_ready(const Unit&) const {}
    __device__ __forceinline__ void done(const Unit&) const {}
    __device__ __forceinline__ bool keep(const Unit&) const { return false; }
};

__device__ __forceinline__ unsigned cvt_pk_bf16(float lo, float hi) { unsigned r; asm volatile("v_cvt_pk_bf16_f32 %0, %1, %2" : "=v"(r) : "v"(lo), "v"(hi)); return r; }
typedef float f32x2 __attribute__((ext_vector_type(2)));
__device__ __forceinline__ f32x2 gelu_pk(f32x2 v) {
    const f32x2 av = __builtin_elementwise_abs(v), d = av * 0.2316418882f + 1.0f;
    f32x2 t; t.x = __builtin_amdgcn_rcpf(d.x); t.y = __builtin_amdgcn_rcpf(d.y);
    f32x2 q = t * 0.5307027145f + (-0.7265760135f); q = q * t + 0.7107068705f; q = q * t + (-0.142248368f); q = q * t + 0.127414796f; q = q * t;
    const f32x2 s = (v * v) * (-0.72134752044f);
    f32x2 e; e.x = __builtin_amdgcn_exp2f(s.x); e.y = __builtin_amdgcn_exp2f(s.y);
    const f32x2 m = v * (q * e), r = v - m;
    f32x2 o; o.x = v.x < 0.f ? m.x : r.x; o.y = v.y < 0.f ? m.y : r.y; return o;
}

template <int ACT  > struct EpiBf16 {
    static constexpr bool PERM = true, AFTER_DRAIN = false; static_assert(ACT == 0 || ACT == 1, "EpiBf16: ACT is 0 (none) or 1 (gelu_pk)");
    bf16_t* O; int ldc; const float* bias; int split_cols; size_t split_stride; float scale0;
    __device__ __forceinline__ void operator()(const f32x4 (&acc)[2][2][4][2], const Unit& u, int wr, int wc, int fr, int fq) const {
        const int row0 = u.pm * BM + wr * 64 + fr; int colt = u.pn * BM; bf16_t* base = O;
        float sc = 1.f; if (split_cols) { const int t = colt / split_cols; base += (size_t)t * split_stride; colt -= t * split_cols; if (t == 0) sc = scale0; }
        const int col0 = colt + wc * 32 + 8 * fq, bcol0 = u.pn * BM + wc * 32 + 8 * fq;
        f32x4 bv[2][2];
#pragma unroll
        for (int bj = 0; bj < 2; ++bj)
#pragma unroll
            for (int n = 0; n < 2; ++n) bv[bj][n] = bias ? *(const f32x4*)(bias + bcol0 + bj * HALF + 4 * n) : (f32x4){0.f, 0.f, 0.f, 0.f};
#pragma unroll
        for (int ai = 0; ai < 2; ++ai)
#pragma unroll
            for (int m = 0; m < 4; ++m) { bf16_t* rowp = base + (size_t)(row0 + ai * HALF + m * 16) * ldc + col0;
#pragma unroll
                for (int bj = 0; bj < 2; ++bj) { f32x4 v0 = acc[ai][bj][m][0] + bv[bj][0], v1 = acc[ai][bj][m][1] + bv[bj][1];
                    if (ACT == 1) { f32x2 a = gelu_pk((f32x2){v0[0], v0[1]}), b = gelu_pk((f32x2){v0[2], v0[3]}), c = gelu_pk((f32x2){v1[0], v1[1]}), d = gelu_pk((f32x2){v1[2], v1[3]});
                        v0 = (f32x4){a.x, a.y, b.x, b.y}; v1 = (f32x4){c.x, c.y, d.x, d.y}; }
                    v0 = v0 * sc; v1 = v1 * sc; u32x4 w; w.x = cvt_pk_bf16(v0[0], v0[1]); w.y = cvt_pk_bf16(v0[2], v0[3]); w.z = cvt_pk_bf16(v1[0], v1[1]); w.w = cvt_pk_bf16(v1[2], v1[3]);
                    *(u32x4*)(rowp + bj * HALF) = w; } }
    }
};
__device__ __forceinline__ float sigm_fast(float v) { return __builtin_amdgcn_rcpf(1.0f + __builtin_amdgcn_exp2f(v * -1.4426950408889634f)); }
struct EpiProj {
    static constexpr bool PERM = true, AFTER_DRAIN = false;
    bf16_t *GQ, *GK, *GV, *GR, *SQ, *SK, *SV, *GA, *GB; const float* rstd;
    __device__ __forceinline__ void operator()(const f32x4 (&acc)[2][2][4][2], const Unit& u, int wr, int wc, int fr, int fq) const {
        const int pn = u.pn; bf16_t* base; int ldc, act = 0;
        if (pn < 2) { base = GQ + pn * 256; ldc = 512; }
        else if (pn < 4) { base = GK + (pn - 2) * 256; ldc = 512; }
        else if (pn < 8) { base = GV + (pn - 4) * 256; ldc = 1024; }
        else if (pn < 12) { base = GR + (pn - 8) * 256; ldc = 1024; act = 1; }
        else if (pn < 16) { base = SQ + (pn - 12) * 256; ldc = 1024; }
        else if (pn == 16) { base = SK; ldc = 256; }
        else if (pn == 17) { base = SV; ldc = 256; }
        else { base = GA; ldc = 1024; act = 2; }
        const int row0 = u.pm * BM + wr * 64 + fr, col0 = wc * 32 + 8 * fq;
        const __amdgpu_buffer_rsrc_t rs_ = wt_rsrc(base);
        if (pn >= 18) {
            const __amdgpu_buffer_rsrc_t ga_r = wt_rsrc(GA), gb_r = wt_rsrc(GB); const int gcol = 128 * (pn - 18) + col0;
#pragma unroll
            for (int ai = 0; ai < 2; ++ai)
#pragma unroll
                for (int m = 0; m < 4; ++m) { const int row = row0 + ai * HALF + m * 16; const float rs = rstd[row]; const unsigned off = (unsigned)(((size_t)row * 1024 + gcol) * 2);
                    float ra[8], sb[8];
#pragma unroll
                    for (int e = 0; e < 4; ++e) { const float b0 = fmaxf(sigm_fast(acc[ai][1][m][0][e] * rs), 1e-30f), b1 = fmaxf(sigm_fast(acc[ai][1][m][1][e] * rs), 1e-30f);
                        sb[e] = b0; sb[4 + e] = b1; ra[e] = sigm_fast(acc[ai][0][m][0][e] * rs) * __builtin_amdgcn_rcpf(b0); ra[4 + e] = sigm_fast(acc[ai][0][m][1][e] * rs) * __builtin_amdgcn_rcpf(b1); }
                    u32x4 w; w.x = cvt_pk_bf16(ra[0], ra[1]); w.y = cvt_pk_bf16(ra[2], ra[3]); w.z = cvt_pk_bf16(ra[4], ra[5]); w.w = cvt_pk_bf16(ra[6], ra[7]);
                    wt_st16(ga_r, off, w);
                    w.x = cvt_pk_bf16(sb[0], sb[1]); w.y = cvt_pk_bf16(sb[2], sb[3]); w.z = cvt_pk_bf16(sb[4], sb[5]); w.w = cvt_pk_bf16(sb[6], sb[7]);
                    wt_st16(gb_r, off, w); }
            return;
        }
#pragma unroll
        for (int ai = 0; ai < 2; ++ai)
#pragma unroll
            for (int m = 0; m < 4; ++m) { const int row = row0 + ai * HALF + m * 16; const float rs = rstd[row]; const unsigned rowoff = (unsigned)(((size_t)row * ldc + col0) * 2);
#pragma unroll
                for (int bj = 0; bj < 2; ++bj) { f32x4 v0 = acc[ai][bj][m][0] * rs, v1 = acc[ai][bj][m][1] * rs;
                    if (act) {
#pragma unroll
                        for (int e = 0; e < 4; ++e) { const float s0 = sigm_fast(v0[e]), s1 = sigm_fast(v1[e]); v0[e] = (act == 1) ? v0[e] * s0 : s0; v1[e] = (act == 1) ? v1[e] * s1 : s1; } }
                    u32x4 w; w.x = cvt_pk_bf16(v0[0], v0[1]); w.y = cvt_pk_bf16(v0[2], v0[3]); w.z = cvt_pk_bf16(v1[0], v1[1]); w.w = cvt_pk_bf16(v1[2], v1[3]);
                    wt_st16(rs_, rowoff + bj * HALF * 2, w); } }
    }
};

__device__ __forceinline__ void bf8_to_f32(const u32x4 raw, float (&f)[8]) {
#pragma unroll
    for (int j = 0; j < 4; ++j) { f[2 * j] = __builtin_bit_cast(float, raw[j] << 16); f[2 * j + 1] = __builtin_bit_cast(float, raw[j] & 0xffff0000u); }
}
template <int STEP> struct EpiMerge {
    static constexpr bool PERM = true, AFTER_DRAIN = false;
    const bf16_t* ga; const bf16_t* gb; bf16_t* outp;
    __device__ __forceinline__ void operator()(f32x4 (&acc)[2][2][4][2], const Unit& u, int wr, int wc, int fr, int fq) const {
        const int row0 = u.pm * BM + wr * 64 + fr, col0 = u.pn * BM + wc * 32 + 8 * fq;
        const __amdgpu_buffer_rsrc_t dst_r = wt_rsrc(outp);
#pragma unroll
        for (int ai = 0; ai < 2; ++ai)
#pragma unroll
            for (int m = 0; m < 4; ++m) { const size_t rb = (size_t)(row0 + ai * HALF + m * 16) * 1024 + col0;
#pragma unroll
                for (int bj = 0; bj < 2; ++bj) { const size_t off = rb + bj * HALF;
                    float g[8]; bf8_to_f32(*(const u32x4*)((STEP == 0 ? ga : gb) + off), g);
                    if (STEP == 0) {
#pragma unroll
                        for (int e = 0; e < 4; ++e) { acc[ai][bj][m][0][e] *= g[e]; acc[ai][bj][m][1][e] *= g[4 + e]; }
                    } else {
                        float v[8];
#pragma unroll
                        for (int e = 0; e < 4; ++e) { v[e] = acc[ai][bj][m][0][e] * g[e]; v[4 + e] = acc[ai][bj][m][1][e] * g[4 + e]; }
                        u32x4 w; w.x = cvt_pk_bf16(v[0], v[1]); w.y = cvt_pk_bf16(v[2], v[3]); w.z = cvt_pk_bf16(v[4], v[5]); w.w = cvt_pk_bf16(v[6], v[7]);
                        wt_st16(dst_r, (unsigned)(off * 2), w); } } }
    }
};
struct EpiOut {
    static constexpr bool PERM = true, AFTER_DRAIN = false;
    const bf16_t* x; float* h1; bf16_t* hb; float* rowss; int M;
    __device__ __forceinline__ void operator()(const f32x4 (&acc)[2][2][4][2], const Unit& u, int wr, int wc, int fr, int fq) const {
        const int row0 = u.pm * BM + wr * 64 + fr, col0 = u.pn * BM + wc * 32 + 8 * fq;
        const __amdgpu_buffer_rsrc_t hb_r = wt_rsrc(hb);
#pragma unroll
        for (int ai = 0; ai < 2; ++ai)
#pragma unroll
            for (int m = 0; m < 4; ++m) { const int row = row0 + ai * HALF + m * 16; const size_t rb = (size_t)row * 1024 + col0; float ss = 0.f;
#pragma unroll
                for (int bj = 0; bj < 2; ++bj) { const size_t off = rb + bj * HALF;
                    const u32x4 xw = *(const u32x4*)(x + off);
                    f32x4 x0, x1; x0[0] = __uint_as_float(xw.x << 16); x0[1] = __uint_as_float(xw.x & 0xffff0000u); x0[2] = __uint_as_float(xw.y << 16); x0[3] = __uint_as_float(xw.y & 0xffff0000u);
                    x1[0] = __uint_as_float(xw.z << 16); x1[1] = __uint_as_float(xw.z & 0xffff0000u); x1[2] = __uint_as_float(xw.w << 16); x1[3] = __uint_as_float(xw.w & 0xffff0000u);
                    const f32x4 v0 = acc[ai][bj][m][0] + x0, v1 = acc[ai][bj][m][1] + x1;
                    u32x4 w; w.x = cvt_pk_bf16(v0[0], v0[1]); w.y = cvt_pk_bf16(v0[2], v0[3]); w.z = cvt_pk_bf16(v1[0], v1[1]); w.w = cvt_pk_bf16(v1[2], v1[3]);
                    wt_st16(hb_r, (unsigned)(off * 2), w);
                    ss += (v0[0] * v0[0] + v0[1] * v0[1]) + (v0[2] * v0[2] + v0[3] * v0[3]) + (v1[0] * v1[0] + v1[1] * v1[1]) + (v1[2] * v1[2] + v1[3] * v1[3]); }
                ss += __shfl_xor(ss, 16); ss += __shfl_xor(ss, 32);
                if (fq == 0) wt_st4(rowss + (size_t)row * 16 + u.pn * 4 + wc, ss); }
    }
};
struct EpiQ {
    static constexpr bool PERM = true, AFTER_DRAIN = false;
    const float* rowss; bf16_t* qp; int M;
    __device__ __forceinline__ void operator()(const f32x4 (&acc)[2][2][4][2], const Unit& u, int wr, int wc, int fr, int fq) const {
        const int row0 = u.pm * BM + wr * 64 + fr, col0 = u.pn * BM + wc * 32 + 8 * fq;
        const __amdgpu_buffer_rsrc_t qp_r = wt_rsrc(qp);
#pragma unroll
        for (int ai = 0; ai < 2; ++ai)
#pragma unroll
            for (int m = 0; m < 4; ++m) { const int row = row0 + ai * HALF + m * 16; float s = 0.f;
#pragma unroll
                for (int k = 0; k < 4; ++k) { const f32x4 p4 = *(const f32x4*)(rowss + (size_t)row * 16 + 4 * k); s += (p4[0] + p4[1]) + (p4[2] + p4[3]); }
                const float rs = rsqrtf(s * (1.f / 1024.f) + 1e-6f);
#pragma unroll
                for (int bj = 0; bj < 2; ++bj) { const f32x4 v0 = acc[ai][bj][m][0] * rs, v1 = acc[ai][bj][m][1] * rs;
                    u32x4 w; w.x = cvt_pk_bf16(v0[0], v0[1]); w.y = cvt_pk_bf16(v0[2], v0[3]); w.z = cvt_pk_bf16(v1[0], v1[1]); w.w = cvt_pk_bf16(v1[2], v1[3]);
                    wt_st16(qp_r, (unsigned)(((size_t)row * 2048 + col0 + bj * HALF) * 2), w); } }
    }
};

struct PairOrder {
    StaticOrder base;
    __device__ bool next(int i, Unit& u) const { const bool ok = base.next(i >> 1, u); u.sel = i & 1; return ok; }
    __device__ __forceinline__ void a_ready(const Unit&) const {}
    __device__ __forceinline__ void done(const Unit&) const {}
    __device__ __forceinline__ bool keep(const Unit& u) const { return u.sel == 0; }
};
struct EpiMergeBoth {
    static constexpr bool PERM = true, AFTER_DRAIN = false;
    EpiMerge<0> e0; EpiMerge<1> e1;
    __device__ __forceinline__ void operator()(f32x4 (&acc)[2][2][4][2], const Unit& u, int wr, int wc, int fr, int fq) const { if (u.sel == 0) e0(acc, u, wr, wc, fr, fq); else e1(acc, u, wr, wc, fr, fq); }
};
template <class Epi, class Sched, bool ALIGN_EPI = false, bool SP2 = false>
__device__ __forceinline__ void gemm_phase(PG8_LAS unsigned char* lds, const Gemm g, const Sched& S, const Epi& E) {
    const int tid = threadIdx.x, wid = __builtin_amdgcn_readfirstlane(tid >> 6), lane = tid & 63, wr = wid >> 2, wc = wid & 3, fr = lane & 15, fq = lane >> 4;
    const int K = g.K, nt = K / BK;
    unsigned voffA[2], voffB[2];
#pragma unroll
    for (int i = 0; i < 2; ++i) { int R, C; stage_rc(tid * 16 + i * 8192, R, C); const int Rb = Epi::PERM ? ((R & ~31) + perm32(R & 31)) : R;
        voffA[i] = (unsigned)(R * K + C) * 2u; voffB[i] = (unsigned)(Rb * K + C) * 2u; }
    const size_t kstep = (size_t)(BK * 2);
    const size_t hstep = (size_t)HALF * K * 2;
    const size_t tstep = 2 * hstep;
    const unsigned ldsw = (unsigned)wid * 1024u;
    const int aoff = lds_byte(wr * 64 + fr, fq * 8), boff = lds_byte(wc * 32 + fr, fq * 8);
#define PG8_SA(b, h) (((b) * 2 + (h)) * HTB)
#define PG8_SB(b, h) ((4 + (b) * 2 + (h)) * HTB)
#define PG8_STAGE(bufoff, gbase, voff) do { _Pragma("unroll") for (int _i = 0; _i < 2; ++_i) \
        __builtin_amdgcn_global_load_lds((const unsigned*)((const char*)(gbase) + (voff)[_i]), (PG8_LAS unsigned*)(lds + (bufoff) + ldsw + _i * 8192), 16, 0, 0); } while (0)
#define PG8_LDA(dst, b, h) do { _Pragma("unroll") for (int m = 0; m < 4; ++m) _Pragma("unroll") for (int k = 0; k < 2; ++k) dst[m][k] = *(const PG8_LAS bf16x8*)(lds + PG8_SA(b, h) + aoff + m * 2048 + k * 1024); } while (0)
#define PG8_LDB(dst, b, h) do { _Pragma("unroll") for (int n = 0; n < 2; ++n) _Pragma("unroll") for (int k = 0; k < 2; ++k) dst[n][k] = *(const PG8_LAS bf16x8*)(lds + PG8_SB(b, h) + boff + n * 2048 + k * 1024); } while (0)
#define PG8_MMA(ai, bj, At, Bt) do { __builtin_amdgcn_s_setprio(1); _Pragma("unroll") for (int m = 0; m < 4; ++m) _Pragma("unroll") for (int n = 0; n < 2; ++n) _Pragma("unroll") for (int k = 0; k < 2; ++k) \
        acc[ai][bj][m][n] = __builtin_amdgcn_mfma_f32_16x16x32_bf16(Bt[n][k], At[m][k], acc[ai][bj][m][n], 0, 0, 0); __builtin_amdgcn_s_setprio(0); } while (0)
#define PG8_WAIT_V(n) asm volatile("s_waitcnt vmcnt(" #n ")" ::: "memory")
#define PG8_WAIT_L(n) asm volatile("s_waitcnt lgkmcnt(" #n ")" ::: "memory")
#define PG8_BAR __builtin_amdgcn_s_barrier()
#define PG8_SCHED __builtin_amdgcn_sched_barrier(0)
    Unit cur, nxt; int ui = 0;
    if (!S.next(0, cur)) return;
    f32x4 acc[2][2][4][2];
#pragma unroll
    for (int a = 0; a < 2; ++a)
#pragma unroll
        for (int b = 0; b < 2; ++b)
#pragma unroll
            for (int m = 0; m < 4; ++m)
#pragma unroll
                for (int n = 0; n < 2; ++n) acc[a][b][m][n] = (f32x4){0.f, 0.f, 0.f, 0.f};
    bf16x8 At[4][2], B0[2][2], B1[2][2];
    const char* cA = (const char*)(cur.sel ? g.A2 : g.A) + (size_t)cur.pm * tstep; const char* cB = (const char*)(cur.sel ? g.Bt2 : g.Bt) + (size_t)cur.pn * tstep;
    S.a_ready(cur);
    if constexpr (SP2) {
        PG8_STAGE(PG8_SB(0, 0), cB, voffB); PG8_STAGE(PG8_SB(0, 1), cB + hstep, voffB); PG8_STAGE(PG8_SA(0, 0), cA, voffA); PG8_STAGE(PG8_SA(0, 1), cA + hstep, voffA);
        if (wr == 1) PG8_BAR;
        PG8_WAIT_V(2); PG8_BAR;
        PG8_STAGE(PG8_SB(1, 0), cB + kstep, voffB); PG8_STAGE(PG8_SA(1, 0), cA + kstep, voffA); PG8_STAGE(PG8_SB(1, 1), cB + hstep + kstep, voffB);
        PG8_WAIT_V(6); PG8_BAR;
    } else {
        PG8_STAGE(PG8_SB(0, 0), cB, voffB); PG8_STAGE(PG8_SA(0, 0), cA, voffA); PG8_STAGE(PG8_SB(0, 1), cB + hstep, voffB); PG8_STAGE(PG8_SA(0, 1), cA + hstep, voffA);
        if (wr == 1) PG8_BAR;
        PG8_WAIT_V(4); PG8_BAR;
        PG8_STAGE(PG8_SB(1, 0), cB + kstep, voffB); PG8_STAGE(PG8_SA(1, 0), cA + kstep, voffA); PG8_STAGE(PG8_SB(1, 1), cB + hstep + kstep, voffB);
        PG8_WAIT_V(6); PG8_BAR;
    }
    for (;;) {
        const bool has_next = S.next(ui + 1, nxt);
        const char* nA = has_next ? (const char*)(nxt.sel ? g.A2 : g.A) + (size_t)nxt.pm * tstep : cA; const char* nB = has_next ? (const char*)(nxt.sel ? g.Bt2 : g.Bt) + (size_t)nxt.pn * tstep : cB;
        for (int t = 0; t < nt; t += 2) {
            const bool last = (t == nt - 2);
            const char* a1 = cA + (size_t)(t + 1) * kstep;
            const char* a2 = last ? nA : cA + (size_t)(t + 2) * kstep; const char* b2 = last ? nB : cB + (size_t)(t + 2) * kstep;
            const char* a3 = a2 + kstep; const char* b3 = b2 + kstep;
            if (last && has_next) S.a_ready(nxt);
            if constexpr (SP2) {
            PG8_LDB(B0, 0, 0); PG8_LDB(B1, 0, 1); PG8_SCHED; PG8_LDA(At, 0, 0); PG8_STAGE(PG8_SA(1, 1), a1 + hstep, voffA);
            PG8_WAIT_V(8); PG8_WAIT_L(0); PG8_BAR; PG8_MMA(0, 0, At, B0); PG8_MMA(0, 1, At, B1); PG8_BAR; PG8_SCHED;
            PG8_LDA(At, 0, 1); PG8_STAGE(PG8_SB(0, 0), b2, voffB); PG8_STAGE(PG8_SB(0, 1), b2 + hstep, voffB); PG8_STAGE(PG8_SA(0, 0), a2, voffA);
            PG8_WAIT_V(8); PG8_WAIT_L(0); PG8_BAR; PG8_MMA(1, 0, At, B0); PG8_MMA(1, 1, At, B1); PG8_BAR; PG8_SCHED;
            PG8_LDB(B0, 1, 0); PG8_LDB(B1, 1, 1); PG8_SCHED; PG8_LDA(At, 1, 0); PG8_STAGE(PG8_SA(0, 1), a2 + hstep, voffA);
            PG8_WAIT_V(8); PG8_WAIT_L(0); PG8_BAR; PG8_MMA(0, 0, At, B0); PG8_MMA(0, 1, At, B1); PG8_BAR; PG8_SCHED;
            PG8_LDA(At, 1, 1); PG8_STAGE(PG8_SB(1, 0), b3, voffB); PG8_STAGE(PG8_SB(1, 1), b3 + hstep, voffB); PG8_STAGE(PG8_SA(1, 0), a3, voffA);
            PG8_WAIT_V(8); PG8_WAIT_L(0); PG8_BAR; PG8_MMA(1, 0, At, B0); PG8_MMA(1, 1, At, B1); PG8_BAR; PG8_SCHED;
            } else {
            PG8_LDB(B0, 0, 0); PG8_SCHED; PG8_LDA(At, 0, 0); PG8_STAGE(PG8_SA(1, 1), a1 + hstep, voffA);
            PG8_WAIT_L(8); PG8_BAR; PG8_WAIT_L(0); PG8_MMA(0, 0, At, B0); PG8_BAR; PG8_SCHED;
            PG8_LDB(B1, 0, 1); PG8_STAGE(PG8_SB(0, 0), b2, voffB);
            PG8_BAR; PG8_WAIT_L(0); PG8_MMA(0, 1, At, B1); PG8_BAR;
            PG8_LDA(At, 0, 1); PG8_STAGE(PG8_SA(0, 0), a2, voffA);
            PG8_BAR; PG8_WAIT_L(0); PG8_MMA(1, 0, At, B0); PG8_BAR; PG8_SCHED;
            PG8_STAGE(PG8_SB(0, 1), b2 + hstep, voffB);
            PG8_WAIT_V(6); PG8_BAR; PG8_MMA(1, 1, At, B1); PG8_BAR;
            PG8_LDB(B0, 1, 0); PG8_SCHED; PG8_LDA(At, 1, 0); PG8_STAGE(PG8_SA(0, 1), a2 + hstep, voffA);
            PG8_WAIT_L(8); PG8_BAR; PG8_WAIT_L(0); PG8_MMA(0, 0, At, B0); PG8_BAR; PG8_SCHED;
            PG8_LDB(B1, 1, 1); PG8_STAGE(PG8_SB(1, 0), b3, voffB);
            PG8_BAR; PG8_WAIT_L(0); PG8_MMA(0, 1, At, B1); PG8_BAR;
            PG8_LDA(At, 1, 1); PG8_STAGE(PG8_SA(1, 0), a3, voffA);
            PG8_BAR; PG8_WAIT_L(0); PG8_MMA(1, 0, At, B0); PG8_BAR; PG8_SCHED;
            PG8_STAGE(PG8_SB(1, 1), b3 + hstep, voffB);
            PG8_WAIT_V(6); PG8_BAR; PG8_MMA(1, 1, At, B1); PG8_BAR;
            }
        }
        if constexpr (ALIGN_EPI) { if (wr == 0) PG8_BAR; }
        if constexpr (!Epi::AFTER_DRAIN) { E(acc, cur, wr, wc, fr, fq); S.done(cur); }
        if (!has_next) break;
        if (!S.keep(cur)) {
#pragma unroll
        for (int a = 0; a < 2; ++a)
#pragma unroll
            for (int b = 0; b < 2; ++b)
#pragma unroll
                for (int m = 0; m < 4; ++m)
#pragma unroll
                    for (int n = 0; n < 2; ++n) acc[a][b][m][n] = (f32x4){0.f, 0.f, 0.f, 0.f};
        }
        cur = nxt; cA = nA; cB = nB; ++ui;
        if constexpr (ALIGN_EPI) { if (wr == 1) PG8_BAR; }
    }
    PG8_WAIT_V(0);
    if constexpr (!ALIGN_EPI) { if (wr == 0) PG8_BAR; }
    PG8_BAR;
    if constexpr (Epi::AFTER_DRAIN) { E.fused(acc, cur, wr, wc, fr, fq, lds, wid, lane); S.done(cur); }
#undef PG8_SA
#undef PG8_SB
#undef PG8_STAGE
#undef PG8_LDA
#undef PG8_LDB
#undef PG8_MMA
#undef PG8_WAIT_V
#undef PG8_WAIT_L
#undef PG8_BAR
#undef PG8_SCHED
}
}
#define PG8_SP2 true
#define PG8_ALIGN true
namespace mk {
using pg8::bf16_t;
#define LAS __attribute__((address_space(3)))
typedef unsigned v4u __attribute__((ext_vector_type(4)));
typedef unsigned v2u __attribute__((ext_vector_type(2)));
typedef float f32x4 __attribute__((ext_vector_type(4)));
typedef float f32x16 __attribute__((ext_vector_type(16)));
typedef short bf16x8 __attribute__((ext_vector_type(8)));
typedef short bf16x4 __attribute__((ext_vector_type(4)));
constexpr int T = 32768, D = 1024, SEQ = 8192, NBATCH = 4, NPROJ = 6656, INW = 6672, C_GA = 3072;
constexpr float EPS = 1e-6f;
constexpr int NWAVES = 8, NTHR = 512;
constexpr int LDS_BYTES = 147456;
constexpr size_t MiB = 1u << 20;
constexpr size_t WS_CTL = 0, CTL_ZERO_BYTES = 1 * MiB;
constexpr size_t WS_RSTD1 = 1 * MiB, WS_ROWSS = WS_RSTD1 + 512 * 1024, WS_ALOW = 2 * MiB, WS_DSC = 4 * MiB, WS_SUBK = 5 * MiB;
constexpr size_t WS_WIN = 8 * MiB, WS_WG = 21 * MiB, WS_WS = 23 * MiB, WS_WO = 25 * MiB, WS_WQ = 27 * MiB;
constexpr size_t WS_XB = 32 * MiB, WS_MERGED = 32 * MiB;
constexpr size_t WS_GQ = 96 * MiB, WS_GK = 128 * MiB, WS_HB = 96 * MiB;
constexpr size_t WS_GV = 160 * MiB, WS_EXD = 160 * MiB, WS_EXU = 192 * MiB;
constexpr size_t WS_GR = 224 * MiB, WS_SQ = 288 * MiB, WS_QP = 224 * MiB;
constexpr size_t WS_SK = 448 * MiB, WS_SV = 464 * MiB,
                  WS_ST = 384 * MiB, WS_IDX = 448 * MiB, WS_GATE = 464 * MiB;
constexpr size_t WS_YG = 448 * MiB, WS_PART = 160 * MiB, WS_MRG = 96 * MiB, WS_HB2 = 160 * MiB, WS_EXD2 = 352 * MiB, WS_EXU2 = 384 * MiB, WS_ROWSS2 = 480 * MiB;

struct Args { const float* in[18]; float* out; unsigned char* ws; int ph_lo, ph_hi; };

__device__ __forceinline__ unsigned f2bf(float f) { unsigned u = __builtin_bit_cast(unsigned, f); return (u + 0x7fffu + ((u >> 16) & 1u)) >> 16; }
typedef float f32x2_t __attribute__((ext_vector_type(2))); typedef __bf16 bf16x2_t __attribute__((ext_vector_type(2)));
__device__ __forceinline__ unsigned pk2(float lo, float hi) { f32x2_t v = {lo, hi}; bf16x2_t b = __builtin_convertvector(v, bf16x2_t); return __builtin_bit_cast(unsigned, b); }
__device__ __forceinline__ float fexp(float x) { return __builtin_amdgcn_exp2f(x * 1.4426950408889634f); }
__device__ __forceinline__ float flog(float x) { return __builtin_amdgcn_logf(x) * 0.6931471805599453f; }
__device__ __forceinline__ float bf2f(unsigned short b) { return __builtin_bit_cast(float, (unsigned)b << 16); }
__device__ __forceinline__ float wave_sum(float v) {
#pragma unroll
    for (int o = 1; o < 64; o <<= 1) v += __shfl_xor(v, o);
    return v;
}
#define LDS_WAIT() asm volatile("s_waitcnt lgkmcnt(0)" ::: "memory")
#define VM_WAIT() asm volatile("s_waitcnt vmcnt(0)" ::: "memory")

struct Frame {
    LAS unsigned char* lds;
    int tid, lane, wave, G, bid;
    float* out; unsigned char* ws;
};

__device__ __forceinline__ void tr_item(const float* __restrict__ W, int ldw, int c0, int K, int nblk, const float* __restrict__ gain, bf16_t* WT, LAS float* scr, int item, int lane, int gate_blk = -1) {
    const int kb = item / nblk, nb = item % nblk, k0 = 64 * kb, n0 = 32 * nb;
    int dn0 = n0;
    if (gate_blk >= 0 && nb >= gate_blk) { const int a = nb - gate_blk, b = a & 31; dn0 = 32 * (gate_blk + 8 * (b >> 2) + 4 * (a >> 5) + (b & 3)); }
    const __amdgpu_buffer_rsrc_t wt_r = wt_rsrc(WT);
    const int c = lane & 7;
    f32x4 g0 = {1.f, 1.f, 1.f, 1.f}, g1 = g0;
    if (gain) { g0 = *(const f32x4*)(gain + k0 + 8 * c); g1 = *(const f32x4*)(gain + k0 + 8 * c + 4); }
    float v[32];
    const float* src = W + (size_t)(k0 + (lane >> 5)) * ldw + c0 + n0 + (lane & 31);
#pragma unroll
    for (int i = 0; i < 32; ++i) v[i] = src[(size_t)(2 * i) * ldw];
#pragma unroll
    for (int i = 0; i < 32; ++i) scr[(2 * i + (lane >> 5)) * 33 + (lane & 31)] = v[i];
    LDS_WAIT(); asm volatile("" ::: "memory");
#pragma unroll
    for (int j = 0; j < 4; ++j) { const int n = (lane >> 3) + 8 * j; const LAS float* s = scr + (8 * c) * 33 + n;
        v4u o; o.x = pk2(s[0 * 33] * g0.x, s[1 * 33] * g0.y); o.y = pk2(s[2 * 33] * g0.z, s[3 * 33] * g0.w); o.z = pk2(s[4 * 33] * g1.x, s[5 * 33] * g1.y); o.w = pk2(s[6 * 33] * g1.z, s[7 * 33] * g1.w);
        wt_st16(wt_r, (unsigned)(((size_t)(dn0 + n) * K + k0 + 8 * c) * 2), o); }
    LDS_WAIT(); asm volatile("" ::: "memory");
}

__device__ __forceinline__ void p0_prologue(Frame& F, const float* x, const float* gain1, const float* w_in, const float* gain2, const float* wbg, const float* wbs, const float* wout, const float* wq, const float* subk) {
    LAS unsigned char* wb = F.lds;
    LAS float* scr = (LAS float*)(F.lds + 65536 + F.wave * 8704);
    { f32x4 wv[8]; float gk[8];
#pragma unroll
      for (int j = 0; j < 8; ++j) { const int idx = F.tid + NTHR * j, k = idx >> 2; wv[j] = *(const f32x4*)(w_in + (size_t)k * INW + C_GA + 4 * (idx & 3)); gk[j] = gain1[k]; }
#pragma unroll
      for (int j = 0; j < 8; ++j) { const int idx = F.tid + NTHR * j, k = idx >> 2;
#pragma unroll
          for (int e = 0; e < 4; ++e) { const int r = 4 * (idx & 3) + e; const float v = gk[j] * wv[j][e];
              const unsigned h = f2bf(v), l = f2bf(v - __builtin_bit_cast(float, h << 16));
              const int off = (((k >> 5) * 64 + ((k >> 3) & 3) * 16 + r) * 16) + 2 * (k & 7);
              *(LAS unsigned short*)(wb + off) = (unsigned short)h; *(LAS unsigned short*)(wb + 32768 + off) = (unsigned short)l; } } }
    __syncthreads();
    const int gw = F.bid * 4 + (F.wave & 3), NGW = F.G * 4, lane = F.lane;
    bf16_t* XB = (bf16_t*)(F.ws + WS_XB); float* RSTD1 = (float*)(F.ws + WS_RSTD1); float* ALOW = (float*)(F.ws + WS_ALOW);
    const __amdgpu_buffer_rsrc_t xb_r = wt_rsrc(XB);
    if (F.wave < 4) for (int g = gw; g < T / 16; g += NGW) {
        const int m = g * 16 + (lane & 15), q = lane >> 4;
        const float* xr = x + (size_t)m * D + 8 * q;
        f32x4 acc = {0.f, 0.f, 0.f, 0.f}; float ss = 0.f;
        for (int s0 = 0; s0 < 32; s0 += 8) {
            asm volatile("" ::: "memory");
            f32x4 a[8][2];
#pragma unroll
            for (int i = 0; i < 8; ++i) { a[i][0] = *(const f32x4*)(xr + 32 * (s0 + i)); a[i][1] = *(const f32x4*)(xr + 32 * (s0 + i) + 4); }
#pragma unroll
            for (int i = 0; i < 8; ++i) { const f32x4 a0 = a[i][0], a1 = a[i][1];
                ss += ((a0.x * a0.x + a0.y * a0.y) + (a0.z * a0.z + a0.w * a0.w)) + ((a1.x * a1.x + a1.y * a1.y) + (a1.z * a1.z + a1.w * a1.w));
                v4u h; h.x = pk2(a0.x, a0.y); h.y = pk2(a0.z, a0.w); h.z = pk2(a1.x, a1.y); h.w = pk2(a1.z, a1.w);
                wt_st16(xb_r, (unsigned)(((size_t)m * D + 8 * q + 32 * (s0 + i)) * 2), h);
                v4u l;
                l.x = pk2(a0.x - __builtin_bit_cast(float, h.x << 16), a0.y - __builtin_bit_cast(float, h.x & 0xffff0000u));
                l.y = pk2(a0.z - __builtin_bit_cast(float, h.y << 16), a0.w - __builtin_bit_cast(float, h.y & 0xffff0000u));
                l.z = pk2(a1.x - __builtin_bit_cast(float, h.z << 16), a1.y - __builtin_bit_cast(float, h.z & 0xffff0000u));
                l.w = pk2(a1.z - __builtin_bit_cast(float, h.w << 16), a1.w - __builtin_bit_cast(float, h.w & 0xffff0000u));
                const bf16x8 wh = *(const LAS bf16x8*)(wb + ((s0 + i) * 64 + lane) * 16), wl = *(const LAS bf16x8*)(wb + 32768 + ((s0 + i) * 64 + lane) * 16);
                const bf16x8 xh = __builtin_bit_cast(bf16x8, h), xl = __builtin_bit_cast(bf16x8, l);
                acc = __builtin_amdgcn_mfma_f32_16x16x32_bf16(xh, wh, acc, 0, 0, 0);
                acc = __builtin_amdgcn_mfma_f32_16x16x32_bf16(xl, wh, acc, 0, 0, 0);
                acc = __builtin_amdgcn_mfma_f32_16x16x32_bf16(xh, wl, acc, 0, 0, 0); }
        }
        ss += __shfl_xor(ss, 16); ss += __shfl_xor(ss, 32);
        const float rstd = rsqrtf(ss * (1.f / D) + EPS);
#pragma unroll
        for (int i = 0; i < 4; ++i) { const float rs = __shfl(rstd, 4 * q + i); wt_st4(ALOW + (size_t)(g * 16 + 4 * q + i) * 16 + (lane & 15), acc[i] * rs); }
        if (lane < 16) wt_st4(RSTD1 + m, rstd);
    }
    constexpr int I_IN1 = 16 * 96, I_IN2 = 16 * 112, I_SQ = 16 * 32, I_Q = 16 * 64;
    constexpr int NITEMS = I_IN1 + I_IN2 + 3 * I_SQ + I_Q;
    bf16_t* WIN = (bf16_t*)(F.ws + WS_WIN);
    if (F.wave >= 4) for (int it = gw; it < NITEMS; it += NGW) {
        int r = it;
        if (r < I_IN1) { tr_item(w_in, INW, 0, D, 96, gain1, WIN, scr, r, lane); continue; } r -= I_IN1;
        if (r < I_IN2) { tr_item(w_in, INW, 3088, D, 112, gain1, WIN + (size_t)3072 * D, scr, r, lane, 48); continue; } r -= I_IN2;
        if (r < I_SQ) { tr_item(wbg, D, 0, D, 32, nullptr, (bf16_t*)(F.ws + WS_WG), scr, r, lane); continue; } r -= I_SQ;
        if (r < I_SQ) { tr_item(wbs, D, 0, D, 32, nullptr, (bf16_t*)(F.ws + WS_WS), scr, r, lane); continue; } r -= I_SQ;
        if (r < I_SQ) { tr_item(wout, D, 0, D, 32, nullptr, (bf16_t*)(F.ws + WS_WO), scr, r, lane); continue; } r -= I_SQ;
        tr_item(wq, 2048, 0, D, 64, gain2, (bf16_t*)(F.ws + WS_WQ), scr, r, lane);
    }
    { const f32x4* sk = (const f32x4*)subk; v2u* o = (v2u*)(F.ws + WS_SUBK);
      for (int i = F.bid * NTHR + F.tid; i < 8 * 2 * 128 * 128 / 4; i += F.G * NTHR) { const f32x4 v = sk[i]; wt_st8(o + i, pk2(v.x, v.y), pk2(v.z, v.w)); } }
}

constexpr int SWA_KROW = 144, SWA_VROW = 592;
__device__ __forceinline__ unsigned swa_voff(unsigned row, unsigned ch) { return 1024u * (row >> 3) + 512u * (ch >> 2) + 64u * (row & 7) + 16u * ((ch & 3) ^ ((row >> 2) & 3)); }
typedef short swa_v4s __attribute__((ext_vector_type(4)));
__device__ __forceinline__ bf16x8 swa_tr2(const LAS unsigned char* p0, const LAS unsigned char* p1) {
    const swa_v4s x = __builtin_amdgcn_ds_read_tr16_b64_v4i16((LAS swa_v4s*)p0), y = __builtin_amdgcn_ds_read_tr16_b64_v4i16((LAS swa_v4s*)p1);
    return (bf16x8){x[0], x[1], x[2], x[3], y[0], y[1], y[2], y[3]};
}
constexpr int SWA_K_OFF = 0, SWA_V_OFF = 256 * SWA_KROW, SWA_TB_OFF = SWA_V_OFF + 64 * SWA_VROW, SWA_LDS = SWA_TB_OFF + 4 * 128 * 4;
__device__ __forceinline__ int t5_bucket(int rel) {
    if (rel < 16) return rel;
    int b = 16;
    b += (rel >= 19); b += (rel >= 21); b += (rel >= 24); b += (rel >= 27); b += (rel >= 31); b += (rel >= 35); b += (rel >= 40); b += (rel >= 46);
    b += (rel >= 52); b += (rel >= 59); b += (rel >= 67); b += (rel >= 77); b += (rel >= 87); b += (rel >= 99); b += (rel >= 113);
    return b;
}
__device__ __forceinline__ void swa_load_kv(const bf16_t* SK, const bf16_t* SV, int u, int tid, int lane, int wave, v4u (&kraw)[4], v4u (&vraw)[4]) {
    const int blk = u & 63, kvh = (u >> 6) & 3, b = u >> 8; const size_t mrow0 = (size_t)b * SEQ; const int t0 = blk * 128, c = tid & 7;
#pragma unroll
    for (int ps = 0; ps < 4; ++ps) {
        const int kjk = ps * 64 + (tid >> 3), posk = t0 - 128 + kjk; kraw[ps] = (v4u){0u, 0u, 0u, 0u};
        if (posk >= 0) kraw[ps] = *(const v4u*)(SK + (mrow0 + posk) * 256 + kvh * 64 + 8 * c);
        const int kjv = ps * 64 + lane, posv = t0 - 128 + kjv; vraw[ps] = (v4u){0u, 0u, 0u, 0u};
        if (posv >= 0) vraw[ps] = *(const v4u*)(SV + (mrow0 + posv) * 256 + kvh * 64 + 8 * wave);
    }
}
__device__ __forceinline__ void swa_phase(Frame& F, const float* qgain, const float* kgain, const float* sinks, const float* rel_bias, size_t ydelta) {
    const bf16_t* SK = (const bf16_t*)(F.ws + WS_SK); const bf16_t* SV = (const bf16_t*)(F.ws + WS_SV); bf16_t* SQ = (bf16_t*)(F.ws + WS_SQ);
    LAS unsigned char* Kn = F.lds + SWA_K_OFF; LAS unsigned char* Vt = F.lds + SWA_V_OFF; LAS float* tb = (LAS float*)(F.lds + SWA_TB_OFF);
    const int tid = F.tid, lane = F.lane, wave = F.wave, l15 = lane & 15, q4 = lane >> 4;
    if (tid < 256) { *(LAS v4u*)(Vt + swa_voff(256 + (tid >> 3), tid & 7)) = (v4u){0u, 0u, 0u, 0u}; }
    const LAS unsigned char* vb0 = Vt + swa_voff(4 * q4 + (l15 >> 2), (l15 >> 1) & 1) + 8 * (l15 & 1); const LAS unsigned char* vb1 = Vt + swa_voff(4 * q4 + (l15 >> 2), 2 + ((l15 >> 1) & 1)) + 8 * (l15 & 1);
    v4u kraw[4], vraw[4];
    const int ub = ((F.G & 7) == 0) ? (F.bid & 7) * (F.G >> 3) + (F.bid >> 3) : F.bid;
    if (ub < 1024) swa_load_kv(SK, SV, ub, tid, lane, wave, kraw, vraw);
    for (int u = ub; u < 1024; u += F.G) {
        const int blk = u & 63, kvh = (u >> 6) & 3, b = u >> 8;
        const size_t mrow0 = (size_t)b * SEQ; const int t0 = blk * 128;
        const int g = wave >> 1, qh = wave & 1, h = kvh * 4 + g;
        v4u qn[2];
        { const bf16_t* qrow = SQ + (mrow0 + t0 + 64 * qh + l15) * 1024 + h * 64; qn[0] = *(const v4u*)(qrow + 8 * q4); qn[1] = *(const v4u*)(qrow + 32 + 8 * q4); }
        __syncthreads();
        { const int c = tid & 7; f32x4 g0 = *(const f32x4*)(kgain + 8 * c), g1 = *(const f32x4*)(kgain + 8 * c + 4);
#pragma unroll
          for (int ps = 0; ps < 4; ++ps) {
              const int kj = ps * 64 + (tid >> 3);
              const v4u raw = kraw[ps];
              float f[8];
#pragma unroll
              for (int j = 0; j < 4; ++j) { f[2 * j] = __builtin_bit_cast(float, raw[j] << 16); f[2 * j + 1] = __builtin_bit_cast(float, raw[j] & 0xffff0000u); }
              float ss = 0.f;
#pragma unroll
              for (int j = 0; j < 8; ++j) ss += f[j] * f[j];
              ss += __builtin_bit_cast(float, __builtin_amdgcn_update_dpp(0, __builtin_bit_cast(int, ss), 0xB1, 0xF, 0xF, false)); ss += __builtin_bit_cast(float, __builtin_amdgcn_update_dpp(0, __builtin_bit_cast(int, ss), 0x4E, 0xF, 0xF, false)); ss += __shfl_xor(ss, 4);
              const float r = rsqrtf(ss * (1.f / 64.f) + EPS);
              v4u w; w.x = pk2(f[0] * r * g0.x, f[1] * r * g0.y); w.y = pk2(f[2] * r * g0.z, f[3] * r * g0.w); w.z = pk2(f[4] * r * g1.x, f[5] * r * g1.y); w.w = pk2(f[6] * r * g1.z, f[7] * r * g1.w);
              *(LAS v4u*)(Kn + kj * SWA_KROW + 16 * c) = w;
          } }
#pragma unroll
        for (int ps = 0; ps < 4; ++ps) {
            const int kj = ps * 64 + lane; const v4u raw = vraw[ps];
            *(LAS v4u*)(Vt + swa_voff(kj, wave)) = raw;
        }
        { const int gg = tid >> 7, rel = tid & 127; tb[tid] = rel_bias[t5_bucket(rel) * 16 + kvh * 4 + gg] * 1.4426950408889634f; }
        if (u + F.G < 1024) swa_load_kv(SK, SV, u + F.G, tid, lane, wave, kraw, vraw);
        __syncthreads();
        const float sink = sinks[h] * 1.4426950408889634f;
        float qg[2][8];
#pragma unroll
        for (int ks = 0; ks < 2; ++ks)
#pragma unroll
            for (int j = 0; j < 8; ++j) qg[ks][j] = qgain[32 * ks + 8 * q4 + j] * (0.125f * 1.4426950408889634f);
#pragma unroll 1
        for (int nt = 0; nt < 4; ++nt) {
            const int q0 = 64 * qh + 16 * nt, qi = q0 + l15, kt0 = q0 >> 4;
            bf16_t* qrow = SQ + (mrow0 + t0 + qi) * 1024 + h * 64;
            bf16x8 qf[2];
            { v4u raw[2]; float f[2][8]; float ss = 0.f;
              raw[0] = qn[0]; raw[1] = qn[1];
              if (nt < 3) { const bf16_t* qnx = qrow + 16 * 1024; qn[0] = *(const v4u*)(qnx + 8 * q4); qn[1] = *(const v4u*)(qnx + 32 + 8 * q4); }
#pragma unroll
              for (int ks = 0; ks < 2; ++ks) {
#pragma unroll
                  for (int j = 0; j < 4; ++j) { f[ks][2 * j] = __builtin_bit_cast(float, raw[ks][j] << 16); f[ks][2 * j + 1] = __builtin_bit_cast(float, raw[ks][j] & 0xffff0000u); }
#pragma unroll
                  for (int j = 0; j < 8; ++j) ss += f[ks][j] * f[ks][j]; }
              ss += __shfl_xor(ss, 16); ss += __shfl_xor(ss, 32);
              const float r = rsqrtf(ss * (1.f / 64.f) + EPS);
#pragma unroll
              for (int ks = 0; ks < 2; ++ks) { v4u w;
#pragma unroll
                  for (int j = 0; j < 4; ++j) w[j] = pk2(f[ks][2 * j] * r * qg[ks][2 * j], f[ks][2 * j + 1] * r * qg[ks][2 * j + 1]);
                  qf[ks] = __builtin_bit_cast(bf16x8, w); } }
            f32x4 s[9];
#pragma unroll
            for (int i = 0; i < 9; ++i) { f32x4 acc = (f32x4){0.f, 0.f, 0.f, 0.f};
#pragma unroll
                for (int ks = 0; ks < 2; ++ks) { const bf16x8 a = *(const LAS bf16x8*)(Kn + (16 * (kt0 + i) + l15) * SWA_KROW + (32 * ks + 8 * q4) * 2); acc = __builtin_amdgcn_mfma_f32_16x16x32_bf16(a, qf[ks], acc, 0, 0, 0); }
                s[i] = acc; }
            const int R0 = l15 + 128 - 4 * q4;
            const LAS float* tbp = tb + g * 128 + R0 - 131;
            float mx = -INFINITY;
            if (blk > 0) {
#pragma unroll
                for (int i = 0; i < 9; ++i)
#pragma unroll
                    for (int r = 0; r < 4; ++r) { const int rel = R0 - 16 * i - r; float v = s[i][r] + tbp[131 - 16 * i - r];
                        if (i == 0) v = (rel < 128) ? v : -INFINITY;
                        if (i == 8) v = (rel >= 0) ? v : -INFINITY;
                        s[i][r] = v; mx = fmaxf(mx, v); }
            } else {
#pragma unroll
                for (int i = 0; i < 9; ++i)
#pragma unroll
                    for (int r = 0; r < 4; ++r) { const int kj = 16 * (kt0 + i) + 4 * q4 + r, rel = R0 - 16 * i - r; const bool valid = ((unsigned)rel < 128u) && (kj >= 128);
                        const float v = valid ? s[i][r] + tbp[131 - 16 * i - r] : -INFINITY; s[i][r] = v; mx = fmaxf(mx, v); }
            }
            mx = fmaxf(mx, __shfl_xor(mx, 16)); mx = fmaxf(mx, __shfl_xor(mx, 32)); mx = fmaxf(mx, sink);
            float sum = 0.f;
#pragma unroll
            for (int i = 0; i < 9; ++i)
#pragma unroll
                for (int r = 0; r < 4; ++r) { const float e = __builtin_amdgcn_exp2f(s[i][r] - mx); s[i][r] = e; sum += e; }
            sum += __shfl_xor(sum, 16); sum += __shfl_xor(sum, 32);
            const float inv = 1.0f / (sum + __builtin_amdgcn_exp2f(sink - mx));
            f32x4 o[4];
#pragma unroll
            for (int mt = 0; mt < 4; ++mt) o[mt] = (f32x4){0.f, 0.f, 0.f, 0.f};
#pragma unroll
            for (int kk = 0; kk < 5; ++kk) {
                v4u w; w.x = pk2(s[2 * kk][0], s[2 * kk][1]); w.y = pk2(s[2 * kk][2], s[2 * kk][3]);
                if (kk < 4) { w.z = pk2(s[2 * kk + 1][0], s[2 * kk + 1][1]); w.w = pk2(s[2 * kk + 1][2], s[2 * kk + 1][3]); } else { w.z = 0u; w.w = 0u; }
                const bf16x8 pb = __builtin_bit_cast(bf16x8, w);
#pragma unroll
                for (int mt = 0; mt < 4; ++mt) {
                    const LAS unsigned char* vr = ((mt & 1) ? vb1 : vb0) + 512 * (mt >> 1) + 2048 * (kt0 + 2 * kk);
                    const bf16x8 a = swa_tr2(vr, vr + 2048);
                    o[mt] = __builtin_amdgcn_mfma_f32_16x16x32_bf16(a, pb, o[mt], 0, 0, 0);
                }
            }
#pragma unroll
            for (int mt = 0; mt < 4; ++mt) { v2u w; w.x = pk2(o[mt][0] * inv, o[mt][1] * inv); w.y = pk2(o[mt][2] * inv, o[mt][3] * inv); wt_st8((unsigned char*)(qrow + 16 * mt + 4 * q4) + ydelta, w.x, w.y); }
        }
    }
    __syncthreads();
}

constexpr int GL_AL = 0, GL_QS = 4096, GL_BL = 6144, GL_DEC = 6656, GL_BQ = 8192, GL_QT = 41984, GL_KT = 59392, GL_OB = 8192, GL_KH = 76800, GL_VT = 95232;
constexpr int GL_BQROW = 528, GL_QROW = 272, GL_KHROW = 144, GL_VROW = 144, GL_OBROW = 1040;
__device__ __forceinline__ f32x16 mfma32(bf16x8 a, bf16x8 b, f32x16 c) { return __builtin_amdgcn_mfma_f32_32x32x16_bf16(a, b, c, 0, 0, 0); }
__device__ __forceinline__ bf16x8 pack8(const f32x16& x, int s) {
    v4u w;
    if (s == 0) { w.x = pk2(x[0], x[1]); w.y = pk2(x[2], x[3]); w.z = pk2(x[4], x[5]); w.w = pk2(x[6], x[7]); }
    else { w.x = pk2(x[8], x[9]); w.y = pk2(x[10], x[11]); w.z = pk2(x[12], x[13]); w.w = pk2(x[14], x[15]); }
    return __builtin_bit_cast(bf16x8, w);
}
__device__ __forceinline__ bf16x8 ld2x8(const LAS unsigned char* p) {
    const v2u a0 = *(const LAS v2u*)p, a1 = *(const LAS v2u*)(p + 16);
    return __builtin_bit_cast(bf16x8, (v4u){a0.x, a0.y, a1.x, a1.y});
}
__device__ __forceinline__ void unpack8(const v4u raw, float (&f)[8]) {
#pragma unroll
    for (int j = 0; j < 4; ++j) { f[2 * j] = __builtin_bit_cast(float, raw[j] << 16); f[2 * j + 1] = __builtin_bit_cast(float, raw[j] & 0xffff0000u); }
}
__device__ __forceinline__ unsigned gl_off(unsigned row, unsigned ch) { return 2048u * (row >> 3) + 512u * (ch >> 2) + 64u * (row & 7) + 16u * ((ch & 3) ^ ((row >> 2) & 3)); }
__device__ __forceinline__ unsigned gl_tr_base(unsigned lane, unsigned rb) { const unsigned blk = (lane >> 4) & 1, q = (lane & 15) >> 2, p = lane & 3; return gl_off(rb + q, 2 * blk + (p >> 1)) + 8 * (p & 1); }
typedef short gl_v4s __attribute__((ext_vector_type(4)));
__device__ __forceinline__ bf16x8 gl_tr2(const LAS unsigned char* p0, const LAS unsigned char* p1) {
    const gl_v4s x = __builtin_amdgcn_ds_read_tr16_b64_v4i16((LAS gl_v4s*)p0), y = __builtin_amdgcn_ds_read_tr16_b64_v4i16((LAS gl_v4s*)p1);
    return (bf16x8){x[0], x[1], x[2], x[3], y[0], y[1], y[2], y[3]};
}
__device__ __forceinline__ void gla_load_w(Frame& F, const float* wgu, const float* bgu, int h, bf16x8& whi, bf16x8& wlo, float& bias) {
    const int dn = 32 * (F.wave >> 1) + (F.lane & 31), hh = F.lane >> 5;
    float v[8];
#pragma unroll
    for (int j = 0; j < 8; ++j) v[j] = wgu[(8 * hh + j) * 512 + h * 128 + dn];
    v4u hi, lo;
#pragma unroll
    for (int j = 0; j < 4; ++j) { hi[j] = pk2(v[2 * j], v[2 * j + 1]); lo[j] = pk2(v[2 * j] - __builtin_bit_cast(float, hi[j] << 16), v[2 * j + 1] - __builtin_bit_cast(float, hi[j] & 0xffff0000u)); }
    whi = __builtin_bit_cast(bf16x8, (v4u){hi[0], hi[1], hi[2], hi[3]}); wlo = __builtin_bit_cast(bf16x8, (v4u){lo[0], lo[1], lo[2], lo[3]});
    bias = bgu[h * 128 + dn];
}
template <bool FULL> __device__ __forceinline__ float gla_stage(Frame& F, int h, size_t m0, const bf16x8 whi, const bf16x8 wlo, float bias) {
    const int tid = F.tid, lane = F.lane, wave = F.wave, d = tid & 127;
    LAS unsigned char* L = F.lds;
    const float* ALOW = (const float*)(F.ws + WS_ALOW);
    const bf16_t* GQ = (const bf16_t*)(F.ws + WS_GQ); const bf16_t* GK = (const bf16_t*)(F.ws + WS_GK); const bf16_t* GV = (const bf16_t*)(F.ws + WS_GV);
    __syncthreads();
    { typedef float f32x2 __attribute__((ext_vector_type(2))); ((LAS f32x2*)(L + GL_AL))[tid] = ((const f32x2*)(ALOW + m0 * 16))[tid]; }
    __syncthreads();
    const int mt = wave & 1, nt = wave >> 1, l31 = lane & 31, hh = lane >> 5, dn = 32 * nt + l31;
    float p[16];
    { const LAS f32x4* ap = (const LAS f32x4*)(L + GL_AL + (32 * mt + l31) * 64 + hh * 32);
      const f32x4 a0 = ap[0], a1 = ap[1];
      v4u ah, al;
      ah.x = pk2(a0.x, a0.y); ah.y = pk2(a0.z, a0.w); ah.z = pk2(a1.x, a1.y); ah.w = pk2(a1.z, a1.w);
      al.x = pk2(a0.x - __builtin_bit_cast(float, ah.x << 16), a0.y - __builtin_bit_cast(float, ah.x & 0xffff0000u)); al.y = pk2(a0.z - __builtin_bit_cast(float, ah.y << 16), a0.w - __builtin_bit_cast(float, ah.y & 0xffff0000u));
      al.z = pk2(a1.x - __builtin_bit_cast(float, ah.z << 16), a1.y - __builtin_bit_cast(float, ah.z & 0xffff0000u)); al.w = pk2(a1.z - __builtin_bit_cast(float, ah.w << 16), a1.w - __builtin_bit_cast(float, ah.w & 0xffff0000u));
      f32x16 z;
#pragma unroll
      for (int r = 0; r < 16; ++r) z[r] = 0.f;
      z = mfma32(__builtin_bit_cast(bf16x8, ah), whi, z); z = mfma32(__builtin_bit_cast(bf16x8, al), whi, z); z = mfma32(__builtin_bit_cast(bf16x8, ah), wlo, z);
#pragma unroll
      for (int r = 0; r < 16; ++r) { const float zz = z[r] + bias; p[r] = (fminf(zz, 0.f) - flog(1.f + fexp(-fabsf(zz)))) * (1.f / 16.f); } }
    float base = 0.f;
#pragma unroll
    for (int g4 = 0; g4 < 4; ++g4) {
        p[4 * g4 + 1] += p[4 * g4]; p[4 * g4 + 2] += p[4 * g4 + 1]; p[4 * g4 + 3] += p[4 * g4 + 2];
        const float gt = p[4 * g4 + 3], pt = __shfl_xor(gt, 32), off = base + (hh ? pt : 0.f);
#pragma unroll
        for (int k = 0; k < 4; ++k) p[4 * g4 + k] += off;
        base += gt + pt;
    }
    if (hh == 0) ((LAS float*)(L + GL_QS))[mt * 128 + dn] = base;
    __syncthreads();
    { const float q0 = ((const LAS float*)(L + GL_QS))[dn], q1 = ((const LAS float*)(L + GL_QS))[128 + dn], blast = q0 + q1, offs = mt ? q0 : 0.f;
#pragma unroll
      for (int r = 0; r < 16; ++r) *(LAS float*)(L + GL_BQ + (32 * mt + 8 * (r >> 2) + 4 * hh + (r & 3)) * GL_BQROW + dn * 4) = p[r] + offs;
      if (mt == 0 && hh == 0) { ((LAS float*)(L + GL_BL))[dn] = blast; ((LAS float*)(L + GL_DEC))[dn] = fexp(blast); } }
    __syncthreads();
    {
        const int t = lane, dg = wave; const size_t row = m0 + t;
        float b[16], bl[16];
#pragma unroll
        for (int i = 0; i < 4; ++i) { const f32x4 v = *(const LAS f32x4*)(L + GL_BQ + t * GL_BQROW + dg * 64 + 16 * i); b[4 * i] = v.x; b[4 * i + 1] = v.y; b[4 * i + 2] = v.z; b[4 * i + 3] = v.w;
                                      const f32x4 u = *(const LAS f32x4*)(L + (FULL ? GL_DEC : GL_BL) + dg * 64 + 16 * i); bl[4 * i] = u.x; bl[4 * i + 1] = u.y; bl[4 * i + 2] = u.z; bl[4 * i + 3] = u.w; }
        float kf[16];
        { const v4u* kp = (const v4u*)(GK + row * 512 + h * 128 + 16 * dg); float t0[8], t1[8]; unpack8(kp[0], t0); unpack8(kp[1], t1);
#pragma unroll
          for (int e = 0; e < 8; ++e) { kf[e] = t0[e]; kf[8 + e] = t1[e]; } }
        float kh[16];
        if (FULL) {
            float qf[16];
            { const v4u* qp = (const v4u*)(GQ + row * 512 + h * 128 + 16 * dg); float t0[8], t1[8]; unpack8(qp[0], t0); unpack8(qp[1], t1);
#pragma unroll
              for (int e = 0; e < 8; ++e) { qf[e] = t0[e]; qf[8 + e] = t1[e]; } }
            v4u wq[2], wk[2];
#pragma unroll
            for (int e = 0; e < 16; e += 2) { const float e0 = fexp(b[e]), e1 = fexp(b[e + 1]);
                const float k0 = kf[e] * __builtin_amdgcn_rcpf(e0), k1 = kf[e + 1] * __builtin_amdgcn_rcpf(e1);
                wq[e >> 3][(e & 7) >> 1] = pk2(qf[e] * e0 * 0.08838834764831845f, qf[e + 1] * e1 * 0.08838834764831845f);
                wk[e >> 3][(e & 7) >> 1] = pk2(k0, k1);
                kh[e] = k0 * bl[e]; kh[e + 1] = k1 * bl[e + 1]; }
            *(LAS v4u*)(L + GL_QT + t * GL_QROW + dg * 32) = wq[0]; *(LAS v4u*)(L + GL_QT + t * GL_QROW + dg * 32 + 16) = wq[1];
            *(LAS v4u*)(L + GL_KT + t * GL_QROW + dg * 32) = wk[0]; *(LAS v4u*)(L + GL_KT + t * GL_QROW + dg * 32 + 16) = wk[1];
        } else {
#pragma unroll
            for (int e = 0; e < 16; ++e) kh[e] = kf[e] * fexp(bl[e] - b[e]);
        }
        { v4u k0, k1; k0.x = pk2(kh[0], kh[1]); k0.y = pk2(kh[2], kh[3]); k0.z = pk2(kh[4], kh[5]); k0.w = pk2(kh[6], kh[7]); k1.x = pk2(kh[8], kh[9]); k1.y = pk2(kh[10], kh[11]); k1.z = pk2(kh[12], kh[13]); k1.w = pk2(kh[14], kh[15]);
          *(LAS v4u*)(L + GL_KH + gl_off(t, 2 * dg)) = k0; *(LAS v4u*)(L + GL_KH + gl_off(t, 2 * dg + 1)) = k1; }
#pragma unroll
        for (int i = 0; i < 4; ++i) { const v4u raw = *(const v4u*)(GV + row * 1024 + h * 256 + 32 * wave + 8 * i);
            *(LAS v4u*)(L + GL_VT + (wave >> 2) * 16384 + gl_off(t, 4 * (wave & 3) + i)) = raw; }
    }
    __syncthreads();
    return ((const LAS float*)(L + GL_BL))[d];
}
__device__ __forceinline__ void gla_state_update(Frame& F, f32x16 (&S)[4]) {
    const int lane = F.lane, l31 = lane & 31, hh = lane >> 5; LAS unsigned char* L = F.lds;
    const LAS unsigned char* ka0 = L + GL_KH + gl_tr_base(lane, 8 * hh); const LAS unsigned char* ka1 = L + GL_KH + gl_tr_base(lane, 8 * hh + 4);
    const LAS unsigned char* va0 = ka0 + (GL_VT - GL_KH) + (F.wave >> 2) * 16384 + (F.wave & 3) * 512; const LAS unsigned char* va1 = ka1 + (GL_VT - GL_KH) + (F.wave >> 2) * 16384 + (F.wave & 3) * 512;
#pragma unroll
    for (int dt = 0; dt < 4; ++dt) {
#pragma unroll
        for (int g = 0; g < 4; ++g) { const f32x4 dc = *(const LAS f32x4*)(L + GL_DEC + (32 * dt + 8 * g + 4 * hh) * 4);
            S[dt][4 * g] *= dc.x; S[dt][4 * g + 1] *= dc.y; S[dt][4 * g + 2] *= dc.z; S[dt][4 * g + 3] *= dc.w; }
#pragma unroll
        for (int ks = 0; ks < 4; ++ks) {
            const bf16x8 a = gl_tr2(ka0 + 4096 * ks + 512 * dt, ka1 + 4096 * ks + 512 * dt);
            const bf16x8 b = gl_tr2(va0 + 4096 * ks, va1 + 4096 * ks);
            S[dt] = mfma32(a, b, S[dt]);
        } __builtin_amdgcn_sched_barrier(0);
    }
}
__device__ __forceinline__ void gla_local_phase(Frame& F, const float* wgu, const float* bgu) {
    float* ST = (float*)(F.ws + WS_ST); float* DSC = (float*)(F.ws + WS_DSC);
    const int lane = F.lane, l31 = lane & 31, hh = lane >> 5;
    for (int u = F.bid; u < 512; u += F.G) {
        const int sc = u & 31, bh = u >> 5, b = bh >> 2, h = bh & 3;
        bf16x8 whi, wlo; float bias; gla_load_w(F, wgu, bgu, h, whi, wlo, bias);
        f32x16 S[4];
#pragma unroll
        for (int dt = 0; dt < 4; ++dt)
#pragma unroll
            for (int r = 0; r < 16; ++r) S[dt][r] = 0.f;
        float sumbl = 0.f;
#pragma unroll 1
        for (int c = 0; c < 4; ++c) {
            const size_t m0 = (size_t)b * SEQ + sc * 256 + c * 64;
            sumbl += gla_stage<false>(F, h, m0, whi, wlo, bias);
            gla_state_update(F, S);
        }
        v4u* st8 = (v4u*)ST + (size_t)(bh * 32 + sc) * 4096 + (F.wave * 4 * 64 + lane) * 2;
#pragma unroll
        for (int dt = 0; dt < 4; ++dt)
#pragma unroll
            for (int hf = 0; hf < 2; ++hf) st8[dt * 128 + hf] = (v4u){pk2(S[dt][8 * hf], S[dt][8 * hf + 1]), pk2(S[dt][8 * hf + 2], S[dt][8 * hf + 3]), pk2(S[dt][8 * hf + 4], S[dt][8 * hf + 5]), pk2(S[dt][8 * hf + 6], S[dt][8 * hf + 7])};
        if (F.tid < 128) wt_st4(DSC + (bh * 32 + sc) * 128 + F.tid, fexp(sumbl));
    }
}
__device__ __forceinline__ void gla_scan_phase(Frame& F) {
    v4u* ST8 = (v4u*)(F.ws + WS_ST); const float* DSC = (const float*)(F.ws + WS_DSC);
    for (int idx = F.bid * NTHR + F.tid; idx < 16 * 4096; idx += F.G * NTHR) {
        const int bh = idx >> 12, u8 = idx & 4095, hf = u8 & 1, ln = (u8 >> 1) & 63, dt = (u8 >> 7) & 3, row0 = 32 * dt + 16 * hf + 4 * (ln >> 5);
        float S[8];
#pragma unroll
        for (int e = 0; e < 8; ++e) S[e] = 0.f;
#pragma unroll 1
        for (int sb = 0; sb < 32; sb += 16) {
            v4u raw[16]; f32x4 dd0[16], dd1[16];
#pragma unroll
            for (int j = 0; j < 16; ++j) { raw[j] = ST8[(size_t)(bh * 32 + sb + j) * 4096 + u8];
                dd0[j] = *(const f32x4*)(DSC + (bh * 32 + sb + j) * 128 + row0); dd1[j] = *(const f32x4*)(DSC + (bh * 32 + sb + j) * 128 + row0 + 8); }
#pragma unroll
            for (int j = 0; j < 16; ++j) {
                float tmp[8]; unpack8(raw[j], tmp);
                ST8[(size_t)(bh * 32 + sb + j) * 4096 + u8] = (v4u){pk2(S[0], S[1]), pk2(S[2], S[3]), pk2(S[4], S[5]), pk2(S[6], S[7])};
                const f32x4 d0 = dd0[j], d1 = dd1[j];
                S[0] = S[0] * d0.x + tmp[0]; S[1] = S[1] * d0.y + tmp[1]; S[2] = S[2] * d0.z + tmp[2]; S[3] = S[3] * d0.w + tmp[3];
                S[4] = S[4] * d1.x + tmp[4]; S[5] = S[5] * d1.y + tmp[5]; S[6] = S[6] * d1.z + tmp[6]; S[7] = S[7] * d1.w + tmp[7];
            }
        }
    }
}
__device__ __forceinline__ void gla_out_phase(Frame& F, const float* wgu, const float* bgu, const float* ogain) {
    const float* ST = (const float*)(F.ws + WS_ST); const bf16_t* GR = (const bf16_t*)(F.ws + WS_GR); const __amdgpu_buffer_rsrc_t gr_r = wt_rsrc(F.ws + WS_YG);
    const int lane = F.lane, l31 = lane & 31, hh = lane >> 5, wave = F.wave; LAS unsigned char* L = F.lds;
    const LAS unsigned char* pv0 = L + GL_VT + (wave >> 2) * 16384 + (wave & 3) * 512 + gl_tr_base(lane, 4 * hh); const LAS unsigned char* pv1 = L + GL_VT + (wave >> 2) * 16384 + (wave & 3) * 512 + gl_tr_base(lane, 4 * hh + 8);
    for (int u = F.bid; u < 512; u += F.G) {
        const int sc = u & 31, bh = u >> 5, b = bh >> 2, h = bh & 3;
        bf16x8 whi, wlo; float bias; gla_load_w(F, wgu, bgu, h, whi, wlo, bias);
        f32x16 S[4];
        { const v4u* st8 = (const v4u*)ST + (size_t)(bh * 32 + sc) * 4096 + (wave * 4 * 64 + lane) * 2;
#pragma unroll
          for (int dt = 0; dt < 4; ++dt)
#pragma unroll
              for (int hf = 0; hf < 2; ++hf) { float f[8]; unpack8(st8[dt * 128 + hf], f);
#pragma unroll
                  for (int e = 0; e < 8; ++e) S[dt][8 * hf + e] = f[e]; } }
#pragma unroll 1
        for (int c = 0; c < 4; ++c) {
            const size_t m0 = (size_t)b * SEQ + sc * 256 + c * 64;
            (void)gla_stage<true>(F, h, m0, whi, wlo, bias);
            f32x16 o0, o1;
#pragma unroll
            for (int r = 0; r < 16; ++r) { o0[r] = 0.f; o1[r] = 0.f; }
#pragma unroll
            for (int dt = 0; dt < 4; ++dt)
#pragma unroll
                for (int s = 0; s < 2; ++s) {
                    const bf16x8 bs = pack8(S[dt], s);
                    const int ko = (32 * dt + 16 * s + 4 * hh) * 2;
                    o0 = mfma32(ld2x8(L + GL_QT + l31 * GL_QROW + ko), bs, o0);
                    o1 = mfma32(ld2x8(L + GL_QT + (32 + l31) * GL_QROW + ko), bs, o1);
                }
            __builtin_amdgcn_sched_barrier(0);
#pragma unroll
            for (int tile = 0; tile < 3; ++tile) {
                const int jt = (tile == 2) ? 1 : 0, it = (tile == 0) ? 0 : 1;
                f32x16 p;
#pragma unroll
                for (int r = 0; r < 16; ++r) p[r] = 0.f;
#pragma unroll
                for (int ks = 0; ks < 8; ++ks) {
                    const int ko = (16 * ks + 8 * hh) * 2;
                    const bf16x8 a = *(const LAS bf16x8*)(L + GL_KT + (32 * jt + l31) * GL_QROW + ko);
                    const bf16x8 b = *(const LAS bf16x8*)(L + GL_QT + (32 * it + l31) * GL_QROW + ko);
                    p = mfma32(a, b, p);
                }
                if (jt == it) {
#pragma unroll
                    for (int r = 0; r < 16; ++r) { const int j = (r & 3) + 8 * (r >> 2) + 4 * hh; p[r] = (j > l31) ? 0.f : p[r]; }
                }
#pragma unroll
                for (int s = 0; s < 2; ++s) {
                    const bf16x8 bv = gl_tr2(pv0 + 8192 * jt + 4096 * s, pv1 + 8192 * jt + 4096 * s);
                    if (it == 0) o0 = mfma32(pack8(p, s), bv, o0); else o1 = mfma32(pack8(p, s), bv, o1);
                }
                __builtin_amdgcn_sched_barrier(0);
            }
            gla_state_update(F, S);
            __syncthreads();
#pragma unroll
            for (int r = 0; r < 16; ++r) { const int i = (r & 3) + 8 * (r >> 2) + 4 * hh;
                *(LAS float*)(L + GL_OB + i * GL_OBROW + (32 * wave + l31) * 4) = o0[r]; *(LAS float*)(L + GL_OB + (32 + i) * GL_OBROW + (32 * wave + l31) * 4) = o1[r]; }
            __syncthreads();
            {
                const int t = F.tid >> 3, part = F.tid & 7;
                float v[32]; float ss = 0.f;
#pragma unroll
                for (int i = 0; i < 8; ++i) { const f32x4 x = *(const LAS f32x4*)(L + GL_OB + t * GL_OBROW + (32 * part + 4 * i) * 4); v[4 * i] = x.x; v[4 * i + 1] = x.y; v[4 * i + 2] = x.z; v[4 * i + 3] = x.w; ss += (x.x * x.x + x.y * x.y) + (x.z * x.z + x.w * x.w); }
                ss += __builtin_bit_cast(float, __builtin_amdgcn_update_dpp(0, __builtin_bit_cast(int, ss), 0xB1, 0xF, 0xF, false)); ss += __builtin_bit_cast(float, __builtin_amdgcn_update_dpp(0, __builtin_bit_cast(int, ss), 0x4E, 0xF, 0xF, false)); ss += __shfl_xor(ss, 4);
                const float rstd = rsqrtf(ss * (1.f / 256.f) + EPS);
                const bf16_t* gp = GR + (m0 + t) * 1024 + h * 256 + 32 * part;
#pragma unroll
                for (int i = 0; i < 4; ++i) { const v4u raw = *(const v4u*)(gp + 8 * i); float rr[8]; unpack8(raw, rr);
                    const f32x4 g0 = *(const f32x4*)(ogain + 32 * part + 8 * i), g1 = *(const f32x4*)(ogain + 32 * part + 8 * i + 4);
                    v4u o; o.x = pk2(v[8 * i] * rstd * g0.x * rr[0], v[8 * i + 1] * rstd * g0.y * rr[1]); o.y = pk2(v[8 * i + 2] * rstd * g0.z * rr[2], v[8 * i + 3] * rstd * g0.w * rr[3]);
                    o.z = pk2(v[8 * i + 4] * rstd * g1.x * rr[4], v[8 * i + 5] * rstd * g1.y * rr[5]); o.w = pk2(v[8 * i + 6] * rstd * g1.z * rr[6], v[8 * i + 7] * rstd * g1.w * rr[7]);
                    wt_st16(gr_r, (unsigned)(((m0 + t) * 1024 + h * 256 + 32 * part + 8 * i) * 2), o); }
            }
        }
    }
    __syncthreads();
}

constexpr int PK_KROW = 272, PK_K_OFF = 0, PK_SCR_OFF = 2 * 128 * PK_KROW;
__device__ __forceinline__ void ce(unsigned& a, unsigned& b) { const unsigned mx = a > b ? a : b, mn = a > b ? b : a; a = mx; b = mn; }
template <int N> __device__ __forceinline__ void bitonic_sort_desc(unsigned (&x)[N]) {
#pragma unroll
    for (int k = 2; k <= N; k <<= 1)
#pragma unroll
        for (int j = k >> 1; j > 0; j >>= 1)
#pragma unroll
            for (int i = 0; i < N; ++i) { const int l = i ^ j; if (l > i) { if ((i & k) == 0) ce(x[i], x[l]); else ce(x[l], x[i]); } }
}
__device__ __forceinline__ void sort16_desc(unsigned (&x)[16]) {
    ce(x[0], x[13]); ce(x[1], x[12]); ce(x[2], x[15]); ce(x[3], x[14]); ce(x[4], x[8]); ce(x[5], x[6]); ce(x[7], x[11]); ce(x[9], x[10]); ce(x[0], x[5]); ce(x[1], x[7]); ce(x[2], x[9]); ce(x[3], x[4]); ce(x[6], x[13]); ce(x[8], x[14]); ce(x[10], x[15]); ce(x[11], x[12]); ce(x[0], x[1]); ce(x[2], x[3]); ce(x[4], x[5]); ce(x[6], x[8]); ce(x[7], x[9]); ce(x[10], x[11]); ce(x[12], x[13]); ce(x[14], x[15]); ce(x[0], x[2]); ce(x[1], x[3]); ce(x[4], x[10]); ce(x[5], x[11]); ce(x[6], x[7]); ce(x[8], x[9]); ce(x[12], x[14]); ce(x[13], x[15]); ce(x[1], x[2]); ce(x[3], x[12]); ce(x[4], x[6]); ce(x[5], x[7]); ce(x[8], x[10]); ce(x[9], x[11]); ce(x[13], x[14]); ce(x[1], x[4]); ce(x[2], x[6]); ce(x[5], x[8]); ce(x[7], x[10]); ce(x[9], x[13]); ce(x[11], x[14]); ce(x[2], x[4]); ce(x[3], x[6]); ce(x[9], x[12]); ce(x[11], x[13]); ce(x[3], x[5]); ce(x[6], x[8]); ce(x[7], x[9]); ce(x[10], x[12]); ce(x[3], x[4]); ce(x[5], x[6]); ce(x[7], x[8]); ce(x[9], x[10]); ce(x[11], x[12]); ce(x[6], x[7]); ce(x[8], x[9]);
}
__device__ __forceinline__ void merge16(unsigned (&a)[16], const unsigned (&b)[16]) {
#pragma unroll
    for (int i = 0; i < 16; ++i) a[i] = a[i] > b[15 - i] ? a[i] : b[15 - i];
#pragma unroll
    for (int j = 8; j > 0; j >>= 1)
#pragma unroll
        for (int i = 0; i < 16; ++i) { const int l = i ^ j; if (l > i) ce(a[i], a[l]); }
}
__device__ __forceinline__ void merge16_partner(unsigned (&a)[16]) {
    unsigned b[16];
#pragma unroll
    for (int i = 0; i < 16; ++i) b[i] = (unsigned)__shfl_xor((int)a[i], 32);
    merge16(a, b);
}
__device__ __forceinline__ unsigned f2key(float f) { const unsigned u = __builtin_bit_cast(unsigned, f); return u ^ ((unsigned)((int)u >> 31) | 0x80000000u); }
__device__ __forceinline__ float key2f(unsigned k) { const unsigned m = ~(unsigned)((int)k >> 31) | 0x80000000u; return __builtin_bit_cast(float, k ^ m); }
__device__ constexpr int PEER_CI[50] = {0,0,0,0,0,0,0,0,0,0,0,0,0,0,0,0, 1,1,1,1,1,1,1,1, 2,2,2,2,2, 3,3,3,3, 4,4,4, 5,5, 6,6, 7,7, 8,9,10,11,12,13,14,15};
__device__ constexpr int PEER_CJ[50] = {0,1,2,3,4,5,6,7,8,9,10,11,12,13,14,15, 0,1,2,3,4,5,6,7, 0,1,2,3,4, 0,1,2,3, 0,1,2, 0,1, 0,1, 0,1, 0,0,0,0,0,0,0,0};
__device__ __forceinline__ void top16_of_tiles(const f32x16 (&s)[4], int hh, unsigned (&top)[16]) {
#pragma unroll
    for (int mt = 0; mt < 4; ++mt) {
        unsigned g[16];
#pragma unroll
        for (int r = 0; r < 16; ++r) { const unsigned low = (unsigned)(127 - (32 * mt + (r & 3) + 8 * (r >> 2))) - 4u * (unsigned)hh; g[r] = (f2key(s[mt][r]) & ~127u) | low; }
        sort16_desc(g);
        if (mt == 0) {
#pragma unroll
            for (int i = 0; i < 16; ++i) top[i] = g[i];
        } else merge16(top, g);
    }
    merge16_partner(top);
}
__device__ __forceinline__ void peer_topk_phase(Frame& F) {
    const bf16_t* QP = (const bf16_t*)(F.ws + WS_QP); const bf16_t* SUBK = (const bf16_t*)(F.ws + WS_SUBK);
    unsigned short* IDX = (unsigned short*)(F.ws + WS_IDX); float* GATE = (float*)(F.ws + WS_GATE);
    LAS unsigned char* L = F.lds; const int tid = F.tid, lane = F.lane, wave = F.wave, l31 = lane & 31, hh = lane >> 5;
    LAS unsigned* scr = (LAS unsigned*)(L + PK_SCR_OFF + wave * 8192);
    pg8::StaticOrder S; S.init(T, 2048, F.G, F.bid);
    for (int ui = 0; ; ++ui) {
        pg8::Unit un; if (!S.next(ui, un)) break;
        const int h = un.pn, tile = un.pm;
        __syncthreads();
#pragma unroll
        for (int i = 0; i < 8; ++i) { const int v = tid + 512 * i, row = v >> 4, c = v & 15;
            *(LAS v4u*)(L + PK_K_OFF + row * PK_KROW + c * 16) = *(const v4u*)(SUBK + ((size_t)h * 256 + row) * 128 + c * 8); }
        __syncthreads();
        const int tok = tile * 256 + wave * 32 + l31;
        unsigned ka[16], kb[16];
#pragma unroll
        for (int p = 0; p < 2; ++p) {
            f32x16 s[4];
#pragma unroll
            for (int mt = 0; mt < 4; ++mt)
#pragma unroll
                for (int r = 0; r < 16; ++r) s[mt][r] = 0.f;
            const bf16_t* qrow = QP + (size_t)tok * 2048 + h * 256 + p * 128 + 8 * hh;
#pragma unroll
            for (int k2 = 0; k2 < 4; ++k2) {
                const bf16x8 q0 = *(const bf16x8*)(qrow + 32 * k2), q1 = *(const bf16x8*)(qrow + 32 * k2 + 16);
#pragma unroll
                for (int mt = 0; mt < 4; ++mt) { const bf16x8 a = *(const LAS bf16x8*)(L + PK_K_OFF + (p * 128 + 32 * mt + l31) * PK_KROW + (32 * k2 + 8 * hh) * 2); s[mt] = mfma32(a, q0, s[mt]); }
#pragma unroll
                for (int mt = 0; mt < 4; ++mt) { const bf16x8 a = *(const LAS bf16x8*)(L + PK_K_OFF + (p * 128 + 32 * mt + l31) * PK_KROW + (32 * k2 + 16 + 8 * hh) * 2); s[mt] = mfma32(a, q1, s[mt]); }
                __builtin_amdgcn_sched_barrier(0);
            }
            if (p == 0) top16_of_tiles(s, hh, ka); else top16_of_tiles(s, hh, kb);
        }
        float sa[16], sb[16];
#pragma unroll
        for (int i = 0; i < 16; ++i) { sa[i] = key2f(ka[i] & ~127u); sb[i] = key2f(kb[i] & ~127u); scr[i * 64 + lane] = 127u - (ka[i] & 127u); scr[(16 + i) * 64 + lane] = 127u - (kb[i] & 127u); }
        unsigned c0[16], c1[16];
#pragma unroll
        for (int n = 0; n < 32; ++n) {
            unsigned key = 0u;
            if (n < 25) { const int e0 = 2 * n, e1 = 2 * n + 1;
                const float v0 = sa[PEER_CI[e0]] + sb[PEER_CJ[e0]], v1 = sa[PEER_CI[e1]] + sb[PEER_CJ[e1]];
                const unsigned k0 = (f2key(v0) & ~255u) | (unsigned)(255 - (PEER_CI[e0] * 16 + PEER_CJ[e0])), k1 = (f2key(v1) & ~255u) | (unsigned)(255 - (PEER_CI[e1] * 16 + PEER_CJ[e1]));
                key = hh ? k1 : k0; }
            if (n < 16) c0[n] = key; else c1[n - 16] = key;
        }
        sort16_desc(c0); sort16_desc(c1); merge16(c0, c1); merge16_partner(c0);
        float e[16]; float sum = 0.f; const float mx = key2f(c0[0] & ~255u);
#pragma unroll
        for (int n = 0; n < 16; ++n) { e[n] = fexp(key2f(c0[n] & ~255u) - mx); sum += e[n]; }
        const float inv = 1.0f / sum;
        int eo[8]; float go[8];
#pragma unroll
        for (int n = 0; n < 8; ++n) { const unsigned kk = hh ? c0[8 + n] : c0[n]; const unsigned id = 255u - (kk & 255u);
            const unsigned i1 = scr[(id >> 4) * 64 + lane], i2 = scr[(16 + (id & 15)) * 64 + lane];
            eo[n] = (int)(i1 * 128u + i2); go[n] = (hh ? e[8 + n] : e[n]) * inv; }
        typedef int i32x4 __attribute__((ext_vector_type(4)));
        { const __amdgpu_buffer_rsrc_t gr = wt_rsrc(GATE); const unsigned bo = (unsigned)(((size_t)tok * 128 + h * 16 + 8 * hh) * 4);
          wt_st16(gr, bo, __builtin_bit_cast(wt_u32x4, (f32x4){go[0], go[1], go[2], go[3]})); wt_st16(gr, bo + 16, __builtin_bit_cast(wt_u32x4, (f32x4){go[4], go[5], go[6], go[7]}));
          *(v4u*)(IDX + (size_t)tok * 128 + 16 * h + 8 * hh) = (v4u){(unsigned)eo[0] | ((unsigned)eo[1] << 16), (unsigned)eo[2] | ((unsigned)eo[3] << 16), (unsigned)eo[4] | ((unsigned)eo[5] << 16), (unsigned)eo[6] | ((unsigned)eo[7] << 16)}; }
    }
    __syncthreads();
}
constexpr size_t WS_RSTD2 = 482 * MiB, WS_EXD8 = 352 * MiB, WS_EXU8 = 368 * MiB, WS_ISD = 6 * MiB, WS_ISU = 6 * MiB + 65536, WS_PA = 32 * MiB, WS_WEX = 416 * MiB, WS_AQ = 96 * MiB, WS_ASC = 130 * MiB;
__device__ __forceinline__ float gelu_exact(float x) { return 0.5f * x * (1.f + erff(x * 0.7071067811865476f)); }
__device__ __forceinline__ unsigned pack_i8x4(float a, float b, float c, float d) {
    const int ia = (int)rintf(a), ib = (int)rintf(b), ic = (int)rintf(c), id = (int)rintf(d);
    return ((unsigned)ia & 0xffu) | (((unsigned)ib & 0xffu) << 8) | (((unsigned)ic & 0xffu) << 16) | ((unsigned)id << 24);
}
__device__ __forceinline__ unsigned nib_lo(unsigned w) { return w & 0x0F0F0F0Fu; }
__device__ __forceinline__ unsigned nib_hi(unsigned w) { return ((((w ^ 0x80808080u) + 0x08080808u) >> 4) & 0x0F0F0F0Fu) ^ 0x08080808u; }
__device__ __forceinline__ void peer_quant_phase(Frame& F) {
    const bf16_t* HB = (const bf16_t*)(F.ws + WS_HB2); unsigned char* AQ = F.ws + WS_AQ; float* ASC = (float*)(F.ws + WS_ASC); const int lane = F.lane;
    for (int t = F.bid * NWAVES + F.wave; t < T; t += F.G * NWAVES) {
        const v4u* hp = (const v4u*)(HB + (size_t)t * D + 16 * lane); float a[8], b[8]; unpack8(hp[0], a); unpack8(hp[1], b);
        float mx = 0.f;
#pragma unroll
        for (int j = 0; j < 8; ++j) mx = fmaxf(mx, fmaxf(fabsf(a[j]), fabsf(b[j])));
        mx = fmaxf(mx, __shfl_xor(mx, 1)); mx = fmaxf(mx, __shfl_xor(mx, 2)); mx = fmaxf(mx, __shfl_xor(mx, 4)); mx = fmaxf(mx, __shfl_xor(mx, 8));
        const float sx = mx > 0.f ? 119.f / mx : 1.f, isx = mx > 0.f ? mx * (1.f / 119.f) : 1.f;
        const unsigned w0 = pack_i8x4(a[0] * sx, a[2] * sx, a[4] * sx, a[6] * sx), w1 = pack_i8x4(a[1] * sx, a[3] * sx, a[5] * sx, a[7] * sx);
        const unsigned w2 = pack_i8x4(b[0] * sx, b[2] * sx, b[4] * sx, b[6] * sx), w3 = pack_i8x4(b[1] * sx, b[3] * sx, b[5] * sx, b[7] * sx);
        unsigned char* base = AQ + ((size_t)(t * 4 + (lane >> 4)) * 8 + ((lane & 15) >> 1)) * 32 + (lane & 1) * 8;
        *(v2u*)base = (v2u){nib_hi(w0) | (nib_hi(w1) << 4), nib_hi(w2) | (nib_hi(w3) << 4)};
        *(v2u*)(base + 16) = (v2u){nib_lo(w0) | (nib_lo(w1) << 4), nib_lo(w2) | (nib_lo(w3) << 4)};
        if ((lane & 15) == 0) ASC[t * 4 + (lane >> 4)] = isx;
    }
}
__device__ __forceinline__ void treduce16(float (&p)[16], int lane, int m) {
#pragma unroll
    for (int i = 0; i < 8; ++i) { const bool hi = lane & m; const float send = hi ? p[i] : p[i + 8], keep = hi ? p[i + 8] : p[i]; p[i] = keep + __shfl_xor(send, m); }
#pragma unroll
    for (int i = 0; i < 4; ++i) { const bool hi = lane & (2 * m); const float send = hi ? p[i] : p[i + 4], keep = hi ? p[i + 4] : p[i]; p[i] = keep + __shfl_xor(send, 2 * m); }
#pragma unroll
    for (int i = 0; i < 2; ++i) { const bool hi = lane & (4 * m); const float send = hi ? p[i] : p[i + 2], keep = hi ? p[i + 2] : p[i]; p[i] = keep + __shfl_xor(send, 4 * m); }
}
typedef int i32x4v __attribute__((ext_vector_type(4)));
__device__ __forceinline__ void treduce16i_g(int (&p)[16], int lane) {
#pragma unroll
    for (int i = 0; i < 8; ++i) { const v2u r = __builtin_amdgcn_permlane32_swap((unsigned)p[i], (unsigned)p[i + 8], false, false); p[i] = (int)(r.x + r.y); }
#pragma unroll
    for (int i = 0; i < 4; ++i) { const v2u r = __builtin_amdgcn_permlane16_swap((unsigned)p[i], (unsigned)p[i + 4], false, false); p[i] = (int)(r.x + r.y); }
    const bool hi = lane & 8;
#pragma unroll
    for (int i = 0; i < 2; ++i) { const int send = hi ? p[i] : p[i + 2], keep = hi ? p[i + 2] : p[i]; p[i] = keep + __builtin_amdgcn_update_dpp(0, send, 0x128, 0xF, 0xF, false); }
}
__device__ __forceinline__ void peer_load_ids(const unsigned short* IDX, size_t t, int g, i32x4v (&id)[4]) {
    const v4u* p = (const v4u*)(IDX + t * 128 + g * 16); const v4u a = p[0], b = p[1];
    id[0] = (i32x4v){(int)(a.x & 0xffffu), (int)(a.x >> 16), (int)(a.y & 0xffffu), (int)(a.y >> 16)}; id[1] = (i32x4v){(int)(a.z & 0xffffu), (int)(a.z >> 16), (int)(a.w & 0xffffu), (int)(a.w >> 16)};
    id[2] = (i32x4v){(int)(b.x & 0xffffu), (int)(b.x >> 16), (int)(b.y & 0xffffu), (int)(b.y >> 16)}; id[3] = (i32x4v){(int)(b.z & 0xffffu), (int)(b.z >> 16), (int)(b.w & 0xffffu), (int)(b.w >> 16)};
}
__device__ __forceinline__ void peer_load_w(const bf16_t* WEX, size_t t, int g, v4u (&w)[2]) {
    const v4u* p = (const v4u*)(WEX + t * 128 + g * 16); w[0] = p[0]; w[1] = p[1];
}
__device__ __forceinline__ void peer_v8_lds(LAS unsigned char* scr, unsigned raw, int lane, int grp, v4u (&o)[2]) {
    *(LAS unsigned*)(scr + 4 * lane) = raw; asm volatile("" ::: "memory");
    o[0] = *(const LAS v4u*)(scr + 32 * grp); o[1] = *(const LAS v4u*)(scr + 32 * grp + 16); asm volatile("" ::: "memory");
}
__device__ __forceinline__ void peer_ids_lds(LAS unsigned char* scr, unsigned raw, int lane, i32x4v (&id)[4]) {
    v4u r[2]; peer_v8_lds(scr, raw, lane, lane >> 3, r); const v4u a = r[0], b = r[1];
    id[0] = (i32x4v){(int)(a.x & 0xffffu), (int)(a.x >> 16), (int)(a.y & 0xffffu), (int)(a.y >> 16)}; id[1] = (i32x4v){(int)(a.z & 0xffffu), (int)(a.z >> 16), (int)(a.w & 0xffffu), (int)(a.w >> 16)};
    id[2] = (i32x4v){(int)(b.x & 0xffffu), (int)(b.x >> 16), (int)(b.y & 0xffffu), (int)(b.y >> 16)}; id[3] = (i32x4v){(int)(b.z & 0xffffu), (int)(b.z >> 16), (int)(b.w & 0xffffu), (int)(b.w >> 16)};
}
#ifndef PEER_GATHER_AUX
#define PEER_GATHER_AUX 16
#endif
__device__ __forceinline__ void peer_gather16(v4u (&q)[16], const __amdgpu_buffer_rsrc_t r, unsigned loff, const i32x4v (&id)[4]) {
#pragma unroll
    for (int i = 0; i < 16; ++i) q[i] = __builtin_bit_cast(v4u, __builtin_amdgcn_raw_buffer_load_b128(r, (unsigned)id[i >> 2][i & 3] * 128u + loff, 0, PEER_GATHER_AUX));
}
__device__ __forceinline__ void peer_down_compute(const v4u (&q)[16], const v4u (&aq)[2], float isx, bf16_t* pa, int lane) {
    float p[16];
#pragma unroll
    for (int i = 0; i < 16; ++i) { int ah = __builtin_amdgcn_sdot8((int)q[i][0], (int)aq[0][0], 0, true), al = __builtin_amdgcn_sdot8((int)q[i][0], (int)aq[1][0], 0, true);
#pragma unroll
        for (int j = 1; j < 4; ++j) { ah = __builtin_amdgcn_sdot8((int)q[i][j], (int)aq[0][j], ah, false); al = __builtin_amdgcn_sdot8((int)q[i][j], (int)aq[1][j], al, false); }
        p[i] = (float)(16 * ah + al) * isx; }
    treduce16(p, lane, 1);
    *(unsigned*)(pa + 2 * lane) = pk2(p[0], p[1]);
}
__device__ __forceinline__ void peer_down_phase(Frame& F) {
    const unsigned char* TD = F.ws + WS_EXD8; const unsigned short* IDX = (const unsigned short*)(F.ws + WS_IDX);
    bf16_t* PA = (bf16_t*)(F.ws + WS_PA); const bf16_t* h1 = (const bf16_t*)(F.ws + WS_HB2);
    const unsigned char* AQ = F.ws + WS_AQ; const float* ASC = (const float*)(F.ws + WS_ASC);
    const int lane = F.lane, g = lane >> 3, cl = lane & 7, k = (F.bid & 7) >> 1, nw = (F.G >> 3) * 2 * NWAVES;
    const __amdgpu_buffer_rsrc_t tk = wt_rsrc(TD + (size_t)k * 16384 * 128); const unsigned loff = 16u * (unsigned)cl;
    int t = ((F.bid >> 3) * 2 + (F.bid & 1)) * NWAVES + F.wave;
    if (t >= T) return;
    LAS unsigned char* scrI = F.lds + F.wave * 512; LAS unsigned char* scrA = scrI + 256;
    const unsigned* IDXW = (const unsigned*)IDX + lane; const unsigned* AQW = (const unsigned*)AQ + k * 64 + lane;
    i32x4v id[4];
    unsigned idr = IDXW[(size_t)t * 64];
    peer_ids_lds(scrI, idr, lane, id);
    v4u qa[16], qb[16];
    peer_gather16(qa, tk, loff, id);
    { const int tl = (t + nw < T) ? t + nw : t; idr = IDXW[(size_t)tl * 64]; }
    float hs = ASC[t * 4 + k];
    unsigned aqr = AQW[(size_t)t * 256];
#define PEER_DOWN_STEP(QC, QN) { \
        const int t1 = t + nw, t2 = t + 2 * nw; const bool has1 = t1 < T; \
        peer_ids_lds(scrI, idr, lane, id); \
        if (has1) peer_gather16(QN, tk, loff, id); \
        { const int tl = (t2 < T) ? t2 : t; idr = IDXW[(size_t)tl * 64]; } \
        v4u hv[2]; peer_v8_lds(scrA, aqr, lane, cl, hv); \
        unsigned aqn; float hsn; { const int tl = has1 ? t1 : t; aqn = AQW[(size_t)tl * 256]; hsn = ASC[tl * 4 + k]; } \
        __builtin_amdgcn_sched_barrier(0); \
        peer_down_compute(QC, hv, hs, PA + ((size_t)k * T + t) * 128, lane); \
        __builtin_amdgcn_sched_barrier(0); \
        if (!has1) break; t = t1; aqr = aqn; hs = hsn; }
    for (;;) { PEER_DOWN_STEP(qa, qb) PEER_DOWN_STEP(qb, qa) }
#undef PEER_DOWN_STEP
}
__device__ __forceinline__ void peer_combine_phase(Frame& F) {
    const unsigned* PAW = (const unsigned*)(F.ws + WS_PA); const unsigned* IDXW = (const unsigned*)(F.ws + WS_IDX); const float* GATE = (const float*)(F.ws + WS_GATE);
    const float* ISD = (const float*)(F.ws + WS_ISD); const float* ISU = (const float*)(F.ws + WS_ISU); unsigned* WQ = (unsigned*)(F.ws + WS_WEX); float* WSC = (float*)(F.ws + WS_WEX + 8 * MiB); const float* RSTD2 = (const float*)(F.ws + WS_RSTD2);
    const int lane = F.lane, g = lane >> 3, w = lane & 7, cl = ((w & 1) << 2) | (w & 2) | ((w >> 2) & 1);
    LAS float* lsd = (LAS float*)F.lds; LAS float* lsu = lsd + 16384;
    __syncthreads();
    for (int i = F.tid; i < 4096; i += NTHR) { *(LAS f32x4*)(lsd + 4 * i) = *(const f32x4*)(ISD + 4 * i); *(LAS f32x4*)(lsu + 4 * i) = *(const f32x4*)(ISU + 4 * i); }
    __syncthreads();
    for (int t = F.bid * NWAVES + F.wave; t < T; t += F.G * NWAVES) {
        float a0 = 0.f, a1 = 0.f;
#pragma unroll
        for (int k = 0; k < 4; ++k) { const unsigned r = PAW[((size_t)k * T + t) * 64 + 8 * g + cl]; a0 += __builtin_bit_cast(float, r << 16); a1 += __builtin_bit_cast(float, r & 0xffff0000u); }
        const unsigned idp = IDXW[(size_t)t * 64 + 8 * g + w]; const int id0 = (int)(idp & 0xffffu), id1 = (int)(idp >> 16);
        const f32x2_t gg = *(const f32x2_t*)(GATE + (size_t)t * 128 + 16 * g + 2 * w); const float g0 = gg.x, g1 = gg.y, rs = RSTD2[t];
        const pg8::f32x2 ge = pg8::gelu_pk((pg8::f32x2){a0 * rs * lsd[id0], a1 * rs * lsd[id1]});
        const float w0 = g0 * ge.x * lsu[id0], w1 = g1 * ge.y * lsu[id1];
        float mx = fmaxf(fabsf(w0), fabsf(w1));
#define P10_DPPF(x, ctrl) __builtin_bit_cast(float, __builtin_amdgcn_update_dpp(0, __builtin_bit_cast(int, x), ctrl, 0xF, 0xF, false))
        mx = fmaxf(mx, P10_DPPF(mx, 0xB1)); mx = fmaxf(mx, P10_DPPF(mx, 0x4E)); mx = fmaxf(mx, P10_DPPF(mx, 0x124)); mx = fmaxf(mx, P10_DPPF(mx, 0x128));
#undef P10_DPPF
        mx = fmaxf(mx, __shfl_xor(mx, 16)); mx = fmaxf(mx, __shfl_xor(mx, 32));
        const float sw = mx > 0.f ? 119.f / mx : 1.f, isw = mx > 0.f ? mx * (1.f / 119.f) : 1.f;
        const unsigned by = ((unsigned)(int)rintf(w0 * sw) & 0xffu) | (((unsigned)(int)rintf(w1 * sw) & 0xffu) << 8);
        const unsigned h = nib_hi(by) & 0x0F0Fu, l = nib_lo(by) & 0x0F0Fu;
        unsigned v0 = (h & 0xFu) << (4 * g), v1 = (l & 0xFu) << (4 * g), v2 = ((h >> 8) & 0xFu) << (4 * g), v3 = ((l >> 8) & 0xFu) << (4 * g);
#pragma unroll
        for (int o = 16; o < 64; o <<= 1) { v0 |= (unsigned)__shfl_xor((int)v0, o); v1 |= (unsigned)__shfl_xor((int)v1, o); v2 |= (unsigned)__shfl_xor((int)v2, o); v3 |= (unsigned)__shfl_xor((int)v3, o); }
        v0 |= (unsigned)__builtin_amdgcn_update_dpp(0, (int)v0, 0x128, 0xF, 0xF, false); v1 |= (unsigned)__builtin_amdgcn_update_dpp(0, (int)v1, 0x128, 0xF, 0xF, false);
        v2 |= (unsigned)__builtin_amdgcn_update_dpp(0, (int)v2, 0x128, 0xF, 0xF, false); v3 |= (unsigned)__builtin_amdgcn_update_dpp(0, (int)v3, 0x128, 0xF, 0xF, false);
        if (g == 0) *(v4u*)(WQ + (size_t)t * 32 + 4 * w) = (v4u){v0, v1, v2, v3};
        if (lane == 0) WSC[t] = isw;
    }
    __syncthreads();
}
constexpr int PU_ROW = 144, PU_BUF = 64 * PU_ROW, PU_OFF = 4096;
typedef int pu_v2i __attribute__((ext_vector_type(2)));
__device__ __forceinline__ void peer_up_compute(const v4u (&q)[16], const LAS unsigned char* scrW, float isw, const unsigned short (&hraw)[4], __amdgpu_buffer_rsrc_t dst_r, unsigned doff, LAS unsigned char* wrb, const LAS unsigned char* trb) {
    int ah[4], al[4];
#define PU_WRITE(qt, bf) { _Pragma("unroll") for (int ip = 0; ip < 4; ++ip) *(LAS v4u*)(wrb + (bf) * 32 * PU_ROW + 8 * PU_ROW * ip) = q[4 * (qt) + ip]; asm volatile("" ::: "memory"); }
#define PU_READ(qt, bf) { _Pragma("unroll") for (int b = 0; b < 2; ++b) { \
        const v4u w4 = *(const LAS v4u*)(scrW + 16 * (2 * (qt) + b));     \
        _Pragma("unroll") for (int m = 0; m < 4; ++m) { \
            const pu_v2i d = __builtin_amdgcn_ds_read_tr4_b64_v2i32((LAS pu_v2i*)(trb + (bf) * 32 * PU_ROW + 16 * PU_ROW * b + 32 * m)); \
            if ((qt) == 0 && b == 0) { ah[m] = __builtin_amdgcn_sdot8(d.x, (int)w4.x, 0, true); al[m] = __builtin_amdgcn_sdot8(d.x, (int)w4.y, 0, true); } \
            else { ah[m] = __builtin_amdgcn_sdot8(d.x, (int)w4.x, ah[m], false); al[m] = __builtin_amdgcn_sdot8(d.x, (int)w4.y, al[m], false); } \
            ah[m] = __builtin_amdgcn_sdot8(d.y, (int)w4.z, ah[m], false); al[m] = __builtin_amdgcn_sdot8(d.y, (int)w4.w, al[m], false); } } \
        asm volatile("" ::: "memory"); }
    PU_WRITE(0, 0) PU_WRITE(1, 1) PU_READ(0, 0) PU_WRITE(2, 0) PU_READ(1, 1) PU_WRITE(3, 1) PU_READ(2, 0) PU_READ(3, 1)
#undef PU_WRITE
#undef PU_READ
#pragma unroll
    for (int m = 0; m < 4; ++m) __builtin_amdgcn_raw_buffer_store_b32(__builtin_bit_cast(unsigned, __builtin_bit_cast(float, (unsigned)hraw[m] << 16) + (float)(16 * ah[m] + al[m]) * isw), dst_r, doff + 256u * m, 0, 0);
}
__device__ __forceinline__ void peer_up_phase(Frame& F, float* dst) {
    const unsigned char* TU = F.ws + WS_EXU8; const unsigned short* IDX = (const unsigned short*)(F.ws + WS_IDX); const bf16_t* WEX = (const bf16_t*)(F.ws + WS_WEX);
    const int lane = F.lane, g = lane >> 3, cl = lane & 7, k = (F.bid & 7) >> 1, nw = (F.G >> 3) * 2 * NWAVES;
    const __amdgpu_buffer_rsrc_t tk = wt_rsrc(TU + (size_t)k * 16384 * 128); const unsigned loff = 16u * (unsigned)cl;
    const int ccol = 256 * k + lane;
    int t = ((F.bid >> 3) * 2 + (F.bid & 1)) * NWAVES + F.wave;
    if (t >= T) return;
    LAS unsigned char* scrI = F.lds + F.wave * 512; LAS unsigned char* scrW = scrI + 256;
    LAS unsigned char* rbuf = F.lds + PU_OFF + F.wave * PU_BUF;
    LAS unsigned char* wrb = rbuf + g * PU_ROW + 16 * cl;
    const LAS unsigned char* trb = rbuf + (lane & 15) * PU_ROW + 8 * (lane >> 4);
    const unsigned* IDXW = (const unsigned*)IDX + lane; const unsigned* WEXW = (const unsigned*)WEX + (lane & 31); const float* WSC = (const float*)(F.ws + WS_WEX + 8 * MiB);
    i32x4v id[4];
    unsigned idr = IDXW[(size_t)t * 64], wr = WEXW[(size_t)t * 32]; float ws = WSC[t];
    peer_ids_lds(scrI, idr, lane, id);
    v4u qa[16], qb[16];
    peer_gather16(qa, tk, loff, id);
    { const int tl = (t + nw < T) ? t + nw : t; idr = IDXW[(size_t)tl * 64]; }
    const __amdgpu_buffer_rsrc_t hb_r = wt_rsrc(F.ws + WS_HB2), dst_r = wt_rsrc(dst);
    unsigned short hcur[4];
#pragma unroll
    for (int m = 0; m < 4; ++m) hcur[m] = __builtin_amdgcn_raw_buffer_load_b16(hb_r, (unsigned)(t * D + ccol) * 2u + 128u * m, 0, 0);
#define PEER_UP_STEP(QC, QN) { \
        const int t1 = t + nw, t2 = t + 2 * nw; const bool has1 = t1 < T; \
        peer_ids_lds(scrI, idr, lane, id); \
        if (has1) peer_gather16(QN, tk, loff, id); \
        { const int tl = (t2 < T) ? t2 : t; idr = IDXW[(size_t)tl * 64]; } \
        const unsigned wrn = WEXW[(size_t)(has1 ? t1 : t) * 32]; const float wsn = WSC[has1 ? t1 : t]; \
        unsigned short hnext[4]; _Pragma("unroll") for (int m = 0; m < 4; ++m) hnext[m] = __builtin_amdgcn_raw_buffer_load_b16(hb_r, (unsigned)((has1 ? t1 : t) * D + ccol) * 2u + 128u * m, 0, 0); \
        *(LAS unsigned*)(scrW + 4 * (lane & 31)) = wr; asm volatile("" ::: "memory"); \
        __builtin_amdgcn_sched_barrier(0); \
        peer_up_compute(QC, scrW, ws, hcur, dst_r, (unsigned)(t * D + ccol) * 4u, wrb, trb); \
        __builtin_amdgcn_sched_barrier(0); \
        if (!has1) break; t = t1; _Pragma("unroll") for (int m = 0; m < 4; ++m) hcur[m] = hnext[m]; wr = wrn; ws = wsn; }
    for (;;) { PEER_UP_STEP(qa, qb) PEER_UP_STEP(qb, qa) }
#undef PEER_UP_STEP
}
__device__ __forceinline__ void expert_convert(Frame& F, const float* exd, const float* exu, const float* gain2) {
    const int lane = F.lane;
    f32x4 gv[4];
#pragma unroll
    for (int j = 0; j < 4; ++j) gv[j] = *(const f32x4*)(gain2 + 16 * lane + 4 * j);
    const bool wsplit = (F.G == 256); const int nscan = 128 * NWAVES;
    int gi = F.bid * NWAVES + F.wave, gstep = F.G * NWAVES, gend = 8192;
    if (wsplit) { gstep = nscan; if (F.bid < 128) { gend = 2 * nscan; } else { gi = 2 * nscan + (F.bid - 128) * NWAVES + F.wave; } }
    for (; gi < gend; gi += gstep) { const int r4 = gi * 4;
        const int tb = r4 >> 14, row0 = r4 & 16383;
        const float* src = (tb ? exu : exd) + (size_t)row0 * D + 16 * lane;
        f32x4 v[4][4]; float mx[4];
#pragma unroll
        for (int r = 0; r < 4; ++r)
#pragma unroll
            for (int j = 0; j < 4; ++j) v[r][j] = *(const f32x4*)(src + (size_t)r * D + 4 * j);
#pragma unroll
        for (int r = 0; r < 4; ++r) { float m = 0.f;
#pragma unroll
            for (int j = 0; j < 4; ++j) { if (tb == 0) v[r][j] = v[r][j] * gv[j]; m = fmaxf(m, fmaxf(fmaxf(fabsf(v[r][j].x), fabsf(v[r][j].y)), fmaxf(fabsf(v[r][j].z), fabsf(v[r][j].w)))); }
            mx[r] = m; }
#pragma unroll
        for (int o = 1; o < 64; o <<= 1)
#pragma unroll
            for (int r = 0; r < 4; ++r) mx[r] = fmaxf(mx[r], __shfl_xor(mx[r], o));
        {
            float ss[4];
#pragma unroll
            for (int r = 0; r < 4; ++r) { float s = 0.f;
#pragma unroll
                for (int j = 0; j < 4; ++j) s += (v[r][j].x * v[r][j].x + v[r][j].y * v[r][j].y) + (v[r][j].z * v[r][j].z + v[r][j].w * v[r][j].w);
                ss[r] = s; }
#pragma unroll
            for (int o = 1; o < 64; o <<= 1)
#pragma unroll
                for (int r = 0; r < 4; ++r) ss[r] += __shfl_xor(ss[r], o);
#pragma unroll
            for (int r = 0; r < 4; ++r) {
                const float rms = sqrtf(ss[r] * (1.f / 1024.f)), step = rms > 0.f ? 0.35f * rms : 1.f, sc = 1.f / step;
                f32x4 c[4];
#pragma unroll
                for (int j = 0; j < 4; ++j) { c[j] = v[r][j] * sc; c[j].x = fminf(fmaxf(c[j].x, -7.f), 7.f); c[j].y = fminf(fmaxf(c[j].y, -7.f), 7.f); c[j].z = fminf(fmaxf(c[j].z, -7.f), 7.f); c[j].w = fminf(fmaxf(c[j].w, -7.f), 7.f); }
                const unsigned x0 = pack_i8x4(c[0].x, c[0].z, c[1].x, c[1].z), y0 = pack_i8x4(c[0].y, c[0].w, c[1].y, c[1].w);
                const unsigned x1 = pack_i8x4(c[2].x, c[2].z, c[3].x, c[3].z), y1 = pack_i8x4(c[2].y, c[2].w, c[3].y, c[3].w);
                *(v2u*)(F.ws + (tb ? WS_EXU8 : WS_EXD8) + ((size_t)(lane >> 4) * 16384 + row0 + r) * 128 + (lane & 15) * 8) = (v2u){nib_lo(x0) | (nib_lo(y0) << 4), nib_lo(x1) | (nib_lo(y1) << 4)};
                if (lane == 0) wt_st4((float*)(F.ws + (tb ? WS_ISU : WS_ISD)) + row0 + r, step);
            }
            continue;
        }
        const __amdgpu_buffer_rsrc_t rr = wt_rsrc(F.ws + (tb ? WS_EXU8 : WS_EXD8));
#pragma unroll
        for (int r = 0; r < 4; ++r) {
            const float sc = mx[r] > 0.f ? 127.f / mx[r] : 1.f, isc = mx[r] > 0.f ? mx[r] * (1.f / 127.f) : 1.f;
            v4u q;
#pragma unroll
            for (int j = 0; j < 4; ++j) q[j] = pack_i8x4(v[r][j].x * sc, v[r][j].y * sc, v[r][j].z * sc, v[r][j].w * sc);
            wt_st16(rr, (unsigned)(((lane >> 3) * 16384 + row0 + r) * 128 + (lane & 7) * 16), q);
            if (lane == 0) wt_st4((float*)(F.ws + (tb ? WS_ISU : WS_ISD)) + row0 + r, isc);
        }
    }
}
#define XB_TMO      128
#define XB_XCNT(j)  (256  + 64 * (j))
#define XB_XSUB(j)  (1280 + 64 * (j))
#define XB_XGEN(j)  (2304 + 64 * (j))
#define XB_TOP      3328
#define XB_TOPGEN   3392
#define XCD_BAR_WORDS 3456
#define XB_SPIN_CAP (1u << 18)

__device__ __forceinline__ unsigned xb_ld(unsigned* p)              { return __hip_atomic_load(p, __ATOMIC_RELAXED, __HIP_MEMORY_SCOPE_AGENT); }
__device__ __forceinline__ unsigned xb_add(unsigned* p, unsigned v) { return __hip_atomic_fetch_add(p, v, __ATOMIC_RELAXED, __HIP_MEMORY_SCOPE_AGENT); }
__device__ __forceinline__ unsigned xb_xcc_id() { return (unsigned)__builtin_amdgcn_s_getreg((3 << 11) | 20) & 0xFu; }
#define XB_SPIN(cond, bar) do { unsigned _sp = 0; while (cond) { __builtin_amdgcn_s_sleep(1); \
    if ((++_sp & 255u) == 0u) { if (xb_ld(&(bar)[XB_TMO])) break; if (_sp > XB_SPIN_CAP) { atomicAdd(&(bar)[XB_TMO], 1u); break; } } } } while (0)

struct XcdBarrier {
    unsigned* bar; unsigned x;
    volatile LAS unsigned* st;
};

__device__ __forceinline__ XcdBarrier xcd_barrier_post(unsigned* bar, volatile LAS unsigned* st) {
    XcdBarrier b; b.bar = bar; b.x = xb_xcc_id(); b.st = st;
    if (threadIdx.x == 0) (void)xb_add(&bar[XB_XCNT(b.x)], 1u);
    return b;
}
__device__ __forceinline__ void xcd_barrier_complete(unsigned* bar, unsigned x, unsigned& nloc, unsigned& nx) {
    const unsigned G = gridDim.x * gridDim.y * gridDim.z;
    unsigned sum, cnt, mine, sp = 0u;
    for (;;) {
        sum = 0u; cnt = 0u; mine = 0u;
#pragma unroll
        for (unsigned j = 0; j < 16; ++j) { const unsigned c = xb_ld(&bar[XB_XCNT(j)]); sum += c; cnt += (c > 0u) ? 1u : 0u; mine = (j == x) ? c : mine; }
        if (sum == G) break;
        __builtin_amdgcn_s_sleep(1);
        if ((++sp & 255u) == 0u) { if (xb_ld(&bar[XB_TMO])) break; if (sp > XB_SPIN_CAP) { atomicAdd(&bar[XB_TMO], 1u); break; } }
    }
    nloc = mine > 0u ? mine : 1u; nx = cnt > 0u ? cnt : 1u;
}

__device__ __forceinline__ void xcd_barrier(const XcdBarrier& b) {
    asm volatile("s_waitcnt vmcnt(0)" ::: "memory");
    __syncthreads();
    if (threadIdx.x == 0) {
        unsigned* bar = b.bar;
        __builtin_amdgcn_s_waitcnt(0);
        unsigned nloc = b.st[0], nx = b.st[1];
        if (nloc == 0u) { xcd_barrier_complete(bar, b.x, nloc, nx); b.st[0] = nloc; b.st[1] = nx; }
        const unsigned old = xb_add(&bar[XB_XSUB(b.x)], 1u);
        const unsigned gen = old / nloc;
        if (old + 1u == (gen + 1u) * nloc) {
            __builtin_amdgcn_fence(__ATOMIC_RELEASE, "agent");
            asm volatile("s_waitcnt vmcnt(0)" ::: "memory");
            const unsigned og = xb_add(&bar[XB_TOP], 1u);
            const unsigned tg = og / nx;
            if (og + 1u == (tg + 1u) * nx) xb_add(&bar[XB_TOPGEN], 1u);
            else XB_SPIN(xb_ld(&bar[XB_TOPGEN]) == tg, bar);
            __builtin_amdgcn_fence(__ATOMIC_ACQUIRE, "agent");
            xb_add(&bar[XB_XGEN(b.x)], 1u);
            asm volatile("s_waitcnt vmcnt(0)" ::: "memory");
        } else {
            XB_SPIN(xb_ld(&bar[XB_XGEN(b.x)]) == gen, bar);
            __builtin_amdgcn_fence(__ATOMIC_ACQUIRE, "agent");
            asm volatile("s_waitcnt vmcnt(0)" ::: "memory");
        }
    }
    __syncthreads();
}

__global__ void __launch_bounds__(NTHR, 2) mega(Args args) {
    extern __shared__ __attribute__((aligned(16))) unsigned char lds_raw[];
    Frame F;
    F.lds = (LAS unsigned char*)lds_raw;
    F.tid = threadIdx.x; F.lane = F.tid & 63; F.wave = __builtin_amdgcn_readfirstlane(F.tid >> 6); F.G = gridDim.x; F.bid = blockIdx.x;
    F.out = args.out; F.ws = args.ws;
    const int lo = args.ph_lo, hi = args.ph_hi;
    cg::grid_group grid = cg::this_grid();
    volatile LAS unsigned* MISC = (volatile LAS unsigned*)(F.lds + LDS_BYTES - 64);
    if (F.tid < 16) MISC[F.tid] = 0u;
    __syncthreads();
    XcdBarrier bar = xcd_barrier_post((unsigned*)(F.ws + WS_CTL) + 4096, MISC + 8);
    if (hi - lo > 1) grid.sync();
#define IN(k) (lo <= (k) && (k) < hi)
#define SEAM(k) do { if (IN(k) && IN((k) + 1)) xcd_barrier(bar); } while (0)
    if (IN(0)) { p0_prologue(F, args.in[0], args.in[1], args.in[2], args.in[13], args.in[10], args.in[11], args.in[12], args.in[14], args.in[15]); }
    SEAM(0);
    if (IN(1)) {
        pg8::Gemm g{(const bf16_t*)(F.ws + WS_XB), (const bf16_t*)(F.ws + WS_WIN), T, NPROJ, D}; pg8::StaticOrder S; S.init(T, NPROJ, F.G, F.bid);
        pg8::EpiProj E{(bf16_t*)(F.ws + WS_GQ), (bf16_t*)(F.ws + WS_GK), (bf16_t*)(F.ws + WS_GV), (bf16_t*)(F.ws + WS_GR), (bf16_t*)(F.ws + WS_SQ), (bf16_t*)(F.ws + WS_SK), (bf16_t*)(F.ws + WS_SV),
                       (bf16_t*)F.out, (bf16_t*)F.out + (size_t)T * D, (const float*)(F.ws + WS_RSTD1)};
        pg8::gemm_phase<pg8::EpiProj, pg8::StaticOrder, PG8_ALIGN, PG8_SP2>(F.lds, g, S, E);
    }
    SEAM(1);
    if (IN(2)) { gla_local_phase(F, args.in[3], args.in[4]); }
    SEAM(2);
    if (IN(3)) { gla_scan_phase(F);
        if (F.bid & 1) { swa_phase(F, args.in[6], args.in[7], args.in[8], args.in[9], (size_t)0); expert_convert(F, args.in[16], args.in[17], args.in[13]); }
        else { expert_convert(F, args.in[16], args.in[17], args.in[13]); swa_phase(F, args.in[6], args.in[7], args.in[8], args.in[9], (size_t)0); } }
    SEAM(3);
    if (IN(4)) { gla_out_phase(F, args.in[3], args.in[4], args.in[5]); }
    SEAM(4);
    if (IN(5)) {
        pg8::PairOrder S; S.base.init(T, D, F.G, F.bid);
        pg8::Gemm g{(const bf16_t*)(F.ws + WS_YG), (const bf16_t*)(F.ws + WS_WG), T, D, D, (const bf16_t*)(F.ws + WS_SQ), (const bf16_t*)(F.ws + WS_WS)};
        pg8::EpiMergeBoth E{{(const bf16_t*)F.out, (const bf16_t*)F.out + (size_t)T * D, (bf16_t*)(F.ws + WS_MRG)}, {(const bf16_t*)F.out, (const bf16_t*)F.out + (size_t)T * D, (bf16_t*)(F.ws + WS_MRG)}};
        pg8::gemm_phase<pg8::EpiMergeBoth, pg8::PairOrder, PG8_ALIGN, PG8_SP2>(F.lds, g, S, E);
    }
    SEAM(5);
    if (IN(6)) {
        pg8::StaticOrder S; S.init(T, D, F.G, F.bid);
        pg8::Gemm g{(const bf16_t*)(F.ws + WS_MRG), (const bf16_t*)(F.ws + WS_WO), T, D, D};
        pg8::EpiOut E{(const bf16_t*)(F.ws + WS_XB), F.out, (bf16_t*)(F.ws + WS_HB2), (float*)(F.ws + WS_ROWSS2), T};
        pg8::gemm_phase<pg8::EpiOut, pg8::StaticOrder, PG8_ALIGN, PG8_SP2>(F.lds, g, S, E);
    }
    SEAM(6);
    if (IN(7)) {
        pg8::StaticOrder S; S.init(T, 2048, F.G, F.bid);
        pg8::Gemm g{(const bf16_t*)(F.ws + WS_HB2), (const bf16_t*)(F.ws + WS_WQ), T, 2048, D};
        pg8::EpiQ E{(const float*)(F.ws + WS_ROWSS2), (bf16_t*)(F.ws + WS_QP), T};
        pg8::gemm_phase<pg8::EpiQ, pg8::StaticOrder, PG8_ALIGN, PG8_SP2>(F.lds, g, S, E);
    }
    if (IN(7) && IN(8)) __syncthreads();
    if (IN(8)) {
        { const float* ROWSS = (const float*)(F.ws + WS_ROWSS2); float* RSTD2 = (float*)(F.ws + WS_RSTD2);
          for (int t = F.bid * NTHR + F.tid; t < T; t += F.G * NTHR) { float s = 0.f;
#pragma unroll
              for (int kk = 0; kk < 4; ++kk) { const f32x4 p4 = *(const f32x4*)(ROWSS + (size_t)t * 16 + 4 * kk); s += (p4.x + p4.y) + (p4.z + p4.w); }
              wt_st4(RSTD2 + t, rsqrtf(s * (1.f / 1024.f) + EPS)); } }
        if (F.bid & 1) { peer_topk_phase(F); peer_quant_phase(F); } else { peer_quant_phase(F); peer_topk_phase(F); }
    }
    SEAM(8);
    if (IN(9)) { peer_down_phase(F); }
    SEAM(9);
    if (IN(10)) { peer_combine_phase(F); }
    SEAM(10);
    if (IN(11)) { peer_up_phase(F, F.out); }
#undef IN
#undef SEAM
}
}

extern "C" void kernel_launch(void* const* d_in, const int* in_sizes, int n_in, void* d_out, int out_size, void* d_ws, size_t ws_size, hipStream_t stream) {
    using namespace mk;
    static int grid = 0;
    if (grid == 0) {
        int dev_ = 0, cus = 0, per_cu = 0;
        if (hipGetDevice(&dev_) != hipSuccess || hipDeviceGetAttribute(&cus, hipDeviceAttributeMultiprocessorCount, dev_) != hipSuccess) { fprintf(stderr, "device query failed\n"); grid = -1; return; }
        if (hipFuncSetAttribute((const void*)mega, hipFuncAttributeMaxDynamicSharedMemorySize, LDS_BYTES) != hipSuccess) { fprintf(stderr, "hipFuncSetAttribute failed\n"); grid = -1; return; }
        if (hipOccupancyMaxActiveBlocksPerMultiprocessor(&per_cu, (const void*)mega, NTHR, LDS_BYTES) != hipSuccess || per_cu < 1) { fprintf(stderr, "occupancy query: %d\n", per_cu); per_cu = 1; }
        (void)hipGetLastError();
        grid = cus * 1;
        fprintf(stderr, "mega: cus %d per_cu %d grid %d\n", cus, per_cu, grid);
    }
    if (grid < 0) return;
    (void)hipMemsetAsync((char*)d_ws + WS_CTL, 0, CTL_ZERO_BYTES, stream);
    Args a{};
    for (int i = 0; i < 18; ++i) a.in[i] = (const float*)d_in[i];
    a.out = (float*)d_out; a.ws = (unsigned char*)d_ws; a.ph_lo = 0; a.ph_hi = 12;
    void* kargs[] = {&a};
    hipError_t e = hipLaunchCooperativeKernel((const void*)mega, dim3(grid), dim3(NTHR), kargs, LDS_BYTES, stream);
    if (e != hipSuccess) fprintf(stderr, "cooperative launch failed: %s\n", hipGetErrorString(e));
}
```
